# Optimizing an MI355X kernel written in HIP

```python
import math
import jax
import jax.numpy as jnp
from jax import lax
import numpy as np

D_MODEL = 1024
BATCH = 8
SEQ = 2048
DEPTH = 2

N_EVEN = (DEPTH + 1) // 2
N_ODD = DEPTH // 2
HEAD_DIM = 64
A_HEADS = 4
A_MAPS = 2 * A_HEADS
A_V_DIM = 2 * HEAD_DIM
B_Q_HEADS = 8
B_KV_HEADS = 2
B_GROUP = B_Q_HEADS // B_KV_HEADS
A_Q_W = A_MAPS * HEAD_DIM
A_V_W = A_HEADS * A_V_DIM
B_Q_W = B_Q_HEADS * HEAD_DIM
B_KV_W = B_KV_HEADS * HEAD_DIM
IN_SPLITS = (A_Q_W, 2 * A_Q_W, 2 * A_Q_W + A_V_W, 2 * A_Q_W + A_V_W + B_Q_W, 2 * A_Q_W + A_V_W + B_Q_W + B_KV_W)
IN_W = 2 * A_Q_W + A_V_W + B_Q_W + 2 * B_KV_W
MIX_W = A_V_W + B_Q_W
Q_BLOCK = 128
GRID_W = 64
ROPE_AXIS_DIM = HEAD_DIM // 2
ROPE_THETA = 10000.0
REL_BUCKETS = 32
REL_MAX_DIST = 128
RWKV_HEAD = 64
RWKV_HEADS = D_MODEL // RWKV_HEAD
DECAY_LORA = 64
ICLR_LORA = 64
GATE_LORA = 128
GN_EPS = 64e-5
PEER_HEADS = 8
N_KEYS = 128
N_EXPERTS = N_KEYS * N_KEYS
PEER_TOPK = 16
D_KEY = 256
D_KEY_HALF = D_KEY // 2
TOKEN_BLOCK = 128
NORM_EPS = 1e-6

kernel_name = 'hybrid_diffattn_gqa_rwkv7_peer_encoder'


def rms_norm(x, g):
    xf = x.astype(jnp.float32)
    y = xf * lax.rsqrt(jnp.mean(xf * xf, axis=-1, keepdims=True) + NORM_EPS)
    return (y * g.astype(jnp.float32)).astype(x.dtype)


def t5_bucket(rel):
    nb = REL_BUCKETS // 2
    max_exact = nb // 2
    ret = jnp.where(rel > 0, nb, 0)
    n = jnp.abs(rel)
    nf = jnp.maximum(n, 1).astype(jnp.float32)
    large = max_exact + (jnp.log(nf / max_exact) / math.log(REL_MAX_DIST / max_exact) * (nb - max_exact)).astype(jnp.int32)
    large = jnp.minimum(large, nb - 1)
    return ret + jnp.where(n < max_exact, n, large)


def axial_angles(seq_len):
    rows = seq_len // GRID_W
    row = jnp.repeat(jnp.arange(rows), GRID_W).astype(jnp.float32)
    col = jnp.tile(jnp.arange(GRID_W), rows).astype(jnp.float32)
    inv = ROPE_THETA ** (-jnp.arange(0, ROPE_AXIS_DIM, 2, dtype=jnp.float32) / ROPE_AXIS_DIM)
    return row[:, None] * inv, col[:, None] * inv


def rot_half(x, ang):
    x1, x2 = jnp.split(x, 2, axis=-1)
    cos = jnp.cos(ang)[:, None, :]
    sin = jnp.sin(ang)[:, None, :]
    return jnp.concatenate([x1 * cos - x2 * sin, x2 * cos + x1 * sin], axis=-1)


def axial_rope(x, ang_row, ang_col):
    xf = x.astype(jnp.float32)
    out = jnp.concatenate([rot_half(xf[..., :ROPE_AXIS_DIM], ang_row), rot_half(xf[..., ROPE_AXIS_DIM:], ang_col)], axis=-1)
    return out.astype(x.dtype)


def hybrid_attention(h, w_in, qk_g, lam_vec, subln_g, w_out, rel_bias, lambda_init):
    B_, S_, _ = h.shape
    nb = S_ // Q_BLOCK
    scale = HEAD_DIM ** -0.5
    qa, ka, va, qb, kb, vb = jnp.split(h @ w_in, IN_SPLITS, axis=-1)
    qa = rms_norm(qa.reshape(B_, S_, A_MAPS, HEAD_DIM), qk_g[0])
    ka = rms_norm(ka.reshape(B_, S_, A_MAPS, HEAD_DIM), qk_g[1])
    va = va.reshape(B_, S_, A_HEADS, A_V_DIM)
    qb = rms_norm(qb.reshape(B_, S_, B_Q_HEADS, HEAD_DIM), qk_g[2])
    kb = rms_norm(kb.reshape(B_, S_, B_KV_HEADS, HEAD_DIM), qk_g[3])
    vb = vb.reshape(B_, S_, B_KV_HEADS, HEAD_DIM)
    ang_r, ang_c = axial_angles(S_)
    qb = axial_rope(qb, ang_r, ang_c)
    kb = axial_rope(kb, ang_r, ang_c)
    ka_t = ka.transpose(0, 2, 1, 3)
    va_t = va.transpose(0, 2, 1, 3)
    kb_t = kb.transpose(0, 2, 1, 3)
    vb_t = vb.transpose(0, 2, 1, 3)
    qa_blk = qa.reshape(B_, nb, Q_BLOCK, A_MAPS, HEAD_DIM).transpose(1, 0, 3, 2, 4)
    qb_blk = qb.reshape(B_, nb, Q_BLOCK, B_KV_HEADS, B_GROUP, HEAD_DIM).transpose(1, 0, 3, 4, 2, 5)
    lv = lam_vec.astype(jnp.float32)
    lam = jnp.exp(jnp.sum(lv[0] * lv[1])) - jnp.exp(jnp.sum(lv[2] * lv[3])) + lambda_init
    key_pos = jnp.arange(S_)

    def block(args):
        qa_i, qb_i, start = args
        qpos = start + jnp.arange(Q_BLOCK)
        bias = rel_bias[t5_bucket(key_pos[None, :] - qpos[:, None])]
        bias = bias.transpose(2, 0, 1).astype(jnp.float32)
        sa = jnp.einsum('bmqd,bmkd->bmqk', qa_i, ka_t).astype(jnp.float32) * scale + bias
        pa = jax.nn.softmax(sa, axis=-1).reshape(B_, A_HEADS, 2, Q_BLOCK, S_)
        diff = (pa[:, :, 0] - lam * pa[:, :, 1]).astype(va_t.dtype)
        oa = jnp.einsum('bhqk,bhkd->bhqd', diff, va_t)
        sb = jnp.einsum('bgrqd,bgkd->bgrqk', qb_i, kb_t).astype(jnp.float32) * scale
        pb = jax.nn.softmax(sb, axis=-1).astype(vb_t.dtype)
        ob = jnp.einsum('bgrqk,bgkd->bgrqd', pb, vb_t)
        return oa, ob

    oa, ob = lax.map(block, (qa_blk, qb_blk, jnp.arange(nb) * Q_BLOCK))
    oa = oa.transpose(1, 0, 3, 2, 4).reshape(B_, S_, A_HEADS, A_V_DIM)
    oa = (rms_norm(oa, subln_g) * (1.0 - lambda_init)).reshape(B_, S_, A_V_W)
    ob = ob.transpose(1, 0, 4, 2, 3, 5).reshape(B_, S_, B_Q_W)
    return jnp.concatenate([oa, ob], axis=-1) @ w_out


def token_shift_centred(x):
    prev = jnp.pad(x, ((0, 0), (1, 0), (0, 0)))[:, :-1]
    nxt = jnp.pad(x, ((0, 0), (0, 1), (0, 0)))[:, 1:]
    return 0.5 * (prev + nxt) - x


def wkv_scan(r, w, k, v, a_vec, b_vec, reverse):
    B_, S_, H_, N_ = r.shape
    xs = tuple(jnp.moveaxis(t, 1, 0) for t in (r, w, k, v, a_vec, b_vec))

    def step(state, inp):
        r_t, w_t, k_t, v_t, a_t, b_t = inp
        sa = jnp.einsum('bhvk,bhk->bhv', state, a_t)
        state = state * w_t[:, :, None, :] + sa[..., None] * b_t[:, :, None, :] + v_t[..., None] * k_t[:, :, None, :]
        return state, jnp.einsum('bhvk,bhk->bhv', state, r_t)

    s0 = jnp.zeros((B_, H_, N_, N_), jnp.float32)
    _, y = lax.scan(step, s0, xs, reverse=reverse)
    return jnp.moveaxis(y, 0, 1)


def rwkv7_bidir(h, mix, w_rkv, w0, w1, w2, a0, a1, a2, g1, g2, k_k, k_a, r_k, ln_g, ln_b, w_o):
    B_, S_, D_ = h.shape
    f32 = jnp.float32
    xx = token_shift_centred(h)
    xr, xw, xk, xv, xa, xg = (h + xx * mix[i] for i in range(6))
    r = xr @ w_rkv[0]
    k = xk @ w_rkv[1]
    v = xv @ w_rkv[2]
    g = jax.nn.sigmoid(xg @ g1) @ g2
    heads = lambda t: t.astype(f32).reshape(B_, S_, RWKV_HEADS, RWKV_HEAD)
    kk = heads(k * k_k)
    kk = kk / jnp.maximum(jnp.sqrt(jnp.sum(kk * kk, axis=-1, keepdims=True)), 1e-12)
    rf = heads(r)
    vf = heads(v)
    rk = r_k.astype(f32)
    ys = []
    bonuses = []
    for z in range(2):
        wlog = -jax.nn.softplus(-(w0[z] + jnp.tanh(xw @ w1[z]) @ w2[z]).astype(f32)) - 0.5
        decay = heads(jnp.exp(-jnp.exp(wlog)))
        a = jax.nn.sigmoid((a0[z] + (xa @ a1[z]) @ a2[z]).astype(f32))
        kz = heads(k.astype(f32) * (1.0 + (a - 1.0) * k_a.astype(f32)))
        az = heads(a)
        ys.append(wkv_scan(rf, decay, kz, vf, -kk, kk * az, reverse=(z == 1)))
        bonuses.append(jnp.sum(rf * kz * rk, axis=-1, keepdims=True) * vf)
    y = ys[0] + ys[1]
    mu = jnp.mean(y, axis=-1, keepdims=True)
    var = jnp.mean(jnp.square(y - mu), axis=-1, keepdims=True)
    yn = ((y - mu) * lax.rsqrt(var + GN_EPS)).reshape(B_, S_, D_) * ln_g.astype(f32) + ln_b.astype(f32)
    out = (yn + (bonuses[0] + bonuses[1]).reshape(B_, S_, D_)) * g.astype(f32)
    return out.astype(h.dtype) @ w_o


def peer(h, w_q, subkeys, u_tab, v_tab):
    B_, S_, D_ = h.shape
    T = B_ * S_
    ht = h.reshape(T, D_)
    q = (ht @ w_q).reshape(T, PEER_HEADS, 2, D_KEY_HALF)
    s = jnp.einsum('thpc,hpnc->thpn', q, subkeys).astype(jnp.float32)
    s_top, i_top = lax.top_k(s, PEER_TOPK)
    cand = s_top[:, :, 0, :, None] + s_top[:, :, 1, None, :]
    cidx = i_top[:, :, 0, :, None] * N_KEYS + i_top[:, :, 1, None, :]
    best, pos = lax.top_k(cand.reshape(T, PEER_HEADS, PEER_TOPK * PEER_TOPK), PEER_TOPK)
    eidx = jnp.take_along_axis(cidx.reshape(T, PEER_HEADS, PEER_TOPK * PEER_TOPK), pos, axis=-1)
    gate = jax.nn.softmax(best, axis=-1).astype(h.dtype)
    nblk = T // TOKEN_BLOCK

    def expert_block(args):
        xb, eb, gb = args
        u = jnp.take(u_tab, eb, axis=0)
        act = jax.nn.gelu(jnp.einsum('thkd,td->thk', u, xb))
        vv = jnp.take(v_tab, eb, axis=0)
        return jnp.einsum('thk,thkd->td', gb * act, vv)

    y = lax.map(expert_block, (ht.reshape(nblk, TOKEN_BLOCK, D_),
                               eidx.reshape(nblk, TOKEN_BLOCK, PEER_HEADS, PEER_TOPK),
                               gate.reshape(nblk, TOKEN_BLOCK, PEER_HEADS, PEER_TOPK)))
    return y.reshape(B_, S_, D_)


def setup_inputs(seed: int = 0) -> dict:
    key = jax.random.key(seed)
    ks = jax.random.split(key, 32)
    D = D_MODEL
    nrm = lambda k, shape, s: jax.random.normal(k, shape, jnp.float32) * s
    return {
        'x': nrm(ks[0], (BATCH, SEQ, D), 1.0),
        'c': nrm(ks[1], (BATCH, D), 1.0),
        'ada_w': nrm(ks[2], (DEPTH, D, 6 * D), 0.5 * D ** -0.5),
        'ada_b': nrm(ks[3], (DEPTH, 6 * D), 0.01),
        'norm_g': 1.0 + nrm(ks[4], (DEPTH, 2, D), 0.02),
        'attn_w_in': nrm(ks[5], (N_EVEN, D, IN_W), D ** -0.5),
        'attn_qk_g': 1.0 + nrm(ks[6], (N_EVEN, 4, HEAD_DIM), 0.02),
        'diff_lambda': nrm(ks[7], (N_EVEN, 4, HEAD_DIM), 0.1),
        'diff_subln_g': 1.0 + nrm(ks[8], (N_EVEN, A_V_DIM), 0.02),
        'attn_w_out': nrm(ks[9], (N_EVEN, MIX_W, D), MIX_W ** -0.5),
        'rel_bias': nrm(ks[10], (REL_BUCKETS, A_MAPS), 0.2),
        'rwkv_mix': jax.random.uniform(ks[11], (N_ODD, 6, D), jnp.float32),
        'rwkv_w_rkv': nrm(ks[12], (N_ODD, 3, D, D), D ** -0.5),
        'rwkv_w0': jax.random.uniform(ks[13], (N_ODD, 2, D), jnp.float32, -4.0, 0.0),
        'rwkv_w1': nrm(ks[14], (N_ODD, 2, D, DECAY_LORA), D ** -0.5),
        'rwkv_w2': nrm(ks[15], (N_ODD, 2, DECAY_LORA, D), 0.5 * DECAY_LORA ** -0.5),
        'rwkv_a0': nrm(ks[16], (N_ODD, 2, D), 0.1),
        'rwkv_a1': nrm(ks[17], (N_ODD, 2, D, ICLR_LORA), D ** -0.5),
        'rwkv_a2': nrm(ks[18], (N_ODD, 2, ICLR_LORA, D), 0.5 * ICLR_LORA ** -0.5),
        'rwkv_g1': nrm(ks[19], (N_ODD, D, GATE_LORA), D ** -0.5),
        'rwkv_g2': nrm(ks[20], (N_ODD, GATE_LORA, D), GATE_LORA ** -0.5),
        'rwkv_k_k': 0.85 + nrm(ks[21], (N_ODD, D), 0.02),
        'rwkv_k_a': 1.0 + nrm(ks[22], (N_ODD, D), 0.02),
        'rwkv_r_k': nrm(ks[23], (N_ODD, RWKV_HEADS, RWKV_HEAD), 0.1),
        'rwkv_ln_g': 1.0 + nrm(ks[24], (N_ODD, D), 0.02),
        'rwkv_ln_b': nrm(ks[25], (N_ODD, D), 0.01),
        'rwkv_w_o': nrm(ks[26], (N_ODD, D, D), D ** -0.5),
        'peer_w_q': nrm(ks[27], (DEPTH, D, PEER_HEADS * D_KEY), D ** -0.5),
        'peer_subkeys': nrm(ks[28], (DEPTH, PEER_HEADS, 2, N_KEYS, D_KEY_HALF), D_KEY_HALF ** -0.5),
        'peer_u': nrm(ks[29], (DEPTH, N_EXPERTS, D), D ** -0.5),
        'peer_v': nrm(ks[30], (DEPTH, N_EXPERTS, D), 0.5),
    }


def reference(x, c, ada_w, ada_b, norm_g, attn_w_in, attn_qk_g, diff_lambda, diff_subln_g, attn_w_out, rel_bias,
              rwkv_mix, rwkv_w_rkv, rwkv_w0, rwkv_w1, rwkv_w2, rwkv_a0, rwkv_a1, rwkv_a2, rwkv_g1, rwkv_g2,
              rwkv_k_k, rwkv_k_a, rwkv_r_k, rwkv_ln_g, rwkv_ln_b, rwkv_w_o,
              peer_w_q, peer_subkeys, peer_u, peer_v):
    cs = jax.nn.silu(c)
    for layer in range(DEPTH):
        mod = cs @ ada_w[layer] + ada_b[layer]
        sh1, sc1, gt1, sh2, sc2, gt2 = jnp.split(mod[:, None, :], 6, axis=-1)
        h = rms_norm(x, norm_g[layer, 0]) * (1.0 + sc1) + sh1
        j = layer // 2
        if layer % 2 == 0:
            lambda_init = 0.8 - 0.6 * math.exp(-0.3 * layer)
            y = hybrid_attention(h, attn_w_in[j], attn_qk_g[j], diff_lambda[j], diff_subln_g[j], attn_w_out[j], rel_bias, lambda_init)
        else:
            y = rwkv7_bidir(h, rwkv_mix[j], rwkv_w_rkv[j], rwkv_w0[j], rwkv_w1[j], rwkv_w2[j], rwkv_a0[j], rwkv_a1[j], rwkv_a2[j],
                            rwkv_g1[j], rwkv_g2[j], rwkv_k_k[j], rwkv_k_a[j], rwkv_r_k[j], rwkv_ln_g[j], rwkv_ln_b[j], rwkv_w_o[j])
        x = x + (gt1 * y).astype(x.dtype)
        h = rms_norm(x, norm_g[layer, 1]) * (1.0 + sc2) + sh2
        x = x + (gt2 * peer(h, peer_w_q[layer], peer_subkeys[layer], peer_u[layer], peer_v[layer])).astype(x.dtype)
    return x
```

```cpp
#include <hip/hip_runtime.h>
#include <cstdio>
#include <cstdint>

#define DI __device__ __forceinline__
#define LAS __attribute__((address_space(3)))
typedef unsigned short bf16_t;
typedef short bf16x8 __attribute__((ext_vector_type(8)));
typedef short s16x4 __attribute__((ext_vector_type(4)));
typedef float f32x2 __attribute__((ext_vector_type(2)));
typedef float f32x4 __attribute__((ext_vector_type(4)));
typedef float f32x16 __attribute__((ext_vector_type(16)));
typedef unsigned u32x2 __attribute__((ext_vector_type(2)));
typedef unsigned u32x4 __attribute__((ext_vector_type(4)));
typedef __bf16 bf16x2v __attribute__((ext_vector_type(2)));

DI unsigned pack_bf16(float lo, float hi) { bf16x2v p; p[0] = (__bf16)lo; p[1] = (__bf16)hi; return __builtin_bit_cast(unsigned, p); }
DI float bf_lo(unsigned u) { return __uint_as_float(u << 16); }
DI float bf_hi(unsigned u) { return __uint_as_float(u & 0xffff0000u); }
DI float bf1(bf16_t v) { return __uint_as_float(((unsigned)v) << 16); }
DI float wave_sum(float v) {
#pragma unroll
    for (int o = 32; o > 0; o >>= 1) v += __shfl_xor(v, o);
    return v;
}
DI float sigmoidf_(float x) { return 1.0f / (1.0f + __expf(-x)); }

constexpr int D = 1024, BATCH = 8, SEQ = 2048, T = BATCH * SEQ;
constexpr int IN_W = 2304;
constexpr int NTHREADS = 512, NWAVES = 8;
constexpr int PQ_LD = 2112;
constexpr int N_EXPERTS = 16384;
constexpr float LOG2E = 1.4426950408889634f;
constexpr float QSCALE = 0.125f * LOG2E;
constexpr size_t MiB = 1ull << 20;

constexpr size_t WS_CTL   = 0;
constexpr size_t CTL_ZERO_BYTES = 16384;
constexpr size_t WS_MOD   = 64 * 1024;
constexpr size_t WS_PSC   = 512 * 1024;
constexpr size_t WS_WIN_T = 1 * MiB;
constexpr size_t WS_WOUT_T= 6 * MiB;
constexpr size_t WS_WRW_T = 8 * MiB;
constexpr size_t WS_W2_T  = 22 * MiB;
constexpr size_t WS_SSQ   = 22 * MiB;
constexpr size_t WS_BQ    = 768 * 1024;
constexpr size_t WS_WO_T  = 27 * MiB;
constexpr size_t WS_WQ_T  = 29 * MiB;
constexpr size_t WS_SK    = 37 * MiB;
constexpr size_t WS_PU1   = 38 * MiB;
constexpr size_t WS_PV1   = 54 * MiB;
constexpr size_t WS_XB    = 70 * MiB;
constexpr size_t WS_PU0   = 102 * MiB;
constexpr size_t WS_PV0   = 134 * MiB;
constexpr size_t WS_ACT   = 166 * MiB;
constexpr size_t WS_H     = WS_ACT + 0 * MiB;
constexpr size_t WS_QKV   = WS_ACT + 32 * MiB;
constexpr size_t WS_QA    = WS_ACT + 104 * MiB;
constexpr size_t WS_KA    = WS_ACT + 120 * MiB;
constexpr size_t WS_VAT   = WS_ACT + 136 * MiB;
constexpr size_t WS_QB    = WS_ACT + 152 * MiB;
constexpr size_t WS_KB    = WS_ACT + 168 * MiB;
constexpr size_t WS_VBT   = WS_ACT + 172 * MiB;
constexpr size_t WS_O     = WS_ACT + 176 * MiB;
constexpr size_t WS_PQ    = WS_ACT + 208 * MiB;
constexpr size_t WS_EIDX  = WS_ACT + 276 * MiB;
constexpr size_t WS_GATE  = WS_ACT + 284 * MiB;
constexpr size_t WS_O0S   = WS_ACT + 292 * MiB;
constexpr size_t WS1_RK   = 102 * MiB;
constexpr size_t WS1_DEC  = 222 * MiB;
constexpr size_t WS1_AZ   = 350 * MiB;
constexpr size_t WS1_G    = 414 * MiB;
constexpr size_t WS1_Y    = 446 * MiB;
constexpr size_t WS1_BON  = 510 * MiB;
constexpr size_t WS1_X6   = 222 * MiB;
constexpr size_t WS1_A3   = 222 * MiB;
constexpr size_t WS1_H2   = 254 * MiB;
constexpr size_t WS1_PQ   = 286 * MiB;
constexpr size_t WS1_EIDX = 354 * MiB;
constexpr size_t WS1_GATE = 362 * MiB;
constexpr size_t WS_END   = 512 * MiB;
constexpr int RW_N = 3840, W2_N = 4096, W2_K = 512;
constexpr size_t WS_G2_T  = 26 * MiB;

constexpr int LDS_BYTES = 147456;
constexpr int LDS_BAR_OFF = 147456 - 64;
#define XB_TMO      128
#define XB_XCNT(j)  (256  + 64 * (j))
#define XB_XSUB(j)  (1280 + 64 * (j))
#define XB_XGEN(j)  (2304 + 64 * (j))
#define XB_TOP      3328
#define XB_TOPGEN   3392
#define XCD_BAR_WORDS 3456
#define XB_SPIN_CAP (1u << 18)

__device__ __forceinline__ unsigned xb_ld(unsigned* p)              { return __hip_atomic_load(p, __ATOMIC_RELAXED, __HIP_MEMORY_SCOPE_AGENT); }
__device__ __forceinline__ unsigned xb_add(unsigned* p, unsigned v) { return __hip_atomic_fetch_add(p, v, __ATOMIC_RELAXED, __HIP_MEMORY_SCOPE_AGENT); }
__device__ __forceinline__ unsigned xb_xcc_id() { return (unsigned)__builtin_amdgcn_s_getreg((3 << 11) | 20) & 0xFu; }
#define XB_SPIN(cond, bar) do { unsigned _sp = 0; while (cond) { __builtin_amdgcn_s_sleep(1); \
    if ((++_sp & 255u) == 0u) { if (xb_ld(&(bar)[XB_TMO])) break; if (_sp > XB_SPIN_CAP) { atomicAdd(&(bar)[XB_TMO], 1u); break; } } } } while (0)

struct XcdBarrier { unsigned* bar; unsigned x; volatile LAS unsigned* st; };

__device__ __forceinline__ XcdBarrier xcd_barrier_post(unsigned* bar, volatile LAS unsigned* st) {
    XcdBarrier b; b.bar = bar; b.x = xb_xcc_id(); b.st = st;
    if (threadIdx.x == 0) (void)xb_add(&bar[XB_XCNT(b.x)], 1u);
    return b;
}
__device__ __forceinline__ void xcd_barrier_complete(unsigned* bar, unsigned x, unsigned& nloc, unsigned& nx) {
    const unsigned G = gridDim.x * gridDim.y * gridDim.z;
    unsigned sum, cnt, mine, sp = 0u;
    for (;;) {
        sum = 0u; cnt = 0u; mine = 0u;
#pragma unroll
        for (unsigned j = 0; j < 16; ++j) { const unsigned c = xb_ld(&bar[XB_XCNT(j)]); sum += c; cnt += (c > 0u) ? 1u : 0u; mine = (j == x) ? c : mine; }
        if (sum == G) break;
        __builtin_amdgcn_s_sleep(1);
        if ((++sp & 255u) == 0u) { if (xb_ld(&bar[XB_TMO])) break; if (sp > XB_SPIN_CAP) { atomicAdd(&bar[XB_TMO], 1u); break; } }
    }
    nloc = mine > 0u ? mine : 1u; nx = cnt > 0u ? cnt : 1u;
}
__device__ __forceinline__ void xcd_barrier(const XcdBarrier& b) {
    asm volatile("s_waitcnt vmcnt(0)" ::: "memory");
    __syncthreads();
    if (threadIdx.x == 0) {
        unsigned* bar; { unsigned long long pv = (unsigned long long)b.bar; unsigned plo = (unsigned)pv, phi = (unsigned)(pv >> 32); asm volatile("" : "+s"(plo), "+s"(phi)); bar = (unsigned*)(__attribute__((address_space(1))) unsigned*)(((unsigned long long)phi << 32) | plo); }
        __builtin_amdgcn_s_waitcnt(0);
        unsigned nloc = b.st[0], nx = b.st[1];
        if (nloc == 0u) { xcd_barrier_complete(bar, b.x, nloc, nx); b.st[0] = nloc; b.st[1] = nx; }
        const unsigned old = xb_add(&bar[XB_XSUB(b.x)], 1u);
        const unsigned gen = old / nloc;
        if (old + 1u == (gen + 1u) * nloc) {
            __builtin_amdgcn_fence(__ATOMIC_RELEASE, "agent");
            asm volatile("s_waitcnt vmcnt(0)" ::: "memory");
            const unsigned og = xb_add(&bar[XB_TOP], 1u);
            const unsigned tg = og / nx;
            if (og + 1u == (tg + 1u) * nx) xb_add(&bar[XB_TOPGEN], 1u);
            else XB_SPIN(xb_ld(&bar[XB_TOPGEN]) == tg, bar);
            __builtin_amdgcn_fence(__ATOMIC_ACQUIRE, "agent");
            xb_add(&bar[XB_XGEN(b.x)], 1u);
            asm volatile("s_waitcnt vmcnt(0)" ::: "memory");
        } else {
            XB_SPIN(xb_ld(&bar[XB_XGEN(b.x)]) == gen, bar);
            __builtin_amdgcn_fence(__ATOMIC_ACQUIRE, "agent");
            asm volatile("s_waitcnt vmcnt(0)" ::: "memory");
        }
    }
    __syncthreads();
}
namespace pg8 {
constexpr int BM = 256, BK = 64, HALF = 128, HTB = HALF * BK * 2, STAGE_BYTES = 8 * HTB, NXCD = 8, WGM = 8;
__host__ __device__ __forceinline__ int lds_byte(int r, int c) { const int st = (r >> 4) * 2 + (c >> 5), rr = r & 15, cc = c & 31, ob = rr * 64 + cc * 2; return st * 1024 + (ob ^ (((ob >> 9) & 1) << 5)); }
__host__ __device__ __forceinline__ void stage_rc(int b, int& R, int& C) { const int st = b / 1024, sb = b % 1024, swz = sb ^ (((sb >> 9) & 1) << 5); R = (st >> 1) * 16 + swz / 64; C = (st & 1) * 32 + (swz % 64) / 2; }
__host__ __device__ __forceinline__ int perm32(int rho) { const int n = rho >> 4, i = rho & 15; return 8 * (i >> 2) + 4 * n + (i & 3); }

struct Unit { int pm, pn; };
struct Gemm { const bf16_t* A; const bf16_t* Bt; int M, N, K, lda, ldb; };

struct StaticOrder {
    int nM, nN, nwg, G, c;
    __device__ void init(int M, int N, int G_, int c_) { nM = M / BM; nN = N / BM; nwg = nM * nN; G = G_; c = c_; }
    __device__ __forceinline__ bool next(int i, Unit& u) const {
        const long L = (long)i * G + c; if (L >= nwg) return false;
        int wgid = (int)L; { const int q = nwg / NXCD, r = nwg % NXCD, xcd = wgid % NXCD, off = wgid / NXCD; wgid = (xcd < r ? xcd * (q + 1) : r * (q + 1) + (xcd - r) * q) + off; }
        const int nig = WGM * nN, gid = wgid / nig, fm = gid * WGM, gsz = (nM - fm) < WGM ? (nM - fm) : WGM;
        u.pm = fm + ((wgid % nig) % gsz); u.pn = (wgid % nig) / gsz; return true;
    }
};

struct BatchOrder {
    StaticOrder S;
    __device__ void init(int M, int N, int G_, int c_) { S.init(M, N, G_, c_); }
    __device__ __forceinline__ bool next(int i, Unit& u) const { if (!S.next(i, u)) return false; u.pn += (u.pm / (SEQ / BM)) * S.nN; return true; }
};

struct RwOrder {
    int G, c;
    __device__ void init(int G_, int c_) { G = G_; c = c_; }
    __device__ __forceinline__ bool next(int i, Unit& u) const {
        int grp, pm, pn;
        if ((G & 7) == 0) { const int x = c & 7, n = i * (G >> 3) + (c >> 3); if (n >= 120) return false;
            const int pmh = n / 15, e = n % 15; pm = x + 8 * pmh;
            if (e < 12) { grp = e >> 2; pn = grp * 4 + (e & 3); } else { grp = 3 + (e - 12); pn = 12 + (e - 12); } }
        else { const int L = i * G + c; if (L >= 960) return false;
            if (L < 768) { grp = L >> 8; pm = L & 63; pn = grp * 4 + ((L >> 6) & 3); } else { const int w = L - 768; grp = 3 + (w >> 6); pm = w & 63; pn = 12 + (grp - 3); } }
        u.pm = grp * 64 + pm; u.pn = pn; return true;
    }
};
template <class Epi, class Sched>
__device__ __forceinline__ void gemm_phase(LAS unsigned char* lds, const Gemm g, const Sched& S, const Epi& E) {
    const int tid = threadIdx.x, wid = __builtin_amdgcn_readfirstlane(tid >> 6), lane = tid & 63, wr = wid >> 2, wc = wid & 3, fr = lane & 15, fq = lane >> 4;
    const int K = g.K, nt = K / BK;
    unsigned voffA[2], voffB[2];
#pragma unroll
    for (int i = 0; i < 2; ++i) { int R, C; stage_rc(tid * 16 + i * 8192, R, C); const int Rb = Epi::PERM ? ((R & ~31) + perm32(R & 31)) : R;
        voffA[i] = (unsigned)(R * g.lda + C) * 2u; voffB[i] = (unsigned)(Rb * g.ldb + C) * 2u; }
    const size_t kstep = (size_t)(BK * 2);
    const size_t hstepA = (size_t)HALF * g.lda * 2, hstepB = (size_t)HALF * g.ldb * 2;
    const size_t tstepA = 2 * hstepA, tstepB = 2 * hstepB;
    const unsigned ldsw = (unsigned)wid * 1024u;
    const int aoff = lds_byte(wr * 64 + fr, fq * 8), boff = lds_byte(wc * 32 + fr, fq * 8);
#define PG8_SA(b, h) (((b) * 2 + (h)) * HTB)
#define PG8_SB(b, h) ((4 + (b) * 2 + (h)) * HTB)
#define PG8_STAGE(bufoff, gbase, voff) do { _Pragma("unroll") for (int _i = 0; _i < 2; ++_i) \
        __builtin_amdgcn_global_load_lds((const unsigned*)((const char*)(gbase) + (voff)[_i]), (LAS unsigned*)(lds + (bufoff) + ldsw + _i * 8192), 16, 0, 0); } while (0)
#define PG8_LDA(dst, b, h) do { _Pragma("unroll") for (int m = 0; m < 4; ++m) _Pragma("unroll") for (int k = 0; k < 2; ++k) dst[m][k] = *(const LAS bf16x8*)(lds + PG8_SA(b, h) + aoff + m * 2048 + k * 1024); } while (0)
#define PG8_LDB(dst, b, h) do { _Pragma("unroll") for (int n = 0; n < 2; ++n) _Pragma("unroll") for (int k = 0; k < 2; ++k) dst[n][k] = *(const LAS bf16x8*)(lds + PG8_SB(b, h) + boff + n * 2048 + k * 1024); } while (0)
#define PG8_MMA(ai, bj, At, Bt) do { __builtin_amdgcn_s_setprio(1); _Pragma("unroll") for (int m = 0; m < 4; ++m) _Pragma("unroll") for (int n = 0; n < 2; ++n) _Pragma("unroll") for (int k = 0; k < 2; ++k) \
        acc[ai][bj][m][n] = __builtin_amdgcn_mfma_f32_16x16x32_bf16(Bt[n][k], At[m][k], acc[ai][bj][m][n], 0, 0, 0); __builtin_amdgcn_s_setprio(0); } while (0)
#define PG8_WAIT_V(n) asm volatile("s_waitcnt vmcnt(" #n ")" ::: "memory")
#define PG8_WAIT_L(n) asm volatile("s_waitcnt lgkmcnt(" #n ")" ::: "memory")
#define PG8_BAR __builtin_amdgcn_s_barrier()
#define PG8_SCHED __builtin_amdgcn_sched_barrier(0)
    Unit cur, nxt; int ui = 0;
    if (!S.next(0, cur)) return;
    f32x4 acc[2][2][4][2];
#pragma unroll
    for (int a = 0; a < 2; ++a)
#pragma unroll
        for (int b = 0; b < 2; ++b)
#pragma unroll
            for (int m = 0; m < 4; ++m)
#pragma unroll
                for (int n = 0; n < 2; ++n) acc[a][b][m][n] = (f32x4){0.f, 0.f, 0.f, 0.f};
    bf16x8 At[4][2], B0[2][2], B1[2][2];
    const char* cA = (const char*)g.A + (size_t)cur.pm * tstepA; const char* cB = (const char*)g.Bt + (size_t)cur.pn * tstepB;
    PG8_STAGE(PG8_SB(0, 0), cB, voffB); PG8_STAGE(PG8_SA(0, 0), cA, voffA); PG8_STAGE(PG8_SB(0, 1), cB + hstepB, voffB); PG8_STAGE(PG8_SA(0, 1), cA + hstepA, voffA);
    if (wr == 1) PG8_BAR;
    PG8_WAIT_V(4); PG8_BAR;
    PG8_STAGE(PG8_SB(1, 0), cB + kstep, voffB); PG8_STAGE(PG8_SA(1, 0), cA + kstep, voffA); PG8_STAGE(PG8_SB(1, 1), cB + hstepB + kstep, voffB);
    PG8_WAIT_V(6); PG8_BAR;
    for (;;) {
        const bool has_next = S.next(ui + 1, nxt);
        const char* nA = has_next ? (const char*)g.A + (size_t)nxt.pm * tstepA : cA; const char* nB = has_next ? (const char*)g.Bt + (size_t)nxt.pn * tstepB : cB;
        for (int t = 0; t < nt; t += 2) {
            const bool last = (t == nt - 2);
            const char* a1 = cA + (size_t)(t + 1) * kstep;
            const char* a2 = last ? nA : cA + (size_t)(t + 2) * kstep; const char* b2 = last ? nB : cB + (size_t)(t + 2) * kstep;
            const char* a3 = a2 + kstep; const char* b3 = b2 + kstep;
            PG8_LDB(B0, 0, 0); PG8_SCHED; PG8_LDA(At, 0, 0); PG8_STAGE(PG8_SA(1, 1), a1 + hstepA, voffA);
            PG8_WAIT_L(8); PG8_BAR; PG8_WAIT_L(0); PG8_MMA(0, 0, At, B0); PG8_BAR; PG8_SCHED;
            PG8_LDB(B1, 0, 1); PG8_STAGE(PG8_SB(0, 0), b2, voffB);
            PG8_BAR; PG8_WAIT_L(0); PG8_MMA(0, 1, At, B1); PG8_BAR;
            PG8_LDA(At, 0, 1); PG8_STAGE(PG8_SA(0, 0), a2, voffA);
            PG8_BAR; PG8_WAIT_L(0); PG8_MMA(1, 0, At, B0); PG8_BAR; PG8_SCHED;
            PG8_STAGE(PG8_SB(0, 1), b2 + hstepB, voffB);
            PG8_WAIT_V(6); PG8_BAR; PG8_MMA(1, 1, At, B1); PG8_BAR;
            PG8_LDB(B0, 1, 0); PG8_SCHED; PG8_LDA(At, 1, 0); PG8_STAGE(PG8_SA(0, 1), a2 + hstepA, voffA);
            PG8_WAIT_L(8); PG8_BAR; PG8_WAIT_L(0); PG8_MMA(0, 0, At, B0); PG8_BAR; PG8_SCHED;
            PG8_LDB(B1, 1, 1); PG8_STAGE(PG8_SB(1, 0), b3, voffB);
            PG8_BAR; PG8_WAIT_L(0); PG8_MMA(0, 1, At, B1); PG8_BAR;
            PG8_LDA(At, 1, 1); PG8_STAGE(PG8_SA(1, 0), a3, voffA);
            PG8_BAR; PG8_WAIT_L(0); PG8_MMA(1, 0, At, B0); PG8_BAR; PG8_SCHED;
            PG8_STAGE(PG8_SB(1, 1), b3 + hstepB, voffB);
            PG8_WAIT_V(6); PG8_BAR; PG8_MMA(1, 1, At, B1); PG8_BAR;
        }
        E(acc, cur, wr, wc, fr, fq);
        if (!has_next) break;
#pragma unroll
        for (int a = 0; a < 2; ++a)
#pragma unroll
            for (int b = 0; b < 2; ++b)
#pragma unroll
                for (int m = 0; m < 4; ++m)
#pragma unroll
                    for (int n = 0; n < 2; ++n) acc[a][b][m][n] = (f32x4){0.f, 0.f, 0.f, 0.f};
        cur = nxt; cA = nA; cB = nB; ++ui;
    }
    PG8_WAIT_V(0);
    if (wr == 0) PG8_BAR;
    PG8_BAR;
#undef PG8_SA
#undef PG8_SB
#undef PG8_STAGE
#undef PG8_LDA
#undef PG8_LDB
#undef PG8_MMA
#undef PG8_WAIT_V
#undef PG8_WAIT_L
#undef PG8_BAR
#undef PG8_SCHED
}

template <int ACT> struct EpiBf16 {
    static constexpr bool PERM = true;
    __device__ __forceinline__ void prefetch(LAS unsigned char*, const Unit&, int) const {}
    bf16_t* O; int ldc;
    __device__ __forceinline__ void operator()(const f32x4 (&acc)[2][2][4][2], const Unit& u, int wr, int wc, int fr, int fq) const {
        const int row0 = (ACT == 1 ? (u.pm & 63) : u.pm) * BM + wr * 64 + fr; const int col0 = u.pn * BM + wc * 32 + 8 * fq;
#pragma unroll
        for (int ai = 0; ai < 2; ++ai)
#pragma unroll
            for (int m = 0; m < 4; ++m) { bf16_t* rowp = O + (size_t)(row0 + ai * HALF + m * 16) * ldc + col0;
#pragma unroll
                for (int bj = 0; bj < 2; ++bj) { f32x4 v0 = acc[ai][bj][m][0], v1 = acc[ai][bj][m][1];
                    if (ACT == 1) { const int c = col0 + bj * HALF;
                        if (c >= 3072 && c < 3200) {
#pragma unroll
                            for (int e = 0; e < 4; ++e) { v0[e] = tanhf(v0[e]); v1[e] = tanhf(v1[e]); } }
                        else if (c >= 3584 && c < 3712) {
#pragma unroll
                            for (int e = 0; e < 4; ++e) { v0[e] = sigmoidf_(v0[e]); v1[e] = sigmoidf_(v1[e]); } } }
                    u32x4 w; w.x = pack_bf16(v0[0], v0[1]); w.y = pack_bf16(v0[2], v0[3]); w.z = pack_bf16(v1[0], v1[1]); w.w = pack_bf16(v1[2], v1[3]);
                    *(u32x4*)(rowp + bj * HALF) = w; } }
    }
};
template <bool IN_BF16> struct EpiResid {
    static constexpr bool PERM = false;
    __device__ __forceinline__ void prefetch(LAS unsigned char* lds, const Unit& u, int tid) const {
        constexpr int RB = IN_BF16 ? 512 : 1024, LPR = RB / 128, NL = 256 * LPR;
        const char* base = (const char*)xin + ((size_t)u.pm * BM * D + (size_t)u.pn * BM) * (IN_BF16 ? 2 : 4);
#pragma unroll
        for (int i = 0; i < NL / NTHREADS; ++i) { const int ln = i * NTHREADS + tid, r = ln / LPR, c = ln % LPR;
            __builtin_amdgcn_global_load_lds((const unsigned*)(base + (size_t)r * D * (IN_BF16 ? 2 : 4) + c * 128), (LAS unsigned*)(lds + STAGE_BYTES + 2048 + (tid >> 6) * 256), 4, 0, 0); }
    }
    const void* xin; bf16_t* out; const float* gate; float* ssq;
    __device__ __forceinline__ void operator()(const f32x4 (&acc)[2][2][4][2], const Unit& u, int wr, int wc, int fr, int fq) const {
        const int row0 = u.pm * BM + wr * 64 + fr, col0 = u.pn * BM + wc * 32 + 4 * fq;
        const float* gp = gate + (size_t)((u.pm * BM) / SEQ) * 6144 + col0;
        f32x4 gv[2][2];
#pragma unroll
        for (int bj = 0; bj < 2; ++bj)
#pragma unroll
            for (int n = 0; n < 2; ++n) gv[bj][n] = *(const f32x4*)(gp + bj * HALF + n * 16);
#pragma unroll
        for (int ai = 0; ai < 2; ++ai)
#pragma unroll
            for (int m = 0; m < 4; ++m) { const size_t off = (size_t)(row0 + ai * HALF + m * 16) * D + col0; float ss = 0.f;
#pragma unroll
                for (int bj = 0; bj < 2; ++bj)
#pragma unroll
                    for (int n = 0; n < 2; ++n) { f32x4 xv;
                        if (IN_BF16) { const u32x2 w = *(const u32x2*)((const bf16_t*)xin + off + bj * HALF + n * 16); xv = (f32x4){bf_lo(w.x), bf_hi(w.x), bf_lo(w.y), bf_hi(w.y)}; }
                        else xv = *(const f32x4*)((const float*)xin + off + bj * HALF + n * 16);
                        const f32x4 r = xv + gv[bj][n] * acc[ai][bj][m][n];
                        ss += (r[0] * r[0] + r[1] * r[1]) + (r[2] * r[2] + r[3] * r[3]);
                        *(u32x2*)(out + off + bj * HALF + n * 16) = (u32x2){pack_bf16(r[0], r[1]), pack_bf16(r[2], r[3])}; }
                ss += __shfl_xor(ss, 16); ss += __shfl_xor(ss, 32);
                if (fq == 0) ssq[(size_t)(row0 + ai * HALF + m * 16) * 16 + u.pn * 4 + wc] = ss; }
    }
};
struct EpiQ {
    static constexpr bool PERM = true;
    __device__ __forceinline__ void prefetch(LAS unsigned char*, const Unit&, int) const {}
    bf16_t* O; int ldc; const float* ssq; const float* bq; const LAS float* rl; int pm_l;
    __device__ __forceinline__ void prep(LAS unsigned char* lds, int pm, int tid) { LAS float* w = (LAS float*)(lds + STAGE_BYTES); rl = w; pm_l = pm;
        if (pm >= 0 && tid < BM) { const f32x4* sp = (const f32x4*)(ssq + (size_t)(pm * BM + tid) * 16); const f32x4 s4 = (sp[0] + sp[1]) + (sp[2] + sp[3]);
            w[tid] = rsqrtf(((s4[0] + s4[1]) + (s4[2] + s4[3])) * (1.0f / 1024.0f) + 1e-6f); }
        __syncthreads(); }
    __device__ __forceinline__ void operator()(const f32x4 (&acc)[2][2][4][2], const Unit& u, int wr, int wc, int fr, int fq) const {
        const int row0 = u.pm * BM + wr * 64 + fr; const int col0 = (u.pn & 7) * BM + wc * 32 + 8 * fq;
        const float* bp = bq + (size_t)(u.pn >> 3) * 2048 + col0;
        f32x4 b0[2], b1[2];
#pragma unroll
        for (int bj = 0; bj < 2; ++bj) { b0[bj] = *(const f32x4*)(bp + bj * HALF); b1[bj] = *(const f32x4*)(bp + bj * HALF + 4); }
#pragma unroll
        for (int ai = 0; ai < 2; ++ai)
#pragma unroll
            for (int m = 0; m < 4; ++m) { const int r = row0 + ai * HALF + m * 16; bf16_t* rowp = O + (size_t)r * ldc + col0;
                float rinv;
                if (u.pm == pm_l) rinv = rl[wr * 64 + fr + ai * HALF + m * 16];
                else { const f32x4* sp = (const f32x4*)(ssq + (size_t)r * 16); const f32x4 s4 = (sp[0] + sp[1]) + (sp[2] + sp[3]);
                    rinv = rsqrtf(((s4[0] + s4[1]) + (s4[2] + s4[3])) * (1.0f / 1024.0f) + 1e-6f); }
#pragma unroll
                for (int bj = 0; bj < 2; ++bj) { const f32x4 v0 = acc[ai][bj][m][0] * rinv + b0[bj], v1 = acc[ai][bj][m][1] * rinv + b1[bj];
                    u32x4 w; w.x = pack_bf16(v0[0], v0[1]); w.y = pack_bf16(v0[2], v0[3]); w.z = pack_bf16(v1[0], v1[1]); w.w = pack_bf16(v1[2], v1[3]);
                    *(u32x4*)(rowp + bj * HALF) = w; } }
    }
};
struct EpiRw2 {
    static constexpr bool PERM = true;
    __device__ __forceinline__ void prefetch(LAS unsigned char*, const Unit&, int) const {}
    float* DEC; bf16_t* AZ; bf16_t* G; const float* w0; const float* a0;
    __device__ __forceinline__ void operator()(const f32x4 (&acc)[2][2][4][2], const Unit& u, int wr, int wc, int fr, int fq) const {
        const int row0 = u.pm * BM + wr * 64 + fr; const int col0 = u.pn * BM + wc * 32 + 8 * fq;
        const int cls = u.pn < 8 ? 0 : 1;
#pragma unroll
        for (int bj = 0; bj < 2; ++bj) {
            const int c = col0 + bj * HALF;
            f32x4 b0 = (f32x4){0.f, 0.f, 0.f, 0.f}, b1 = b0;
            if (cls == 0) { b0 = *(const f32x4*)(w0 + c); b1 = *(const f32x4*)(w0 + c + 4); }
            else if (cls == 1) { b0 = *(const f32x4*)(a0 + c - 2048); b1 = *(const f32x4*)(a0 + c - 2048 + 4); }
#pragma unroll
            for (int ai = 0; ai < 2; ++ai)
#pragma unroll
                for (int m = 0; m < 4; ++m) { const size_t r = (size_t)(row0 + ai * HALF + m * 16);
                    f32x4 v0 = acc[ai][bj][m][0] + b0, v1 = acc[ai][bj][m][1] + b1;
                    if (cls == 0) {
#pragma unroll
                        for (int e = 0; e < 4; ++e) { v0[e] = __expf(-0.6065306597126334f * sigmoidf_(v0[e])); v1[e] = __expf(-0.6065306597126334f * sigmoidf_(v1[e])); }
                        *(f32x4*)(DEC + r * 2048 + c) = v0; *(f32x4*)(DEC + r * 2048 + c + 4) = v1;
                    } else {
                        if (cls == 1) {
#pragma unroll
                            for (int e = 0; e < 4; ++e) { v0[e] = sigmoidf_(v0[e]); v1[e] = sigmoidf_(v1[e]); } }
                        u32x4 w; w.x = pack_bf16(v0[0], v0[1]); w.y = pack_bf16(v0[2], v0[3]); w.z = pack_bf16(v1[0], v1[1]); w.w = pack_bf16(v1[2], v1[3]);
                        if (cls == 1) *(u32x4*)(AZ + r * 2048 + (c - 2048)) = w; else *(u32x4*)(G + r * 1024 + (c - 4096)) = w;
                    } }
        }
    }
};
}
struct Params { const float* in[31]; float* out; unsigned char* ws; int ph_lo, ph_hi; };
struct Frame {
    LAS unsigned char* lds; int tid, lane, wave, G, bid;
    const float* const* in; float* out; unsigned char* ws;
};

DI void fp8_row_store(const float (&v)[16], int row, int lane, unsigned char* dst, float* scale);
DI void fp8_row_load(const float* src, int row, int lane, float (&v)[16]);
DI void p0_convert_fp8(const Frame& F, const float* src, unsigned char* dst, float* scale, int widx, int nw);
template <bool SPLIT> DI void p0_mod(const Frame& F) {
    constexpr int NKG = SPLIT ? 21 : 42, NB = SPLIT ? 4 : 2, NTH = NKG * 12;
    const float* c = F.in[1]; const float* ada_w = F.in[2]; const float* ada_b = F.in[3];
    float* mod = (float*)(F.ws + WS_MOD);
    LAS float* sc = (LAS float*)F.lds;
    LAS float* part = (LAS float*)(F.lds + 32768);
    for (int i = F.tid; i < 8 * 1024; i += NTHREADS) { const int b = i >> 10, k = i & 1023; const float v = c[i]; sc[k * 8 + b] = v * sigmoidf_(v); }
    __syncthreads();
    for (int cb = F.bid; cb < 256; cb += F.G) {
        const int colbase = cb * 48, l = colbase / 6144, n0 = colbase % 6144;
        if (F.tid < NTH) {
            const int q = F.tid % 12, kg = F.tid / 12, krot = (cb * 148) & 1023;
            const float* wp = ada_w + (size_t)l * 1024 * 6144 + n0 + 4 * q;
            f32x4 acc[8];
#pragma unroll
            for (int b = 0; b < 8; ++b) acc[b] = (f32x4){0.f, 0.f, 0.f, 0.f};
#pragma unroll
            for (int bt = 0; bt < NB; ++bt) {
                f32x4 w[13];
#pragma unroll
                for (int i = 0; i < 13; ++i) { const int k = kg + NKG * (13 * bt + i), kk = ((k < 1024 ? k : 1023) + krot) & 1023; w[i] = *(const f32x4*)(wp + (size_t)kk * 6144); }
#pragma unroll
                for (int i = 0; i < 13; ++i) { const int k = kg + NKG * (13 * bt + i), kk = ((k < 1024 ? k : 1023) + krot) & 1023;
                    const f32x4 wv = k < 1024 ? w[i] : (f32x4){0.f, 0.f, 0.f, 0.f};
                    const f32x4 s0 = *(const LAS f32x4*)(sc + kk * 8), s1 = *(const LAS f32x4*)(sc + kk * 8 + 4);
                    acc[0] += wv * s0[0]; acc[1] += wv * s0[1]; acc[2] += wv * s0[2]; acc[3] += wv * s0[3];
                    acc[4] += wv * s1[0]; acc[5] += wv * s1[1]; acc[6] += wv * s1[2]; acc[7] += wv * s1[3]; }
            }
#pragma unroll
            for (int e = 0; e < 4; ++e) { LAS float* pp = part + ((size_t)kg * 48 + 4 * q + e) * 8;
                *(LAS f32x4*)pp = (f32x4){acc[0][e], acc[1][e], acc[2][e], acc[3][e]}; *(LAS f32x4*)(pp + 4) = (f32x4){acc[4][e], acc[5][e], acc[6][e], acc[7][e]}; }
        } else if (SPLIT && F.wave >= 4) {
            p0_convert_fp8(F, F.in[29], F.ws + WS_PU0, (float*)(F.ws + WS_PSC), F.bid * 4 + (F.wave - 4), F.G * 4);
        }
        __syncthreads();
        if (F.tid < 256) for (int o = F.tid; o < 384; o += 256) {
            const int cl = o >> 3, b = o & 7; const int col = colbase + cl;
            float s = ada_b[col];
#pragma unroll
            for (int kg = 0; kg < NKG; ++kg) s += part[(kg * 48 + cl) * 8 + b];
            mod[((size_t)l * 8 + b) * 6144 + n0 + cl] = s;
        }
        __syncthreads();
    }
}
DI void p0_transpose(const Frame& F, const float* src, int ld, int K, int N, bf16_t* dst, int ldd, const float* mix) {
    (void)mix;
    LAS float* tiles = (LAS float*)F.lds;
    const int tn = N / 64, nt = (K / 64) * tn;
    for (int t0 = F.bid; t0 < nt; t0 += 4 * F.G) {
        __syncthreads();
        f32x4 v[4][2];
#pragma unroll
        for (int q = 0; q < 4; ++q) { const int tt = t0 + q * F.G, t = tt < nt ? tt : t0; const int k0 = (t / tn) * 64, n0 = (t % tn) * 64;
#pragma unroll
            for (int h = 0; h < 2; ++h) { const int i = F.tid + h * NTHREADS, r = i >> 4, c4 = (i & 15) * 4; v[q][h] = *(const f32x4*)(src + (size_t)(k0 + r) * ld + n0 + c4); } }
#pragma unroll
        for (int q = 0; q < 4; ++q)
#pragma unroll
            for (int h = 0; h < 2; ++h) { const int i = F.tid + h * NTHREADS, r = i >> 4, c4 = (i & 15) * 4; LAS float* tp = tiles + q * 4160 + r * 65 + c4;
                tp[0] = v[q][h][0]; tp[1] = v[q][h][1]; tp[2] = v[q][h][2]; tp[3] = v[q][h][3]; }
        __syncthreads();
#pragma unroll
        for (int q = 0; q < 4; ++q) { const int t = t0 + q * F.G; if (t < nt) { const int k0 = (t / tn) * 64, n0 = (t % tn) * 64;
            const int n = F.tid >> 3, kc = (F.tid & 7) * 8;
            float w8[8];
#pragma unroll
            for (int e = 0; e < 8; ++e) w8[e] = tiles[q * 4160 + (kc + e) * 65 + n];
            u32x4 w; w.x = pack_bf16(w8[0], w8[1]); w.y = pack_bf16(w8[2], w8[3]); w.z = pack_bf16(w8[4], w8[5]); w.w = pack_bf16(w8[6], w8[7]);
            *(u32x4*)(dst + (size_t)(n0 + n) * ldd + k0 + kc) = w; } }
    }
    __syncthreads();
}
DI void p0_wqs(const Frame& F, const float* W, const float* g, const float* modl, bf16_t* dst) {
    LAS float* tiles = (LAS float*)F.lds;
    LAS float* gsl = (LAS float*)(F.lds + 69632);
    const int nt = 16 * 32;
    if (F.bid >= nt) return;
    __syncthreads();
    for (int i = F.tid; i < 8 * 1024; i += NTHREADS) gsl[i] = g[i & 1023] * (1.0f + modl[(size_t)(i >> 10) * 6144 + 4096 + (i & 1023)]);
    for (int t0 = F.bid; t0 < nt; t0 += 4 * F.G) {
        __syncthreads();
        f32x4 v[4][2];
#pragma unroll
        for (int q = 0; q < 4; ++q) { const int tt = t0 + q * F.G, t = tt < nt ? tt : t0; const int k0 = (t / 32) * 64, n0 = (t % 32) * 64;
#pragma unroll
            for (int h = 0; h < 2; ++h) { const int i = F.tid + h * NTHREADS, r = i >> 4, c4 = (i & 15) * 4; v[q][h] = *(const f32x4*)(W + (size_t)(k0 + r) * 2048 + n0 + c4); } }
#pragma unroll
        for (int q = 0; q < 4; ++q)
#pragma unroll
            for (int h = 0; h < 2; ++h) { const int i = F.tid + h * NTHREADS, r = i >> 4, c4 = (i & 15) * 4; LAS float* tp = tiles + q * 4160 + r * 65 + c4;
                tp[0] = v[q][h][0]; tp[1] = v[q][h][1]; tp[2] = v[q][h][2]; tp[3] = v[q][h][3]; }
        __syncthreads();
        for (int q = 0; q < 4; ++q) { const int t = t0 + q * F.G; if (t < nt) { const int k0 = (t / 32) * 64, n0 = (t % 32) * 64;
            const int n = F.tid >> 3, kc = (F.tid & 7) * 8;
            float w8[8];
#pragma unroll
            for (int e = 0; e < 8; ++e) w8[e] = tiles[q * 4160 + (kc + e) * 65 + n];
#pragma unroll
            for (int b = 0; b < 8; ++b) { const f32x4 s0 = *(const LAS f32x4*)(gsl + b * 1024 + k0 + kc), s1 = *(const LAS f32x4*)(gsl + b * 1024 + k0 + kc + 4);
                u32x4 w; w.x = pack_bf16(w8[0] * s0[0], w8[1] * s0[1]); w.y = pack_bf16(w8[2] * s0[2], w8[3] * s0[3]);
                w.z = pack_bf16(w8[4] * s1[0], w8[5] * s1[1]); w.w = pack_bf16(w8[6] * s1[2], w8[7] * s1[3]);
                *(u32x4*)(dst + ((size_t)b * 2048 + n0 + n) * 1024 + k0 + kc) = w; } } }
    }
    __syncthreads();
}
DI void p0_bq(const Frame& F, const float* W, const float* modl, float* bq) {
    LAS float* shl = (LAS float*)F.lds;
    LAS float* part = (LAS float*)(F.lds + 32768);
    if (F.bid >= 128) return;
    __syncthreads();
    for (int i = F.tid; i < 8 * 1024; i += NTHREADS) { const int b = i >> 10, k = i & 1023; shl[k * 8 + b] = modl[(size_t)b * 6144 + 3072 + k]; }
    __syncthreads();
    for (int task = F.bid; task < 128; task += F.G) {
        const int cl = F.tid & 15, kp = F.tid >> 4; const float* wp = W + (size_t)(kp * 32) * 2048 + task * 16 + cl;
        float wv[32];
#pragma unroll
        for (int k = 0; k < 32; ++k) wv[k] = wp[(size_t)k * 2048];
        float a[8];
#pragma unroll
        for (int b = 0; b < 8; ++b) a[b] = 0.f;
#pragma unroll
        for (int k = 0; k < 32; ++k) { const float w = wv[k];
            const f32x4 s0 = *(const LAS f32x4*)(shl + (kp * 32 + k) * 8), s1 = *(const LAS f32x4*)(shl + (kp * 32 + k) * 8 + 4);
            a[0] += w * s0[0]; a[1] += w * s0[1]; a[2] += w * s0[2]; a[3] += w * s0[3]; a[4] += w * s1[0]; a[5] += w * s1[1]; a[6] += w * s1[2]; a[7] += w * s1[3]; }
#pragma unroll
        for (int b = 0; b < 8; ++b) part[(kp * 16 + cl) * 8 + b] = a[b];
        __syncthreads();
        if (F.tid < 128) { const int c2 = F.tid >> 3, b = F.tid & 7; float s = 0.f;
#pragma unroll
            for (int q = 0; q < 32; ++q) s += part[(q * 16 + c2) * 8 + b];
            bq[(size_t)b * 2048 + task * 16 + c2] = s; }
        __syncthreads();
    }
}
DI void p0_convert(const Frame& F, const float* src, bf16_t* dst, size_t n) {
    const size_t n8 = n / 8;
    for (size_t i = (size_t)F.bid * NTHREADS + F.tid; i < n8; i += (size_t)F.G * NTHREADS) {
        const f32x4 a = *(const f32x4*)(src + i * 8), b = *(const f32x4*)(src + i * 8 + 4);
        u32x4 w; w.x = pack_bf16(a[0], a[1]); w.y = pack_bf16(a[2], a[3]); w.z = pack_bf16(b[0], b[1]); w.w = pack_bf16(b[2], b[3]);
        *(u32x4*)(dst + i * 8) = w;
    }
}
DI void fp8_row_store(const float (&v)[16], int row, int lane, unsigned char* dst, float* scale) {
    float am = 0.f;
#pragma unroll
    for (int e = 0; e < 16; ++e) am = fmaxf(am, fabsf(v[e]));
#pragma unroll
    for (int o = 32; o > 0; o >>= 1) am = fmaxf(am, __shfl_xor(am, o));
    const float sc = am > 0.f ? am * (1.0f / 384.0f) : 1.0f, inv = 1.0f / sc;
    u32x4 w;
    { int t0 = 0; t0 = __builtin_amdgcn_cvt_pk_fp8_f32(v[0] * inv, v[1] * inv, t0, false); t0 = __builtin_amdgcn_cvt_pk_fp8_f32(v[2] * inv, v[3] * inv, t0, true); w.x = (unsigned)t0; }
    { int t0 = 0; t0 = __builtin_amdgcn_cvt_pk_fp8_f32(v[4] * inv, v[5] * inv, t0, false); t0 = __builtin_amdgcn_cvt_pk_fp8_f32(v[6] * inv, v[7] * inv, t0, true); w.y = (unsigned)t0; }
    { int t0 = 0; t0 = __builtin_amdgcn_cvt_pk_fp8_f32(v[8] * inv, v[9] * inv, t0, false); t0 = __builtin_amdgcn_cvt_pk_fp8_f32(v[10] * inv, v[11] * inv, t0, true); w.z = (unsigned)t0; }
    { int t0 = 0; t0 = __builtin_amdgcn_cvt_pk_fp8_f32(v[12] * inv, v[13] * inv, t0, false); t0 = __builtin_amdgcn_cvt_pk_fp8_f32(v[14] * inv, v[15] * inv, t0, true); w.w = (unsigned)t0; }
    *(u32x4*)(dst + (size_t)row * 1024 + 16 * lane) = w;
    if (lane == 0) scale[row] = sc;
}
DI void fp8_row_load(const float* src, int row, int lane, float (&v)[16]) {
#pragma unroll
    for (int j = 0; j < 4; ++j) { const f32x4 a = *(const f32x4*)(src + (size_t)row * 1024 + 256 * j + 4 * lane); v[4 * j] = a[0]; v[4 * j + 1] = a[1]; v[4 * j + 2] = a[2]; v[4 * j + 3] = a[3]; }
}
DI void p0_convert_fp8(const Frame& F, const float* src, unsigned char* dst, float* scale, int widx, int nw) {
    const int lane = F.lane;
    for (int row = widx; row < N_EXPERTS; row += 4 * nw) {
        float v0[16], v1[16], v2[16], v3[16];
        const int r1 = row + nw, r2 = row + 2 * nw, r3 = row + 3 * nw;
        fp8_row_load(src, row, lane, v0);
        if (r1 < N_EXPERTS) fp8_row_load(src, r1, lane, v1);
        if (r2 < N_EXPERTS) fp8_row_load(src, r2, lane, v2);
        if (r3 < N_EXPERTS) fp8_row_load(src, r3, lane, v3);
        fp8_row_store(v0, row, lane, dst, scale);
        if (r1 < N_EXPERTS) fp8_row_store(v1, r1, lane, dst, scale);
        if (r2 < N_EXPERTS) fp8_row_store(v2, r2, lane, dst, scale);
        if (r3 < N_EXPERTS) fp8_row_store(v3, r3, lane, dst, scale);
    }
}
DI void p0_prologue(const Frame& F) {
    const bool split = (F.G == 256);
    if (split) p0_mod<true>(F); else p0_mod<false>(F);
    bf16_t* WIN_T = (bf16_t*)(F.ws + WS_WIN_T);
    p0_transpose(F, F.in[5], IN_W, 1024, IN_W, WIN_T, 1024, nullptr);
    float* psc = (float*)(F.ws + WS_PSC);
    if (!split) p0_convert_fp8(F, F.in[29], F.ws + WS_PU0, psc + 0 * N_EXPERTS, F.bid * NWAVES + F.wave, F.G * NWAVES);
    p0_convert_fp8(F, F.in[30], F.ws + WS_PV0, psc + 1 * N_EXPERTS, F.bid * NWAVES + F.wave, F.G * NWAVES);
}
DI void p0_late_weights(const Frame& Fin, int nunits) {
    const int nmax = (nunits + Fin.G - 1) / Fin.G, nfull = nunits - (nmax - 1) * Fin.G;
    Frame F = Fin;
    if (nfull < Fin.G) { if (Fin.bid < nfull) return; F.bid = Fin.bid - nfull; F.G = Fin.G - nfull; }
    bf16_t* WRW_T = (bf16_t*)(F.ws + WS_WRW_T);
    p0_transpose(F, F.in[12] + 0 * 1048576, 1024, 1024, 1024, WRW_T + (size_t)0    * 1024, 1024, nullptr);
    p0_transpose(F, F.in[12] + 1 * 1048576, 1024, 1024, 1024, WRW_T + (size_t)1024 * 1024, 1024, nullptr);
    p0_transpose(F, F.in[12] + 2 * 1048576, 1024, 1024, 1024, WRW_T + (size_t)2048 * 1024, 1024, nullptr);
    p0_transpose(F, F.in[14] + 0 * 65536, 64, 1024, 64, WRW_T + (size_t)3072 * 1024, 1024, nullptr);
    p0_transpose(F, F.in[14] + 1 * 65536, 64, 1024, 64, WRW_T + (size_t)3136 * 1024, 1024, nullptr);
    p0_transpose(F, F.in[17] + 0 * 65536, 64, 1024, 64, WRW_T + (size_t)3328 * 1024, 1024, nullptr);
    p0_transpose(F, F.in[17] + 1 * 65536, 64, 1024, 64, WRW_T + (size_t)3392 * 1024, 1024, nullptr);
    p0_transpose(F, F.in[19], 128, 1024, 128, WRW_T + (size_t)3584 * 1024, 1024, nullptr);
    { const u32x4 z = (u32x4){0u, 0u, 0u, 0u};
      for (int i = F.bid * NTHREADS + F.tid; i < 3 * 128 * 1024 / 8; i += F.G * NTHREADS) { const int blk = i / (128 * 128), r = i % (128 * 128);
          ((u32x4*)(WRW_T + (size_t)(3200 + 256 * blk) * 1024))[r] = z; } }
    { const float* g2 = F.in[20]; bf16_t* G2_T = (bf16_t*)(F.ws + WS_G2_T);
      for (int i = F.bid * NTHREADS + F.tid; i < 1024 * 32; i += F.G * NTHREADS) { const int n = i % 1024, k0 = (i / 1024) * 8;
          float v[8];
#pragma unroll
          for (int e = 0; e < 8; ++e) v[e] = (k0 + e < 128) ? g2[(size_t)(k0 + e) * 1024 + n] : 0.f;
          u32x4 w; w.x = pack_bf16(v[0], v[1]); w.y = pack_bf16(v[2], v[3]); w.z = pack_bf16(v[4], v[5]); w.w = pack_bf16(v[6], v[7]);
          *(u32x4*)(G2_T + (size_t)n * 256 + k0) = w; } }
    p0_transpose(F, F.in[9], 1024, 1024, 1024, (bf16_t*)(F.ws + WS_WOUT_T), 1024, nullptr);
    p0_convert(F, F.in[28], (bf16_t*)(F.ws + WS_SK), (size_t)2 * 16 * 128 * 128);
    const float* mod = (const float*)(F.ws + WS_MOD);
    p0_wqs(F, F.in[27], F.in[4] + 1 * 1024, mod, (bf16_t*)F.out);
    { Frame Fr = F; Fr.bid = F.G - 1 - F.bid;
      p0_bq(Fr, F.in[27], mod, (float*)(F.ws + WS_BQ)); }
}
DI void p0_late_weights2(const Frame& Fin) {
    Frame F = Fin;
    if ((Fin.G & 7) == 0) { const int g8 = Fin.G >> 3, nmax = (120 + g8 - 1) / g8, nfull = 120 - (nmax - 1) * g8;
        if (nfull < g8) { if ((Fin.bid >> 3) < nfull) return; F.bid = ((Fin.bid >> 3) - nfull) * 8 + (Fin.bid & 7); F.G = (g8 - nfull) * 8; } }
    else { const int nmax = (960 + Fin.G - 1) / Fin.G, nfull = 960 - (nmax - 1) * Fin.G;
        if (nfull < Fin.G) { if (Fin.bid < nfull) return; F.bid = Fin.bid - nfull; F.G = Fin.G - nfull; } }
    p0_wqs(F, F.in[27] + (size_t)1024 * 2048, F.in[4] + 3 * 1024, (const float*)(F.ws + WS_MOD) + 8 * 6144, (bf16_t*)F.out + (size_t)8 * 2048 * 1024);
    p0_transpose(F, F.in[26], 1024, 1024, 1024, (bf16_t*)(F.ws + WS_WO_T), 1024, nullptr);
    { Frame Fr = F; Fr.bid = F.G - 1 - F.bid; p0_bq(Fr, F.in[27] + (size_t)1024 * 2048, (const float*)(F.ws + WS_MOD) + 8 * 6144, (float*)(F.ws + WS_BQ) + 8 * 2048); }
}

DI void norm_row16(const float* xr, int lane, float (&v)[16], float& rinv) {
    float ss = 0.f;
#pragma unroll
    for (int j = 0; j < 4; ++j) { const f32x4 a = *(const f32x4*)(xr + j * 256 + lane * 4); v[4 * j] = a[0]; v[4 * j + 1] = a[1]; v[4 * j + 2] = a[2]; v[4 * j + 3] = a[3];
        ss += a[0] * a[0] + a[1] * a[1] + a[2] * a[2] + a[3] * a[3]; }
    ss = wave_sum(ss);
    rinv = rsqrtf(ss * (1.0f / 1024.0f) + 1e-6f);
}
DI void ada_apply(float (&v)[16], float rinv, const float* g, const float* sc, const float* sh, int lane) {
#pragma unroll
    for (int j = 0; j < 4; ++j) { const int c = j * 256 + lane * 4;
        const f32x4 gg = *(const f32x4*)(g + c), s1 = *(const f32x4*)(sc + c), s0 = *(const f32x4*)(sh + c);
#pragma unroll
        for (int e = 0; e < 4; ++e) v[4 * j + e] = v[4 * j + e] * rinv * gg[e] * (1.0f + s1[e]) + s0[e]; }
}
DI void norm_row16_b(const bf16_t* xr, int lane, float (&v)[16], float& rinv) {
    float ss = 0.f;
#pragma unroll
    for (int j = 0; j < 4; ++j) { const u32x2 a = *(const u32x2*)(xr + j * 256 + lane * 4); v[4 * j] = bf_lo(a.x); v[4 * j + 1] = bf_hi(a.x); v[4 * j + 2] = bf_lo(a.y); v[4 * j + 3] = bf_hi(a.y);
        ss += v[4 * j] * v[4 * j] + v[4 * j + 1] * v[4 * j + 1] + v[4 * j + 2] * v[4 * j + 2] + v[4 * j + 3] * v[4 * j + 3]; }
    ss = wave_sum(ss);
    rinv = rsqrtf(ss * (1.0f / 1024.0f) + 1e-6f);
}
template <bool IN_BF16> DI void p_norm(const Frame& F, const void* x, const float* g, const float* modl  , int sh_off, int sc_off, bf16_t* H) {
    for (int r = F.bid * NWAVES + F.wave; r < T; r += F.G * NWAVES) {
        const int b = r / SEQ; float v[16], rinv;
        if (IN_BF16) norm_row16_b((const bf16_t*)x + (size_t)r * D, F.lane, v, rinv); else norm_row16((const float*)x + (size_t)r * D, F.lane, v, rinv);
        ada_apply(v, rinv, g, modl + (size_t)b * 6144 + sc_off, modl + (size_t)b * 6144 + sh_off, F.lane);
#pragma unroll
        for (int j = 0; j < 4; ++j) { u32x2 w; w.x = pack_bf16(v[4 * j], v[4 * j + 1]); w.y = pack_bf16(v[4 * j + 2], v[4 * j + 3]);
            *(u32x2*)(H + (size_t)r * D + j * 256 + F.lane * 4) = w; }
    }
}
DI void p_qkprep(const Frame& F) {
    const bf16_t* QKV = (const bf16_t*)(F.ws + WS_QKV);
    bf16_t* QA = (bf16_t*)(F.ws + WS_QA); bf16_t* KA = (bf16_t*)(F.ws + WS_KA); bf16_t* VAT = (bf16_t*)(F.ws + WS_VAT);
    bf16_t* QB = (bf16_t*)(F.ws + WS_QB); bf16_t* KB = (bf16_t*)(F.ws + WS_KB); bf16_t* VBT = (bf16_t*)(F.ws + WS_VBT);
    const float* qk_g = F.in[6];
    LAS float* cs = (LAS float*)F.lds;
    LAS unsigned short* vt = (LAS unsigned short*)(F.lds + 16384);
    for (int tile = F.bid; tile < T / 64; tile += F.G) {
        const int t0 = tile * 64, b = t0 / SEQ, s0 = t0 % SEQ;
        __syncthreads();
        for (int i = F.tid; i < 64 * 32; i += NTHREADS) { const int tok = i >> 5, ai = i & 31, axis = ai >> 4, ii = ai & 15;
            const int s = s0 + tok; const float pos = (float)(axis == 0 ? (s >> 6) : (s & 63));
            const float inv = exp2f(-(float)ii * (13.287712379549449f / 16.0f));
            float sn, cn; sincosf(pos * inv, &sn, &cn); cs[2 * i] = cn; cs[2 * i + 1] = sn; }
        for (int i = F.tid; i < 64 * 80; i += NTHREADS) { const int tok = i / 80, ch = i % 80; const int col = ch < 64 ? 1024 + 8 * ch : 2176 + 8 * (ch - 64);
            const u32x4 v = *(const u32x4*)(QKV + (size_t)(t0 + tok) * IN_W + col);
            *(LAS u32x4*)(vt + tok * 648 + 8 * ch) = v; }
        __syncthreads();
        const int tok = F.tid >> 3, j = F.tid & 7, s = s0 + tok;
        for (int slot = 0; slot < 26; ++slot) {
            int col, type; bf16_t* dst;
            if (slot < 8)       { col = 64 * slot;               type = 0; dst = QA + ((size_t)(b * 8 + slot) * SEQ + s) * 64; }
            else if (slot < 16) { col = 512 + 64 * (slot - 8);   type = 1; dst = KA + ((size_t)(b * 8 + slot - 8) * SEQ + s) * 64; }
            else if (slot < 24) { col = 1536 + 64 * (slot - 16); type = 2; dst = QB + ((size_t)(b * 8 + slot - 16) * SEQ + s) * 64; }
            else                { col = 2048 + 64 * (slot - 24); type = 3; dst = KB + ((size_t)(b * 2 + slot - 24) * SEQ + s) * 64; }
            const u32x4 raw = *(const u32x4*)(QKV + (size_t)(t0 + tok) * IN_W + col + 8 * j);
            float v[8]; v[0] = bf_lo(raw.x); v[1] = bf_hi(raw.x); v[2] = bf_lo(raw.y); v[3] = bf_hi(raw.y); v[4] = bf_lo(raw.z); v[5] = bf_hi(raw.z); v[6] = bf_lo(raw.w); v[7] = bf_hi(raw.w);
            float ss = 0.f;
#pragma unroll
            for (int e = 0; e < 8; ++e) ss += v[e] * v[e];
            ss += __shfl_xor(ss, 1); ss += __shfl_xor(ss, 2); ss += __shfl_xor(ss, 4);
            const float rinv = rsqrtf(ss * (1.0f / 64.0f) + 1e-6f);
            const f32x4 g0 = *(const f32x4*)(qk_g + type * 64 + 8 * j), g1 = *(const f32x4*)(qk_g + type * 64 + 8 * j + 4);
#pragma unroll
            for (int e = 0; e < 4; ++e) { v[e] = v[e] * rinv * g0[e]; v[4 + e] = v[4 + e] * rinv * g1[e]; }
            if (type >= 2) {
                const int axis = j >> 2; const bool first = (j & 2) == 0;
#pragma unroll
                for (int e = 0; e < 8; ++e) { const float p = __shfl_xor(v[e], 2); const int ii = 8 * (j & 1) + e;
                    const float cn = cs[2 * (tok * 32 + axis * 16 + ii)], sn = cs[2 * (tok * 32 + axis * 16 + ii) + 1];
                    v[e] = first ? (v[e] * cn - p * sn) : (v[e] * cn + p * sn); }
            }
            if (type == 0 || type == 2) {
#pragma unroll
                for (int e = 0; e < 8; ++e) v[e] *= QSCALE; }
            u32x4 w; w.x = pack_bf16(v[0], v[1]); w.y = pack_bf16(v[2], v[3]); w.z = pack_bf16(v[4], v[5]); w.w = pack_bf16(v[6], v[7]);
            *(u32x4*)(dst + 8 * j) = w;
        }
        for (int i = F.tid; i < 640 * 8; i += NTHREADS) { const int c = i & 7, dv = i >> 3;
            unsigned short e[8];
#pragma unroll
            for (int k = 0; k < 8; ++k) e[k] = vt[(16 * (c >> 1) + 4 * (c & 1) + (k & 3) + 8 * (k >> 2)) * 648 + dv];
            u32x4 w; w.x = e[0] | ((unsigned)e[1] << 16); w.y = e[2] | ((unsigned)e[3] << 16); w.z = e[4] | ((unsigned)e[5] << 16); w.w = e[6] | ((unsigned)e[7] << 16);
            bf16_t* dp = dv < 512 ? VAT + ((size_t)b * 512 + dv) * SEQ + s0 + 8 * c : VBT + ((size_t)b * 128 + (dv - 512)) * SEQ + s0 + 8 * c;
            *(u32x4*)dp = w; }
    }
    __syncthreads();
}

DI int t5_bucket(int rel) {
    const int ret = rel > 0 ? 16 : 0; const int n = rel < 0 ? -rel : rel;
    if (n < 8) return ret + n;
    int large = 8 + (n >= 12) + (n >= 16) + (n >= 23) + (n >= 32) + (n >= 46) + (n >= 64) + (n >= 91);
    return ret + large;
}
constexpr int AT_NS = 4, AT_PD = AT_NS - 1, AT_STG = 24576, AT_TB = AT_NS * AT_STG, AT_Q = AT_TB + 3072;
DI void glds16(const void* gsrc, unsigned lds_dst) { unsigned keep;
    asm volatile("s_mov_b32 %0, m0\n\ts_mov_b32 m0, %2\n\ts_nop 0\n\tglobal_load_lds_dwordx4 %1, off\n\ts_mov_b32 m0, %0" : "=&s"(keep) : "v"(gsrc), "s"(lds_dst) : "memory"); }

template <int NC, bool BIAS>
DI void attn_pass(const Frame& F, const bf16_t* Qp, const bf16_t* Kp, const bf16_t* Vt, int q0, const LAS float* tb, float c_neg, float c_pos, f32x16 (&o)[NC], float& l_out) {
    int lane = F.lane, tid_ = F.tid; asm volatile("" : "+v"(lane), "+v"(tid_));
    const int r31 = lane & 31, h = lane >> 5;
    LAS unsigned char* lds = F.lds;
    constexpr int NT = SEQ / 64, PT = 1 + NC / 2;
    __syncthreads();
#pragma unroll
    for (int i = 0; i < 4; ++i) { const int idx = i * NTHREADS + tid_, row = idx >> 3, ch = idx & 7;
        const u32x4 v = *(const u32x4*)(Qp + (size_t)(q0 + row) * 64 + 8 * ch);
        *(LAS u32x4*)(lds + AT_Q + row * 128 + ((ch ^ (row & 7)) << 4)) = v; }
    unsigned koffs[4], qoffs[4], voffs[4];
#pragma unroll
    for (int s_ = 0; s_ < 4; ++s_) { const unsigned sw = (unsigned)(((2 * s_ + h) ^ (r31 & 7)) << 4);
        koffs[s_] = (unsigned)(r31 * 128) + sw; qoffs[s_] = (unsigned)(AT_Q + (32 * F.wave + r31) * 128) + sw;
        voffs[s_] = 8192u + (unsigned)(r31 * 128) + (unsigned)(((2 * s_ + h) ^ ((r31 >> 1) & 7)) << 4); }
#pragma unroll
    for (int c = 0; c < NC; ++c)
#pragma unroll
        for (int r = 0; r < 16; ++r) o[c][r] = 0.f;
    float m = -INFINITY, l = 0.f;
    const int qlo = q0 + 32 * F.wave, qme = qlo + r31;
    const int krow = F.wave * 8 + (lane >> 3);
    const bf16_t* ksrc = Kp + (size_t)krow * 64 + 8 * ((lane & 7) ^ (krow & 7));
    const bf16_t* vsrc[NC / 2];
#pragma unroll
    for (int i = 0; i < NC / 2; ++i) { const int vrow = (i * 8 + F.wave) * 8 + (lane >> 3); vsrc[i] = Vt + (size_t)vrow * SEQ + 8 * ((lane & 7) ^ ((vrow >> 1) & 7)); }
    const unsigned lbase = (unsigned)(size_t)lds;
    const unsigned kdst = lbase + (unsigned)F.wave * 1024u;
#define AT_ISSUE(tt) do { const unsigned sb_ = (unsigned)(((tt) % AT_NS) * AT_STG); \
        glds16(ksrc + (size_t)(tt) * 64 * 64, (unsigned)__builtin_amdgcn_readfirstlane(kdst + sb_)); \
        _Pragma("unroll") for (int i_ = 0; i_ < NC / 2; ++i_) glds16(vsrc[i_] + (size_t)(tt) * 64, (unsigned)__builtin_amdgcn_readfirstlane(kdst + sb_ + 8192u + (unsigned)i_ * 8192u)); } while (0)
    __syncthreads();
    bf16x8 qreg[4];
    {
#pragma unroll
        for (int s = 0; s < 4; ++s) qreg[s] = *(const LAS bf16x8*)(lds + qoffs[s]); }
#pragma unroll
    for (int tt = 0; tt < AT_PD; ++tt) AT_ISSUE(tt);
#pragma unroll 1
    for (int t = 0; t < NT; ++t) {
        const int k0 = t * 64;
        if (t < NT - 2) { if (PT == 3) asm volatile("s_waitcnt vmcnt(6)" ::: "memory"); else asm volatile("s_waitcnt vmcnt(4)" ::: "memory"); }
        else if (t == NT - 2) { if (PT == 3) asm volatile("s_waitcnt vmcnt(3)" ::: "memory"); else asm volatile("s_waitcnt vmcnt(2)" ::: "memory"); }
        else asm volatile("s_waitcnt vmcnt(0)" ::: "memory");
        __builtin_amdgcn_s_barrier();
        asm volatile("" ::: "memory");
        if (t + AT_PD < NT) AT_ISSUE(t + AT_PD);
        const LAS unsigned char* st_ = lds + (t % AT_NS) * AT_STG;
        f32x16 sT[2];
#pragma unroll
        for (int s = 0; s < 4; ++s) { const bf16x8 qf = qreg[s];
#pragma unroll
            for (int kb = 0; kb < 2; ++kb) { const bf16x8 kf = *(const LAS bf16x8*)(st_ + koffs[s] + kb * 4096);
                if (s == 0) sT[kb] = __builtin_amdgcn_mfma_f32_32x32x16_bf16(kf, qf, (f32x16){0.f, 0.f, 0.f, 0.f, 0.f, 0.f, 0.f, 0.f, 0.f, 0.f, 0.f, 0.f, 0.f, 0.f, 0.f, 0.f}, 0, 0, 0);
                else sT[kb] = __builtin_amdgcn_mfma_f32_32x32x16_bf16(kf, qf, sT[kb], 0, 0, 0); } }
        float cb = 0.f;
        if (BIAS) {
            if (k0 + 63 - qlo <= -91) cb = c_neg;
            else if (k0 - (qlo + 31) >= 91) cb = c_pos;
            else {
#pragma unroll
                for (int kb = 0; kb < 2; ++kb)
#pragma unroll
                    for (int r = 0; r < 16; ++r) { const int key = k0 + 32 * kb + (r & 3) + 8 * (r >> 2) + 4 * h; sT[kb][r] += tb[key - qme + 192]; }
            }
        }
        float mx = sT[0][0];
#pragma unroll
        for (int kb = 0; kb < 2; ++kb)
#pragma unroll
            for (int r = 0; r < 16; ++r) mx = fmaxf(mx, sT[kb][r]);
        mx = fmaxf(mx, __shfl_xor(mx, 32)) + cb;
        if (__builtin_amdgcn_ballot_w64(mx > m) != 0ull) {
            const float mn = fmaxf(m, mx), alpha = __builtin_amdgcn_exp2f(m - mn);
            m = mn; l *= alpha;
#pragma unroll
            for (int c = 0; c < NC; ++c)
#pragma unroll
                for (int r = 0; r < 16; ++r) o[c][r] *= alpha;
        }
        const float sh = cb - m;
        float ps = 0.f;
#pragma unroll
        for (int kb = 0; kb < 2; ++kb)
#pragma unroll
            for (int r = 0; r < 16; ++r) { const float p = __builtin_amdgcn_exp2f(sT[kb][r] + sh); sT[kb][r] = p; ps += p; }
        l += ps;
        bf16x8 pf[2][2];
#pragma unroll
        for (int kb = 0; kb < 2; ++kb)
#pragma unroll
            for (int s2 = 0; s2 < 2; ++s2) {
                u32x4 pw; pw.x = pack_bf16(sT[kb][8 * s2 + 0], sT[kb][8 * s2 + 1]); pw.y = pack_bf16(sT[kb][8 * s2 + 2], sT[kb][8 * s2 + 3]);
                pw.z = pack_bf16(sT[kb][8 * s2 + 4], sT[kb][8 * s2 + 5]); pw.w = pack_bf16(sT[kb][8 * s2 + 6], sT[kb][8 * s2 + 7]);
                pf[kb][s2] = __builtin_bit_cast(bf16x8, pw); }
        __builtin_amdgcn_sched_barrier(0);
#pragma unroll
        for (int g = 0; g < 4; ++g) {
#pragma unroll
            for (int c = 0; c < NC; ++c) { const bf16x8 vf = *(const LAS bf16x8*)(st_ + voffs[g] + c * 4096);
                o[c] = __builtin_amdgcn_mfma_f32_32x32x16_bf16(vf, pf[g >> 1][g & 1], o[c], 0, 0, 0); }
        }
    }
#undef AT_ISSUE
    l_out = l + __shfl_xor(l, 32);
}

template <int MODE> DI void p_attention(const Frame& F) {
    const bf16_t* QA = (const bf16_t*)(F.ws + WS_QA); const bf16_t* KA = (const bf16_t*)(F.ws + WS_KA); const bf16_t* VAT = (const bf16_t*)(F.ws + WS_VAT);
    const bf16_t* QB = (const bf16_t*)(F.ws + WS_QB); const bf16_t* KB = (const bf16_t*)(F.ws + WS_KB); const bf16_t* VBT = (const bf16_t*)(F.ws + WS_VBT);
    bf16_t* O = (bf16_t*)(F.ws + WS_O);
    const float* rel_bias = F.in[10]; const float* lv = F.in[7]; const float* subg = F.in[8];
    LAS float* tb = (LAS float*)(F.lds + AT_TB);
    const int lane = F.lane;
    float lam;
    { const float a = lv[lane] * lv[64 + lane], b2 = lv[128 + lane] * lv[192 + lane];
      lam = __expf(wave_sum(a)) - __expf(wave_sum(b2)) + 0.2f; }
    if (MODE & 1) for (int u = F.bid; u < 256; u += F.G) {
        const int b = u >> 5, hd = (u >> 3) & 3, qb = u & 7, q0 = qb * 256;
        __syncthreads();
        for (int i = F.tid; i < 2 * 384; i += NTHREADS) { const int mi = i / 384, ii = i % 384; tb[i] = rel_bias[t5_bucket(ii - 192) * 8 + 2 * hd + mi] * LOG2E; }
        __syncthreads();
        const bf16_t* Vt = VAT + (size_t)(b * 4 + hd) * 128 * SEQ;
        unsigned* o0s = (unsigned*)(F.ws + WS_O0S) + (size_t)F.bid * NTHREADS + F.tid;
        const size_t o0p = (size_t)F.G * NTHREADS;
        f32x16 o[4]; float l;
        { const int mp = 2 * hd;
          attn_pass<4, true>(F, QA + (size_t)(b * 8 + mp) * SEQ * 64, KA + (size_t)(b * 8 + mp) * SEQ * 64, Vt, q0, tb, rel_bias[15 * 8 + mp] * LOG2E, rel_bias[31 * 8 + mp] * LOG2E, o, l);
          const float il = 1.0f / l;
#pragma unroll
          for (int c = 0; c < 4; ++c)
#pragma unroll
              for (int r = 0; r < 8; ++r) o0s[(c * 8 + r) * o0p] = pack_bf16(o[c][2 * r] * il, o[c][2 * r + 1] * il); }
        { const int mp = 2 * hd + 1;
          attn_pass<4, true>(F, QA + (size_t)(b * 8 + mp) * SEQ * 64, KA + (size_t)(b * 8 + mp) * SEQ * 64, Vt, q0, tb + 384, rel_bias[15 * 8 + mp] * LOG2E, rel_bias[31 * 8 + mp] * LOG2E, o, l);
          int ln = F.lane; asm volatile("" : "+v"(ln)); const int r31 = ln & 31, h = ln >> 5;
          const float il = lam / l; float ss = 0.f;
#pragma unroll
          for (int c = 0; c < 4; ++c)
#pragma unroll
              for (int r = 0; r < 8; ++r) { const unsigned pk = __hip_atomic_load(o0s + (c * 8 + r) * o0p, __ATOMIC_RELAXED, __HIP_MEMORY_SCOPE_AGENT); const float d0 = bf_lo(pk) - o[c][2 * r] * il, d1 = bf_hi(pk) - o[c][2 * r + 1] * il; o[c][2 * r] = d0; o[c][2 * r + 1] = d1; ss += d0 * d0 + d1 * d1; }
          ss += __shfl_xor(ss, 32);
          const float rinv = rsqrtf(ss * (1.0f / 128.0f) + 1e-6f) * 0.8f;
          bf16_t* op = O + (size_t)(b * SEQ + q0 + 32 * F.wave + r31) * D + hd * 128;
#pragma unroll
          for (int c = 0; c < 4; ++c)
#pragma unroll
              for (int g = 0; g < 4; ++g) { const int dv = 32 * c + 8 * g + 4 * h; const f32x4 sg = *(const f32x4*)(subg + dv);
                  u32x2 w; w.x = pack_bf16(o[c][4 * g] * rinv * sg[0], o[c][4 * g + 1] * rinv * sg[1]); w.y = pack_bf16(o[c][4 * g + 2] * rinv * sg[2], o[c][4 * g + 3] * rinv * sg[3]);
                  *(u32x2*)(op + dv) = w; } }
    }
    if (MODE & 2) for (int u = F.bid; u < 512; u += F.G) {
        const int b = u >> 6, hq = (u >> 3) & 7, qb = u & 7, q0 = qb * 256, kv = hq >> 2;
        f32x16 o[2]; float l;
        attn_pass<2, false>(F, QB + (size_t)(b * 8 + hq) * SEQ * 64, KB + (size_t)(b * 2 + kv) * SEQ * 64, VBT + (size_t)(b * 2 + kv) * 64 * SEQ, q0, tb, 0.f, 0.f, o, l);
        int ln = F.lane; asm volatile("" : "+v"(ln)); const int r31 = ln & 31, h = ln >> 5;
        const float il = 1.0f / l;
        bf16_t* op = O + (size_t)(b * SEQ + q0 + 32 * F.wave + r31) * D + 512 + hq * 64;
#pragma unroll
        for (int c = 0; c < 2; ++c)
#pragma unroll
            for (int g = 0; g < 4; ++g) { const int dv = 32 * c + 8 * g + 4 * h;
                u32x2 w; w.x = pack_bf16(o[c][4 * g] * il, o[c][4 * g + 1] * il); w.y = pack_bf16(o[c][4 * g + 2] * il, o[c][4 * g + 3] * il);
                *(u32x2*)(op + dv) = w; }
    }
    __syncthreads();
}
#define CE_DESC(ka, pa, kb, pb) do { const bool _sw = (kb) > (ka); const float _k0 = _sw ? (kb) : (ka), _k1 = _sw ? (ka) : (kb); const int _p0 = _sw ? (pb) : (pa), _p1 = _sw ? (pa) : (pb); \
    (ka) = _k0; (kb) = _k1; (pa) = _p0; (pb) = _p1; } while (0)
template <int BASE> DI void sort16_desc(float (&k)[64], int (&p)[64]) {
#pragma unroll
    for (int k2 = 2; k2 <= 16; k2 <<= 1)
#pragma unroll
        for (int j = k2 >> 1; j > 0; j >>= 1)
#pragma unroll
            for (int i = 0; i < 16; ++i) { const int l = i ^ j;
                if (l > i) { if ((i & k2) == 0 || k2 == 16) CE_DESC(k[BASE + i], p[BASE + i], k[BASE + l], p[BASE + l]); else CE_DESC(k[BASE + l], p[BASE + l], k[BASE + i], p[BASE + i]); } }
}
template <int BA, int BB> DI void merge_top16(float (&k)[64], int (&p)[64]) {
#pragma unroll
    for (int i = 0; i < 16; ++i) { const bool sw = k[BB + 15 - i] > k[BA + i]; k[BA + i] = sw ? k[BB + 15 - i] : k[BA + i]; p[BA + i] = sw ? p[BB + 15 - i] : p[BA + i]; }
#pragma unroll
    for (int j = 8; j > 0; j >>= 1)
#pragma unroll
        for (int i = 0; i < 16; ++i) { const int l = i ^ j; if (l > i) CE_DESC(k[BA + i], p[BA + i], k[BA + l], p[BA + l]); }
}
DI void top16_of_64(float (&k)[64], int (&p)[64]) {
    sort16_desc<0>(k, p); sort16_desc<16>(k, p); sort16_desc<32>(k, p); sort16_desc<48>(k, p);
    merge_top16<0, 16>(k, p); merge_top16<32, 48>(k, p); merge_top16<0, 32>(k, p);
}
#define CEK_DESC(ka, kb) do { const float _h = fmaxf((ka), (kb)), _l = fminf((ka), (kb)); (ka) = _h; (kb) = _l; } while (0)
template <int BASE> DI void sort16k_desc(float (&k)[64]) {
#pragma unroll
    for (int k2 = 2; k2 <= 16; k2 <<= 1)
#pragma unroll
        for (int j = k2 >> 1; j > 0; j >>= 1)
#pragma unroll
            for (int i = 0; i < 16; ++i) { const int l = i ^ j;
                if (l > i) { if ((i & k2) == 0) CEK_DESC(k[BASE + i], k[BASE + l]); else CEK_DESC(k[BASE + l], k[BASE + i]); } }
}
template <int BA, int BB> DI void merge_top16k(float (&k)[64]) {
#pragma unroll
    for (int i = 0; i < 16; ++i) k[BA + i] = fmaxf(k[BA + i], k[BB + 15 - i]);
#pragma unroll
    for (int j = 8; j > 0; j >>= 1)
#pragma unroll
        for (int i = 0; i < 16; ++i) { const int l = i ^ j; if (l > i) CEK_DESC(k[BA + i], k[BA + l]); }
}
DI void top16k_of_64(float (&k)[64]) {
    sort16k_desc<0>(k); sort16k_desc<16>(k); sort16k_desc<32>(k); sort16k_desc<48>(k);
    merge_top16k<0, 16>(k); merge_top16k<32, 48>(k); merge_top16k<0, 32>(k);
}
constexpr int cand_off(int a) { int s = 0; for (int i = 0; i < a; ++i) s += 16 / (i + 1); return s; }

DI void p_peer_topk(const Frame& F, const bf16_t* PQ, const bf16_t* SK  , int* EIDX, float* GATE) {
    const int lane = F.lane, r31 = lane & 31, h = lane >> 5, w = F.wave;
    for (int tile = F.bid; tile < T / 64; tile += F.G) {
        for (int tt = 0; tt < 2; ++tt) {
            const int tok = tile * 64 + tt * 32 + r31;
            float lv[2][16];
#pragma unroll
            for (int p = 0; p < 2; ++p) {
                const int hp = 2 * w + p;
                f32x16 acc[4];
#pragma unroll
                for (int nb = 0; nb < 4; ++nb)
#pragma unroll
                    for (int r = 0; r < 16; ++r) acc[nb][r] = 0.f;
                const bf16_t* qp = PQ + (size_t)tok * PQ_LD + hp * 128 + 8 * h;
                const bf16_t* sp = SK + ((size_t)hp * 128 + r31) * 128 + 8 * h;
#pragma unroll 4
                for (int s = 0; s < 8; ++s) { const bf16x8 qf = *(const bf16x8*)(qp + 16 * s);
#pragma unroll
                    for (int nb = 0; nb < 4; ++nb) { const bf16x8 af = *(const bf16x8*)(sp + (size_t)nb * 32 * 128 + 16 * s);
                        acc[nb] = __builtin_amdgcn_mfma_f32_32x32x16_bf16(af, qf, acc[nb], 0, 0, 0); } }
                float k[64];
#pragma unroll
                for (int nb = 0; nb < 4; ++nb)
#pragma unroll
                    for (int r = 0; r < 16; ++r) { const int n = 32 * nb + (r & 3) + 8 * (r >> 2) + 4 * h;
                        k[16 * nb + r] = __uint_as_float((__float_as_uint(acc[nb][r]) & 0xFFFFFF80u) | (unsigned)(127 - n)); }
                top16k_of_64(k);
#pragma unroll
                for (int i = 0; i < 16; ++i) k[16 + i] = __shfl_xor(k[i], 32);
                merge_top16k<0, 16>(k);
#pragma unroll
                for (int i = 0; i < 16; ++i) lv[p][i] = k[i];
                __builtin_amdgcn_sched_barrier(0);
            }
            float ck[64];
#pragma unroll
            for (int i = 0; i < 64; ++i) ck[i] = -INFINITY;
#pragma unroll
            for (int a = 0; a < 16; ++a) {
#pragma unroll
                for (int b2 = 0; b2 < 16 / (a + 1); ++b2) ck[cand_off(a) + b2] = __uint_as_float((__float_as_uint(lv[0][a] + lv[1][b2]) & 0xFFFFFF00u) | (unsigned)(a * 16 + b2)); }
            LAS float* lst = (LAS float*)F.lds + F.tid;
#pragma unroll
            for (int i = 0; i < 16; ++i) { lst[i * NTHREADS] = lv[0][i]; lst[(16 + i) * NTHREADS] = lv[1][i]; }
            top16k_of_64(ck);
            float den = 0.f, ex[16]; int cp[16];
#pragma unroll
            for (int i = 0; i < 16; ++i) { ex[i] = __expf(ck[i] - ck[0]); den += ex[i];
                const unsigned cb = __float_as_uint(ck[i]); const int a = (cb >> 4) & 15, b2 = cb & 15;
                const unsigned u0 = __float_as_uint(lst[a * NTHREADS]), u1 = __float_as_uint(lst[(16 + b2) * NTHREADS]);
                cp[i] = (127 - (int)(u0 & 127u)) * 128 + (127 - (int)(u1 & 127u)); }
            const float iden = 1.0f / den;
            if (h == 0) {
                int* ep = EIDX + (size_t)tok * 128 + w * 16; float* gp = GATE + (size_t)tok * 128 + w * 16;
#pragma unroll
                for (int i = 0; i < 4; ++i) { *(u32x4*)(ep + 4 * i) = (u32x4){(unsigned)cp[4 * i], (unsigned)cp[4 * i + 1], (unsigned)cp[4 * i + 2], (unsigned)cp[4 * i + 3]};
                    *(f32x4*)(gp + 4 * i) = (f32x4){ex[4 * i] * iden, ex[4 * i + 1] * iden, ex[4 * i + 2] * iden, ex[4 * i + 3] * iden}; }
            }
        }
    }
}

DI void fp8x16_to_f32(const u32x4 w, float (&o)[16]) {
    f32x2 t;
    t = __builtin_amdgcn_cvt_pk_f32_fp8((int)w.x, false); o[0] = t[0]; o[1] = t[1];  t = __builtin_amdgcn_cvt_pk_f32_fp8((int)w.x, true); o[2] = t[0]; o[3] = t[1];
    t = __builtin_amdgcn_cvt_pk_f32_fp8((int)w.y, false); o[4] = t[0]; o[5] = t[1];  t = __builtin_amdgcn_cvt_pk_f32_fp8((int)w.y, true); o[6] = t[0]; o[7] = t[1];
    t = __builtin_amdgcn_cvt_pk_f32_fp8((int)w.z, false); o[8] = t[0]; o[9] = t[1];  t = __builtin_amdgcn_cvt_pk_f32_fp8((int)w.z, true); o[10] = t[0]; o[11] = t[1];
    t = __builtin_amdgcn_cvt_pk_f32_fp8((int)w.w, false); o[12] = t[0]; o[13] = t[1]; t = __builtin_amdgcn_cvt_pk_f32_fp8((int)w.w, true); o[14] = t[0]; o[15] = t[1];
}
DI float gelu_tanh_fast(float x) { const float z2 = 2.302208198f * (x + 0.044715f * x * x * x);
    return x * __builtin_amdgcn_rcpf(1.0f + __builtin_amdgcn_exp2f(-z2)); }
constexpr int PB = 4;
DI void peer_load(const unsigned char* PU, const unsigned char* PV, int ev, int base, int lane, u32x4 (&U)[PB], u32x4 (&V)[PB]) {
#pragma unroll
    for (int q = 0; q < PB; ++q) { const int e = __builtin_amdgcn_readlane(ev, base + q);
        U[q] = *(const u32x4*)(PU + (size_t)e * 1024 + 16 * lane); V[q] = *(const u32x4*)(PV + (size_t)e * 1024 + 16 * lane); }
}
struct RsMap { unsigned tag; int l0, l1, l2, l3; };
DI unsigned swp32(unsigned a, unsigned b, unsigned& other) { auto r = __builtin_amdgcn_permlane32_swap(a, b, false, false); other = r[1]; return r[0]; }
DI unsigned swp16(unsigned a, unsigned b, unsigned& other) { auto r = __builtin_amdgcn_permlane16_swap(a, b, false, false); other = r[1]; return r[0]; }
DI RsMap rs_map_init() {
    unsigned o, t0 = 0u, t1 = 1u, t2 = 2u, t3 = 3u;
    asm volatile("" : "+v"(t0), "+v"(t1), "+v"(t2), "+v"(t3));
    const unsigned ta = swp32(t0, t2, o), tb = swp32(t1, t3, o);
    RsMap m; m.tag = swp16(ta, tb, o);
    m.l0 = __builtin_ctzll(__builtin_amdgcn_ballot_w64(m.tag == 0u)); m.l1 = __builtin_ctzll(__builtin_amdgcn_ballot_w64(m.tag == 1u));
    m.l2 = __builtin_ctzll(__builtin_amdgcn_ballot_w64(m.tag == 2u)); m.l3 = __builtin_ctzll(__builtin_amdgcn_ballot_w64(m.tag == 3u));
    return m;
}
template <int CTRL> DI float dpp_g(float v) { return __builtin_bit_cast(float, __builtin_amdgcn_update_dpp(0, __builtin_bit_cast(int, v), CTRL, 0xF, 0xF, true)); }
DI void peer_comp(const u32x4 (&U)[PB], const u32x4 (&V)[PB], float su, float gvs, int base, const RsMap& M, const float (&x)[16], float (&y)[16]) {
    float d[PB];
#pragma unroll
    for (int q = 0; q < PB; ++q) { float u[16]; fp8x16_to_f32(U[q], u);
        float a0 = u[0] * x[0], a1 = u[1] * x[1], a2 = u[2] * x[2], a3 = u[3] * x[3];
#pragma unroll
        for (int i = 4; i < 16; i += 4) { a0 += u[i] * x[i]; a1 += u[i + 1] * x[i + 1]; a2 += u[i + 2] * x[i + 2]; a3 += u[i + 3] * x[i + 3]; }
        d[q] = (a0 + a1) + (a2 + a3); }
    unsigned o;
    const float f0a = __uint_as_float(swp32(__float_as_uint(d[0]), __float_as_uint(d[2]), o)); const float f0 = f0a + __uint_as_float(o);
    const float f1a = __uint_as_float(swp32(__float_as_uint(d[1]), __float_as_uint(d[3]), o)); const float f1 = f1a + __uint_as_float(o);
    const float ga = __uint_as_float(swp16(__float_as_uint(f0), __float_as_uint(f1), o)); float g = ga + __uint_as_float(o);
    g += dpp_g<0xB1>(g); g += dpp_g<0x4E>(g); g += dpp_g<0x141>(g); g += dpp_g<0x140>(g);
    const int src = (base + (int)M.tag) * 4;
    const float su_b = __uint_as_float(__builtin_amdgcn_ds_bpermute(src, __float_as_uint(su))), gv_b = __uint_as_float(__builtin_amdgcn_ds_bpermute(src, __float_as_uint(gvs)));
    const float c = gv_b * gelu_tanh_fast(g * su_b);
    const float c0 = __uint_as_float(__builtin_amdgcn_readlane(__float_as_uint(c), M.l0)), c1 = __uint_as_float(__builtin_amdgcn_readlane(__float_as_uint(c), M.l1));
    const float c2 = __uint_as_float(__builtin_amdgcn_readlane(__float_as_uint(c), M.l2)), c3 = __uint_as_float(__builtin_amdgcn_readlane(__float_as_uint(c), M.l3));
    const float cq[4] = {c0, c1, c2, c3};
#pragma unroll
    for (int q = 0; q < PB; ++q) { float v[16]; fp8x16_to_f32(V[q], v);
#pragma unroll
        for (int i = 0; i < 16; ++i) y[i] += cq[q] * v[i]; }
}
constexpr int PM_SHIFT = 11, PM_NP = 16384 >> PM_SHIFT;
struct PBatch { u32x4 U[4], V[4]; float su[4], gv[4]; int n; };
DI void pm_fetch(PBatch& B, unsigned long long& mA, unsigned long long& mB, int e0, int e1, float su0, float su1, float gv0, float gv1, const unsigned char* PU, const unsigned char* PV, int lane) {
    B.n = 0;
    if ((mA | mB) == 0ull) return;
    int eid[4];
#pragma unroll
    for (int q = 0; q < 4; ++q) {
        if (mA != 0ull) { const int l = __builtin_ctzll(mA); mA &= mA - 1ull;
            eid[q] = __builtin_amdgcn_readlane(e0, l); B.su[q] = __uint_as_float(__builtin_amdgcn_readlane(__float_as_uint(su0), l)); B.gv[q] = __uint_as_float(__builtin_amdgcn_readlane(__float_as_uint(gv0), l)); B.n = q + 1; }
        else if (mB != 0ull) { const int l = __builtin_ctzll(mB); mB &= mB - 1ull;
            eid[q] = __builtin_amdgcn_readlane(e1, l); B.su[q] = __uint_as_float(__builtin_amdgcn_readlane(__float_as_uint(su1), l)); B.gv[q] = __uint_as_float(__builtin_amdgcn_readlane(__float_as_uint(gv1), l)); B.n = q + 1; }
        else { eid[q] = eid[0]; B.su[q] = 0.f; B.gv[q] = 0.f; }
        B.U[q] = *(const u32x4*)(PU + (size_t)eid[q] * 1024 + 16 * lane); B.V[q] = *(const u32x4*)(PV + (size_t)eid[q] * 1024 + 16 * lane);
    }
}
DI void pm_comp(const PBatch& B, const RsMap& M, const float (&x)[16], float (&y)[16]) {
    float d[4];
#pragma unroll
    for (int q = 0; q < 4; ++q) { float u[16]; fp8x16_to_f32(B.U[q], u);
        f32x2 a0 = (f32x2){u[0], u[1]} * (f32x2){x[0], x[1]}, a1 = (f32x2){u[2], u[3]} * (f32x2){x[2], x[3]};
#pragma unroll
        for (int i = 4; i < 16; i += 4) { a0 = __builtin_elementwise_fma((f32x2){u[i], u[i + 1]}, (f32x2){x[i], x[i + 1]}, a0); a1 = __builtin_elementwise_fma((f32x2){u[i + 2], u[i + 3]}, (f32x2){x[i + 2], x[i + 3]}, a1); }
        const f32x2 as = a0 + a1; d[q] = as[0] + as[1]; }
    unsigned o;
    const float f0a = __uint_as_float(swp32(__float_as_uint(d[0]), __float_as_uint(d[2]), o)); const float f0 = f0a + __uint_as_float(o);
    const float f1a = __uint_as_float(swp32(__float_as_uint(d[1]), __float_as_uint(d[3]), o)); const float f1 = f1a + __uint_as_float(o);
    const float ga = __uint_as_float(swp16(__float_as_uint(f0), __float_as_uint(f1), o)); float g = ga + __uint_as_float(o);
    g += dpp_g<0xB1>(g); g += dpp_g<0x4E>(g); g += dpp_g<0x141>(g); g += dpp_g<0x140>(g);
    const float su_b = M.tag == 0u ? B.su[0] : (M.tag == 1u ? B.su[1] : (M.tag == 2u ? B.su[2] : B.su[3]));
    const float gv_b = M.tag == 0u ? B.gv[0] : (M.tag == 1u ? B.gv[1] : (M.tag == 2u ? B.gv[2] : B.gv[3]));
    const float c = gv_b * gelu_tanh_fast(g * su_b);
    const float cq[4] = {__uint_as_float(__builtin_amdgcn_readlane(__float_as_uint(c), M.l0)), __uint_as_float(__builtin_amdgcn_readlane(__float_as_uint(c), M.l1)),
                         __uint_as_float(__builtin_amdgcn_readlane(__float_as_uint(c), M.l2)), __uint_as_float(__builtin_amdgcn_readlane(__float_as_uint(c), M.l3))};
#pragma unroll
    for (int q = 0; q < 4; ++q) { float v[16]; fp8x16_to_f32(B.V[q], v);
#pragma unroll
        for (int i = 0; i < 16; ++i) y[i] += cq[q] * v[i]; }
}
template <bool FINAL> DI void p_peer_gather(const Frame& F, const float* gn  , const float* modl  , const unsigned char* PU, const unsigned char* PV, const float* SU, const float* SV, const int* EIDX, const float* GATE, const float* gt2  , bf16_t* xb, float* out) {
    const int lane = F.lane;
    const RsMap M = rs_map_init();
    for (int tile = F.bid; tile < T / 64; tile += F.G) {
        for (int grp = 0; grp < 4; ++grp) {
            const int tb = tile * 64 + F.wave * 8 + grp * 2;
            float x[2][16], y[2][16]; int e0[2], e1[2]; float su0[2], su1[2], gv0[2], gv1[2];
#pragma unroll
            for (int i = 0; i < 2; ++i) { const int t = tb + i;
                { float rinv; norm_row16_b(xb + (size_t)t * D, lane, x[i], rinv);
                  ada_apply(x[i], rinv, gn, modl + (size_t)(t / SEQ) * 6144 + 4096, modl + (size_t)(t / SEQ) * 6144 + 3072, lane); }
#pragma unroll
                for (int k = 0; k < 16; ++k) y[i][k] = 0.f;
                e0[i] = EIDX[(size_t)t * 128 + lane]; e1[i] = EIDX[(size_t)t * 128 + 64 + lane];
                su0[i] = SU[e0[i]]; su1[i] = SU[e1[i]]; gv0[i] = GATE[(size_t)t * 128 + lane] * SV[e0[i]]; gv1[i] = GATE[(size_t)t * 128 + 64 + lane] * SV[e1[i]]; }
            for (int p = 0; p < PM_NP; ++p) {
#pragma unroll
                for (int i = 0; i < 2; ++i) {
                    unsigned long long mA = __builtin_amdgcn_ballot_w64((e0[i] >> PM_SHIFT) == p), mB = __builtin_amdgcn_ballot_w64((e1[i] >> PM_SHIFT) == p);
                    PBatch A, B;
                    pm_fetch(A, mA, mB, e0[i], e1[i], su0[i], su1[i], gv0[i], gv1[i], PU, PV, lane);
                    while (A.n > 0) {
                        pm_fetch(B, mA, mB, e0[i], e1[i], su0[i], su1[i], gv0[i], gv1[i], PU, PV, lane);
                        pm_comp(A, M, x[i], y[i]);
                        if (B.n == 0) break;
                        pm_fetch(A, mA, mB, e0[i], e1[i], su0[i], su1[i], gv0[i], gv1[i], PU, PV, lane);
                        pm_comp(B, M, x[i], y[i]);
                    }
                }
            }
#pragma unroll
            for (int i = 0; i < 2; ++i) { const int t = tb + i; const int b = t / SEQ; const float* gp = gt2 + (size_t)b * 6144; bf16_t* xp = xb + (size_t)t * D;
#pragma unroll
                for (int j = 0; j < 4; ++j) { const int c = 256 * j + 4 * lane; const f32x4 g = *(const f32x4*)(gp + c); const u32x2 xw = *(const u32x2*)(xp + c);
                    f32x4 xo = (f32x4){bf_lo(xw.x), bf_hi(xw.x), bf_lo(xw.y), bf_hi(xw.y)};
                    xo[0] += g[0] * y[i][4 * j]; xo[1] += g[1] * y[i][4 * j + 1]; xo[2] += g[2] * y[i][4 * j + 2]; xo[3] += g[3] * y[i][4 * j + 3];
                    if (FINAL) *(f32x4*)(out + (size_t)t * D + c) = xo; else *(u32x2*)(xp + c) = (u32x2){pack_bf16(xo[0], xo[1]), pack_bf16(xo[2], xo[3])}; } }
        }
    }
}
DI void norm_row16c(const float* xr, int lane, float (&v)[16], float& rinv) {
    float ss = 0.f;
#pragma unroll
    for (int j = 0; j < 2; ++j)
#pragma unroll
        for (int q = 0; q < 2; ++q) { const f32x4 a = *(const f32x4*)(xr + 512 * j + 8 * lane + 4 * q); v[8 * j + 4 * q] = a[0]; v[8 * j + 4 * q + 1] = a[1]; v[8 * j + 4 * q + 2] = a[2]; v[8 * j + 4 * q + 3] = a[3];
            ss += a[0] * a[0] + a[1] * a[1] + a[2] * a[2] + a[3] * a[3]; }
    ss = wave_sum(ss);
    rinv = rsqrtf(ss * (1.0f / 1024.0f) + 1e-6f);
}
DI void ada_apply_c(float (&v)[16], float rinv, const float* g, const float* sc, const float* sh, int lane) {
#pragma unroll
    for (int j = 0; j < 2; ++j)
#pragma unroll
        for (int q = 0; q < 2; ++q) { const int c = 512 * j + 8 * lane + 4 * q;
            const f32x4 gg = *(const f32x4*)(g + c), s1 = *(const f32x4*)(sc + c), s0 = *(const f32x4*)(sh + c);
#pragma unroll
            for (int e = 0; e < 4; ++e) v[8 * j + 4 * q + e] = v[8 * j + 4 * q + e] * rinv * gg[e] * (1.0f + s1[e]) + s0[e]; }
}
DI void row_load(const bf16_t* xr, int lane, float (&v)[16]) {
#pragma unroll
    for (int j = 0; j < 2; ++j) { const u32x4 a = *(const u32x4*)(xr + 512 * j + 8 * lane);
        v[8 * j] = bf_lo(a.x); v[8 * j + 1] = bf_hi(a.x); v[8 * j + 2] = bf_lo(a.y); v[8 * j + 3] = bf_hi(a.y); v[8 * j + 4] = bf_lo(a.z); v[8 * j + 5] = bf_hi(a.z); v[8 * j + 6] = bf_lo(a.w); v[8 * j + 7] = bf_hi(a.w); }
}
DI void row_finish(const float (&raw)[16], int lane, const LAS float* ga, const LAS float* sh, float (&v)[16]) {
    float ss = 0.f;
#pragma unroll
    for (int e = 0; e < 16; ++e) ss += raw[e] * raw[e];
    ss = wave_sum(ss);
    const float rinv = rsqrtf(ss * (1.0f / 1024.0f) + 1e-6f);
#pragma unroll
    for (int j = 0; j < 2; ++j)
#pragma unroll
        for (int q = 0; q < 2; ++q) { const int c = 512 * j + 8 * lane + 4 * q; const f32x4 gg = *(const LAS f32x4*)(ga + c), s0 = *(const LAS f32x4*)(sh + c);
#pragma unroll
            for (int e = 0; e < 4; ++e) v[8 * j + 4 * q + e] = raw[8 * j + 4 * q + e] * rinv * gg[e] + s0[e]; }
}
DI void p_rwkv_prep(const Frame& F, const bf16_t* x, const float* g, const float* modl, const float* mix, bf16_t* X6) {
    const int lane = F.lane;
    LAS float* ga = (LAS float*)F.lds; LAS float* shl = ga + 1024; LAS float* mixl = ga + 2048;
    int cur_b = -1;
    for (int run0 = F.bid * NWAVES; run0 < T / 8; run0 += F.G * NWAVES) {
        const int run = run0 + F.wave;
        const int bb = (run0 * 8) / SEQ;
        if (bb != cur_b) { __syncthreads();
            for (int i = F.tid; i < 1024; i += NTHREADS) { ga[i] = g[i] * (1.0f + modl[(size_t)bb * 6144 + 1024 + i]); shl[i] = modl[(size_t)bb * 6144 + i]; }
            if (cur_b < 0) for (int i = F.tid; i < 6 * 1024; i += NTHREADS) mixl[i] = mix[i];
            cur_b = bb; __syncthreads(); }
        const int r0 = run * 8, s0 = r0 % SEQ;
        float hp[16], hc[16], hn[16], ra[16], rb[16];
        if (s0 > 0) row_load(x + (size_t)(r0 - 1) * D, lane, ra);
        row_load(x + (size_t)r0 * D, lane, rb);
        if (s0 > 0) row_finish(ra, lane, ga, shl, hp);
        else {
#pragma unroll
            for (int i = 0; i < 16; ++i) hp[i] = 0.f; }
        if (s0 + 1 < SEQ) row_load(x + (size_t)(r0 + 1) * D, lane, ra);
        row_finish(rb, lane, ga, shl, hc);
        for (int i = 0; i < 8; ++i) {
            const int s = s0 + i;
            if (i + 1 < 8 && s + 2 < SEQ) row_load(x + (size_t)(r0 + i + 2) * D, lane, rb);
            if (s + 1 < SEQ) row_finish(ra, lane, ga, shl, hn);
            else {
#pragma unroll
                for (int e = 0; e < 16; ++e) hn[e] = 0.f; }
#pragma unroll
            for (int e = 0; e < 16; ++e) ra[e] = rb[e];
            float xx[16];
#pragma unroll
            for (int e = 0; e < 16; ++e) xx[e] = 0.5f * (hp[e] + hn[e]) - hc[e];
#pragma unroll
            for (int grp = 0; grp < 6; ++grp) { const int mi = grp == 0 ? 0 : (grp == 1 ? 2 : (grp == 2 ? 3 : (grp == 3 ? 1 : grp)));
                bf16_t* op = X6 + ((size_t)grp * T + r0 + i) * D;
#pragma unroll
                for (int j = 0; j < 2; ++j) { const f32x4 m0 = *(const LAS f32x4*)(mixl + mi * 1024 + 512 * j + 8 * lane), m1 = *(const LAS f32x4*)(mixl + mi * 1024 + 512 * j + 8 * lane + 4);
                    u32x4 w; w.x = pack_bf16(hc[8 * j] + xx[8 * j] * m0[0], hc[8 * j + 1] + xx[8 * j + 1] * m0[1]); w.y = pack_bf16(hc[8 * j + 2] + xx[8 * j + 2] * m0[2], hc[8 * j + 3] + xx[8 * j + 3] * m0[3]);
                    w.z = pack_bf16(hc[8 * j + 4] + xx[8 * j + 4] * m1[0], hc[8 * j + 5] + xx[8 * j + 5] * m1[1]); w.w = pack_bf16(hc[8 * j + 6] + xx[8 * j + 6] * m1[2], hc[8 * j + 7] + xx[8 * j + 7] * m1[3]);
                    *(u32x4*)(op + 512 * j + 8 * lane) = w; } }
#pragma unroll
            for (int e = 0; e < 16; ++e) { hp[e] = hc[e]; hc[e] = hn[e]; }
        }
    }
    __syncthreads();
}

constexpr int SC_L = 16;
constexpr int SC_NB = 5;
constexpr int SCP = 272;
constexpr int SCB_W = 0, SCB_BKZ = 16 * SCP, SCB_VV = 32 * SCP, SCB_AR = 48 * SCP, SCB_SIZE = 64 * SCP;
constexpr int SC_Y = SC_NB * SCB_SIZE;
constexpr int SC_CST = SC_Y + SC_NB * 4096;
constexpr int SC_AFR = SC_CST + 1280;
constexpr int SC_PS = SC_AFR + 16384;
constexpr int SC_SCR = SC_PS + SC_NB * 512;
constexpr int SC_FLG = SC_SCR + 16384;
static_assert(SC_FLG + 64 <= LDS_BAR_OFF, "scan LDS map overflows");
DI void lds_wait_ge(volatile LAS int* p, int v) { while (*p < v) __builtin_amdgcn_s_sleep(1); asm volatile("" ::: "memory"); }
DI void p_rwkv_scan(const Frame& F) {
    const bf16_t* RK = (const bf16_t*)(F.ws + WS1_RK);
    bf16_t* Y = (bf16_t*)(F.ws + WS1_Y); float* BON = (float*)(F.ws + WS1_BON);
    const float* k_k = F.in[21]; const float* k_a = F.in[22]; const float* r_k = F.in[23];
    LAS unsigned char* lds = F.lds;
    const int tid = F.tid, lane = F.lane;
    constexpr int NCH = SEQ / SC_L;
    for (int u = F.bid; u < 256; u += F.G) {
        const int b = u >> 5, hd = (u >> 1) & 15, z = u & 1;
        __syncthreads();
        if (tid < 16) ((volatile LAS int*)(lds + SC_FLG))[tid] = 0;
        { const float* w2 = F.in[15] + (size_t)z * 65536 + hd * 64; const float* a2 = F.in[18] + (size_t)z * 65536 + hd * 64;
          LAS unsigned short* stw = (LAS unsigned short*)(lds + SC_AFR);
          for (int idx = tid; idx < 8192; idx += NTHREADS) { const int mat = idx >> 12, i = (idx >> 6) & 63, c = idx & 63;
              const float v = (mat ? a2 : w2)[(size_t)i * 1024 + c]; stw[mat * 4096 + c * 64 + i] = (unsigned short)(pack_bf16(v, 0.f) & 0xffffu); } }
        __syncthreads();
        if (F.wave >= 4) {
            const int pw = F.wave - 4, s16 = lane & 15, q = lane >> 4;
            const int chb = hd * 64 + 4 * q;
            const LAS unsigned short* stg = (const LAS unsigned short*)(lds + SC_AFR);
            LAS float* cst = (LAS float*)(lds + SC_CST);
            { cst[lane] = F.in[13][z * 1024 + hd * 64 + lane]; cst[64 + lane] = F.in[16][z * 1024 + hd * 64 + lane]; cst[128 + lane] = k_k[hd * 64 + lane]; cst[192 + lane] = k_a[hd * 64 + lane]; cst[256 + lane] = r_k[hd * 64 + lane]; }
            u32x2 rr[4], kr[4], vr[4]; u32x4 Bw[2], Ba[2];
#define SC_ROW(i_) ((size_t)(b * SEQ + (z ? (SEQ - 1 - (i_)) : (i_))))
#define SC_LOADC(cc) do { int s16l_ = s16, ql_ = q; asm volatile("" : "+v"(s16l_), "+v"(ql_)); const int chb_ = hd * 64 + 4 * ql_;     \
        const bf16_t* rp_ = RK + SC_ROW((cc) * SC_L + s16l_) * RW_N; \
        _Pragma("unroll") for (int cb = 0; cb < 4; ++cb) { rr[cb] = *(const u32x2*)(rp_ + chb_ + 16 * cb); kr[cb] = *(const u32x2*)(rp_ + 1024 + chb_ + 16 * cb); vr[cb] = *(const u32x2*)(rp_ + 2048 + chb_ + 16 * cb); } \
        _Pragma("unroll") for (int ks = 0; ks < 2; ++ks) { Bw[ks] = *(const u32x4*)(rp_ + 3072 + 64 * z + 32 * ks + 8 * ql_); Ba[ks] = *(const u32x4*)(rp_ + 3328 + 64 * z + 32 * ks + 8 * ql_); } } while (0)
#define SC_XFORM(cc_, buf_) do { \
            int s16_ = s16, q_ = q; asm volatile("" : "+v"(s16_), "+v"(q_));     \
            LAS unsigned char* bp = lds + (buf_) * SCB_SIZE; const int t_ = s16_; const bool odd_ = (s16_ & 1) != 0; \
            float ss = 0.f, bs = 0.f; LAS float* scr_ = (LAS float*)(lds + SC_SCR) + (pw * 4) * 256 + (q_ * 16 + s16_) * 4;     \
            _Pragma("unroll") for (int cb = 0; cb < 4; ++cb) { \
                f32x4 dw = __builtin_amdgcn_mfma_f32_16x16x32_bf16(*(const LAS bf16x8*)(stg + (16 * cb + s16_) * 64 + 8 * q_), __builtin_bit_cast(bf16x8, Bw[0]), (f32x4){0.f, 0.f, 0.f, 0.f}, 0, 0, 0); \
                dw = __builtin_amdgcn_mfma_f32_16x16x32_bf16(*(const LAS bf16x8*)(stg + (16 * cb + s16_) * 64 + 32 + 8 * q_), __builtin_bit_cast(bf16x8, Bw[1]), dw, 0, 0, 0); \
                f32x4 da = __builtin_amdgcn_mfma_f32_16x16x32_bf16(*(const LAS bf16x8*)(stg + 4096 + (16 * cb + s16_) * 64 + 8 * q_), __builtin_bit_cast(bf16x8, Ba[0]), (f32x4){0.f, 0.f, 0.f, 0.f}, 0, 0, 0); \
                da = __builtin_amdgcn_mfma_f32_16x16x32_bf16(*(const LAS bf16x8*)(stg + 4096 + (16 * cb + s16_) * 64 + 32 + 8 * q_), __builtin_bit_cast(bf16x8, Ba[1]), da, 0, 0, 0); \
                const f32x4 w0v = *(const LAS f32x4*)(cst + 16 * cb + 4 * q_), a0v = *(const LAS f32x4*)(cst + 64 + 16 * cb + 4 * q_); \
                const f32x4 kkw = *(const LAS f32x4*)(cst + 128 + 16 * cb + 4 * q_), kaw = *(const LAS f32x4*)(cst + 192 + 16 * cb + 4 * q_), rkw = *(const LAS f32x4*)(cst + 256 + 16 * cb + 4 * q_); \
                const float r4[4] = {bf_lo(rr[cb].x), bf_hi(rr[cb].x), bf_lo(rr[cb].y), bf_hi(rr[cb].y)}, k4[4] = {bf_lo(kr[cb].x), bf_hi(kr[cb].x), bf_lo(kr[cb].y), bf_hi(kr[cb].y)}; \
                f32x4 dec, azq, kzq; \
                _Pragma("unroll") for (int e = 0; e < 4; ++e) { \
                    const float sgw = __builtin_amdgcn_rcpf(1.0f + __builtin_amdgcn_exp2f(-1.4426950408889634f * (dw[e] + w0v[e])));     \
                    dec[e] = __builtin_amdgcn_exp2f(-0.8750387749f * sgw);                                                     \
                    const float az = __builtin_amdgcn_rcpf(1.0f + __builtin_amdgcn_exp2f(-1.4426950408889634f * (da[e] + a0v[e]))); azq[e] = az; \
                    { const float kk_ = k4[e] * kkw[e]; ss += kk_ * kk_; } kzq[e] = k4[e] * (1.0f + (az - 1.0f) * kaw[e]); bs += r4[e] * kzq[e] * rkw[e]; } \
                { const int o = t_ * SCP + (16 * cb + 4 * q_) * 4; \
                    *(LAS f32x4*)(scr_ + cb * 256) = azq; *(LAS f32x4*)(bp + SCB_BKZ + o) = kzq;     \
                    *(LAS f32x4*)(bp + SCB_W + o) = dec;                        \
                    *(LAS f32x4*)(bp + SCB_VV + o) = (f32x4){bf_lo(vr[cb].x), bf_hi(vr[cb].x), bf_lo(vr[cb].y), bf_hi(vr[cb].y)}; } } \
            ss += __shfl_xor(ss, 16); ss += __shfl_xor(ss, 32); bs += __shfl_xor(bs, 16); bs += __shfl_xor(bs, 32); \
            const float inv = __builtin_amdgcn_rsqf(fmaxf(ss, 1e-24f));     \
              \
            float s_bb = 0.f, s_kk = 0.f, c_g = 0.f, c_h = 0.f, c_br = 0.f, c_kr = 0.f; const bool pB_ = (s16_ & 2) != 0;     \
            f32x4 Ga = (f32x4){0.f, 0.f, 0.f, 0.f}, Gr = Ga;     \
            _Pragma("unroll") for (int cb = 0; cb < 4; ++cb) { float kn[4], bo[4], bq[4], kq[4]; \
                const float r4[4] = {bf_lo(rr[cb].x), bf_hi(rr[cb].x), bf_lo(rr[cb].y), bf_hi(rr[cb].y)}, k4[4] = {bf_lo(kr[cb].x), bf_hi(kr[cb].x), bf_lo(kr[cb].y), bf_hi(kr[cb].y)}; \
                const f32x4 kkw = *(const LAS f32x4*)(cst + 128 + 16 * cb + 4 * q_); \
                const f32x4 dcv = *(const LAS f32x4*)(bp + SCB_W + t_ * SCP + (16 * cb + 4 * q_) * 4), wp = *(const LAS f32x4*)(bp + SCB_W + (t_ ^ 1) * SCP + (16 * cb + 4 * q_) * 4);     \
                const f32x4 azq = *(const LAS f32x4*)(scr_ + cb * 256), kzq = *(const LAS f32x4*)(bp + SCB_BKZ + t_ * SCP + (16 * cb + 4 * q_) * 4); \
                _Pragma("unroll") for (int e = 0; e < 4; ++e) { kn[e] = k4[e] * kkw[e] * inv; bo[e] = kn[e] * azq[e]; \
                    bq[e] = dpp_g<0xB1>(bo[e]); kq[e] = dpp_g<0xB1>(kzq[e]); \
                    const float ao = -kn[e], rd = r4[e] * dcv[e]; \
                    s_bb += bo[e] * r4[e]; s_kk += kzq[e] * r4[e]; c_g += bq[e] * ao; c_h += kq[e] * ao; c_br += bq[e] * rd; c_kr += kq[e] * rd; } \
                float fb[4], fk[4], xa[4], xr[4], wq[4], sA[4], sB[4]; \
                _Pragma("unroll") for (int e = 0; e < 4; ++e) { const float wpr = dcv[e] * wp[e], wo = dpp_g<0x4E>(wpr);     \
                    const float mb = odd_ ? 1.0f : wp[e], ma = odd_ ? -wp[e] : -1.0f, mr = odd_ ? wpr : dcv[e]; \
                    fb[e] = bo[e] * mb; fk[e] = kzq[e] * mb; xa[e] = kn[e] * ma; xr[e] = r4[e] * mr; wq[e] = wpr * wo; sA[e] = pB_ ? 1.0f : wo; sB[e] = pB_ ? wo : 1.0f; \
                    const float fb0 = dpp_g<0x00>(fb[e]), fk0 = dpp_g<0x00>(fk[e]), fb1 = dpp_g<0x55>(fb[e]), fk1 = dpp_g<0x55>(fk[e]);     \
                    Ga[0] += fb0 * xa[e]; Ga[1] += fk0 * xa[e]; Ga[2] += fb1 * xa[e]; Ga[3] += fk1 * xa[e]; Gr[0] += fb0 * xr[e]; Gr[1] += fk0 * xr[e]; Gr[2] += fb1 * xr[e]; Gr[3] += fk1 * xr[e]; } \
                *(LAS f32x4*)(bp + SCB_W + t_ * SCP + (16 * cb + 4 * q_) * 4) = (f32x4){wq[0], wq[1], wq[2], wq[3]};            \
                *(LAS u32x4*)(bp + SCB_BKZ + t_ * SCP + (16 * cb + 4 * q_) * 4) = (u32x4){pack_bf16(fb[0] * sA[0], fk[0] * sA[0]), pack_bf16(fb[1] * sA[1], fk[1] * sA[1]), pack_bf16(fb[2] * sA[2], fk[2] * sA[2]), pack_bf16(fb[3] * sA[3], fk[3] * sA[3])};     \
                *(LAS u32x2*)(bp + SCB_AR + t_ * SCP + ((cb >> 1) * 4 + q_) * 16 + (cb & 1) * 8) = (u32x2){pack_bf16(xa[0] * sB[0], xa[1] * sB[1]), pack_bf16(xa[2] * sB[2], xa[3] * sB[3])};            \
                *(LAS u32x2*)(bp + SCB_AR + t_ * SCP + 128 + ((cb >> 1) * 4 + q_) * 16 + (cb & 1) * 8) = (u32x2){pack_bf16(xr[0] * sB[0], xr[1] * sB[1]), pack_bf16(xr[2] * sB[2], xr[3] * sB[3])}; }   \
            s_bb += __shfl_xor(s_bb, 16); s_bb += __shfl_xor(s_bb, 32); s_kk += __shfl_xor(s_kk, 16); s_kk += __shfl_xor(s_kk, 32); \
            c_g += __shfl_xor(c_g, 16); c_g += __shfl_xor(c_g, 32); c_h += __shfl_xor(c_h, 16); c_h += __shfl_xor(c_h, 32); \
            c_br += __shfl_xor(c_br, 16); c_br += __shfl_xor(c_br, 32); c_kr += __shfl_xor(c_kr, 16); c_kr += __shfl_xor(c_kr, 32); \
            _Pragma("unroll") for (int e = 0; e < 4; ++e) { Ga[e] += __shfl_xor(Ga[e], 16); Ga[e] += __shfl_xor(Ga[e], 32); Gr[e] += __shfl_xor(Gr[e], 16); Gr[e] += __shfl_xor(Gr[e], 32); } \
            if (q_ == 0) { LAS float* ps_ = (LAS float*)(lds + SC_PS + (buf_) * 512) + (t_ >> 1) * 8;     \
                if (pB_) { LAS float* pq_ = (LAS float*)(lds + SC_PS + (buf_) * 512) + 64 + (t_ >> 2) * 16 + (odd_ ? 4 : 0);     \
                    *(LAS f32x4*)pq_ = Ga; *(LAS f32x4*)(pq_ + 8) = Gr; } \
                if (odd_) { ps_[0] = c_g; ps_[1] = c_h; *(LAS f32x4*)(ps_ + 4) = (f32x4){c_br, c_kr, s_bb, s_kk}; } else { ps_[2] = s_bb; ps_[3] = s_kk; } \
                BON[((size_t)z * T + SC_ROW((cc_) * SC_L + t_)) * 16 + hd] = bs; } } while (0)
#define SC_FLUSH(cc, slot_) do { const LAS float* yb_ = (const LAS float*)(lds + SC_Y + (slot_) * 4096); const int ft_ = lane >> 2, fj_ = (lane & 3) * 16;     \
            const f32x4 y0_ = *(const LAS f32x4*)(yb_ + ft_ * 64 + fj_), y1_ = *(const LAS f32x4*)(yb_ + ft_ * 64 + fj_ + 4), y2_ = *(const LAS f32x4*)(yb_ + ft_ * 64 + fj_ + 8), y3_ = *(const LAS f32x4*)(yb_ + ft_ * 64 + fj_ + 12); \
            bf16_t* yp_ = Y + ((size_t)z * T + SC_ROW((cc) * SC_L + ft_)) * D + hd * 64 + fj_; \
            *(u32x4*)yp_ = (u32x4){pack_bf16(y0_[0], y0_[1]), pack_bf16(y0_[2], y0_[3]), pack_bf16(y1_[0], y1_[1]), pack_bf16(y1_[2], y1_[3])}; \
            *(u32x4*)(yp_ + 8) = (u32x4){pack_bf16(y2_[0], y2_[1]), pack_bf16(y2_[2], y2_[3]), pack_bf16(y3_[0], y3_[1]), pack_bf16(y3_[2], y3_[3])}; } while (0)
            volatile LAS int* rdy = (volatile LAS int*)(lds + SC_FLG); volatile LAS int* prog = rdy + 8;
            SC_LOADC(pw);
            for (int n = pw; n < NCH; n += 4) {
                const int buf = n % SC_NB;
                if (n >= SC_NB) { lds_wait_ge(prog + 0, n - 4); lds_wait_ge(prog + 1, n - 4); lds_wait_ge(prog + 2, n - 4); lds_wait_ge(prog + 3, n - 4); SC_FLUSH(n - SC_NB, buf); }
                SC_XFORM(n, buf);
                asm volatile("s_waitcnt lgkmcnt(0)" ::: "memory");
                if (lane == 0) rdy[buf] = n + 1;
                if (n + 4 < NCH) SC_LOADC(n + 4);
            }
            for (int c = NCH - SC_NB; c < NCH; ++c) if (((c + SC_NB) & 3) == pw) {
                lds_wait_ge(prog + 0, c + 1); lds_wait_ge(prog + 1, c + 1); lds_wait_ge(prog + 2, c + 1); lds_wait_ge(prog + 3, c + 1); SC_FLUSH(c, c % SC_NB); }
#undef SC_ROW
#undef SC_LOADC
#undef SC_XFORM
#undef SC_FLUSH
        } else {
            const int w = F.wave, i16 = lane & 15, q = lane >> 4;
            f32x4 Sd[4];
#pragma unroll
            for (int k = 0; k < 4; ++k) Sd[k] = (f32x4){0.f, 0.f, 0.f, 0.f};
            const int m4 = i16 & 3;
            const int w_off = (4 * q) * 4, bkz_off = i16 * 4, vv_off = (16 * w + i16) * 4, ar_off = (m4 & 1) * SCP + (m4 >> 1) * 128 + q * 16;
            const int bkq_off = (2 * (q & 1)) * SCP + i16 * 4;
            __builtin_amdgcn_s_setprio(3);
            typedef short s16x4v __attribute__((ext_vector_type(4)));
#define ST_LD(o_, Q_) do { _Pragma("unroll") for (int j = 0; j < 4; ++j) o_.vv[j] = *(const LAS float*)(bp + SCB_VV + (4 * (Q_) + j) * SCP + vv_off); \
        o_.a1lo = *(const LAS bf16x8*)(bp + SCB_AR + (4 * (Q_)) * SCP + ar_off); o_.a1hi = *(const LAS bf16x8*)(bp + SCB_AR + (4 * (Q_)) * SCP + 64 + ar_off); \
        o_.a2lo = *(const LAS bf16x8*)(bp + SCB_AR + (4 * (Q_) + 2) * SCP + ar_off); o_.a2hi = *(const LAS bf16x8*)(bp + SCB_AR + (4 * (Q_) + 2) * SCP + 64 + ar_off); } while (0)
#define ST_STEP(o_, Q_) do { \
        const bf16x8 Bd0 = __builtin_bit_cast(bf16x8, (u32x4){pack_bf16(Sd[0][0], Sd[0][1]), pack_bf16(Sd[0][2], Sd[0][3]), pack_bf16(Sd[1][0], Sd[1][1]), pack_bf16(Sd[1][2], Sd[1][3])}); \
        const bf16x8 Bd1 = __builtin_bit_cast(bf16x8, (u32x4){pack_bf16(Sd[2][0], Sd[2][1]), pack_bf16(Sd[2][2], Sd[2][3]), pack_bf16(Sd[3][0], Sd[3][1]), pack_bf16(Sd[3][2], Sd[3][3])}); \
        const f32x4 d1a = __builtin_amdgcn_mfma_f32_16x16x32_bf16(o_.a1lo, Bd0, (f32x4){0.f, 0.f, 0.f, 0.f}, 0, 0, 0); \
        const f32x4 e1a = __builtin_amdgcn_mfma_f32_16x16x32_bf16(o_.a2lo, Bd0, (f32x4){0.f, 0.f, 0.f, 0.f}, 0, 0, 0); \
        const f32x4 dd = __builtin_amdgcn_mfma_f32_16x16x32_bf16(o_.a1hi, Bd1, d1a, 0, 0, 0); \
        const f32x4 ee = __builtin_amdgcn_mfma_f32_16x16x32_bf16(o_.a2hi, Bd1, e1a, 0, 0, 0); \
        const LAS float* pa_ = psp + (2 * (Q_)) * 8; const LAS float* pg_ = psp + 64 + (Q_) * 16; \
        const f32x4 pA0 = *(const LAS f32x4*)pa_, pA1 = *(const LAS f32x4*)(pa_ + 4), pB0 = *(const LAS f32x4*)(pa_ + 8), pB1 = *(const LAS f32x4*)(pa_ + 12); \
        const f32x4 g0 = *(const LAS f32x4*)pg_, g1 = *(const LAS f32x4*)(pg_ + 4), g2 = *(const LAS f32x4*)(pg_ + 8), g3 = *(const LAS f32x4*)(pg_ + 12); \
        f32x4 wv[4]; u32x2 bk[4]; \
        _Pragma("unroll") for (int k = 0; k < 4; ++k) { wv[k] = *(const LAS f32x4*)(bp + SCB_W + (4 * (Q_)) * SCP + 64 * k + w_off); \
            bk[k] = (u32x2){*(const LAS unsigned*)(bkp + (4 * (Q_)) * SCP + 64 * k), *(const LAS unsigned*)(bkp + (4 * (Q_) + 1) * SCP + 64 * k)}; } \
        const float v1 = o_.vv[0], v2 = o_.vv[1], v3 = o_.vv[2], v4 = o_.vv[3]; \
        const float u1 = dd[0]; \
        const float u2 = dd[1] + u1 * pA0[0] + v1 * pA0[1]; \
        const float f0 = ee[0] + u1 * g0[0] + v1 * g0[1] + u2 * g0[2] + v2 * g0[3]; \
        const float f1 = ee[1] + u1 * g1[0] + v1 * g1[1] + u2 * g1[2] + v2 * g1[3]; \
        const float u3 = f0; \
        const float u4 = f1 + u3 * pB0[0] + v3 * pB0[1]; \
        const unsigned b2lo = q == 0 ? pack_bf16(u1, v1) : (q == 1 ? pack_bf16(u3, v3) : 0u), b2hi = q == 0 ? pack_bf16(u2, v2) : (q == 1 ? pack_bf16(u4, v4) : 0u); \
        const s16x4v B2 = __builtin_bit_cast(s16x4v, (u32x2){b2lo, b2hi}); \
        _Pragma("unroll") for (int k = 0; k < 4; ++k) Sd[k] = __builtin_amdgcn_mfma_f32_16x16x16bf16_1k(__builtin_bit_cast(s16x4v, bk[k]), B2, Sd[k] * wv[k], 0, 0, 0); \
        const float f2 = ee[2] + u1 * g2[0] + v1 * g2[1] + u2 * g2[2] + v2 * g2[3]; \
        const float f3 = ee[3] + u1 * g3[0] + v1 * g3[1] + u2 * g3[2] + v2 * g3[3]; \
        yb[(4 * (Q_)) * 64 + 16 * w + i16] = dd[2] + u1 * pA0[2] + v1 * pA0[3]; \
        yb[(4 * (Q_) + 1) * 64 + 16 * w + i16] = dd[3] + u1 * pA1[0] + v1 * pA1[1] + u2 * pA1[2] + v2 * pA1[3]; \
        yb[(4 * (Q_) + 2) * 64 + 16 * w + i16] = f2 + u3 * pB0[2] + v3 * pB0[3]; \
        yb[(4 * (Q_) + 3) * 64 + 16 * w + i16] = f3 + u3 * pB1[0] + v3 * pB1[1] + u4 * pB1[2] + v4 * pB1[3]; } while (0)
            struct StepOps { float vv[4]; bf16x8 a1lo, a1hi, a2lo, a2hi; };
            volatile LAS int* rdy = (volatile LAS int*)(lds + SC_FLG); volatile LAS int* prog = rdy + 8;
            int buf = 0;
            for (int c = 0; c < NCH; ++c) {
                const LAS unsigned char* bp = lds + buf * SCB_SIZE; LAS float* yb = (LAS float*)(lds + SC_Y + buf * 4096);
                const LAS unsigned char* bkp = bp + SCB_BKZ + bkq_off;
                const LAS float* psp = (const LAS float*)(lds + SC_PS + buf * 512);
                lds_wait_ge(rdy + buf, c + 1);
                const bool conv = (c & 3) == w; float tv[16]; const int tr = u * NCH + c, ttab = tr >> 14, trow = tr & 16383;
                int ln2 = lane; asm volatile("" : "+v"(ln2));
                if (conv) fp8_row_load(F.in[ttab ? 30 : 29] + (size_t)N_EXPERTS * 1024, trow, ln2, tv);
                else {
#pragma unroll
                    for (int i = 0; i < 16; ++i) tv[i] = 0.f; }
                StepOps oa, ob; ST_LD(oa, 0);
                ST_LD(ob, 1); ST_STEP(oa, 0);
                ST_LD(oa, 2); ST_STEP(ob, 1);
                ST_LD(ob, 3); ST_STEP(oa, 2);
                ST_STEP(ob, 3);
                asm volatile("s_waitcnt lgkmcnt(0)" ::: "memory");
                if (lane == 0) prog[w] = c + 1;
                if (conv) fp8_row_store(tv, trow, ln2, F.ws + (ttab ? WS_PV1 : WS_PU1), (float*)(F.ws + WS_PSC) + (2 + ttab) * N_EXPERTS);
                buf = (buf + 1 == SC_NB) ? 0 : buf + 1;
            }
#undef ST_LD
#undef ST_STEP
            __builtin_amdgcn_s_setprio(0);
            __builtin_amdgcn_s_setprio(0);
        }
    }
    __syncthreads();
}

DI void unpack8(const u32x4 w, float* o) { o[0] = bf_lo(w.x); o[1] = bf_hi(w.x); o[2] = bf_lo(w.y); o[3] = bf_hi(w.y); o[4] = bf_lo(w.z); o[5] = bf_hi(w.z); o[6] = bf_lo(w.w); o[7] = bf_hi(w.w); }
DI void p_rwkv_post(const Frame& F) {
    const bf16_t* RK = (const bf16_t*)(F.ws + WS1_RK); const bf16_t* Y = (const bf16_t*)(F.ws + WS1_Y); const float* BON = (const float*)(F.ws + WS1_BON);
    const bf16_t* G = (const bf16_t*)(F.ws + WS1_G); bf16_t* A3 = (bf16_t*)(F.ws + WS1_A3);
    const float* ln_g = F.in[24]; const float* ln_b = F.in[25];
    const int lane = F.lane, c0 = 16 * lane, hd = lane >> 2;
    for (int t = F.bid * NWAVES + F.wave; t < T; t += F.G * NWAVES) {
        float y[16], tmp[16], vv[16], gg[16];
        unpack8(*(const u32x4*)(Y + (size_t)t * D + c0), y); unpack8(*(const u32x4*)(Y + (size_t)t * D + c0 + 8), y + 8);
        unpack8(*(const u32x4*)(Y + ((size_t)T + t) * D + c0), tmp); unpack8(*(const u32x4*)(Y + ((size_t)T + t) * D + c0 + 8), tmp + 8);
        unpack8(*(const u32x4*)(RK + (size_t)t * RW_N + 2048 + c0), vv); unpack8(*(const u32x4*)(RK + (size_t)t * RW_N + 2048 + c0 + 8), vv + 8);
        unpack8(*(const u32x4*)(G + (size_t)t * D + c0), gg); unpack8(*(const u32x4*)(G + (size_t)t * D + c0 + 8), gg + 8);
        const float bon = BON[(size_t)t * 16 + hd] + BON[((size_t)T + t) * 16 + hd];
        float sm = 0.f;
#pragma unroll
        for (int e = 0; e < 16; ++e) { y[e] += tmp[e]; sm += y[e]; }
        sm += __shfl_xor(sm, 1); sm += __shfl_xor(sm, 2);
        const float mu = sm * (1.0f / 64.0f);
        float vr = 0.f;
#pragma unroll
        for (int e = 0; e < 16; ++e) { const float d = y[e] - mu; vr += d * d; }
        vr += __shfl_xor(vr, 1); vr += __shfl_xor(vr, 2);
        const float rs = rsqrtf(vr * (1.0f / 64.0f) + 64e-5f);
        float o[16];
#pragma unroll
        for (int q = 0; q < 4; ++q) { const f32x4 lg = *(const f32x4*)(ln_g + c0 + 4 * q), lb = *(const f32x4*)(ln_b + c0 + 4 * q);
#pragma unroll
            for (int e = 0; e < 4; ++e) { const int i = 4 * q + e; o[i] = ((y[i] - mu) * rs * lg[e] + lb[e] + bon * vv[i]) * gg[i]; } }
        u32x4 w0, w1; w0.x = pack_bf16(o[0], o[1]); w0.y = pack_bf16(o[2], o[3]); w0.z = pack_bf16(o[4], o[5]); w0.w = pack_bf16(o[6], o[7]);
        w1.x = pack_bf16(o[8], o[9]); w1.y = pack_bf16(o[10], o[11]); w1.z = pack_bf16(o[12], o[13]); w1.w = pack_bf16(o[14], o[15]);
        *(u32x4*)(A3 + (size_t)t * D + c0) = w0; *(u32x4*)(A3 + (size_t)t * D + c0 + 8) = w1;
    }
}
__global__ void __launch_bounds__(NTHREADS, 2) mega_fwd(Params P) {
    extern __shared__ __attribute__((aligned(16))) unsigned char lds_raw[];
    Frame F;
    F.lds = (LAS unsigned char*)lds_raw;
    F.tid = threadIdx.x; F.lane = F.tid & 63; F.wave = __builtin_amdgcn_readfirstlane(F.tid >> 6);
    F.G = gridDim.x; F.bid = blockIdx.x; F.in = P.in; F.out = P.out; F.ws = P.ws;
    volatile LAS unsigned* bst = (volatile LAS unsigned*)(F.lds + LDS_BAR_OFF);
    if (F.tid == 0) { bst[0] = 0u; bst[1] = 0u; bst[2] = 0u; bst[3] = 0u; }
    __syncthreads();
    XcdBarrier bar = xcd_barrier_post((unsigned*)(P.ws + WS_CTL), bst);
    const int lo = P.ph_lo, hi = P.ph_hi;
#ifdef ONLY_PHASE
#define IN(k) ((k) == ONLY_PHASE && lo <= (k) && (k) < hi)
#else
#define IN(k) (lo <= (k) && (k) < hi)
#endif
#define SEAM(k) do { if (IN(k) && IN((k) + 1)) xcd_barrier(bar); } while (0)
#define LSEAM(k) do { if (IN(k) && IN((k) + 1)) __syncthreads(); } while (0)
#define LAUNDER(T, dst, src) T dst; { unsigned long long _v = (unsigned long long)(src); unsigned _lo = (unsigned)_v, _hi = (unsigned)(_v >> 32); asm volatile("" : "+s"(_lo), "+s"(_hi)); dst = (T)(__attribute__((address_space(1))) unsigned char*)(((unsigned long long)_hi << 32) | _lo); }
#define PH_BEGIN LAUNDER(unsigned char*, ws, P.ws) LAUNDER(float*, outp, P.out) F.ws = ws; F.out = outp; \
    const float* mod0 = (const float*)(ws + WS_MOD); const float* mod1 = mod0 + 8 * 6144; const float* norm_g = P.in[4]; bf16_t* H = (bf16_t*)(ws + WS_H); bf16_t* H2 = (bf16_t*)(ws + WS1_H2); \
    (void)mod0; (void)mod1; (void)norm_g; (void)H; (void)H2;

    if (IN(0)) { PH_BEGIN p0_prologue(F); } SEAM(0);
    if (IN(1)) { PH_BEGIN p_norm<false>(F, P.in[0], norm_g + 0 * 1024, mod0, 0, 1024, H); } SEAM(1);
    if (IN(2)) { PH_BEGIN pg8::Gemm g{H, (const bf16_t*)(ws + WS_WIN_T), T, IN_W, 1024, 1024, 1024}; pg8::StaticOrder S; S.init(T, IN_W, F.G, F.bid);
        pg8::EpiBf16<0> E{(bf16_t*)(ws + WS_QKV), IN_W}; pg8::gemm_phase(F.lds, g, S, E);
        p0_late_weights(F, (T / 256) * (IN_W / 256)); } SEAM(2);
    if (IN(3)) { PH_BEGIN p_qkprep(F); } SEAM(3);
    if (IN(4)) { PH_BEGIN p_attention<3>(F); } SEAM(4);
    if (IN(5)) { PH_BEGIN pg8::Gemm g{(const bf16_t*)(ws + WS_O), (const bf16_t*)(ws + WS_WOUT_T), T, 1024, 1024, 1024, 1024}; pg8::StaticOrder S; S.init(T, 1024, F.G, F.bid);
        pg8::EpiResid<false> E{P.in[0], (bf16_t*)(ws + WS_XB), mod0 + 2048, (float*)(ws + WS_SSQ)}; pg8::gemm_phase(F.lds, g, S, E); } SEAM(5);
    if (IN(7)) { PH_BEGIN pg8::Gemm g{(const bf16_t*)(ws + WS_XB), (const bf16_t*)outp, T, 2048, 1024, 1024, 1024}; pg8::BatchOrder S; S.init(T, 2048, F.G, F.bid);
        pg8::EpiQ E{(bf16_t*)(ws + WS_PQ), PQ_LD, (const float*)(ws + WS_SSQ), (const float*)(ws + WS_BQ), nullptr, -1}; { pg8::Unit u0; E.prep(F.lds, S.next(0, u0) ? u0.pm : -1, F.tid); } pg8::gemm_phase(F.lds, g, S, E); } SEAM(7);
    if (IN(8)) { PH_BEGIN p_peer_topk(F, (const bf16_t*)(ws + WS_PQ), (const bf16_t*)(ws + WS_SK), (int*)(ws + WS_EIDX), (float*)(ws + WS_GATE)); } LSEAM(8);
    if (IN(9)) { PH_BEGIN p_peer_gather<false>(F, norm_g + 1 * 1024, mod0, ws + WS_PU0, ws + WS_PV0, (const float*)(ws + WS_PSC), (const float*)(ws + WS_PSC) + N_EXPERTS, (const int*)(ws + WS_EIDX), (const float*)(ws + WS_GATE), mod0 + 5120, (bf16_t*)(ws + WS_XB), outp); } SEAM(9);
    if (IN(10)) { PH_BEGIN p_rwkv_prep(F, (const bf16_t*)(ws + WS_XB), norm_g + 2 * 1024, mod1, P.in[11], (bf16_t*)(ws + WS1_X6)); } SEAM(10);
    if (IN(11)) { PH_BEGIN pg8::Gemm g{(const bf16_t*)(ws + WS1_X6), (const bf16_t*)(ws + WS_WRW_T), 6 * T, RW_N, 1024, 1024, 1024}; pg8::RwOrder S; S.init(F.G, F.bid);
        pg8::EpiBf16<1> E{(bf16_t*)(ws + WS1_RK), RW_N}; pg8::gemm_phase(F.lds, g, S, E);
        p0_late_weights2(F); } SEAM(11);
    if (IN(12)) { PH_BEGIN pg8::Gemm g{(const bf16_t*)(ws + WS1_RK) + 3584, (const bf16_t*)(ws + WS_G2_T), T, 1024, 256, RW_N, 256}; pg8::StaticOrder S; S.init(T, 1024, F.G, F.bid);
        pg8::EpiBf16<0> E{(bf16_t*)(ws + WS1_G), 1024}; pg8::gemm_phase(F.lds, g, S, E); }
    if (IN(13)) { PH_BEGIN p_rwkv_scan(F); } SEAM(13);
    if (IN(14)) { PH_BEGIN p_rwkv_post(F); } SEAM(14);
    if (IN(15)) { PH_BEGIN pg8::Gemm g{(const bf16_t*)(ws + WS1_A3), (const bf16_t*)(ws + WS_WO_T), T, 1024, 1024, 1024, 1024}; pg8::StaticOrder S; S.init(T, 1024, F.G, F.bid);
        pg8::EpiResid<true> E{ws + WS_XB, (bf16_t*)(ws + WS_XB), mod1 + 2048, (float*)(ws + WS_SSQ)}; pg8::gemm_phase(F.lds, g, S, E); } SEAM(15);
    if (IN(17)) { PH_BEGIN pg8::Gemm g{(const bf16_t*)(ws + WS_XB), (const bf16_t*)outp + (size_t)8 * 2048 * 1024, T, 2048, 1024, 1024, 1024}; pg8::BatchOrder S; S.init(T, 2048, F.G, F.bid);
        pg8::EpiQ E{(bf16_t*)(ws + WS1_PQ), PQ_LD, (const float*)(ws + WS_SSQ), (const float*)(ws + WS_BQ) + 8 * 2048, nullptr, -1}; { pg8::Unit u0; E.prep(F.lds, S.next(0, u0) ? u0.pm : -1, F.tid); } pg8::gemm_phase(F.lds, g, S, E); } SEAM(17);
    if (IN(18)) { PH_BEGIN p_peer_topk(F, (const bf16_t*)(ws + WS1_PQ), (const bf16_t*)(ws + WS_SK) + (size_t)16 * 128 * 128, (int*)(ws + WS1_EIDX), (float*)(ws + WS1_GATE)); } LSEAM(18);
    if (IN(19)) { PH_BEGIN p_peer_gather<true>(F, norm_g + 3 * 1024, mod1, ws + WS_PU1, ws + WS_PV1, (const float*)(ws + WS_PSC) + 2 * N_EXPERTS, (const float*)(ws + WS_PSC) + 3 * N_EXPERTS, (const int*)(ws + WS1_EIDX), (const float*)(ws + WS1_GATE), mod1 + 5120, (bf16_t*)(ws + WS_XB), outp); }
    if (hi <= 5) { const f32x4* s = (const f32x4*)P.in[0]; f32x4* d = (f32x4*)P.out;
        for (size_t i = (size_t)F.bid * NTHREADS + F.tid; i < (size_t)T * D / 4; i += (size_t)F.G * NTHREADS) d[i] = s[i]; }
#undef IN
#undef SEAM
#undef LSEAM
}

#ifndef PH_HI
#define PH_HI 20
#endif
extern "C" void kernel_launch(void* const* d_in, const int* in_sizes, int n_in, void* d_out, int out_size, void* d_ws, size_t ws_size, hipStream_t stream) {
    static int grid = 0;
    if (grid == 0) {
        if (n_in != 31 || out_size != T * D || ws_size < WS_END) { fprintf(stderr, "kernel_launch: unexpected shapes (n_in %d, out %d, ws %zu)\n", n_in, out_size, ws_size); grid = -1; return; }
        int dev = 0, cus = 0, per_cu = 0;
        if (hipGetDevice(&dev) != hipSuccess || hipDeviceGetAttribute(&cus, hipDeviceAttributeMultiprocessorCount, dev) != hipSuccess) { grid = -1; return; }
        if (hipFuncSetAttribute((const void*)mega_fwd, hipFuncAttributeMaxDynamicSharedMemorySize, LDS_BYTES) != hipSuccess) { fprintf(stderr, "kernel_launch: hipFuncSetAttribute failed\n"); grid = -1; return; }
        if (hipOccupancyMaxActiveBlocksPerMultiprocessor(&per_cu, (const void*)mega_fwd, NTHREADS, LDS_BYTES) != hipSuccess || per_cu < 1) { fprintf(stderr, "kernel_launch: occupancy query says %d\n", per_cu); (void)hipGetLastError(); grid = -1; return; }
        grid = cus;
    }
    if (grid < 0) return;
    (void)hipMemsetAsync((char*)d_ws + WS_CTL, 0, CTL_ZERO_BYTES, stream);
    Params p{};
    for (int i = 0; i < 31; ++i) p.in[i] = (const float*)d_in[i];
    p.out = (float*)d_out; p.ws = (unsigned char*)d_ws; p.ph_lo = 0; p.ph_hi = PH_HI;
    hipLaunchKernelGGL(mega_fwd, dim3(grid), dim3(NTHREADS), LDS_BYTES, stream, p);
}
```

```cpp
#include <hip/hip_runtime.h>
#include <cstdio>
#include <cstdint>

#define DI __device__ __forceinline__
#define LAS __attribute__((address_space(3)))
typedef unsigned short bf16_t;
typedef short bf16x8 __attribute__((ext_vector_type(8)));
typedef short s16x4 __attribute__((ext_vector_type(4)));
typedef float f32x2 __attribute__((ext_vector_type(2)));
typedef float f32x4 __attribute__((ext_vector_type(4)));
typedef float f32x16 __attribute__((ext_vector_type(16)));
typedef unsigned u32x2 __attribute__((ext_vector_type(2)));
typedef unsigned u32x4 __attribute__((ext_vector_type(4)));
typedef __bf16 bf16x2v __attribute__((ext_vector_type(2)));

DI unsigned pack_bf16(float lo, float hi) { bf16x2v p; p[0] = (__bf16)lo; p[1] = (__bf16)hi; return __builtin_bit_cast(unsigned, p); }
DI float bf_lo(unsigned u) { return __uint_as_float(u << 16); }
DI float bf_hi(unsigned u) { return __uint_as_float(u & 0xffff0000u); }
DI float bf1(bf16_t v) { return __uint_as_float(((unsigned)v) << 16); }
DI float wave_sum(float v) {
#pragma unroll
    for (int o = 32; o > 0; o >>= 1) v += __shfl_xor(v, o);
    return v;
}
DI float sigmoidf_(float x) { return 1.0f / (1.0f + __expf(-x)); }

constexpr int D = 1024, BATCH = 8, SEQ = 2048, T = BATCH * SEQ;
constexpr int IN_W = 2304;
constexpr int NTHREADS = 512, NWAVES = 8;
constexpr int PQ_LD = 2112;
constexpr int N_EXPERTS = 16384;
constexpr float LOG2E = 1.4426950408889634f;
constexpr float QSCALE = 0.125f * LOG2E;
constexpr size_t MiB = 1ull << 20;

constexpr size_t WS_CTL   = 0;
constexpr size_t CTL_ZERO_BYTES = 16384;
constexpr size_t WS_MOD   = 64 * 1024;
constexpr size_t WS_PSC   = 512 * 1024;
constexpr size_t WS_WIN_T = 1 * MiB;
constexpr size_t WS_WOUT_T= 6 * MiB;
constexpr size_t WS_WRW_T = 8 * MiB;
constexpr size_t WS_W2_T  = 22 * MiB;
constexpr size_t WS_SSQ   = 22 * MiB;
constexpr size_t WS_BQ    = 768 * 1024;
constexpr size_t WS_WO_T  = 27 * MiB;
constexpr size_t WS_WQ_T  = 29 * MiB;
constexpr size_t WS_SK    = 37 * MiB;
constexpr size_t WS_PU1   = 38 * MiB;
constexpr size_t WS_PV1   = 54 * MiB;
constexpr size_t WS_XB    = 70 * MiB;
constexpr size_t WS_PU0   = 102 * MiB;
constexpr size_t WS_PV0   = 134 * MiB;
constexpr size_t WS_ACT   = 166 * MiB;
constexpr size_t WS_H     = WS_ACT + 0 * MiB;
constexpr size_t WS_QKV   = WS_ACT + 32 * MiB;
constexpr size_t WS_QA    = WS_ACT + 104 * MiB;
constexpr size_t WS_KA    = WS_ACT + 120 * MiB;
constexpr size_t WS_VAT   = WS_ACT + 136 * MiB;
constexpr size_t WS_QB    = WS_ACT + 152 * MiB;
constexpr size_t WS_KB    = WS_ACT + 168 * MiB;
constexpr size_t WS_VBT   = WS_ACT + 172 * MiB;
constexpr size_t WS_O     = WS_ACT + 176 * MiB;
constexpr size_t WS_PQ    = WS_ACT + 208 * MiB;
constexpr size_t WS_EIDX  = WS_ACT + 276 * MiB;
constexpr size_t WS_GATE  = WS_ACT + 284 * MiB;
constexpr size_t WS_O0S   = WS_ACT + 292 * MiB;
constexpr size_t WS1_RK   = 102 * MiB;
constexpr size_t WS1_DEC  = 222 * MiB;
constexpr size_t WS1_AZ   = 350 * MiB;
constexpr size_t WS1_G    = 414 * MiB;
constexpr size_t WS1_Y    = 446 * MiB;
constexpr size_t WS1_BON  = 510 * MiB;
constexpr size_t WS1_X6   = 222 * MiB;
constexpr size_t WS1_A3   = 222 * MiB;
constexpr size_t WS1_H2   = 254 * MiB;
constexpr size_t WS1_PQ   = 286 * MiB;
constexpr size_t WS1_EIDX = 354 * MiB;
constexpr size_t WS1_GATE = 362 * MiB;
constexpr size_t WS_END   = 512 * MiB;
constexpr int RW_N = 3840, W2_N = 4096, W2_K = 512;
constexpr size_t WS_G2_T  = 26 * MiB;

constexpr int LDS_BYTES = 147456;
constexpr int LDS_BAR_OFF = 147456 - 64;
#define XB_TMO      128
#define XB_XCNT(j)  (256  + 64 * (j))
#define XB_XSUB(j)  (1280 + 64 * (j))
#define XB_XGEN(j)  (2304 + 64 * (j))
#define XB_TOP      3328
#define XB_TOPGEN   3392
#define XCD_BAR_WORDS 3456
#define XB_SPIN_CAP (1u << 18)

__device__ __forceinline__ unsigned xb_ld(unsigned* p)              { return __hip_atomic_load(p, __ATOMIC_RELAXED, __HIP_MEMORY_SCOPE_AGENT); }
__device__ __forceinline__ unsigned xb_add(unsigned* p, unsigned v) { return __hip_atomic_fetch_add(p, v, __ATOMIC_RELAXED, __HIP_MEMORY_SCOPE_AGENT); }
__device__ __forceinline__ unsigned xb_xcc_id() { return (unsigned)__builtin_amdgcn_s_getreg((3 << 11) | 20) & 0xFu; }
#define XB_SPIN(cond, bar) do { unsigned _sp = 0; while (cond) { __builtin_amdgcn_s_sleep(1); \
    if ((++_sp & 255u) == 0u) { if (xb_ld(&(bar)[XB_TMO])) break; if (_sp > XB_SPIN_CAP) { atomicAdd(&(bar)[XB_TMO], 1u); break; } } } } while (0)

struct XcdBarrier { unsigned* bar; unsigned x; volatile LAS unsigned* st; };

__device__ __forceinline__ XcdBarrier xcd_barrier_post(unsigned* bar, volatile LAS unsigned* st) {
    XcdBarrier b; b.bar = bar; b.x = xb_xcc_id(); b.st = st;
    if (threadIdx.x == 0) (void)xb_add(&bar[XB_XCNT(b.x)], 1u);
    return b;
}
__device__ __forceinline__ void xcd_barrier_complete(unsigned* bar, unsigned x, unsigned& nloc, unsigned& nx) {
    const unsigned G = gridDim.x * gridDim.y * gridDim.z;
    unsigned sum, cnt, mine, sp = 0u;
    for (;;) {
        sum = 0u; cnt = 0u; mine = 0u;
#pragma unroll
        for (unsigned j = 0; j < 16; ++j) { const unsigned c = xb_ld(&bar[XB_XCNT(j)]); sum += c; cnt += (c > 0u) ? 1u : 0u; mine = (j == x) ? c : mine; }
        if (sum == G) break;
        __builtin_amdgcn_s_sleep(1);
        if ((++sp & 255u) == 0u) { if (xb_ld(&bar[XB_TMO])) break; if (sp > XB_SPIN_CAP) { atomicAdd(&bar[XB_TMO], 1u); break; } }
    }
    nloc = mine > 0u ? mine : 1u; nx = cnt > 0u ? cnt : 1u;
}
__device__ __forceinline__ void xcd_barrier(const XcdBarrier& b) {
    asm volatile("s_waitcnt vmcnt(0)" ::: "memory");
    __syncthreads();
    if (threadIdx.x == 0) {
        unsigned* bar; { unsigned long long pv = (unsigned long long)b.bar; unsigned plo = (unsigned)pv, phi = (unsigned)(pv >> 32); asm volatile("" : "+s"(plo), "+s"(phi)); bar = (unsigned*)(__attribute__((address_space(1))) unsigned*)(((unsigned long long)phi << 32) | plo); }
        __builtin_amdgcn_s_waitcnt(0);
        unsigned nloc = b.st[0], nx = b.st[1];
        if (nloc == 0u) { xcd_barrier_complete(bar, b.x, nloc, nx); b.st[0] = nloc; b.st[1] = nx; }
        const unsigned old = xb_add(&bar[XB_XSUB(b.x)], 1u);
        const unsigned gen = old / nloc;
        if (old + 1u == (gen + 1u) * nloc) {
            __builtin_amdgcn_fence(__ATOMIC_RELEASE, "agent");
            asm volatile("s_waitcnt vmcnt(0)" ::: "memory");
            const unsigned og = xb_add(&bar[XB_TOP], 1u);
            const unsigned tg = og / nx;
            if (og + 1u == (tg + 1u) * nx) xb_add(&bar[XB_TOPGEN], 1u);
            else XB_SPIN(xb_ld(&bar[XB_TOPGEN]) == tg, bar);
            __builtin_amdgcn_fence(__ATOMIC_ACQUIRE, "agent");
            xb_add(&bar[XB_XGEN(b.x)], 1u);
            asm volatile("s_waitcnt vmcnt(0)" ::: "memory");
        } else {
            XB_SPIN(xb_ld(&bar[XB_XGEN(b.x)]) == gen, bar);
            __builtin_amdgcn_fence(__ATOMIC_ACQUIRE, "agent");
            asm volatile("s_waitcnt vmcnt(0)" ::: "memory");
        }
    }
    __syncthreads();
}
namespace pg8 {
constexpr int BM = 256, BK = 64, HALF = 128, HTB = HALF * BK * 2, STAGE_BYTES = 8 * HTB, NXCD = 8, WGM = 8;
__host__ __device__ __forceinline__ int lds_byte(int r, int c) { const int st = (r >> 4) * 2 + (c >> 5), rr = r & 15, cc = c & 31, ob = rr * 64 + cc * 2; return st * 1024 + (ob ^ (((ob >> 9) & 1) << 5)); }
__host__ __device__ __forceinline__ void stage_rc(int b, int& R, int& C) { const int st = b / 1024, sb = b % 1024, swz = sb ^ (((sb >> 9) & 1) << 5); R = (st >> 1) * 16 + swz / 64; C = (st & 1) * 32 + (swz % 64) / 2; }
__host__ __device__ __forceinline__ int perm32(int rho) { const int n = rho >> 4, i = rho & 15; return 8 * (i >> 2) + 4 * n + (i & 3); }

struct Unit { int pm, pn; };
struct Gemm { const bf16_t* A; const bf16_t* Bt; int M, N, K, lda, ldb; };

struct StaticOrder {
    int nM, nN, nwg, G, c;
    __device__ void init(int M, int N, int G_, int c_) { nM = M / BM; nN = N / BM; nwg = nM * nN; G = G_; c = c_; }
    __device__ __forceinline__ bool next(int i, Unit& u) const {
        const long L = (long)i * G + c; if (L >= nwg) return false;
        int wgid = (int)L; { const int q = nwg / NXCD, r = nwg % NXCD, xcd = wgid % NXCD, off = wgid / NXCD; wgid = (xcd < r ? xcd * (q + 1) : r * (q + 1) + (xcd - r) * q) + off; }
        const int nig = WGM * nN, gid = wgid / nig, fm = gid * WGM, gsz = (nM - fm) < WGM ? (nM - fm) : WGM;
        u.pm = fm + ((wgid % nig) % gsz); u.pn = (wgid % nig) / gsz; return true;
    }
};

struct BatchOrder {
    StaticOrder S;
    __device__ void init(int M, int N, int G_, int c_) { S.init(M, N, G_, c_); }
    __device__ __forceinline__ bool next(int i, Unit& u) const { if (!S.next(i, u)) return false; u.pn += (u.pm / (SEQ / BM)) * S.nN; return true; }
};

struct RwOrder {
    int G, c;
    __device__ void init(int G_, int c_) { G = G_; c = c_; }
    __device__ __forceinline__ bool next(int i, Unit& u) const {
        int grp, pm, pn;
        if ((G & 7) == 0) { const int x = c & 7, n = i * (G >> 3) + (c >> 3); if (n >= 120) return false;
            const int pmh = n / 15, e = n % 15; pm = x + 8 * pmh;
            if (e < 12) { grp = e >> 2; pn = grp * 4 + (e & 3); } else { grp = 3 + (e - 12); pn = 12 + (e - 12); } }
        else { const int L = i * G + c; if (L >= 960) return false;
            if (L < 768) { grp = L >> 8; pm = L & 63; pn = grp * 4 + ((L >> 6) & 3); } else { const int w = L - 768; grp = 3 + (w >> 6); pm = w & 63; pn = 12 + (grp - 3); } }
        u.pm = grp * 64 + pm; u.pn = pn; return true;
    }
};
template <class Epi, class Sched>
__device__ __forceinline__ void gemm_phase(LAS unsigned char* lds, const Gemm g, const Sched& S, const Epi& E) {
    const int tid = threadIdx.x, wid = __builtin_amdgcn_readfirstlane(tid >> 6), lane = tid & 63, wr = wid >> 2, wc = wid & 3, fr = lane & 15, fq = lane >> 4;
    const int K = g.K, nt = K / BK;
    unsigned voffA[2], voffB[2];
#pragma unroll
    for (int i = 0; i < 2; ++i) { int R, C; stage_rc(tid * 16 + i * 8192, R, C); const int Rb = Epi::PERM ? ((R & ~31) + perm32(R & 31)) : R;
        voffA[i] = (unsigned)(R * g.lda + C) * 2u; voffB[i] = (unsigned)(Rb * g.ldb + C) * 2u; }
    const size_t kstep = (size_t)(BK * 2);
    const size_t hstepA = (size_t)HALF * g.lda * 2, hstepB = (size_t)HALF * g.ldb * 2;
    const size_t tstepA = 2 * hstepA, tstepB = 2 * hstepB;
    const unsigned ldsw = (unsigned)wid * 1024u;
    const int aoff = lds_byte(wr * 64 + fr, fq * 8), boff = lds_byte(wc * 32 + fr, fq * 8);
#define PG8_SA(b, h) (((b) * 2 + (h)) * HTB)
#define PG8_SB(b, h) ((4 + (b) * 2 + (h)) * HTB)
#define PG8_STAGE(bufoff, gbase, voff) do { _Pragma("unroll") for (int _i = 0; _i < 2; ++_i) \
        __builtin_amdgcn_global_load_lds((const unsigned*)((const char*)(gbase) + (voff)[_i]), (LAS unsigned*)(lds + (bufoff) + ldsw + _i * 8192), 16, 0, 0); } while (0)
#define PG8_LDA(dst, b, h) do { _Pragma("unroll") for (int m = 0; m < 4; ++m) _Pragma("unroll") for (int k = 0; k < 2; ++k) dst[m][k] = *(const LAS bf16x8*)(lds + PG8_SA(b, h) + aoff + m * 2048 + k * 1024); } while (0)
#define PG8_LDB(dst, b, h) do { _Pragma("unroll") for (int n = 0; n < 2; ++n) _Pragma("unroll") for (int k = 0; k < 2; ++k) dst[n][k] = *(const LAS bf16x8*)(lds + PG8_SB(b, h) + boff + n * 2048 + k * 1024); } while (0)
#define PG8_MMA(ai, bj, At, Bt) do { __builtin_amdgcn_s_setprio(1); _Pragma("unroll") for (int m = 0; m < 4; ++m) _Pragma("unroll") for (int n = 0; n < 2; ++n) _Pragma("unroll") for (int k = 0; k < 2; ++k) \
        acc[ai][bj][m][n] = __builtin_amdgcn_mfma_f32_16x16x32_bf16(Bt[n][k], At[m][k], acc[ai][bj][m][n], 0, 0, 0); __builtin_amdgcn_s_setprio(0); } while (0)
#define PG8_WAIT_V(n) asm volatile("s_waitcnt vmcnt(" #n ")" ::: "memory")
#define PG8_WAIT_L(n) asm volatile("s_waitcnt lgkmcnt(" #n ")" ::: "memory")
#define PG8_BAR __builtin_amdgcn_s_barrier()
#define PG8_SCHED __builtin_amdgcn_sched_barrier(0)
    Unit cur, nxt; int ui = 0;
    if (!S.next(0, cur)) return;
    f32x4 acc[2][2][4][2];
#pragma unroll
    for (int a = 0; a < 2; ++a)
#pragma unroll
        for (int b = 0; b < 2; ++b)
#pragma unroll
            for (int m = 0; m < 4; ++m)
#pragma unroll
                for (int n = 0; n < 2; ++n) acc[a][b][m][n] = (f32x4){0.f, 0.f, 0.f, 0.f};
    bf16x8 At[4][2], B0[2][2], B1[2][2];
    const char* cA = (const char*)g.A + (size_t)cur.pm * tstepA; const char* cB = (const char*)g.Bt + (size_t)cur.pn * tstepB;
    PG8_STAGE(PG8_SB(0, 0), cB, voffB); PG8_STAGE(PG8_SA(0, 0), cA, voffA); PG8_STAGE(PG8_SB(0, 1), cB + hstepB, voffB); PG8_STAGE(PG8_SA(0, 1), cA + hstepA, voffA);
    if (wr == 1) PG8_BAR;
    PG8_WAIT_V(4); PG8_BAR;
    PG8_STAGE(PG8_SB(1, 0), cB + kstep, voffB); PG8_STAGE(PG8_SA(1, 0), cA + kstep, voffA); PG8_STAGE(PG8_SB(1, 1), cB + hstepB + kstep, voffB);
    PG8_WAIT_V(6); PG8_BAR;
    for (;;) {
        const bool has_next = S.next(ui + 1, nxt);
        const char* nA = has_next ? (const char*)g.A + (size_t)nxt.pm * tstepA : cA; const char* nB = has_next ? (const char*)g.Bt + (size_t)nxt.pn * tstepB : cB;
        for (int t = 0; t < nt; t += 2) {
            const bool last = (t == nt - 2);
            const char* a1 = cA + (size_t)(t + 1) * kstep;
            const char* a2 = last ? nA : cA + (size_t)(t + 2) * kstep; const char* b2 = last ? nB : cB + (size_t)(t + 2) * kstep;
            const char* a3 = a2 + kstep; const char* b3 = b2 + kstep;
            PG8_LDB(B0, 0, 0); PG8_SCHED; PG8_LDA(At, 0, 0); PG8_STAGE(PG8_SA(1, 1), a1 + hstepA, voffA);
            PG8_WAIT_L(8); PG8_BAR; PG8_WAIT_L(0); PG8_MMA(0, 0, At, B0); PG8_BAR; PG8_SCHED;
            PG8_LDB(B1, 0, 1); PG8_STAGE(PG8_SB(0, 0), b2, voffB);
            PG8_BAR; PG8_WAIT_L(0); PG8_MMA(0, 1, At, B1); PG8_BAR;
            PG8_LDA(At, 0, 1); PG8_STAGE(PG8_SA(0, 0), a2, voffA);
            PG8_BAR; PG8_WAIT_L(0); PG8_MMA(1, 0, At, B0); PG8_BAR; PG8_SCHED;
            PG8_STAGE(PG8_SB(0, 1), b2 + hstepB, voffB);
            PG8_WAIT_V(6); PG8_BAR; PG8_MMA(1, 1, At, B1); PG8_BAR;
            PG8_LDB(B0, 1, 0); PG8_SCHED; PG8_LDA(At, 1, 0); PG8_STAGE(PG8_SA(0, 1), a2 + hstepA, voffA);
            PG8_WAIT_L(8); PG8_BAR; PG8_WAIT_L(0); PG8_MMA(0, 0, At, B0); PG8_BAR; PG8_SCHED;
            PG8_LDB(B1, 1, 1); PG8_STAGE(PG8_SB(1, 0), b3, voffB);
            PG8_BAR; PG8_WAIT_L(0); PG8_MMA(0, 1, At, B1); PG8_BAR;
            PG8_LDA(At, 1, 1); PG8_STAGE(PG8_SA(1, 0), a3, voffA);
            PG8_BAR; PG8_WAIT_L(0); PG8_MMA(1, 0, At, B0); PG8_BAR; PG8_SCHED;
            PG8_STAGE(PG8_SB(1, 1), b3 + hstepB, voffB);
            PG8_WAIT_V(6); PG8_BAR; PG8_MMA(1, 1, At, B1); PG8_BAR;
        }
        E(acc, cur, wr, wc, fr, fq);
        if (!has_next) break;
#pragma unroll
        for (int a = 0; a < 2; ++a)
#pragma unroll
            for (int b = 0; b < 2; ++b)
#pragma unroll
                for (int m = 0; m < 4; ++m)
#pragma unroll
                    for (int n = 0; n < 2; ++n) acc[a][b][m][n] = (f32x4){0.f, 0.f, 0.f, 0.f};
        cur = nxt; cA = nA; cB = nB; ++ui;
    }
    PG8_WAIT_V(0);
    if (wr == 0) PG8_BAR;
    PG8_BAR;
#undef PG8_SA
#undef PG8_SB
#undef PG8_STAGE
#undef PG8_LDA
#undef PG8_LDB
#undef PG8_MMA
#undef PG8_WAIT_V
#undef PG8_WAIT_L
#undef PG8_BAR
#undef PG8_SCHED
}

template <int ACT> struct EpiBf16 {
    static constexpr bool PERM = true;
    __device__ __forceinline__ void prefetch(LAS unsigned char*, const Unit&, int) const {}
    bf16_t* O; int ldc;
    __device__ __forceinline__ void operator()(const f32x4 (&acc)[2][2][4][2], const Unit& u, int wr, int wc, int fr, int fq) const {
        const int row0 = (ACT == 1 ? (u.pm & 63) : u.pm) * BM + wr * 64 + fr; const int col0 = u.pn * BM + wc * 32 + 8 * fq;
#pragma unroll
        for (int ai = 0; ai < 2; ++ai)
#pragma unroll
            for (int m = 0; m < 4; ++m) { bf16_t* rowp = O + (size_t)(row0 + ai * HALF + m * 16) * ldc + col0;
#pragma unroll
                for (int bj = 0; bj < 2; ++bj) { f32x4 v0 = acc[ai][bj][m][0], v1 = acc[ai][bj][m][1];
                    if (ACT == 1) { const int c = col0 + bj * HALF;
                        if (c >= 3072 && c < 3200) {
#pragma unroll
                            for (int e = 0; e < 4; ++e) { v0[e] = tanhf(v0[e]); v1[e] = tanhf(v1[e]); } }
                        else if (c >= 3584 && c < 3712) {
#pragma unroll
                            for (int e = 0; e < 4; ++e) { v0[e] = sigmoidf_(v0[e]); v1[e] = sigmoidf_(v1[e]); } } }
                    u32x4 w; w.x = pack_bf16(v0[0], v0[1]); w.y = pack_bf16(v0[2], v0[3]); w.z = pack_bf16(v1[0], v1[1]); w.w = pack_bf16(v1[2], v1[3]);
                    *(u32x4*)(rowp + bj * HALF) = w; } }
    }
};
template <bool IN_BF16> struct EpiResid {
    static constexpr bool PERM = false;
    __device__ __forceinline__ void prefetch(LAS unsigned char* lds, const Unit& u, int tid) const {
        constexpr int RB = IN_BF16 ? 512 : 1024, LPR = RB / 128, NL = 256 * LPR;
        const char* base = (const char*)xin + ((size_t)u.pm * BM * D + (size_t)u.pn * BM) * (IN_BF16 ? 2 : 4);
#pragma unroll
        for (int i = 0; i < NL / NTHREADS; ++i) { const int ln = i * NTHREADS + tid, r = ln / LPR, c = ln % LPR;
            __builtin_amdgcn_global_load_lds((const unsigned*)(base + (size_t)r * D * (IN_BF16 ? 2 : 4) + c * 128), (LAS unsigned*)(lds + STAGE_BYTES + 2048 + (tid >> 6) * 256), 4, 0, 0); }
    }
    const void* xin; bf16_t* out; const float* gate; float* ssq;
    __device__ __forceinline__ void operator()(const f32x4 (&acc)[2][2][4][2], const Unit& u, int wr, int wc, int fr, int fq) const {
        const int row0 = u.pm * BM + wr * 64 + fr, col0 = u.pn * BM + wc * 32 + 4 * fq;
        const float* gp = gate + (size_t)((u.pm * BM) / SEQ) * 6144 + col0;
        f32x4 gv[2][2];
#pragma unroll
        for (int bj = 0; bj < 2; ++bj)
#pragma unroll
            for (int n = 0; n < 2; ++n) gv[bj][n] = *(const f32x4*)(gp + bj * HALF + n * 16);
#pragma unroll
        for (int ai = 0; ai < 2; ++ai)
#pragma unroll
            for (int m = 0; m < 4; ++m) { const size_t off = (size_t)(row0 + ai * HALF + m * 16) * D + col0; float ss = 0.f;
#pragma unroll
                for (int bj = 0; bj < 2; ++bj)
#pragma unroll
                    for (int n = 0; n < 2; ++n) { f32x4 xv;
                        if (IN_BF16) { const u32x2 w = *(const u32x2*)((const bf16_t*)xin + off + bj * HALF + n * 16); xv = (f32x4){bf_lo(w.x), bf_hi(w.x), bf_lo(w.y), bf_hi(w.y)}; }
                        else xv = *(const f32x4*)((const float*)xin + off + bj * HALF + n * 16);
                        const f32x4 r = xv + gv[bj][n] * acc[ai][bj][m][n];
                        ss += (r[0] * r[0] + r[1] * r[1]) + (r[2] * r[2] + r[3] * r[3]);
                        *(u32x2*)(out + off + bj * HALF + n * 16) = (u32x2){pack_bf16(r[0], r[1]), pack_bf16(r[2], r[3])}; }
                ss += __shfl_xor(ss, 16); ss += __shfl_xor(ss, 32);
                if (fq == 0) ssq[(size_t)(row0 + ai * HALF + m * 16) * 16 + u.pn * 4 + wc] = ss; }
    }
};
struct EpiQ {
    static constexpr bool PERM = true;
    __device__ __forceinline__ void prefetch(LAS unsigned char*, const Unit&, int) const {}
    bf16_t* O; int ldc; const float* ssq; const float* bq; const LAS float* rl; int pm_l;
    __device__ __forceinline__ void prep(LAS unsigned char* lds, int pm, int tid) { LAS float* w = (LAS float*)(lds + STAGE_BYTES); rl = w; pm_l = pm;
        if (pm >= 0 && tid < BM) { const f32x4* sp = (const f32x4*)(ssq + (size_t)(pm * BM + tid) * 16); const f32x4 s4 = (sp[0] + sp[1]) + (sp[2] + sp[3]);
            w[tid] = rsqrtf(((s4[0] + s4[1]) + (s4[2] + s4[3])) * (1.0f / 1024.0f) + 1e-6f); }
        __syncthreads(); }
    __device__ __forceinline__ void operator()(const f32x4 (&acc)[2][2][4][2], const Unit& u, int wr, int wc, int fr, int fq) const {
        const int row0 = u.pm * BM + wr * 64 + fr; const int col0 = (u.pn & 7) * BM + wc * 32 + 8 * fq;
        const float* bp = bq + (size_t)(u.pn >> 3) * 2048 + col0;
        f32x4 b0[2], b1[2];
#pragma unroll
        for (int bj = 0; bj < 2; ++bj) { b0[bj] = *(const f32x4*)(bp + bj * HALF); b1[bj] = *(const f32x4*)(bp + bj * HALF + 4); }
#pragma unroll
        for (int ai = 0; ai < 2; ++ai)
#pragma unroll
            for (int m = 0; m < 4; ++m) { const int r = row0 + ai * HALF + m * 16; bf16_t* rowp = O + (size_t)r * ldc + col0;
                float rinv;
                if (u.pm == pm_l) rinv = rl[wr * 64 + fr + ai * HALF + m * 16];
                else { const f32x4* sp = (const f32x4*)(ssq + (size_t)r * 16); const f32x4 s4 = (sp[0] + sp[1]) + (sp[2] + sp[3]);
                    rinv = rsqrtf(((s4[0] + s4[1]) + (s4[2] + s4[3])) * (1.0f / 1024.0f) + 1e-6f); }
#pragma unroll
                for (int bj = 0; bj < 2; ++bj) { const f32x4 v0 = acc[ai][bj][m][0] * rinv + b0[bj], v1 = acc[ai][bj][m][1] * rinv + b1[bj];
                    u32x4 w; w.x = pack_bf16(v0[0], v0[1]); w.y = pack_bf16(v0[2], v0[3]); w.z = pack_bf16(v1[0], v1[1]); w.w = pack_bf16(v1[2], v1[3]);
                    *(u32x4*)(rowp + bj * HALF) = w; } }
    }
};
struct EpiRw2 {
    static constexpr bool PERM = true;
    __device__ __forceinline__ void prefetch(LAS unsigned char*, const Unit&, int) const {}
    float* DEC; bf16_t* AZ; bf16_t* G; const float* w0; const float* a0;
    __device__ __forceinline__ void operator()(const f32x4 (&acc)[2][2][4][2], const Unit& u, int wr, int wc, int fr, int fq) const {
        const int row0 = u.pm * BM + wr * 64 + fr; const int col0 = u.pn * BM + wc * 32 + 8 * fq;
        const int cls = u.pn < 8 ? 0 : 1;
#pragma unroll
        for (int bj = 0; bj < 2; ++bj) {
            const int c = col0 + bj * HALF;
            f32x4 b0 = (f32x4){0.f, 0.f, 0.f, 0.f}, b1 = b0;
            if (cls == 0) { b0 = *(const f32x4*)(w0 + c); b1 = *(const f32x4*)(w0 + c + 4); }
            else if (cls == 1) { b0 = *(const f32x4*)(a0 + c - 2048); b1 = *(const f32x4*)(a0 + c - 2048 + 4); }
#pragma unroll
            for (int ai = 0; ai < 2; ++ai)
#pragma unroll
                for (int m = 0; m < 4; ++m) { const size_t r = (size_t)(row0 + ai * HALF + m * 16);
                    f32x4 v0 = acc[ai][bj][m][0] + b0, v1 = acc[ai][bj][m][1] + b1;
                    if (cls == 0) {
#pragma unroll
                        for (int e = 0; e < 4; ++e) { v0[e] = __expf(-0.6065306597126334f * sigmoidf_(v0[e])); v1[e] = __expf(-0.6065306597126334f * sigmoidf_(v1[e])); }
                        *(f32x4*)(DEC + r * 2048 + c) = v0; *(f32x4*)(DEC + r * 2048 + c + 4) = v1;
                    } else {
                        if (cls == 1) {
#pragma unroll
                            for (int e = 0; e < 4; ++e) { v0[e] = sigmoidf_(v0[e]); v1[e] = sigmoidf_(v1[e]); } }
                        u32x4 w; w.x = pack_bf16(v0[0], v0[1]); w.y = pack_bf16(v0[2], v0[3]); w.z = pack_bf16(v1[0], v1[1]); w.w = pack_bf16(v1[2], v1[3]);
                        if (cls == 1) *(u32x4*)(AZ + r * 2048 + (c - 2048)) = w; else *(u32x4*)(G + r * 1024 + (c - 4096)) = w;
                    } }
        }
    }
};
}
struct Params { const float* in[31]; float* out; unsigned char* ws; int ph_lo, ph_hi; };
struct Frame {
    LAS unsigned char* lds; int tid, lane, wave, G, bid;
    const float* const* in; float* out; unsigned char* ws;
};

DI void fp8_row_store(const float (&v)[16], int row, int lane, unsigned char* dst, float* scale);
DI void fp8_row_load(const float* src, int row, int lane, float (&v)[16]);
DI void p0_convert_fp8(const Frame& F, const float* src, unsigned char* dst, float* scale, int widx, int nw);
template <bool SPLIT> DI void p0_mod(const Frame& F) {
    constexpr int NKG = SPLIT ? 21 : 42, NB = SPLIT ? 4 : 2, NTH = NKG * 12;
    const float* c = F.in[1]; const float* ada_w = F.in[2]; const float* ada_b = F.in[3];
    float* mod = (float*)(F.ws + WS_MOD);
    LAS float* sc = (LAS float*)F.lds;
    LAS float* part = (LAS float*)(F.lds + 32768);
    for (int i = F.tid; i < 8 * 1024; i += NTHREADS) { const int b = i >> 10, k = i & 1023; const float v = c[i]; sc[k * 8 + b] = v * sigmoidf_(v); }
    __syncthreads();
    for (int cb = F.bid; cb < 256; cb += F.G) {
        const int colbase = cb * 48, l = colbase / 6144, n0 = colbase % 6144;
        if (F.tid < NTH) {
            const int q = F.tid % 12, kg = F.tid / 12, krot = (cb * 148) & 1023;
            const float* wp = ada_w + (size_t)l * 1024 * 6144 + n0 + 4 * q;
            f32x4 acc[8];
#pragma unroll
            for (int b = 0; b < 8; ++b) acc[b] = (f32x4){0.f, 0.f, 0.f, 0.f};
#pragma unroll
            for (int bt = 0; bt < NB; ++bt) {
                f32x4 w[13];
#pragma unroll
                for (int i = 0; i < 13; ++i) { const int k = kg + NKG * (13 * bt + i), kk = ((k < 1024 ? k : 1023) + krot) & 1023; w[i] = *(const f32x4*)(wp + (size_t)kk * 6144); }
#pragma unroll
                for (int i = 0; i < 13; ++i) { const int k = kg + NKG * (13 * bt + i), kk = ((k < 1024 ? k : 1023) + krot) & 1023;
                    const f32x4 wv = k < 1024 ? w[i] : (f32x4){0.f, 0.f, 0.f, 0.f};
                    const f32x4 s0 = *(const LAS f32x4*)(sc + kk * 8), s1 = *(const LAS f32x4*)(sc + kk * 8 + 4);
                    acc[0] += wv * s0[0]; acc[1] += wv * s0[1]; acc[2] += wv * s0[2]; acc[3] += wv * s0[3];
                    acc[4] += wv * s1[0]; acc[5] += wv * s1[1]; acc[6] += wv * s1[2]; acc[7] += wv * s1[3]; }
            }
#pragma unroll
            for (int e = 0; e < 4; ++e) { LAS float* pp = part + ((size_t)kg * 48 + 4 * q + e) * 8;
                *(LAS f32x4*)pp = (f32x4){acc[0][e], acc[1][e], acc[2][e], acc[3][e]}; *(LAS f32x4*)(pp + 4) = (f32x4){acc[4][e], acc[5][e], acc[6][e], acc[7][e]}; }
        } else if (SPLIT && F.wave >= 4) {
            p0_convert_fp8(F, F.in[29], F.ws + WS_PU0, (float*)(F.ws + WS_PSC), F.bid * 4 + (F.wave - 4), F.G * 4);
        }
        __syncthreads();
        if (F.tid < 256) for (int o = F.tid; o < 384; o += 256) {
            const int cl = o >> 3, b = o & 7; const int col = colbase + cl;
            float s = ada_b[col];
#pragma unroll
            for (int kg = 0; kg < NKG; ++kg) s += part[(kg * 48 + cl) * 8 + b];
            mod[((size_t)l * 8 + b) * 6144 + n0 + cl] = s;
        }
        __syncthreads();
    }
}
DI void p0_transpose(const Frame& F, const float* src, int ld, int K, int N, bf16_t* dst, int ldd, const float* mix) {
    (void)mix;
    LAS float* tiles = (LAS float*)F.lds;
    const int tn = N / 64, nt = (K / 64) * tn;
    for (int t0 = F.bid; t0 < nt; t0 += 4 * F.G) {
        __syncthreads();
        f32x4 v[4][2];
#pragma unroll
        for (int q = 0; q < 4; ++q) { const int tt = t0 + q * F.G, t = tt < nt ? tt : t0; const int k0 = (t / tn) * 64, n0 = (t % tn) * 64;
#pragma unroll
            for (int h = 0; h < 2; ++h) { const int i = F.tid + h * NTHREADS, r = i >> 4, c4 = (i & 15) * 4; v[q][h] = *(const f32x4*)(src + (size_t)(k0 + r) * ld + n0 + c4); } }
#pragma unroll
        for (int q = 0; q < 4; ++q)
#pragma unroll
            for (int h = 0; h < 2; ++h) { const int i = F.tid + h * NTHREADS, r = i >> 4, c4 = (i & 15) * 4; LAS float* tp = tiles + q * 4160 + r * 65 + c4;
                tp[0] = v[q][h][0]; tp[1] = v[q][h][1]; tp[2] = v[q][h][2]; tp[3] = v[q][h][3]; }
        __syncthreads();
#pragma unroll
        for (int q = 0; q < 4; ++q) { const int t = t0 + q * F.G; if (t < nt) { const int k0 = (t / tn) * 64, n0 = (t % tn) * 64;
            const int n = F.tid >> 3, kc = (F.tid & 7) * 8;
            float w8[8];
#pragma unroll
            for (int e = 0; e < 8; ++e) w8[e] = tiles[q * 4160 + (kc + e) * 65 + n];
            u32x4 w; w.x = pack_bf16(w8[0], w8[1]); w.y = pack_bf16(w8[2], w8[3]); w.z = pack_bf16(w8[4], w8[5]); w.w = pack_bf16(w8[6], w8[7]);
            *(u32x4*)(dst + (size_t)(n0 + n) * ldd + k0 + kc) = w; } }
    }
    __syncthreads();
}
DI void p0_wqs(const Frame& F, const float* W, const float* g, const float* modl, bf16_t* dst) {
    LAS float* tiles = (LAS float*)F.lds;
    LAS float* gsl = (LAS float*)(F.lds + 69632);
    const int nt = 16 * 32;
    if (F.bid >= nt) return;
    __syncthreads();
    for (int i = F.tid; i < 8 * 1024; i += NTHREADS) gsl[i] = g[i & 1023] * (1.0f + modl[(size_t)(i >> 10) * 6144 + 4096 + (i & 1023)]);
    for (int t0 = F.bid; t0 < nt; t0 += 4 * F.G) {
        __syncthreads();
        f32x4 v[4][2];
#pragma unroll
        for (int q = 0; q < 4; ++q) { const int tt = t0 + q * F.G, t = tt < nt ? tt : t0; const int k0 = (t / 32) * 64, n0 = (t % 32) * 64;
#pragma unroll
            for (int h = 0; h < 2; ++h) { const int i = F.tid + h * NTHREADS, r = i >> 4, c4 = (i & 15) * 4; v[q][h] = *(const f32x4*)(W + (size_t)(k0 + r) * 2048 + n0 + c4); } }
#pragma unroll
        for (int q = 0; q < 4; ++q)
#pragma unroll
            for (int h = 0; h < 2; ++h) { const int i = F.tid + h * NTHREADS, r = i >> 4, c4 = (i & 15) * 4; LAS float* tp = tiles + q * 4160 + r * 65 + c4;
                tp[0] = v[q][h][0]; tp[1] = v[q][h][1]; tp[2] = v[q][h][2]; tp[3] = v[q][h][3]; }
        __syncthreads();
        for (int q = 0; q < 4; ++q) { const int t = t0 + q * F.G; if (t < nt) { const int k0 = (t / 32) * 64, n0 = (t % 32) * 64;
            const int n = F.tid >> 3, kc = (F.tid & 7) * 8;
            float w8[8];
#pragma unroll
            for (int e = 0; e < 8; ++e) w8[e] = tiles[q * 4160 + (kc + e) * 65 + n];
#pragma unroll
            for (int b = 0; b < 8; ++b) { const f32x4 s0 = *(const LAS f32x4*)(gsl + b * 1024 + k0 + kc), s1 = *(const LAS f32x4*)(gsl + b * 1024 + k0 + kc + 4);
                u32x4 w; w.x = pack_bf16(w8[0] * s0[0], w8[1] * s0[1]); w.y = pack_bf16(w8[2] * s0[2], w8[3] * s0[3]);
                w.z = pack_bf16(w8[4] * s1[0], w8[5] * s1[1]); w.w = pack_bf16(w8[6] * s1[2], w8[7] * s1[3]);
                *(u32x4*)(dst + ((size_t)b * 2048 + n0 + n) * 1024 + k0 + kc) = w; } } }
    }
    __syncthreads();
}
DI void p0_bq(const Frame& F, const float* W, const float* modl, float* bq) {
    LAS float* shl = (LAS float*)F.lds;
    LAS float* part = (LAS float*)(F.lds + 32768);
    if (F.bid >= 128) return;
    __syncthreads();
    for (int i = F.tid; i < 8 * 1024; i += NTHREADS) { const int b = i >> 10, k = i & 1023; shl[k * 8 + b] = modl[(size_t)b * 6144 + 3072 + k]; }
    __syncthreads();
    for (int task = F.bid; task < 128; task += F.G) {
        const int cl = F.tid & 15, kp = F.tid >> 4; const float* wp = W + (size_t)(kp * 32) * 2048 + task * 16 + cl;
        float wv[32];
#pragma unroll
        for (int k = 0; k < 32; ++k) wv[k] = wp[(size_t)k * 2048];
        float a[8];
#pragma unroll
        for (int b = 0; b < 8; ++b) a[b] = 0.f;
#pragma unroll
        for (int k = 0; k < 32; ++k) { const float w = wv[k];
            const f32x4 s0 = *(const LAS f32x4*)(shl + (kp * 32 + k) * 8), s1 = *(const LAS f32x4*)(shl + (kp * 32 + k) * 8 + 4);
            a[0] += w * s0[0]; a[1] += w * s0[1]; a[2] += w * s0[2]; a[3] += w * s0[3]; a[4] += w * s1[0]; a[5] += w * s1[1]; a[6] += w * s1[2]; a[7] += w * s1[3]; }
#pragma unroll
        for (int b = 0; b < 8; ++b) part[(kp * 16 + cl) * 8 + b] = a[b];
        __syncthreads();
        if (F.tid < 128) { const int c2 = F.tid >> 3, b = F.tid & 7; float s = 0.f;
#pragma unroll
            for (int q = 0; q < 32; ++q) s += part[(q * 16 + c2) * 8 + b];
            bq[(size_t)b * 2048 + task * 16 + c2] = s; }
        __syncthreads();
    }
}
DI void p0_convert(const Frame& F, const float* src, bf16_t* dst, size_t n) {
    const size_t n8 = n / 8;
    for (size_t i = (size_t)F.bid * NTHREADS + F.tid; i < n8; i += (size_t)F.G * NTHREADS) {
        const f32x4 a = *(const f32x4*)(src + i * 8), b = *(const f32x4*)(src + i * 8 + 4);
        u32x4 w; w.x = pack_bf16(a[0], a[1]); w.y = pack_bf16(a[2], a[3]); w.z = pack_bf16(b[0], b[1]); w.w = pack_bf16(b[2], b[3]);
        *(u32x4*)(dst + i * 8) = w;
    }
}
DI void fp8_row_store(const float (&v)[16], int row, int lane, unsigned char* dst, float* scale) {
    float am = 0.f;
#pragma unroll
    for (int e = 0; e < 16; ++e) am = fmaxf(am, fabsf(v[e]));
#pragma unroll
    for (int o = 32; o > 0; o >>= 1) am = fmaxf(am, __shfl_xor(am, o));
    const float sc = am > 0.f ? am * (1.0f / 384.0f) : 1.0f, inv = 1.0f / sc;
    u32x4 w;
    { int t0 = 0; t0 = __builtin_amdgcn_cvt_pk_fp8_f32(v[0] * inv, v[1] * inv, t0, false); t0 = __builtin_amdgcn_cvt_pk_fp8_f32(v[2] * inv, v[3] * inv, t0, true); w.x = (unsigned)t0; }
    { int t0 = 0; t0 = __builtin_amdgcn_cvt_pk_fp8_f32(v[4] * inv, v[5] * inv, t0, false); t0 = __builtin_amdgcn_cvt_pk_fp8_f32(v[6] * inv, v[7] * inv, t0, true); w.y = (unsigned)t0; }
    { int t0 = 0; t0 = __builtin_amdgcn_cvt_pk_fp8_f32(v[8] * inv, v[9] * inv, t0, false); t0 = __builtin_amdgcn_cvt_pk_fp8_f32(v[10] * inv, v[11] * inv, t0, true); w.z = (unsigned)t0; }
    { int t0 = 0; t0 = __builtin_amdgcn_cvt_pk_fp8_f32(v[12] * inv, v[13] * inv, t0, false); t0 = __builtin_amdgcn_cvt_pk_fp8_f32(v[14] * inv, v[15] * inv, t0, true); w.w = (unsigned)t0; }
    *(u32x4*)(dst + (size_t)row * 1024 + 16 * lane) = w;
    if (lane == 0) scale[row] = sc;
}
DI void fp8_row_load(const float* src, int row, int lane, float (&v)[16]) {
#pragma unroll
    for (int j = 0; j < 4; ++j) { const f32x4 a = *(const f32x4*)(src + (size_t)row * 1024 + 256 * j + 4 * lane); v[4 * j] = a[0]; v[4 * j + 1] = a[1]; v[4 * j + 2] = a[2]; v[4 * j + 3] = a[3]; }
}
DI void p0_convert_fp8(const Frame& F, const float* src, unsigned char* dst, float* scale, int widx, int nw) {
    const int lane = F.lane;
    for (int row = widx; row < N_EXPERTS; row += 4 * nw) {
        float v0[16], v1[16], v2[16], v3[16];
        const int r1 = row + nw, r2 = row + 2 * nw, r3 = row + 3 * nw;
        fp8_row_load(src, row, lane, v0);
        if (r1 < N_EXPERTS) fp8_row_load(src, r1, lane, v1);
        if (r2 < N_EXPERTS) fp8_row_load(src, r2, lane, v2);
        if (r3 < N_EXPERTS) fp8_row_load(src, r3, lane, v3);
        fp8_row_store(v0, row, lane, dst, scale);
        if (r1 < N_EXPERTS) fp8_row_store(v1, r1, lane, dst, scale);
        if (r2 < N_EXPERTS) fp8_row_store(v2, r2, lane, dst, scale);
        if (r3 < N_EXPERTS) fp8_row_store(v3, r3, lane, dst, scale);
    }
}
DI void p0_prologue(const Frame& F) {
    const bool split = (F.G == 256);
    if (split) p0_mod<true>(F); else p0_mod<false>(F);
    bf16_t* WIN_T = (bf16_t*)(F.ws + WS_WIN_T);
    p0_transpose(F, F.in[5], IN_W, 1024, IN_W, WIN_T, 1024, nullptr);
    float* psc = (float*)(F.ws + WS_PSC);
    if (!split) p0_convert_fp8(F, F.in[29], F.ws + WS_PU0, psc + 0 * N_EXPERTS, F.bid * NWAVES + F.wave, F.G * NWAVES);
    p0_convert_fp8(F, F.in[30], F.ws + WS_PV0, psc + 1 * N_EXPERTS, F.bid * NWAVES + F.wave, F.G * NWAVES);
}
DI void p0_late_weights(const Frame& Fin, int nunits) {
    const int nmax = (nunits + Fin.G - 1) / Fin.G, nfull = nunits - (nmax - 1) * Fin.G;
    Frame F = Fin;
    if (nfull < Fin.G) { if (Fin.bid < nfull) return; F.bid = Fin.bid - nfull; F.G = Fin.G - nfull; }
    bf16_t* WRW_T = (bf16_t*)(F.ws + WS_WRW_T);
    p0_transpose(F, F.in[12] + 0 * 1048576, 1024, 1024, 1024, WRW_T + (size_t)0    * 1024, 1024, nullptr);
    p0_transpose(F, F.in[12] + 1 * 1048576, 1024, 1024, 1024, WRW_T + (size_t)1024 * 1024, 1024, nullptr);
    p0_transpose(F, F.in[12] + 2 * 1048576, 1024, 1024, 1024, WRW_T + (size_t)2048 * 1024, 1024, nullptr);
    p0_transpose(F, F.in[14] + 0 * 65536, 64, 1024, 64, WRW_T + (size_t)3072 * 1024, 1024, nullptr);
    p0_transpose(F, F.in[14] + 1 * 65536, 64, 1024, 64, WRW_T + (size_t)3136 * 1024, 1024, nullptr);
    p0_transpose(F, F.in[17] + 0 * 65536, 64, 1024, 64, WRW_T + (size_t)3328 * 1024, 1024, nullptr);
    p0_transpose(F, F.in[17] + 1 * 65536, 64, 1024, 64, WRW_T + (size_t)3392 * 1024, 1024, nullptr);
    p0_transpose(F, F.in[19], 128, 1024, 128, WRW_T + (size_t)3584 * 1024, 1024, nullptr);
    { const u32x4 z = (u32x4){0u, 0u, 0u, 0u};
      for (int i = F.bid * NTHREADS + F.tid; i < 3 * 128 * 1024 / 8; i += F.G * NTHREADS) { const int blk = i / (128 * 128), r = i % (128 * 128);
          ((u32x4*)(WRW_T + (size_t)(3200 + 256 * blk) * 1024))[r] = z; } }
    { const float* g2 = F.in[20]; bf16_t* G2_T = (bf16_t*)(F.ws + WS_G2_T);
      for (int i = F.bid * NTHREADS + F.tid; i < 1024 * 32; i += F.G * NTHREADS) { const int n = i % 1024, k0 = (i / 1024) * 8;
          float v[8];
#pragma unroll
          for (int e = 0; e < 8; ++e) v[e] = (k0 + e < 128) ? g2[(size_t)(k0 + e) * 1024 + n] : 0.f;
          u32x4 w; w.x = pack_bf16(v[0], v[1]); w.y = pack_bf16(v[2], v[3]); w.z = pack_bf16(v[4], v[5]); w.w = pack_bf16(v[6], v[7]);
          *(u32x4*)(G2_T + (size_t)n * 256 + k0) = w; } }
    p0_transpose(F, F.in[9], 1024, 1024, 1024, (bf16_t*)(F.ws + WS_WOUT_T), 1024, nullptr);
    p0_convert(F, F.in[28], (bf16_t*)(F.ws + WS_SK), (size_t)2 * 16 * 128 * 128);
    const float* mod = (const float*)(F.ws + WS_MOD);
    p0_wqs(F, F.in[27], F.in[4] + 1 * 1024, mod, (bf16_t*)F.out);
    { Frame Fr = F; Fr.bid = F.G - 1 - F.bid;
      p0_bq(Fr, F.in[27], mod, (float*)(F.ws + WS_BQ)); }
}
DI void p0_late_weights2(const Frame& Fin) {
    Frame F = Fin;
    if ((Fin.G & 7) == 0) { const int g8 = Fin.G >> 3, nmax = (120 + g8 - 1) / g8, nfull = 120 - (nmax - 1) * g8;
        if (nfull < g8) { if ((Fin.bid >> 3) < nfull) return; F.bid = ((Fin.bid >> 3) - nfull) * 8 + (Fin.bid & 7); F.G = (g8 - nfull) * 8; } }
    else { const int nmax = (960 + Fin.G - 1) / Fin.G, nfull = 960 - (nmax - 1) * Fin.G;
        if (nfull < Fin.G) { if (Fin.bid < nfull) return; F.bid = Fin.bid - nfull; F.G = Fin.G - nfull; } }
    p0_wqs(F, F.in[27] + (size_t)1024 * 2048, F.in[4] + 3 * 1024, (const float*)(F.ws + WS_MOD) + 8 * 6144, (bf16_t*)F.out + (size_t)8 * 2048 * 1024);
    p0_transpose(F, F.in[26], 1024, 1024, 1024, (bf16_t*)(F.ws + WS_WO_T), 1024, nullptr);
    { Frame Fr = F; Fr.bid = F.G - 1 - F.bid; p0_bq(Fr, F.in[27] + (size_t)1024 * 2048, (const float*)(F.ws + WS_MOD) + 8 * 6144, (float*)(F.ws + WS_BQ) + 8 * 2048); }
}

DI void norm_row16(const float* xr, int lane, float (&v)[16], float& rinv) {
    float ss = 0.f;
#pragma unroll
    for (int j = 0; j < 4; ++j) { const f32x4 a = *(const f32x4*)(xr + j * 256 + lane * 4); v[4 * j] = a[0]; v[4 * j + 1] = a[1]; v[4 * j + 2] = a[2]; v[4 * j + 3] = a[3];
        ss += a[0] * a[0] + a[1] * a[1] + a[2] * a[2] + a[3] * a[3]; }
    ss = wave_sum(ss);
    rinv = rsqrtf(ss * (1.0f / 1024.0f) + 1e-6f);
}
DI void ada_apply(float (&v)[16], float rinv, const float* g, const float* sc, const float* sh, int lane) {
#pragma unroll
    for (int j = 0; j < 4; ++j) { const int c = j * 256 + lane * 4;
        const f32x4 gg = *(const f32x4*)(g + c), s1 = *(const f32x4*)(sc + c), s0 = *(const f32x4*)(sh + c);
#pragma unroll
        for (int e = 0; e < 4; ++e) v[4 * j + e] = v[4 * j + e] * rinv * gg[e] * (1.0f + s1[e]) + s0[e]; }
}
DI void norm_row16_b(const bf16_t* xr, int lane, float (&v)[16], float& rinv) {
    float ss = 0.f;
#pragma unroll
    for (int j = 0; j < 4; ++j) { const u32x2 a = *(const u32x2*)(xr + j * 256 + lane * 4); v[4 * j] = bf_lo(a.x); v[4 * j + 1] = bf_hi(a.x); v[4 * j + 2] = bf_lo(a.y); v[4 * j + 3] = bf_hi(a.y);
        ss += v[4 * j] * v[4 * j] + v[4 * j + 1] * v[4 * j + 1] + v[4 * j + 2] * v[4 * j + 2] + v[4 * j + 3] * v[4 * j + 3]; }
    ss = wave_sum(ss);
    rinv = rsqrtf(ss * (1.0f / 1024.0f) + 1e-6f);
}
template <bool IN_BF16> DI void p_norm(const Frame& F, const void* x, const float* g, const float* modl  , int sh_off, int sc_off, bf16_t* H) {
    for (int r = F.bid * NWAVES + F.wave; r < T; r += F.G * NWAVES) {
        const int b = r / SEQ; float v[16], rinv;
        if (IN_BF16) norm_row16_b((const bf16_t*)x + (size_t)r * D, F.lane, v, rinv); else norm_row16((const float*)x + (size_t)r * D, F.lane, v, rinv);
        ada_apply(v, rinv, g, modl + (size_t)b * 6144 + sc_off, modl + (size_t)b * 6144 + sh_off, F.lane);
#pragma unroll
        for (int j = 0; j < 4; ++j) { u32x2 w; w.x = pack_bf16(v[4 * j], v[4 * j + 1]); w.y = pack_bf16(v[4 * j + 2], v[4 * j + 3]);
            *(u32x2*)(H + (size_t)r * D + j * 256 + F.lane * 4) = w; }
    }
}
DI void p_qkprep(const Frame& F) {
    const bf16_t* QKV = (const bf16_t*)(F.ws + WS_QKV);
    bf16_t* QA = (bf16_t*)(F.ws + WS_QA); bf16_t* KA = (bf16_t*)(F.ws + WS_KA); bf16_t* VAT = (bf16_t*)(F.ws + WS_VAT);
    bf16_t* QB = (bf16_t*)(F.ws + WS_QB); bf16_t* KB = (bf16_t*)(F.ws + WS_KB); bf16_t* VBT = (bf16_t*)(F.ws + WS_VBT);
    const float* qk_g = F.in[6];
    LAS float* cs = (LAS float*)F.lds;
    LAS unsigned short* vt = (LAS unsigned short*)(F.lds + 16384);
    for (int tile = F.bid; tile < T / 64; tile += F.G) {
        const int t0 = tile * 64, b = t0 / SEQ, s0 = t0 % SEQ;
        __syncthreads();
        for (int i = F.tid; i < 64 * 32; i += NTHREADS) { const int tok = i >> 5, ai = i & 31, axis = ai >> 4, ii = ai & 15;
            const int s = s0 + tok; const float pos = (float)(axis == 0 ? (s >> 6) : (s & 63));
            const float inv = exp2f(-(float)ii * (13.287712379549449f / 16.0f));
            float sn, cn; sincosf(pos * inv, &sn, &cn); cs[2 * i] = cn; cs[2 * i + 1] = sn; }
        for (int i = F.tid; i < 64 * 80; i += NTHREADS) { const int tok = i / 80, ch = i % 80; const int col = ch < 64 ? 1024 + 8 * ch : 2176 + 8 * (ch - 64);
            const u32x4 v = *(const u32x4*)(QKV + (size_t)(t0 + tok) * IN_W + col);
            *(LAS u32x4*)(vt + tok * 648 + 8 * ch) = v; }
        __syncthreads();
        const int tok = F.tid >> 3, j = F.tid & 7, s = s0 + tok;
        for (int slot = 0; slot < 26; ++slot) {
            int col, type; bf16_t* dst;
            if (slot < 8)       { col = 64 * slot;               type = 0; dst = QA + ((size_t)(b * 8 + slot) * SEQ + s) * 64; }
            else if (slot < 16) { col = 512 + 64 * (slot - 8);   type = 1; dst = KA + ((size_t)(b * 8 + slot - 8) * SEQ + s) * 64; }
            else if (slot < 24) { col = 1536 + 64 * (slot - 16); type = 2; dst = QB + ((size_t)(b * 8 + slot - 16) * SEQ + s) * 64; }
            else                { col = 2048 + 64 * (slot - 24); type = 3; dst = KB + ((size_t)(b * 2 + slot - 24) * SEQ + s) * 64; }
            const u32x4 raw = *(const u32x4*)(QKV + (size_t)(t0 + tok) * IN_W + col + 8 * j);
            float v[8]; v[0] = bf_lo(raw.x); v[1] = bf_hi(raw.x); v[2] = bf_lo(raw.y); v[3] = bf_hi(raw.y); v[4] = bf_lo(raw.z); v[5] = bf_hi(raw.z); v[6] = bf_lo(raw.w); v[7] = bf_hi(raw.w);
            float ss = 0.f;
#pragma unroll
            for (int e = 0; e < 8; ++e) ss += v[e] * v[e];
            ss += __shfl_xor(ss, 1); ss += __shfl_xor(ss, 2); ss += __shfl_xor(ss, 4);
            const float rinv = rsqrtf(ss * (1.0f / 64.0f) + 1e-6f);
            const f32x4 g0 = *(const f32x4*)(qk_g + type * 64 + 8 * j), g1 = *(const f32x4*)(qk_g + type * 64 + 8 * j + 4);
#pragma unroll
            for (int e = 0; e < 4; ++e) { v[e] = v[e] * rinv * g0[e]; v[4 + e] = v[4 + e] * rinv * g1[e]; }
            if (type >= 2) {
                const int axis = j >> 2; const bool first = (j & 2) == 0;
#pragma unroll
                for (int e = 0; e < 8; ++e) { const float p = __shfl_xor(v[e], 2); const int ii = 8 * (j & 1) + e;
                    const float cn = cs[2 * (tok * 32 + axis * 16 + ii)], sn = cs[2 * (tok * 32 + axis * 16 + ii) + 1];
                    v[e] = first ? (v[e] * cn - p * sn) : (v[e] * cn + p * sn); }
            }
            if (type == 0 || type == 2) {
#pragma unroll
                for (int e = 0; e < 8; ++e) v[e] *= QSCALE; }
            u32x4 w; w.x = pack_bf16(v[0], v[1]); w.y = pack_bf16(v[2], v[3]); w.z = pack_bf16(v[4], v[5]); w.w = pack_bf16(v[6], v[7]);
            *(u32x4*)(dst + 8 * j) = w;
        }
        for (int i = F.tid; i < 640 * 8; i += NTHREADS) { const int c = i & 7, dv = i >> 3;
            unsigned short e[8];
#pragma unroll
            for (int k = 0; k < 8; ++k) e[k] = vt[(16 * (c >> 1) + 4 * (c & 1) + (k & 3) + 8 * (k >> 2)) * 648 + dv];
            u32x4 w; w.x = e[0] | ((unsigned)e[1] << 16); w.y = e[2] | ((unsigned)e[3] << 16); w.z = e[4] | ((unsigned)e[5] << 16); w.w = e[6] | ((unsigned)e[7] << 16);
            bf16_t* dp = dv < 512 ? VAT + ((size_t)b * 512 + dv) * SEQ + s0 + 8 * c : VBT + ((size_t)b * 128 + (dv - 512)) * SEQ + s0 + 8 * c;
            *(u32x4*)dp = w; }
    }
    __syncthreads();
}

DI int t5_bucket(int rel) {
    const int ret = rel > 0 ? 16 : 0; const int n = rel < 0 ? -rel : rel;
    if (n < 8) return ret + n;
    int large = 8 + (n >= 12) + (n >= 16) + (n >= 23) + (n >= 32) + (n >= 46) + (n >= 64) + (n >= 91);
    return ret + large;
}
constexpr int AT_NS = 4, AT_PD = AT_NS - 1, AT_STG = 24576, AT_TB = AT_NS * AT_STG, AT_Q = AT_TB + 3072;
DI void glds16(const void* gsrc, unsigned lds_dst) { unsigned keep;
    asm volatile("s_mov_b32 %0, m0\n\ts_mov_b32 m0, %2\n\ts_nop 0\n\tglobal_load_lds_dwordx4 %1, off\n\ts_mov_b32 m0, %0" : "=&s"(keep) : "v"(gsrc), "s"(lds_dst) : "memory"); }

template <int NC, bool BIAS>
DI void attn_pass(const Frame& F, const bf16_t* Qp, const bf16_t* Kp, const bf16_t* Vt, int q0, const LAS float* tb, float c_neg, float c_pos, f32x16 (&o)[NC], float& l_out) {
    int lane = F.lane, tid_ = F.tid; asm volatile("" : "+v"(lane), "+v"(tid_));
    const int r31 = lane & 31, h = lane >> 5;
    LAS unsigned char* lds = F.lds;
    constexpr int NT = SEQ / 64, PT = 1 + NC / 2;
    __syncthreads();
#pragma unroll
    for (int i = 0; i < 4; ++i) { const int idx = i * NTHREADS + tid_, row = idx >> 3, ch = idx & 7;
        const u32x4 v = *(const u32x4*)(Qp + (size_t)(q0 + row) * 64 + 8 * ch);
        *(LAS u32x4*)(lds + AT_Q + row * 128 + ((ch ^ (row & 7)) << 4)) = v; }
    unsigned koffs[4], qoffs[4], voffs[4];
#pragma unroll
    for (int s_ = 0; s_ < 4; ++s_) { const unsigned sw = (unsigned)(((2 * s_ + h) ^ (r31 & 7)) << 4);
        koffs[s_] = (unsigned)(r31 * 128) + sw; qoffs[s_] = (unsigned)(AT_Q + (32 * F.wave + r31) * 128) + sw;
        voffs[s_] = 8192u + (unsigned)(r31 * 128) + (unsigned)(((2 * s_ + h) ^ ((r31 >> 1) & 7)) << 4); }
#pragma unroll
    for (int c = 0; c < NC; ++c)
#pragma unroll
        for (int r = 0; r < 16; ++r) o[c][r] = 0.f;
    float m = -INFINITY, l = 0.f;
    const int qlo = q0 + 32 * F.wave, qme = qlo + r31;
    const int krow = F.wave * 8 + (lane >> 3);
    const bf16_t* ksrc = Kp + (size_t)krow * 64 + 8 * ((lane & 7) ^ (krow & 7));
    const bf16_t* vsrc[NC / 2];
#pragma unroll
    for (int i = 0; i < NC / 2; ++i) { const int vrow = (i * 8 + F.wave) * 8 + (lane >> 3); vsrc[i] = Vt + (size_t)vrow * SEQ + 8 * ((lane & 7) ^ ((vrow >> 1) & 7)); }
    const unsigned lbase = (unsigned)(size_t)lds;
    const unsigned kdst = lbase + (unsigned)F.wave * 1024u;
#define AT_ISSUE(tt) do { const unsigned sb_ = (unsigned)(((tt) % AT_NS) * AT_STG); \
        glds16(ksrc + (size_t)(tt) * 64 * 64, (unsigned)__builtin_amdgcn_readfirstlane(kdst + sb_)); \
        _Pragma("unroll") for (int i_ = 0; i_ < NC / 2; ++i_) glds16(vsrc[i_] + (size_t)(tt) * 64, (unsigned)__builtin_amdgcn_readfirstlane(kdst + sb_ + 8192u + (unsigned)i_ * 8192u)); } while (0)
    __syncthreads();
    bf16x8 qreg[4];
    {
#pragma unroll
        for (int s = 0; s < 4; ++s) qreg[s] = *(const LAS bf16x8*)(lds + qoffs[s]); }
#pragma unroll
    for (int tt = 0; tt < AT_PD; ++tt) AT_ISSUE(tt);
#pragma unroll 1
    for (int t = 0; t < NT; ++t) {
        const int k0 = t * 64;
        if (t < NT - 2) { if (PT == 3) asm volatile("s_waitcnt vmcnt(6)" ::: "memory"); else asm volatile("s_waitcnt vmcnt(4)" ::: "memory"); }
        else if (t == NT - 2) { if (PT == 3) asm volatile("s_waitcnt vmcnt(3)" ::: "memory"); else asm volatile("s_waitcnt vmcnt(2)" ::: "memory"); }
        else asm volatile("s_waitcnt vmcnt(0)" ::: "memory");
        __builtin_amdgcn_s_barrier();
        asm volatile("" ::: "memory");
        if (t + AT_PD < NT) AT_ISSUE(t + AT_PD);
        const LAS unsigned char* st_ = lds + (t % AT_NS) * AT_STG;
        f32x16 sT[2];
#pragma unroll
        for (int s = 0; s < 4; ++s) { const bf16x8 qf = qreg[s];
#pragma unroll
            for (int kb = 0; kb < 2; ++kb) { const bf16x8 kf = *(const LAS bf16x8*)(st_ + koffs[s] + kb * 4096);
                if (s == 0) sT[kb] = __builtin_amdgcn_mfma_f32_32x32x16_bf16(kf, qf, (f32x16){0.f, 0.f, 0.f, 0.f, 0.f, 0.f, 0.f, 0.f, 0.f, 0.f, 0.f, 0.f, 0.f, 0.f, 0.f, 0.f}, 0, 0, 0);
                else sT[kb] = __builtin_amdgcn_mfma_f32_32x32x16_bf16(kf, qf, sT[kb], 0, 0, 0); } }
        float cb = 0.f;
        if (BIAS) {
            if (k0 + 63 - qlo <= -91) cb = c_neg;
            else if (k0 - (qlo + 31) >= 91) cb = c_pos;
            else {
#pragma unroll
                for (int kb = 0; kb < 2; ++kb)
#pragma unroll
                    for (int r = 0; r < 16; ++r) { const int key = k0 + 32 * kb + (r & 3) + 8 * (r >> 2) + 4 * h; sT[kb][r] += tb[key - qme + 192]; }
            }
        }
        float mx = sT[0][0];
#pragma unroll
        for (int kb = 0; kb < 2; ++kb)
#pragma unroll
            for (int r = 0; r < 16; ++r) mx = fmaxf(mx, sT[kb][r]);
        mx = fmaxf(mx, __shfl_xor(mx, 32)) + cb;
        if (__builtin_amdgcn_ballot_w64(mx > m) != 0ull) {
            const float mn = fmaxf(m, mx), alpha = __builtin_amdgcn_exp2f(m - mn);
            m = mn; l *= alpha;
#pragma unroll
            for (int c = 0; c < NC; ++c)
#pragma unroll
                for (int r = 0; r < 16; ++r) o[c][r] *= alpha;
        }
        const float sh = cb - m;
        float ps = 0.f;
#pragma unroll
        for (int kb = 0; kb < 2; ++kb)
#pragma unroll
            for (int r = 0; r < 16; ++r) { const float p = __builtin_amdgcn_exp2f(sT[kb][r] + sh); sT[kb][r] = p; ps += p; }
        l += ps;
        bf16x8 pf[2][2];
#pragma unroll
        for (int kb = 0; kb < 2; ++kb)
#pragma unroll
            for (int s2 = 0; s2 < 2; ++s2) {
                u32x4 pw; pw.x = pack_bf16(sT[kb][8 * s2 + 0], sT[kb][8 * s2 + 1]); pw.y = pack_bf16(sT[kb][8 * s2 + 2], sT[kb][8 * s2 + 3]);
                pw.z = pack_bf16(sT[kb][8 * s2 + 4], sT[kb][8 * s2 + 5]); pw.w = pack_bf16(sT[kb][8 * s2 + 6], sT[kb][8 * s2 + 7]);
                pf[kb][s2] = __builtin_bit_cast(bf16x8, pw); }
        __builtin_amdgcn_sched_barrier(0);
#pragma unroll
        for (int g = 0; g < 4; ++g) {
#pragma unroll
            for (int c = 0; c < NC; ++c) { const bf16x8 vf = *(const LAS bf16x8*)(st_ + voffs[g] + c * 4096);
                o[c] = __builtin_amdgcn_mfma_f32_32x32x16_bf16(vf, pf[g >> 1][g & 1], o[c], 0, 0, 0); }
        }
    }
#undef AT_ISSUE
    l_out = l + __shfl_xor(l, 32);
}

template <int MODE> DI void p_attention(const Frame& F) {
    const bf16_t* QA = (const bf16_t*)(F.ws + WS_QA); const bf16_t* KA = (const bf16_t*)(F.ws + WS_KA); const bf16_t* VAT = (const bf16_t*)(F.ws + WS_VAT);
    const bf16_t* QB = (const bf16_t*)(F.ws + WS_QB); const bf16_t* KB = (const bf16_t*)(F.ws + WS_KB); const bf16_t* VBT = (const bf16_t*)(F.ws + WS_VBT);
    bf16_t* O = (bf16_t*)(F.ws + WS_O);
    const float* rel_bias = F.in[10]; const float* lv = F.in[7]; const float* subg = F.in[8];
    LAS float* tb = (LAS float*)(F.lds + AT_TB);
    const int lane = F.lane;
    float lam;
    { const float a = lv[lane] * lv[64 + lane], b2 = lv[128 + lane] * lv[192 + lane];
      lam = __expf(wave_sum(a)) - __expf(wave_sum(b2)) + 0.2f; }
    if (MODE & 1) for (int u = F.bid; u < 256; u += F.G) {
        const int b = u >> 5, hd = (u >> 3) & 3, qb = u & 7, q0 = qb * 256;
        __syncthreads();
        for (int i = F.tid; i < 2 * 384; i += NTHREADS) { const int mi = i / 384, ii = i % 384; tb[i] = rel_bias[t5_bucket(ii - 192) * 8 + 2 * hd + mi] * LOG2E; }
        __syncthreads();
        const bf16_t* Vt = VAT + (size_t)(b * 4 + hd) * 128 * SEQ;
        unsigned* o0s = (unsigned*)(F.ws + WS_O0S) + (size_t)F.bid * NTHREADS + F.tid;
        const size_t o0p = (size_t)F.G * NTHREADS;
        f32x16 o[4]; float l;
        { const int mp = 2 * hd;
          attn_pass<4, true>(F, QA + (size_t)(b * 8 + mp) * SEQ * 64, KA + (size_t)(b * 8 + mp) * SEQ * 64, Vt, q0, tb, rel_bias[15 * 8 + mp] * LOG2E, rel_bias[31 * 8 + mp] * LOG2E, o, l);
          const float il = 1.0f / l;
#pragma unroll
          for (int c = 0; c < 4; ++c)
#pragma unroll
              for (int r = 0; r < 8; ++r) o0s[(c * 8 + r) * o0p] = pack_bf16(o[c][2 * r] * il, o[c][2 * r + 1] * il); }
        { const int mp = 2 * hd + 1;
          attn_pass<4, true>(F, QA + (size_t)(b * 8 + mp) * SEQ * 64, KA + (size_t)(b * 8 + mp) * SEQ * 64, Vt, q0, tb + 384, rel_bias[15 * 8 + mp] * LOG2E, rel_bias[31 * 8 + mp] * LOG2E, o, l);
          int ln = F.lane; asm volatile("" : "+v"(ln)); const int r31 = ln & 31, h = ln >> 5;
          const float il = lam / l; float ss = 0.f;
#pragma unroll
          for (int c = 0; c < 4; ++c)
#pragma unroll
              for (int r = 0; r < 8; ++r) { const unsigned pk = __hip_atomic_load(o0s + (c * 8 + r) * o0p, __ATOMIC_RELAXED, __HIP_MEMORY_SCOPE_AGENT); const float d0 = bf_lo(pk) - o[c][2 * r] * il, d1 = bf_hi(pk) - o[c][2 * r + 1] * il; o[c][2 * r] = d0; o[c][2 * r + 1] = d1; ss += d0 * d0 + d1 * d1; }
          ss += __shfl_xor(ss, 32);
          const float rinv = rsqrtf(ss * (1.0f / 128.0f) + 1e-6f) * 0.8f;
          bf16_t* op = O + (size_t)(b * SEQ + q0 + 32 * F.wave + r31) * D + hd * 128;
#pragma unroll
          for (int c = 0; c < 4; ++c)
#pragma unroll
              for (int g = 0; g < 4; ++g) { const int dv = 32 * c + 8 * g + 4 * h; const f32x4 sg = *(const f32x4*)(subg + dv);
                  u32x2 w; w.x = pack_bf16(o[c][4 * g] * rinv * sg[0], o[c][4 * g + 1] * rinv * sg[1]); w.y = pack_bf16(o[c][4 * g + 2] * rinv * sg[2], o[c][4 * g + 3] * rinv * sg[3]);
                  *(u32x2*)(op + dv) = w; } }
    }
    if (MODE & 2) for (int u = F.bid; u < 512; u += F.G) {
        const int b = u >> 6, hq = (u >> 3) & 7, qb = u & 7, q0 = qb * 256, kv = hq >> 2;
        f32x16 o[2]; float l;
        attn_pass<2, false>(F, QB + (size_t)(b * 8 + hq) * SEQ * 64, KB + (size_t)(b * 2 + kv) * SEQ * 64, VBT + (size_t)(b * 2 + kv) * 64 * SEQ, q0, tb, 0.f, 0.f, o, l);
        int ln = F.lane; asm volatile("" : "+v"(ln)); const int r31 = ln & 31, h = ln >> 5;
        const float il = 1.0f / l;
        bf16_t* op = O + (size_t)(b * SEQ + q0 + 32 * F.wave + r31) * D + 512 + hq * 64;
#pragma unroll
        for (int c = 0; c < 2; ++c)
#pragma unroll
            for (int g = 0; g < 4; ++g) { const int dv = 32 * c + 8 * g + 4 * h;
                u32x2 w; w.x = pack_bf16(o[c][4 * g] * il, o[c][4 * g + 1] * il); w.y = pack_bf16(o[c][4 * g + 2] * il, o[c][4 * g + 3] * il);
                *(u32x2*)(op + dv) = w; }
    }
    __syncthreads();
}
#define CE_DESC(ka, pa, kb, pb) do { const bool _sw = (kb) > (ka); const float _k0 = _sw ? (kb) : (ka), _k1 = _sw ? (ka) : (kb); const int _p0 = _sw ? (pb) : (pa), _p1 = _sw ? (pa) : (pb); \
    (ka) = _k0; (kb) = _k1; (pa) = _p0; (pb) = _p1; } while (0)
template <int BASE> DI void sort16_desc(float (&k)[64], int (&p)[64]) {
#pragma unroll
    for (int k2 = 2; k2 <= 16; k2 <<= 1)
#pragma unroll
        for (int j = k2 >> 1; j > 0; j >>= 1)
#pragma unroll
            for (int i = 0; i < 16; ++i) { const int l = i ^ j;
                if (l > i) { if ((i & k2) == 0 || k2 == 16) CE_DESC(k[BASE + i], p[BASE + i], k[BASE + l], p[BASE + l]); else CE_DESC(k[BASE + l], p[BASE + l], k[BASE + i], p[BASE + i]); } }
}
template <int BA, int BB> DI void merge_top16(float (&k)[64], int (&p)[64]) {
#pragma unroll
    for (int i = 0; i < 16; ++i) { const bool sw = k[BB + 15 - i] > k[BA + i]; k[BA + i] = sw ? k[BB + 15 - i] : k[BA + i]; p[BA + i] = sw ? p[BB + 15 - i] : p[BA + i]; }
#pragma unroll
    for (int j = 8; j > 0; j >>= 1)
#pragma unroll
        for (int i = 0; i < 16; ++i) { const int l = i ^ j; if (l > i) CE_DESC(k[BA + i], p[BA + i], k[BA + l], p[BA + l]); }
}
DI void top16_of_64(float (&k)[64], int (&p)[64]) {
    sort16_desc<0>(k, p); sort16_desc<16>(k, p); sort16_desc<32>(k, p); sort16_desc<48>(k, p);
    merge_top16<0, 16>(k, p); merge_top16<32, 48>(k, p); merge_top16<0, 32>(k, p);
}
#define CEK_DESC(ka, kb) do { const float _h = fmaxf((ka), (kb)), _l = fminf((ka), (kb)); (ka) = _h; (kb) = _l; } while (0)
template <int BASE> DI void sort16k_desc(float (&k)[64]) {
#pragma unroll
    for (int k2 = 2; k2 <= 16; k2 <<= 1)
#pragma unroll
        for (int j = k2 >> 1; j > 0; j >>= 1)
#pragma unroll
            for (int i = 0; i < 16; ++i) { const int l = i ^ j;
                if (l > i) { if ((i & k2) == 0) CEK_DESC(k[BASE + i], k[BASE + l]); else CEK_DESC(k[BASE + l], k[BASE + i]); } }
}
template <int BA, int BB> DI void merge_top16k(float (&k)[64]) {
#pragma unroll
    for (int i = 0; i < 16; ++i) k[BA + i] = fmaxf(k[BA + i], k[BB + 15 - i]);
#pragma unroll
    for (int j = 8; j > 0; j >>= 1)
#pragma unroll
        for (int i = 0; i < 16; ++i) { const int l = i ^ j; if (l > i) CEK_DESC(k[BA + i], k[BA + l]); }
}
DI void top16k_of_64(float (&k)[64]) {
    sort16k_desc<0>(k); sort16k_desc<16>(k); sort16k_desc<32>(k); sort16k_desc<48>(k);
    merge_top16k<0, 16>(k); merge_top16k<32, 48>(k); merge_top16k<0, 32>(k);
}
constexpr int cand_off(int a) { int s = 0; for (int i = 0; i < a; ++i) s += 16 / (i + 1); return s; }

DI void p_peer_topk(const Frame& F, const bf16_t* PQ, const bf16_t* SK  , int* EIDX, float* GATE) {
    const int lane = F.lane, r31 = lane & 31, h = lane >> 5, w = F.wave;
    for (int tile = F.bid; tile < T / 64; tile += F.G) {
        for (int tt = 0; tt < 2; ++tt) {
            const int tok = tile * 64 + tt * 32 + r31;
            float lv[2][16];
#pragma unroll
            for (int p = 0; p < 2; ++p) {
                const int hp = 2 * w + p;
                f32x16 acc[4];
#pragma unroll
                for (int nb = 0; nb < 4; ++nb)
#pragma unroll
                    for (int r = 0; r < 16; ++r) acc[nb][r] = 0.f;
                const bf16_t* qp = PQ + (size_t)tok * PQ_LD + hp * 128 + 8 * h;
                const bf16_t* sp = SK + ((size_t)hp * 128 + r31) * 128 + 8 * h;
#pragma unroll 4
                for (int s = 0; s < 8; ++s) { const bf16x8 qf = *(const bf16x8*)(qp + 16 * s);
#pragma unroll
                    for (int nb = 0; nb < 4; ++nb) { const bf16x8 af = *(const bf16x8*)(sp + (size_t)nb * 32 * 128 + 16 * s);
                        acc[nb] = __builtin_amdgcn_mfma_f32_32x32x16_bf16(af, qf, acc[nb], 0, 0, 0); } }
                float k[64];
#pragma unroll
                for (int nb = 0; nb < 4; ++nb)
#pragma unroll
                    for (int r = 0; r < 16; ++r) { const int n = 32 * nb + (r & 3) + 8 * (r >> 2) + 4 * h;
                        k[16 * nb + r] = __uint_as_float((__float_as_uint(acc[nb][r]) & 0xFFFFFF80u) | (unsigned)(127 - n)); }
                top16k_of_64(k);
#pragma unroll
                for (int i = 0; i < 16; ++i) k[16 + i] = __shfl_xor(k[i], 32);
                merge_top16k<0, 16>(k);
#pragma unroll
                for (int i = 0; i < 16; ++i) lv[p][i] = k[i];
                __builtin_amdgcn_sched_barrier(0);
            }
            float ck[64];
#pragma unroll
            for (int i = 0; i < 64; ++i) ck[i] = -INFINITY;
#pragma unroll
            for (int a = 0; a < 16; ++a) {
#pragma unroll
                for (int b2 = 0; b2 < 16 / (a + 1); ++b2) ck[cand_off(a) + b2] = __uint_as_float((__float_as_uint(lv[0][a] + lv[1][b2]) & 0xFFFFFF00u) | (unsigned)(a * 16 + b2)); }
            LAS float* lst = (LAS float*)F.lds + F.tid;
#pragma unroll
            for (int i = 0; i < 16; ++i) { lst[i * NTHREADS] = lv[0][i]; lst[(16 + i) * NTHREADS] = lv[1][i]; }
            top16k_of_64(ck);
            float den = 0.f, ex[16]; int cp[16];
#pragma unroll
            for (int i = 0; i < 16; ++i) { ex[i] = __expf(ck[i] - ck[0]); den += ex[i];
                const unsigned cb = __float_as_uint(ck[i]); const int a = (cb >> 4) & 15, b2 = cb & 15;
                const unsigned u0 = __float_as_uint(lst[a * NTHREADS]), u1 = __float_as_uint(lst[(16 + b2) * NTHREADS]);
                cp[i] = (127 - (int)(u0 & 127u)) * 128 + (127 - (int)(u1 & 127u)); }
            const float iden = 1.0f / den;
            if (h == 0) {
                int* ep = EIDX + (size_t)tok * 128 + w * 16; float* gp = GATE + (size_t)tok * 128 + w * 16;
#pragma unroll
                for (int i = 0; i < 4; ++i) { *(u32x4*)(ep + 4 * i) = (u32x4){(unsigned)cp[4 * i], (unsigned)cp[4 * i + 1], (unsigned)cp[4 * i + 2], (unsigned)cp[4 * i + 3]};
                    *(f32x4*)(gp + 4 * i) = (f32x4){ex[4 * i] * iden, ex[4 * i + 1] * iden, ex[4 * i + 2] * iden, ex[4 * i + 3] * iden}; }
            }
        }
    }
}

DI void fp8x16_to_f32(const u32x4 w, float (&o)[16]) {
    f32x2 t;
    t = __builtin_amdgcn_cvt_pk_f32_fp8((int)w.x, false); o[0] = t[0]; o[1] = t[1];  t = __builtin_amdgcn_cvt_pk_f32_fp8((int)w.x, true); o[2] = t[0]; o[3] = t[1];
    t = __builtin_amdgcn_cvt_pk_f32_fp8((int)w.y, false); o[4] = t[0]; o[5] = t[1];  t = __builtin_amdgcn_cvt_pk_f32_fp8((int)w.y, true); o[6] = t[0]; o[7] = t[1];
    t = __builtin_amdgcn_cvt_pk_f32_fp8((int)w.z, false); o[8] = t[0]; o[9] = t[1];  t = __builtin_amdgcn_cvt_pk_f32_fp8((int)w.z, true); o[10] = t[0]; o[11] = t[1];
    t = __builtin_amdgcn_cvt_pk_f32_fp8((int)w.w, false); o[12] = t[0]; o[13] = t[1]; t = __builtin_amdgcn_cvt_pk_f32_fp8((int)w.w, true); o[14] = t[0]; o[15] = t[1];
}
DI float gelu_tanh_fast(float x) { const float z2 = 2.302208198f * (x + 0.044715f * x * x * x);
    return x * __builtin_amdgcn_rcpf(1.0f + __builtin_amdgcn_exp2f(-z2)); }
constexpr int PB = 4;
DI void peer_load(const unsigned char* PU, const unsigned char* PV, int ev, int base, int lane, u32x4 (&U)[PB], u32x4 (&V)[PB]) {
#pragma unroll
    for (int q = 0; q < PB; ++q) { const int e = __builtin_amdgcn_readlane(ev, base + q);
        U[q] = *(const u32x4*)(PU + (size_t)e * 1024 + 16 * lane); V[q] = *(const u32x4*)(PV + (size_t)e * 1024 + 16 * lane); }
}
struct RsMap { unsigned tag; int l0, l1, l2, l3; };
DI unsigned swp32(unsigned a, unsigned b, unsigned& other) { auto r = __builtin_amdgcn_permlane32_swap(a, b, false, false); other = r[1]; return r[0]; }
DI unsigned swp16(unsigned a, unsigned b, unsigned& other) { auto r = __builtin_amdgcn_permlane16_swap(a, b, false, false); other = r[1]; return r[0]; }
DI RsMap rs_map_init() {
    unsigned o, t0 = 0u, t1 = 1u, t2 = 2u, t3 = 3u;
    asm volatile("" : "+v"(t0), "+v"(t1), "+v"(t2), "+v"(t3));
    const unsigned ta = swp32(t0, t2, o), tb = swp32(t1, t3, o);
    RsMap m; m.tag = swp16(ta, tb, o);
    m.l0 = __builtin_ctzll(__builtin_amdgcn_ballot_w64(m.tag == 0u)); m.l1 = __builtin_ctzll(__builtin_amdgcn_ballot_w64(m.tag == 1u));
    m.l2 = __builtin_ctzll(__builtin_amdgcn_ballot_w64(m.tag == 2u)); m.l3 = __builtin_ctzll(__builtin_amdgcn_ballot_w64(m.tag == 3u));
    return m;
}
template <int CTRL> DI float dpp_g(float v) { return __builtin_bit_cast(float, __builtin_amdgcn_update_dpp(0, __builtin_bit_cast(int, v), CTRL, 0xF, 0xF, true)); }
DI void peer_comp(const u32x4 (&U)[PB], const u32x4 (&V)[PB], float su, float gvs, int base, const RsMap& M, const float (&x)[16], float (&y)[16]) {
    float d[PB];
#pragma unroll
    for (int q = 0; q < PB; ++q) { float u[16]; fp8x16_to_f32(U[q], u);
        float a0 = u[0] * x[0], a1 = u[1] * x[1], a2 = u[2] * x[2], a3 = u[3] * x[3];
#pragma unroll
        for (int i = 4; i < 16; i += 4) { a0 += u[i] * x[i]; a1 += u[i + 1] * x[i + 1]; a2 += u[i + 2] * x[i + 2]; a3 += u[i + 3] * x[i + 3]; }
        d[q] = (a0 + a1) + (a2 + a3); }
    unsigned o;
    const float f0a = __uint_as_float(swp32(__float_as_uint(d[0]), __float_as_uint(d[2]), o)); const float f0 = f0a + __uint_as_float(o);
    const float f1a = __uint_as_float(swp32(__float_as_uint(d[1]), __float_as_uint(d[3]), o)); const float f1 = f1a + __uint_as_float(o);
    const float ga = __uint_as_float(swp16(__float_as_uint(f0), __float_as_uint(f1), o)); float g = ga + __uint_as_float(o);
    g += dpp_g<0xB1>(g); g += dpp_g<0x4E>(g); g += dpp_g<0x141>(g); g += dpp_g<0x140>(g);
    const int src = (base + (int)M.tag) * 4;
    const float su_b = __uint_as_float(__builtin_amdgcn_ds_bpermute(src, __float_as_uint(su))), gv_b = __uint_as_float(__builtin_amdgcn_ds_bpermute(src, __float_as_uint(gvs)));
    const float c = gv_b * gelu_tanh_fast(g * su_b);
    const float c0 = __uint_as_float(__builtin_amdgcn_readlane(__float_as_uint(c), M.l0)), c1 = __uint_as_float(__builtin_amdgcn_readlane(__float_as_uint(c), M.l1));
    const float c2 = __uint_as_float(__builtin_amdgcn_readlane(__float_as_uint(c), M.l2)), c3 = __uint_as_float(__builtin_amdgcn_readlane(__float_as_uint(c), M.l3));
    const float cq[4] = {c0, c1, c2, c3};
#pragma unroll
    for (int q = 0; q < PB; ++q) { float v[16]; fp8x16_to_f32(V[q], v);
#pragma unroll
        for (int i = 0; i < 16; ++i) y[i] += cq[q] * v[i]; }
}
constexpr int PM_SHIFT = 11, PM_NP = 16384 >> PM_SHIFT;
struct PBatch { u32x4 U[4], V[4]; float su[4], gv[4]; int n; };
DI void pm_fetch(PBatch& B, unsigned long long& mA, unsigned long long& mB, int e0, int e1, float su0, float su1, float gv0, float gv1, const unsigned char* PU, const unsigned char* PV, int lane) {
    B.n = 0;
    if ((mA | mB) == 0ull) return;
    int eid[4];
#pragma unroll
    for (int q = 0; q < 4; ++q) {
        if (mA != 0ull) { const int l = __builtin_ctzll(mA); mA &= mA - 1ull;
            eid[q] = __builtin_amdgcn_readlane(e0, l); B.su[q] = __uint_as_float(__builtin_amdgcn_readlane(__float_as_uint(su0), l)); B.gv[q] = __uint_as_float(__builtin_amdgcn_readlane(__float_as_uint(gv0), l)); B.n = q + 1; }
        else if (mB != 0ull) { const int l = __builtin_ctzll(mB); mB &= mB - 1ull;
            eid[q] = __builtin_amdgcn_readlane(e1, l); B.su[q] = __uint_as_float(__builtin_amdgcn_readlane(__float_as_uint(su1), l)); B.gv[q] = __uint_as_float(__builtin_amdgcn_readlane(__float_as_uint(gv1), l)); B.n = q + 1; }
        else { eid[q] = eid[0]; B.su[q] = 0.f; B.gv[q] = 0.f; }
        B.U[q] = *(const u32x4*)(PU + (size_t)eid[q] * 1024 + 16 * lane); B.V[q] = *(const u32x4*)(PV + (size_t)eid[q] * 1024 + 16 * lane);
    }
}
DI void pm_comp(const PBatch& B, const RsMap& M, const float (&x)[16], float (&y)[16]) {
    float d[4];
#pragma unroll
    for (int q = 0; q < 4; ++q) { float u[16]; fp8x16_to_f32(B.U[q], u);
        f32x2 a0 = (f32x2){u[0], u[1]} * (f32x2){x[0], x[1]}, a1 = (f32x2){u[2], u[3]} * (f32x2){x[2], x[3]};
#pragma unroll
        for (int i = 4; i < 16; i += 4) { a0 = __builtin_elementwise_fma((f32x2){u[i], u[i + 1]}, (f32x2){x[i], x[i + 1]}, a0); a1 = __builtin_elementwise_fma((f32x2){u[i + 2], u[i + 3]}, (f32x2){x[i + 2], x[i + 3]}, a1); }
        const f32x2 as = a0 + a1; d[q] = as[0] + as[1]; }
    unsigned o;
    const float f0a = __uint_as_float(swp32(__float_as_uint(d[0]), __float_as_uint(d[2]), o)); const float f0 = f0a + __uint_as_float(o);
    const float f1a = __uint_as_float(swp32(__float_as_uint(d[1]), __float_as_uint(d[3]), o)); const float f1 = f1a + __uint_as_float(o);
    const float ga = __uint_as_float(swp16(__float_as_uint(f0), __float_as_uint(f1), o)); float g = ga + __uint_as_float(o);
    g += dpp_g<0xB1>(g); g += dpp_g<0x4E>(g); g += dpp_g<0x141>(g); g += dpp_g<0x140>(g);
    const float su_b = M.tag == 0u ? B.su[0] : (M.tag == 1u ? B.su[1] : (M.tag == 2u ? B.su[2] : B.su[3]));
    const float gv_b = M.tag == 0u ? B.gv[0] : (M.tag == 1u ? B.gv[1] : (M.tag == 2u ? B.gv[2] : B.gv[3]));
    const float c = gv_b * gelu_tanh_fast(g * su_b);
    const float cq[4] = {__uint_as_float(__builtin_amdgcn_readlane(__float_as_uint(c), M.l0)), __uint_as_float(__builtin_amdgcn_readlane(__float_as_uint(c), M.l1)),
                         __uint_as_float(__builtin_amdgcn_readlane(__float_as_uint(c), M.l2)), __uint_as_float(__builtin_amdgcn_readlane(__float_as_uint(c), M.l3))};
#pragma unroll
    for (int q = 0; q < 4; ++q) { float v[16]; fp8x16_to_f32(B.V[q], v);
#pragma unroll
        for (int i = 0; i < 16; ++i) y[i] += cq[q] * v[i]; }
}
template <bool FINAL> DI void p_peer_gather(const Frame& F, const float* gn  , const float* modl  , const unsigned char* PU, const unsigned char* PV, const float* SU, const float* SV, const int* EIDX, const float* GATE, const float* gt2  , bf16_t* xb, float* out) {
    const int lane = F.lane;
    const RsMap M = rs_map_init();
    for (int tile = F.bid; tile < T / 64; tile += F.G) {
        for (int grp = 0; grp < 4; ++grp) {
            const int tb = tile * 64 + F.wave * 8 + grp * 2;
            float x[2][16], y[2][16]; int e0[2], e1[2]; float su0[2], su1[2], gv0[2], gv1[2];
#pragma unroll
            for (int i = 0; i < 2; ++i) { const int t = tb + i;
                { float rinv; norm_row16_b(xb + (size_t)t * D, lane, x[i], rinv);
                  ada_apply(x[i], rinv, gn, modl + (size_t)(t / SEQ) * 6144 + 4096, modl + (size_t)(t / SEQ) * 6144 + 3072, lane); }
#pragma unroll
                for (int k = 0; k < 16; ++k) y[i][k] = 0.f;
                e0[i] = EIDX[(size_t)t * 128 + lane]; e1[i] = EIDX[(size_t)t * 128 + 64 + lane];
                su0[i] = SU[e0[i]]; su1[i] = SU[e1[i]]; gv0[i] = GATE[(size_t)t * 128 + lane] * SV[e0[i]]; gv1[i] = GATE[(size_t)t * 128 + 64 + lane] * SV[e1[i]]; }
            for (int p = 0; p < PM_NP; ++p) {
#pragma unroll
                for (int i = 0; i < 2; ++i) {
                    unsigned long long mA = __builtin_amdgcn_ballot_w64((e0[i] >> PM_SHIFT) == p), mB = __builtin_amdgcn_ballot_w64((e1[i] >> PM_SHIFT) == p);
                    PBatch A, B;
                    pm_fetch(A, mA, mB, e0[i], e1[i], su0[i], su1[i], gv0[i], gv1[i], PU, PV, lane);
                    while (A.n > 0) {
                        pm_fetch(B, mA, mB, e0[i], e1[i], su0[i], su1[i], gv0[i], gv1[i], PU, PV, lane);
                        pm_comp(A, M, x[i], y[i]);
                        if (B.n == 0) break;
                        pm_fetch(A, mA, mB, e0[i], e1[i], su0[i], su1[i], gv0[i], gv1[i], PU, PV, lane);
                        pm_comp(B, M, x[i], y[i]);
                    }
                }
            }
#pragma unroll
            for (int i = 0; i < 2; ++i) { const int t = tb + i; const int b = t / SEQ; const float* gp = gt2 + (size_t)b * 6144; bf16_t* xp = xb + (size_t)t * D;
#pragma unroll
                for (int j = 0; j < 4; ++j) { const int c = 256 * j + 4 * lane; const f32x4 g = *(const f32x4*)(gp + c); const u32x2 xw = *(const u32x2*)(xp + c);
                    f32x4 xo = (f32x4){bf_lo(xw.x), bf_hi(xw.x), bf_lo(xw.y), bf_hi(xw.y)};
                    xo[0] += g[0] * y[i][4 * j]; xo[1] += g[1] * y[i][4 * j + 1]; xo[2] += g[2] * y[i][4 * j + 2]; xo[3] += g[3] * y[i][4 * j + 3];
                    if (FINAL) *(f32x4*)(out + (size_t)t * D + c) = xo; else *(u32x2*)(xp + c) = (u32x2){pack_bf16(xo[0], xo[1]), pack_bf16(xo[2], xo[3])}; } }
        }
    }
}
DI void norm_row16c(const float* xr, int lane, float (&v)[16], float& rinv) {
    float ss = 0.f;
#pragma unroll
    for (int j = 0; j < 2; ++j)
#pragma unroll
        for (int q = 0; q < 2; ++q) { const f32x4 a = *(const f32x4*)(xr + 512 * j + 8 * lane + 4 * q); v[8 * j + 4 * q] = a[0]; v[8 * j + 4 * q + 1] = a[1]; v[8 * j + 4 * q + 2] = a[2]; v[8 * j + 4 * q + 3] = a[3];
            ss += a[0] * a[0] + a[1] * a[1] + a[2] * a[2] + a[3] * a[3]; }
    ss = wave_sum(ss);
    rinv = rsqrtf(ss * (1.0f / 1024.0f) + 1e-6f);
}
DI void ada_apply_c(float (&v)[16], float rinv, const float* g, const float* sc, const float* sh, int lane) {
#pragma unroll
    for (int j = 0; j < 2; ++j)
#pragma unroll
        for (int q = 0; q < 2; ++q) { const int c = 512 * j + 8 * lane + 4 * q;
            const f32x4 gg = *(const f32x4*)(g + c), s1 = *(const f32x4*)(sc + c), s0 = *(const f32x4*)(sh + c);
#pragma unroll
            for (int e = 0; e < 4; ++e) v[8 * j + 4 * q + e] = v[8 * j + 4 * q + e] * rinv * gg[e] * (1.0f + s1[e]) + s0[e]; }
}
DI void row_load(const bf16_t* xr, int lane, float (&v)[16]) {
#pragma unroll
    for (int j = 0; j < 2; ++j) { const u32x4 a = *(const u32x4*)(xr + 512 * j + 8 * lane);
        v[8 * j] = bf_lo(a.x); v[8 * j + 1] = bf_hi(a.x); v[8 * j + 2] = bf_lo(a.y); v[8 * j + 3] = bf_hi(a.y); v[8 * j + 4] = bf_lo(a.z); v[8 * j + 5] = bf_hi(a.z); v[8 * j + 6] = bf_lo(a.w); v[8 * j + 7] = bf_hi(a.w); }
}
DI void row_finish(const float (&raw)[16], int lane, const LAS float* ga, const LAS float* sh, float (&v)[16]) {
    float ss = 0.f;
#pragma unroll
    for (int e = 0; e < 16; ++e) ss += raw[e] * raw[e];
    ss = wave_sum(ss);
    const float rinv = rsqrtf(ss * (1.0f / 1024.0f) + 1e-6f);
#pragma unroll
    for (int j = 0; j < 2; ++j)
#pragma unroll
        for (int q = 0; q < 2; ++q) { const int c = 512 * j + 8 * lane + 4 * q; const f32x4 gg = *(const LAS f32x4*)(ga + c), s0 = *(const LAS f32x4*)(sh + c);
#pragma unroll
            for (int e = 0; e < 4; ++e) v[8 * j + 4 * q + e] = raw[8 * j + 4 * q + e] * rinv * gg[e] + s0[e]; }
}
DI void p_rwkv_prep(const Frame& F, const bf16_t* x, const float* g, const float* modl, const float* mix, bf16_t* X6) {
    const int lane = F.lane;
    LAS float* ga = (LAS float*)F.lds; LAS float* shl = ga + 1024; LAS float* mixl = ga + 2048;
    int cur_b = -1;
    for (int run0 = F.bid * NWAVES; run0 < T / 8; run0 += F.G * NWAVES) {
        const int run = run0 + F.wave;
        const int bb = (run0 * 8) / SEQ;
        if (bb != cur_b) { __syncthreads();
            for (int i = F.tid; i < 1024; i += NTHREADS) { ga[i] = g[i] * (1.0f + modl[(size_t)bb * 6144 + 1024 + i]); shl[i] = modl[(size_t)bb * 6144 + i]; }
            if (cur_b < 0) for (int i = F.tid; i < 6 * 1024; i += NTHREADS) mixl[i] = mix[i];
            cur_b = bb; __syncthreads(); }
        const int r0 = run * 8, s0 = r0 % SEQ;
        float hp[16], hc[16], hn[16], ra[16], rb[16];
        if (s0 > 0) row_load(x + (size_t)(r0 - 1) * D, lane, ra);
        row_load(x + (size_t)r0 * D, lane, rb);
        if (s0 > 0) row_finish(ra, lane, ga, shl, hp);
        else {
#pragma unroll
            for (int i = 0; i < 16; ++i) hp[i] = 0.f; }
        if (s0 + 1 < SEQ) row_load(x + (size_t)(r0 + 1) * D, lane, ra);
        row_finish(rb, lane, ga, shl, hc);
        for (int i = 0; i < 8; ++i) {
            const int s = s0 + i;
            if (i + 1 < 8 && s + 2 < SEQ) row_load(x + (size_t)(r0 + i + 2) * D, lane, rb);
            if (s + 1 < SEQ) row_finish(ra, lane, ga, shl, hn);
            else {
#pragma unroll
                for (int e = 0; e < 16; ++e) hn[e] = 0.f; }
#pragma unroll
            for (int e = 0; e < 16; ++e) ra[e] = rb[e];
            float xx[16];
#pragma unroll
            for (int e = 0; e < 16; ++e) xx[e] = 0.5f * (hp[e] + hn[e]) - hc[e];
#pragma unroll
            for (int grp = 0; grp < 6; ++grp) { const int mi = grp == 0 ? 0 : (grp == 1 ? 2 : (grp == 2 ? 3 : (grp == 3 ? 1 : grp)));
                bf16_t* op = X6 + ((size_t)grp * T + r0 + i) * D;
#pragma unroll
                for (int j = 0; j < 2; ++j) { const f32x4 m0 = *(const LAS f32x4*)(mixl + mi * 1024 + 512 * j + 8 * lane), m1 = *(const LAS f32x4*)(mixl + mi * 1024 + 512 * j + 8 * lane + 4);
                    u32x4 w; w.x = pack_bf16(hc[8 * j] + xx[8 * j] * m0[0], hc[8 * j + 1] + xx[8 * j + 1] * m0[1]); w.y = pack_bf16(hc[8 * j + 2] + xx[8 * j + 2] * m0[2], hc[8 * j + 3] + xx[8 * j + 3] * m0[3]);
                    w.z = pack_bf16(hc[8 * j + 4] + xx[8 * j + 4] * m1[0], hc[8 * j + 5] + xx[8 * j + 5] * m1[1]); w.w = pack_bf16(hc[8 * j + 6] + xx[8 * j + 6] * m1[2], hc[8 * j + 7] + xx[8 * j + 7] * m1[3]);
                    *(u32x4*)(op + 512 * j + 8 * lane) = w; } }
#pragma unroll
            for (int e = 0; e < 16; ++e) { hp[e] = hc[e]; hc[e] = hn[e]; }
        }
    }
    __syncthreads();
}

constexpr int SC_L = 16;
constexpr int SC_NB = 5;
constexpr int SCP = 272;
constexpr int SCB_W = 0, SCB_BKZ = 16 * SCP, SCB_VV = 32 * SCP, SCB_AR = 48 * SCP, SCB_SIZE = 64 * SCP;
constexpr int SC_Y = SC_NB * SCB_SIZE;
constexpr int SC_CST = SC_Y + SC_NB * 4096;
constexpr int SC_AFR = SC_CST + 1280;
constexpr int SC_PS = SC_AFR + 16384;
constexpr int SC_SCR = SC_PS + SC_NB * 512;
constexpr int SC_FLG = SC_SCR + 16384;
constexpr int SC_CY = SC_FLG + 64;
static_assert(SC_CY + SC_NB * 256 <= LDS_BAR_OFF, "scan LDS map overflows");
DI void lds_wait_ge(volatile LAS int* p, int v) { while (*p < v) __builtin_amdgcn_s_sleep(1); asm volatile("" ::: "memory"); }
DI void p_rwkv_scan(const Frame& F) {
    const bf16_t* RK = (const bf16_t*)(F.ws + WS1_RK);
    bf16_t* Y = (bf16_t*)(F.ws + WS1_Y); float* BON = (float*)(F.ws + WS1_BON);
    const float* k_k = F.in[21]; const float* k_a = F.in[22]; const float* r_k = F.in[23];
    LAS unsigned char* lds = F.lds;
    const int tid = F.tid, lane = F.lane;
    constexpr int NCH = SEQ / SC_L;
    for (int u = F.bid; u < 256; u += F.G) {
        const int b = u >> 5, hd = (u >> 1) & 15, z = u & 1;
        __syncthreads();
        if (tid < 16) ((volatile LAS int*)(lds + SC_FLG))[tid] = 0;
        { const float* w2 = F.in[15] + (size_t)z * 65536 + hd * 64; const float* a2 = F.in[18] + (size_t)z * 65536 + hd * 64;
          LAS unsigned short* stw = (LAS unsigned short*)(lds + SC_AFR);
          for (int idx = tid; idx < 8192; idx += NTHREADS) { const int mat = idx >> 12, i = (idx >> 6) & 63, c = idx & 63;
              const float v = (mat ? a2 : w2)[(size_t)i * 1024 + c]; stw[mat * 4096 + c * 64 + i] = (unsigned short)(pack_bf16(v, 0.f) & 0xffffu); } }
        __syncthreads();
        if (F.wave >= 4) {
            const int pw = F.wave - 4, s16 = lane & 15, q = lane >> 4;
            const int chb = hd * 64 + 4 * q;
            const LAS unsigned short* stg = (const LAS unsigned short*)(lds + SC_AFR);
            LAS float* cst = (LAS float*)(lds + SC_CST);
            { cst[lane] = F.in[13][z * 1024 + hd * 64 + lane]; cst[64 + lane] = F.in[16][z * 1024 + hd * 64 + lane]; cst[128 + lane] = k_k[hd * 64 + lane]; cst[192 + lane] = k_a[hd * 64 + lane]; cst[256 + lane] = r_k[hd * 64 + lane]; }
            u32x2 rr[4], kr[4], vr[4]; u32x4 Bw[2], Ba[2];
#define SC_ROW(i_) ((size_t)(b * SEQ + (z ? (SEQ - 1 - (i_)) : (i_))))
#define SC_LOADC(cc) do { int s16l_ = s16, ql_ = q; asm volatile("" : "+v"(s16l_), "+v"(ql_)); const int chb_ = hd * 64 + 4 * ql_;     \
        const bf16_t* rp_ = RK + SC_ROW((cc) * SC_L + s16l_) * RW_N; \
        _Pragma("unroll") for (int cb = 0; cb < 4; ++cb) { rr[cb] = *(const u32x2*)(rp_ + chb_ + 16 * cb); kr[cb] = *(const u32x2*)(rp_ + 1024 + chb_ + 16 * cb); vr[cb] = *(const u32x2*)(rp_ + 2048 + chb_ + 16 * cb); } \
        _Pragma("unroll") for (int ks = 0; ks < 2; ++ks) { Bw[ks] = *(const u32x4*)(rp_ + 3072 + 64 * z + 32 * ks + 8 * ql_); Ba[ks] = *(const u32x4*)(rp_ + 3328 + 64 * z + 32 * ks + 8 * ql_); } } while (0)
#define SC_XFORM(cc_, buf_) do { \
            int s16_ = s16, q_ = q; asm volatile("" : "+v"(s16_), "+v"(q_));     \
            LAS unsigned char* bp = lds + (buf_) * SCB_SIZE; const int t_ = s16_; const bool odd_ = (s16_ & 1) != 0; \
            float ss = 0.f, bs = 0.f; LAS float* scr_ = (LAS float*)(lds + SC_SCR) + (pw * 4) * 256 + (q_ * 16 + s16_) * 4;     \
            _Pragma("unroll") for (int cb = 0; cb < 4; ++cb) { \
                f32x4 dw = __builtin_amdgcn_mfma_f32_16x16x32_bf16(*(const LAS bf16x8*)(stg + (16 * cb + s16_) * 64 + 8 * q_), __builtin_bit_cast(bf16x8, Bw[0]), (f32x4){0.f, 0.f, 0.f, 0.f}, 0, 0, 0); \
                dw = __builtin_amdgcn_mfma_f32_16x16x32_bf16(*(const LAS bf16x8*)(stg + (16 * cb + s16_) * 64 + 32 + 8 * q_), __builtin_bit_cast(bf16x8, Bw[1]), dw, 0, 0, 0); \
                f32x4 da = __builtin_amdgcn_mfma_f32_16x16x32_bf16(*(const LAS bf16x8*)(stg + 4096 + (16 * cb + s16_) * 64 + 8 * q_), __builtin_bit_cast(bf16x8, Ba[0]), (f32x4){0.f, 0.f, 0.f, 0.f}, 0, 0, 0); \
                da = __builtin_amdgcn_mfma_f32_16x16x32_bf16(*(const LAS bf16x8*)(stg + 4096 + (16 * cb + s16_) * 64 + 32 + 8 * q_), __builtin_bit_cast(bf16x8, Ba[1]), da, 0, 0, 0); \
                const f32x4 w0v = *(const LAS f32x4*)(cst + 16 * cb + 4 * q_), a0v = *(const LAS f32x4*)(cst + 64 + 16 * cb + 4 * q_); \
                const f32x4 kkw = *(const LAS f32x4*)(cst + 128 + 16 * cb + 4 * q_), kaw = *(const LAS f32x4*)(cst + 192 + 16 * cb + 4 * q_), rkw = *(const LAS f32x4*)(cst + 256 + 16 * cb + 4 * q_); \
                const float r4[4] = {bf_lo(rr[cb].x), bf_hi(rr[cb].x), bf_lo(rr[cb].y), bf_hi(rr[cb].y)}, k4[4] = {bf_lo(kr[cb].x), bf_hi(kr[cb].x), bf_lo(kr[cb].y), bf_hi(kr[cb].y)}; \
                f32x4 dec, azq, kzq; \
                _Pragma("unroll") for (int e = 0; e < 4; ++e) { \
                    const float sgw = __builtin_amdgcn_rcpf(1.0f + __builtin_amdgcn_exp2f(-1.4426950408889634f * (dw[e] + w0v[e])));     \
                    dec[e] = __builtin_amdgcn_exp2f(-0.8750387749f * sgw);                                                     \
                    const float az = __builtin_amdgcn_rcpf(1.0f + __builtin_amdgcn_exp2f(-1.4426950408889634f * (da[e] + a0v[e]))); azq[e] = az; \
                    { const float kk_ = k4[e] * kkw[e]; ss += kk_ * kk_; } kzq[e] = k4[e] * (1.0f + (az - 1.0f) * kaw[e]); bs += r4[e] * kzq[e] * rkw[e]; } \
                { const int o = t_ * SCP + (16 * cb + 4 * q_) * 4; \
                    *(LAS f32x4*)(scr_ + cb * 256) = azq; *(LAS f32x4*)(bp + SCB_BKZ + o) = kzq;     \
                    *(LAS f32x4*)(bp + SCB_W + o) = dec;                        \
                    *(LAS f32x4*)(bp + SCB_VV + o) = (f32x4){bf_lo(vr[cb].x), bf_hi(vr[cb].x), bf_lo(vr[cb].y), bf_hi(vr[cb].y)}; } } \
            ss += __shfl_xor(ss, 16); ss += __shfl_xor(ss, 32); bs += __shfl_xor(bs, 16); bs += __shfl_xor(bs, 32); \
            const float inv = __builtin_amdgcn_rsqf(fmaxf(ss, 1e-24f));     \
              \
            float s_bb = 0.f, s_kk = 0.f, c_g = 0.f, c_h = 0.f, c_br = 0.f, c_kr = 0.f; const bool pB_ = (s16_ & 2) != 0;     \
            f32x4 Ga = (f32x4){0.f, 0.f, 0.f, 0.f}, Gr = Ga;     \
            _Pragma("unroll") for (int cb = 0; cb < 4; ++cb) { float kn[4], bo[4], bq[4], kq[4]; \
                const float r4[4] = {bf_lo(rr[cb].x), bf_hi(rr[cb].x), bf_lo(rr[cb].y), bf_hi(rr[cb].y)}, k4[4] = {bf_lo(kr[cb].x), bf_hi(kr[cb].x), bf_lo(kr[cb].y), bf_hi(kr[cb].y)}; \
                const f32x4 kkw = *(const LAS f32x4*)(cst + 128 + 16 * cb + 4 * q_); \
                const f32x4 dcv = *(const LAS f32x4*)(bp + SCB_W + t_ * SCP + (16 * cb + 4 * q_) * 4), wp = *(const LAS f32x4*)(bp + SCB_W + (t_ ^ 1) * SCP + (16 * cb + 4 * q_) * 4);     \
                const f32x4 azq = *(const LAS f32x4*)(scr_ + cb * 256), kzq = *(const LAS f32x4*)(bp + SCB_BKZ + t_ * SCP + (16 * cb + 4 * q_) * 4); \
                _Pragma("unroll") for (int e = 0; e < 4; ++e) { kn[e] = k4[e] * kkw[e] * inv; bo[e] = kn[e] * azq[e]; \
                    bq[e] = dpp_g<0xB1>(bo[e]); kq[e] = dpp_g<0xB1>(kzq[e]); \
                    const float ao = -kn[e], rd = r4[e] * dcv[e]; \
                    s_bb += bo[e] * r4[e]; s_kk += kzq[e] * r4[e]; c_g += bq[e] * ao; c_h += kq[e] * ao; c_br += bq[e] * rd; c_kr += kq[e] * rd; } \
                float fb[4], fk[4], xa[4], xr[4], wq[4], sA[4], sB[4]; \
                _Pragma("unroll") for (int e = 0; e < 4; ++e) { const float wpr = dcv[e] * wp[e], wo = dpp_g<0x4E>(wpr);     \
                    const float mb = odd_ ? 1.0f : wp[e], ma = odd_ ? -wp[e] : -1.0f, mr = odd_ ? wpr : dcv[e]; \
                    fb[e] = bo[e] * mb; fk[e] = kzq[e] * mb; xa[e] = kn[e] * ma; xr[e] = r4[e] * mr; wq[e] = wpr * wo; sA[e] = pB_ ? 1.0f : wo; sB[e] = pB_ ? wo : 1.0f; \
                    const float fb0 = dpp_g<0x00>(fb[e]), fk0 = dpp_g<0x00>(fk[e]), fb1 = dpp_g<0x55>(fb[e]), fk1 = dpp_g<0x55>(fk[e]);     \
                    Ga[0] += fb0 * xa[e]; Ga[1] += fk0 * xa[e]; Ga[2] += fb1 * xa[e]; Ga[3] += fk1 * xa[e]; Gr[0] += fb0 * xr[e]; Gr[1] += fk0 * xr[e]; Gr[2] += fb1 * xr[e]; Gr[3] += fk1 * xr[e]; } \
                *(LAS f32x4*)(bp + SCB_W + t_ * SCP + (16 * cb + 4 * q_) * 4) = (f32x4){wq[0], wq[1], wq[2], wq[3]};            \
                *(LAS u32x4*)(bp + SCB_BKZ + t_ * SCP + (16 * cb + 4 * q_) * 4) = (u32x4){pack_bf16(fb[0] * sA[0], fk[0] * sA[0]), pack_bf16(fb[1] * sA[1], fk[1] * sA[1]), pack_bf16(fb[2] * sA[2], fk[2] * sA[2]), pack_bf16(fb[3] * sA[3], fk[3] * sA[3])};     \
                *(LAS u32x2*)(bp + SCB_AR + t_ * SCP + ((cb >> 1) * 4 + q_) * 16 + (cb & 1) * 8) = (u32x2){pack_bf16(xa[0] * sB[0], xa[1] * sB[1]), pack_bf16(xa[2] * sB[2], xa[3] * sB[3])};            \
                *(LAS u32x2*)(bp + SCB_AR + t_ * SCP + 128 + ((cb >> 1) * 4 + q_) * 16 + (cb & 1) * 8) = (u32x2){pack_bf16(xr[0] * sB[0], xr[1] * sB[1]), pack_bf16(xr[2] * sB[2], xr[3] * sB[3])}; }   \
            s_bb += __shfl_xor(s_bb, 16); s_bb += __shfl_xor(s_bb, 32); s_kk += __shfl_xor(s_kk, 16); s_kk += __shfl_xor(s_kk, 32); \
            c_g += __shfl_xor(c_g, 16); c_g += __shfl_xor(c_g, 32); c_h += __shfl_xor(c_h, 16); c_h += __shfl_xor(c_h, 32); \
            c_br += __shfl_xor(c_br, 16); c_br += __shfl_xor(c_br, 32); c_kr += __shfl_xor(c_kr, 16); c_kr += __shfl_xor(c_kr, 32); \
            _Pragma("unroll") for (int e = 0; e < 4; ++e) { Ga[e] += __shfl_xor(Ga[e], 16); Ga[e] += __shfl_xor(Ga[e], 32); Gr[e] += __shfl_xor(Gr[e], 16); Gr[e] += __shfl_xor(Gr[e], 32); } \
            if (q_ == 0) { LAS float* ps_ = (LAS float*)(lds + SC_PS + (buf_) * 512) + (t_ >> 1) * 8;     \
                if (odd_) { ps_[0] = c_g; ps_[1] = c_h; } \
                if (pB_) { LAS float* pq_ = (LAS float*)(lds + SC_PS + (buf_) * 512) + 64 + (t_ >> 2) * 16 + (odd_ ? 4 : 0); *(LAS f32x4*)pq_ = Ga; } \
                  \
                const float o0_ = odd_ ? c_br : s_bb, o1_ = odd_ ? c_kr : s_kk, o2_ = odd_ ? s_bb : 0.f, o3_ = odd_ ? s_kk : 0.f; \
                const unsigned ow0_ = pack_bf16(o0_, o1_), ow1_ = pack_bf16(o2_, o3_), gw0_ = pack_bf16(Gr[0], Gr[1]), gw1_ = pack_bf16(Gr[2], Gr[3]); \
                *(LAS u32x4*)(lds + SC_CY + (buf_) * 256 + (t_ >> 2) * 64 + (t_ & 3) * 16) = pB_ ? (u32x4){gw0_, gw1_, ow0_, ow1_} : (u32x4){ow0_, ow1_, 0u, 0u}; \
                BON[((size_t)z * T + SC_ROW((cc_) * SC_L + t_)) * 16 + hd] = bs; } } while (0)
#define SC_FLUSH(cc, slot_) do { const LAS float* yb_ = (const LAS float*)(lds + SC_Y + (slot_) * 4096); const int ft_ = lane >> 2, fj_ = (lane & 3) * 16;     \
            const f32x4 y0_ = *(const LAS f32x4*)(yb_ + ft_ * 64 + fj_), y1_ = *(const LAS f32x4*)(yb_ + ft_ * 64 + fj_ + 4), y2_ = *(const LAS f32x4*)(yb_ + ft_ * 64 + fj_ + 8), y3_ = *(const LAS f32x4*)(yb_ + ft_ * 64 + fj_ + 12); \
            bf16_t* yp_ = Y + ((size_t)z * T + SC_ROW((cc) * SC_L + ft_)) * D + hd * 64 + fj_; \
            *(u32x4*)yp_ = (u32x4){pack_bf16(y0_[0], y0_[1]), pack_bf16(y0_[2], y0_[3]), pack_bf16(y1_[0], y1_[1]), pack_bf16(y1_[2], y1_[3])}; \
            *(u32x4*)(yp_ + 8) = (u32x4){pack_bf16(y2_[0], y2_[1]), pack_bf16(y2_[2], y2_[3]), pack_bf16(y3_[0], y3_[1]), pack_bf16(y3_[2], y3_[3])}; } while (0)
            volatile LAS int* rdy = (volatile LAS int*)(lds + SC_FLG); volatile LAS int* prog = rdy + 8;
            SC_LOADC(pw);
            for (int n = pw; n < NCH; n += 4) {
                const int buf = n % SC_NB;
                if (n >= SC_NB) { lds_wait_ge(prog + 0, n - 4); lds_wait_ge(prog + 1, n - 4); lds_wait_ge(prog + 2, n - 4); lds_wait_ge(prog + 3, n - 4); SC_FLUSH(n - SC_NB, buf); }
                SC_XFORM(n, buf);
                asm volatile("s_waitcnt lgkmcnt(0)" ::: "memory");
                if (lane == 0) rdy[buf] = n + 1;
                if (n + 4 < NCH) SC_LOADC(n + 4);
            }
            for (int c = NCH - SC_NB; c < NCH; ++c) if (((c + SC_NB) & 3) == pw) {
                lds_wait_ge(prog + 0, c + 1); lds_wait_ge(prog + 1, c + 1); lds_wait_ge(prog + 2, c + 1); lds_wait_ge(prog + 3, c + 1); SC_FLUSH(c, c % SC_NB); }
#undef SC_ROW
#undef SC_LOADC
#undef SC_XFORM
#undef SC_FLUSH
        } else {
            const int w = F.wave, i16 = lane & 15, q = lane >> 4;
            f32x4 Sd[4];
#pragma unroll
            for (int k = 0; k < 4; ++k) Sd[k] = (f32x4){0.f, 0.f, 0.f, 0.f};
            const int m4 = i16 & 3;
            const int w_off = (4 * q) * 4, bkz_off = i16 * 4, vv_off = (16 * w + i16) * 4, ar_off = (m4 & 1) * SCP + (m4 >> 1) * 128 + q * 16;
            const int bkq_off = (2 * (q & 1)) * SCP + i16 * 4;
            __builtin_amdgcn_s_setprio(3);
            typedef short s16x4v __attribute__((ext_vector_type(4)));
#define ST_LD(o_, Q_) do { _Pragma("unroll") for (int j = 0; j < 4; ++j) o_.vv[j] = *(const LAS float*)(bp + SCB_VV + (4 * (Q_) + j) * SCP + vv_off); \
        o_.a1lo = *(const LAS bf16x8*)(bp + SCB_AR + (4 * (Q_)) * SCP + ar_off); o_.a1hi = *(const LAS bf16x8*)(bp + SCB_AR + (4 * (Q_)) * SCP + 64 + ar_off); \
        o_.a2lo = *(const LAS bf16x8*)(bp + SCB_AR + (4 * (Q_) + 2) * SCP + ar_off); o_.a2hi = *(const LAS bf16x8*)(bp + SCB_AR + (4 * (Q_) + 2) * SCP + 64 + ar_off); } while (0)
#define ST_STEP(o_, Q_) do { \
        const bf16x8 Bd0 = __builtin_bit_cast(bf16x8, (u32x4){pack_bf16(Sd[0][0], Sd[0][1]), pack_bf16(Sd[0][2], Sd[0][3]), pack_bf16(Sd[1][0], Sd[1][1]), pack_bf16(Sd[1][2], Sd[1][3])}); \
        const bf16x8 Bd1 = __builtin_bit_cast(bf16x8, (u32x4){pack_bf16(Sd[2][0], Sd[2][1]), pack_bf16(Sd[2][2], Sd[2][3]), pack_bf16(Sd[3][0], Sd[3][1]), pack_bf16(Sd[3][2], Sd[3][3])}); \
        const f32x4 d1a = __builtin_amdgcn_mfma_f32_16x16x32_bf16(o_.a1lo, Bd0, (f32x4){0.f, 0.f, 0.f, 0.f}, 0, 0, 0); \
        const f32x4 e1a = __builtin_amdgcn_mfma_f32_16x16x32_bf16(o_.a2lo, Bd0, (f32x4){0.f, 0.f, 0.f, 0.f}, 0, 0, 0); \
        const f32x4 dd = __builtin_amdgcn_mfma_f32_16x16x32_bf16(o_.a1hi, Bd1, d1a, 0, 0, 0); \
        const f32x4 ee = __builtin_amdgcn_mfma_f32_16x16x32_bf16(o_.a2hi, Bd1, e1a, 0, 0, 0); \
        const LAS float* pa_ = psp + (2 * (Q_)) * 8; const LAS float* pg_ = psp + 64 + (Q_) * 16; \
        const f32x4 pA0 = *(const LAS f32x4*)pa_, pB0 = *(const LAS f32x4*)(pa_ + 8), g0 = *(const LAS f32x4*)pg_, g1 = *(const LAS f32x4*)(pg_ + 4); \
        const u32x2 cyw = *(const LAS u32x2*)(cyp + (Q_) * 64); \
        f32x4 wv[4]; u32x2 bk[4]; \
        _Pragma("unroll") for (int k = 0; k < 4; ++k) { wv[k] = *(const LAS f32x4*)(bp + SCB_W + (4 * (Q_)) * SCP + 64 * k + w_off); \
            bk[k] = (u32x2){*(const LAS unsigned*)(bkp + (4 * (Q_)) * SCP + 64 * k), *(const LAS unsigned*)(bkp + (4 * (Q_) + 1) * SCP + 64 * k)}; } \
        const float v1 = o_.vv[0], v2 = o_.vv[1], v3 = o_.vv[2], v4 = o_.vv[3]; \
        const float u1 = dd[0]; \
        const float u2 = dd[1] + u1 * pA0[0] + v1 * pA0[1]; \
        const float u3 = ee[0] + u1 * g0[0] + v1 * g0[1] + u2 * g0[2] + v2 * g0[3]; \
        const float u4 = ee[1] + u1 * g1[0] + v1 * g1[1] + u2 * g1[2] + v2 * g1[3] + u3 * pB0[0] + v3 * pB0[1]; \
        const unsigned pa0_ = pack_bf16(u1, v1), pa1_ = pack_bf16(u2, v2), pb0_ = pack_bf16(u3, v3), pb1_ = pack_bf16(u4, v4); \
        unsigned b2lo = (q & 1) ? pb0_ : pa0_, b2hi = (q & 1) ? pb1_ : pa1_; b2lo = (q & 2) ? 0u : b2lo; b2hi = (q & 2) ? 0u : b2hi;     \
        const s16x4v B2 = __builtin_bit_cast(s16x4v, (u32x2){b2lo, b2hi}); \
        _Pragma("unroll") for (int k = 0; k < 4; ++k) Sd[k] = __builtin_amdgcn_mfma_f32_16x16x16bf16_1k(__builtin_bit_cast(s16x4v, bk[k]), B2, Sd[k] * wv[k], 0, 0, 0); \
        const f32x4 yv = __builtin_amdgcn_mfma_f32_16x16x16bf16_1k(__builtin_bit_cast(s16x4v, cyw), B2, (f32x4){dd[2], dd[3], ee[2], ee[3]}, 0, 0, 0);     \
        yb[(4 * (Q_)) * 64 + 16 * w + i16] = yv[0]; yb[(4 * (Q_) + 1) * 64 + 16 * w + i16] = yv[1]; yb[(4 * (Q_) + 2) * 64 + 16 * w + i16] = yv[2]; yb[(4 * (Q_) + 3) * 64 + 16 * w + i16] = yv[3]; } while (0)
            struct StepOps { float vv[4]; bf16x8 a1lo, a1hi, a2lo, a2hi; };
            volatile LAS int* rdy = (volatile LAS int*)(lds + SC_FLG); volatile LAS int* prog = rdy + 8;
            int buf = 0;
            for (int c = 0; c < NCH; ++c) {
                const LAS unsigned char* bp = lds + buf * SCB_SIZE; LAS float* yb = (LAS float*)(lds + SC_Y + buf * 4096);
                const LAS unsigned char* bkp = bp + SCB_BKZ + bkq_off;
                const LAS float* psp = (const LAS float*)(lds + SC_PS + buf * 512);
                const LAS unsigned char* cyp = lds + SC_CY + buf * 256 + (i16 & 3) * 16 + (q & 1) * 8;
                lds_wait_ge(rdy + buf, c + 1);
                const bool conv = (c & 3) == w; float tv[16]; const int tr = u * NCH + c, ttab = tr >> 14, trow = tr & 16383;
                int ln2 = lane; asm volatile("" : "+v"(ln2));
                if (conv) fp8_row_load(F.in[ttab ? 30 : 29] + (size_t)N_EXPERTS * 1024, trow, ln2, tv);
                else {
#pragma unroll
                    for (int i = 0; i < 16; ++i) tv[i] = 0.f; }
                StepOps oa, ob; ST_LD(oa, 0);
                ST_LD(ob, 1); ST_STEP(oa, 0);
                ST_LD(oa, 2); ST_STEP(ob, 1);
                ST_LD(ob, 3); ST_STEP(oa, 2);
                ST_STEP(ob, 3);
                asm volatile("s_waitcnt lgkmcnt(0)" ::: "memory");
                if (lane == 0) prog[w] = c + 1;
                if (conv) fp8_row_store(tv, trow, ln2, F.ws + (ttab ? WS_PV1 : WS_PU1), (float*)(F.ws + WS_PSC) + (2 + ttab) * N_EXPERTS);
                buf = (buf + 1 == SC_NB) ? 0 : buf + 1;
            }
#undef ST_LD
#undef ST_STEP
            __builtin_amdgcn_s_setprio(0);
            __builtin_amdgcn_s_setprio(0);
        }
    }
    __syncthreads();
}

DI void unpack8(const u32x4 w, float* o) { o[0] = bf_lo(w.x); o[1] = bf_hi(w.x); o[2] = bf_lo(w.y); o[3] = bf_hi(w.y); o[4] = bf_lo(w.z); o[5] = bf_hi(w.z); o[6] = bf_lo(w.w); o[7] = bf_hi(w.w); }
DI void p_rwkv_post(const Frame& F) {
    const bf16_t* RK = (const bf16_t*)(F.ws + WS1_RK); const bf16_t* Y = (const bf16_t*)(F.ws + WS1_Y); const float* BON = (const float*)(F.ws + WS1_BON);
    const bf16_t* G = (const bf16_t*)(F.ws + WS1_G); bf16_t* A3 = (bf16_t*)(F.ws + WS1_A3);
    const float* ln_g = F.in[24]; const float* ln_b = F.in[25];
    const int lane = F.lane, c0 = 16 * lane, hd = lane >> 2;
    for (int t = F.bid * NWAVES + F.wave; t < T; t += F.G * NWAVES) {
        float y[16], tmp[16], vv[16], gg[16];
        unpack8(*(const u32x4*)(Y + (size_t)t * D + c0), y); unpack8(*(const u32x4*)(Y + (size_t)t * D + c0 + 8), y + 8);
        unpack8(*(const u32x4*)(Y + ((size_t)T + t) * D + c0), tmp); unpack8(*(const u32x4*)(Y + ((size_t)T + t) * D + c0 + 8), tmp + 8);
        unpack8(*(const u32x4*)(RK + (size_t)t * RW_N + 2048 + c0), vv); unpack8(*(const u32x4*)(RK + (size_t)t * RW_N + 2048 + c0 + 8), vv + 8);
        unpack8(*(const u32x4*)(G + (size_t)t * D + c0), gg); unpack8(*(const u32x4*)(G + (size_t)t * D + c0 + 8), gg + 8);
        const float bon = BON[(size_t)t * 16 + hd] + BON[((size_t)T + t) * 16 + hd];
        float sm = 0.f;
#pragma unroll
        for (int e = 0; e < 16; ++e) { y[e] += tmp[e]; sm += y[e]; }
        sm += __shfl_xor(sm, 1); sm += __shfl_xor(sm, 2);
        const float mu = sm * (1.0f / 64.0f);
        float vr = 0.f;
#pragma unroll
        for (int e = 0; e < 16; ++e) { const float d = y[e] - mu; vr += d * d; }
        vr += __shfl_xor(vr, 1); vr += __shfl_xor(vr, 2);
        const float rs = rsqrtf(vr * (1.0f / 64.0f) + 64e-5f);
        float o[16];
#pragma unroll
        for (int q = 0; q < 4; ++q) { const f32x4 lg = *(const f32x4*)(ln_g + c0 + 4 * q), lb = *(const f32x4*)(ln_b + c0 + 4 * q);
#pragma unroll
            for (int e = 0; e < 4; ++e) { const int i = 4 * q + e; o[i] = ((y[i] - mu) * rs * lg[e] + lb[e] + bon * vv[i]) * gg[i]; } }
        u32x4 w0, w1; w0.x = pack_bf16(o[0], o[1]); w0.y = pack_bf16(o[2], o[3]); w0.z = pack_bf16(o[4], o[5]); w0.w = pack_bf16(o[6], o[7]);
        w1.x = pack_bf16(o[8], o[9]); w1.y = pack_bf16(o[10], o[11]); w1.z = pack_bf16(o[12], o[13]); w1.w = pack_bf16(o[14], o[15]);
        *(u32x4*)(A3 + (size_t)t * D + c0) = w0; *(u32x4*)(A3 + (size_t)t * D + c0 + 8) = w1;
    }
}
__global__ void __launch_bounds__(NTHREADS, 2) mega_fwd(Params P) {
    extern __shared__ __attribute__((aligned(16))) unsigned char lds_raw[];
    Frame F;
    F.lds = (LAS unsigned char*)lds_raw;
    F.tid = threadIdx.x; F.lane = F.tid & 63; F.wave = __builtin_amdgcn_readfirstlane(F.tid >> 6);
    F.G = gridDim.x; F.bid = blockIdx.x; F.in = P.in; F.out = P.out; F.ws = P.ws;
    volatile LAS unsigned* bst = (volatile LAS unsigned*)(F.lds + LDS_BAR_OFF);
    if (F.tid == 0) { bst[0] = 0u; bst[1] = 0u; bst[2] = 0u; bst[3] = 0u; }
    __syncthreads();
    XcdBarrier bar = xcd_barrier_post((unsigned*)(P.ws + WS_CTL), bst);
    const int lo = P.ph_lo, hi = P.ph_hi;
#ifdef ONLY_PHASE
#define IN(k) ((k) == ONLY_PHASE && lo <= (k) && (k) < hi)
#else
#define IN(k) (lo <= (k) && (k) < hi)
#endif
#define SEAM(k) do { if (IN(k) && IN((k) + 1)) xcd_barrier(bar); } while (0)
#define LSEAM(k) do { if (IN(k) && IN((k) + 1)) __syncthreads(); } while (0)
#define LAUNDER(T, dst, src) T dst; { unsigned long long _v = (unsigned long long)(src); unsigned _lo = (unsigned)_v, _hi = (unsigned)(_v >> 32); asm volatile("" : "+s"(_lo), "+s"(_hi)); dst = (T)(__attribute__((address_space(1))) unsigned char*)(((unsigned long long)_hi << 32) | _lo); }
#define PH_BEGIN LAUNDER(unsigned char*, ws, P.ws) LAUNDER(float*, outp, P.out) F.ws = ws; F.out = outp; \
    const float* mod0 = (const float*)(ws + WS_MOD); const float* mod1 = mod0 + 8 * 6144; const float* norm_g = P.in[4]; bf16_t* H = (bf16_t*)(ws + WS_H); bf16_t* H2 = (bf16_t*)(ws + WS1_H2); \
    (void)mod0; (void)mod1; (void)norm_g; (void)H; (void)H2;

    if (IN(0)) { PH_BEGIN p0_prologue(F); } SEAM(0);
    if (IN(1)) { PH_BEGIN p_norm<false>(F, P.in[0], norm_g + 0 * 1024, mod0, 0, 1024, H); } SEAM(1);
    if (IN(2)) { PH_BEGIN pg8::Gemm g{H, (const bf16_t*)(ws + WS_WIN_T), T, IN_W, 1024, 1024, 1024}; pg8::StaticOrder S; S.init(T, IN_W, F.G, F.bid);
        pg8::EpiBf16<0> E{(bf16_t*)(ws + WS_QKV), IN_W}; pg8::gemm_phase(F.lds, g, S, E);
        p0_late_weights(F, (T / 256) * (IN_W / 256)); } SEAM(2);
    if (IN(3)) { PH_BEGIN p_qkprep(F); } SEAM(3);
    if (IN(4)) { PH_BEGIN p_attention<3>(F); } SEAM(4);
    if (IN(5)) { PH_BEGIN pg8::Gemm g{(const bf16_t*)(ws + WS_O), (const bf16_t*)(ws + WS_WOUT_T), T, 1024, 1024, 1024, 1024}; pg8::StaticOrder S; S.init(T, 1024, F.G, F.bid);
        pg8::EpiResid<false> E{P.in[0], (bf16_t*)(ws + WS_XB), mod0 + 2048, (float*)(ws + WS_SSQ)}; pg8::gemm_phase(F.lds, g, S, E); } SEAM(5);
    if (IN(7)) { PH_BEGIN pg8::Gemm g{(const bf16_t*)(ws + WS_XB), (const bf16_t*)outp, T, 2048, 1024, 1024, 1024}; pg8::BatchOrder S; S.init(T, 2048, F.G, F.bid);
        pg8::EpiQ E{(bf16_t*)(ws + WS_PQ), PQ_LD, (const float*)(ws + WS_SSQ), (const float*)(ws + WS_BQ), nullptr, -1}; { pg8::Unit u0; E.prep(F.lds, S.next(0, u0) ? u0.pm : -1, F.tid); } pg8::gemm_phase(F.lds, g, S, E); } SEAM(7);
    if (IN(8)) { PH_BEGIN p_peer_topk(F, (const bf16_t*)(ws + WS_PQ), (const bf16_t*)(ws + WS_SK), (int*)(ws + WS_EIDX), (float*)(ws + WS_GATE)); } LSEAM(8);
    if (IN(9)) { PH_BEGIN p_peer_gather<false>(F, norm_g + 1 * 1024, mod0, ws + WS_PU0, ws + WS_PV0, (const float*)(ws + WS_PSC), (const float*)(ws + WS_PSC) + N_EXPERTS, (const int*)(ws + WS_EIDX), (const float*)(ws + WS_GATE), mod0 + 5120, (bf16_t*)(ws + WS_XB), outp); } SEAM(9);
    if (IN(10)) { PH_BEGIN p_rwkv_prep(F, (const bf16_t*)(ws + WS_XB), norm_g + 2 * 1024, mod1, P.in[11], (bf16_t*)(ws + WS1_X6)); } SEAM(10);
    if (IN(11)) { PH_BEGIN pg8::Gemm g{(const bf16_t*)(ws + WS1_X6), (const bf16_t*)(ws + WS_WRW_T), 6 * T, RW_N, 1024, 1024, 1024}; pg8::RwOrder S; S.init(F.G, F.bid);
        pg8::EpiBf16<1> E{(bf16_t*)(ws + WS1_RK), RW_N}; pg8::gemm_phase(F.lds, g, S, E);
        p0_late_weights2(F); } SEAM(11);
    if (IN(12)) { PH_BEGIN pg8::Gemm g{(const bf16_t*)(ws + WS1_RK) + 3584, (const bf16_t*)(ws + WS_G2_T), T, 1024, 256, RW_N, 256}; pg8::StaticOrder S; S.init(T, 1024, F.G, F.bid);
        pg8::EpiBf16<0> E{(bf16_t*)(ws + WS1_G), 1024}; pg8::gemm_phase(F.lds, g, S, E); }
    if (IN(13)) { PH_BEGIN p_rwkv_scan(F); } SEAM(13);
    if (IN(14)) { PH_BEGIN p_rwkv_post(F); } SEAM(14);
    if (IN(15)) { PH_BEGIN pg8::Gemm g{(const bf16_t*)(ws + WS1_A3), (const bf16_t*)(ws + WS_WO_T), T, 1024, 1024, 1024, 1024}; pg8::StaticOrder S; S.init(T, 1024, F.G, F.bid);
        pg8::EpiResid<true> E{ws + WS_XB, (bf16_t*)(ws + WS_XB), mod1 + 2048, (float*)(ws + WS_SSQ)}; pg8::gemm_phase(F.lds, g, S, E); } SEAM(15);
    if (IN(17)) { PH_BEGIN pg8::Gemm g{(const bf16_t*)(ws + WS_XB), (const bf16_t*)outp + (size_t)8 * 2048 * 1024, T, 2048, 1024, 1024, 1024}; pg8::BatchOrder S; S.init(T, 2048, F.G, F.bid);
        pg8::EpiQ E{(bf16_t*)(ws + WS1_PQ), PQ_LD, (const float*)(ws + WS_SSQ), (const float*)(ws + WS_BQ) + 8 * 2048, nullptr, -1}; { pg8::Unit u0; E.prep(F.lds, S.next(0, u0) ? u0.pm : -1, F.tid); } pg8::gemm_phase(F.lds, g, S, E); } SEAM(17);
    if (IN(18)) { PH_BEGIN p_peer_topk(F, (const bf16_t*)(ws + WS1_PQ), (const bf16_t*)(ws + WS_SK) + (size_t)16 * 128 * 128, (int*)(ws + WS1_EIDX), (float*)(ws + WS1_GATE)); } LSEAM(18);
    if (IN(19)) { PH_BEGIN p_peer_gather<true>(F, norm_g + 3 * 1024, mod1, ws + WS_PU1, ws + WS_PV1, (const float*)(ws + WS_PSC) + 2 * N_EXPERTS, (const float*)(ws + WS_PSC) + 3 * N_EXPERTS, (const int*)(ws + WS1_EIDX), (const float*)(ws + WS1_GATE), mod1 + 5120, (bf16_t*)(ws + WS_XB), outp); }
    if (hi <= 5) { const f32x4* s = (const f32x4*)P.in[0]; f32x4* d = (f32x4*)P.out;
        for (size_t i = (size_t)F.bid * NTHREADS + F.tid; i < (size_t)T * D / 4; i += (size_t)F.G * NTHREADS) d[i] = s[i]; }
#undef IN
#undef SEAM
#undef LSEAM
}

#ifndef PH_HI
#define PH_HI 20
#endif
extern "C" void kernel_launch(void* const* d_in, const int* in_sizes, int n_in, void* d_out, int out_size, void* d_ws, size_t ws_size, hipStream_t stream) {
    static int grid = 0;
    if (grid == 0) {
        if (n_in != 31 || out_size != T * D || ws_size < WS_END) { fprintf(stderr, "kernel_launch: unexpected shapes (n_in %d, out %d, ws %zu)\n", n_in, out_size, ws_size); grid = -1; return; }
        int dev = 0, cus = 0, per_cu = 0;
        if (hipGetDevice(&dev) != hipSuccess || hipDeviceGetAttribute(&cus, hipDeviceAttributeMultiprocessorCount, dev) != hipSuccess) { grid = -1; return; }
        if (hipFuncSetAttribute((const void*)mega_fwd, hipFuncAttributeMaxDynamicSharedMemorySize, LDS_BYTES) != hipSuccess) { fprintf(stderr, "kernel_launch: hipFuncSetAttribute failed\n"); grid = -1; return; }
        if (hipOccupancyMaxActiveBlocksPerMultiprocessor(&per_cu, (const void*)mega_fwd, NTHREADS, LDS_BYTES) != hipSuccess || per_cu < 1) { fprintf(stderr, "kernel_launch: occupancy query says %d\n", per_cu); (void)hipGetLastError(); grid = -1; return; }
        grid = cus;
    }
    if (grid < 0) return;
    (void)hipMemsetAsync((char*)d_ws + WS_CTL, 0, CTL_ZERO_BYTES, stream);
    Params p{};
    for (int i = 0; i < 31; ++i) p.in[i] = (const float*)d_in[i];
    p.out = (float*)d_out; p.ws = (unsigned char*)d_ws; p.ph_lo = 0; p.ph_hi = PH_HI;
    hipLaunchKernelGGL(mega_fwd, dim3(grid), dim3(NTHREADS), LDS_BYTES, stream, p);
}
```

```cpp
#include <hip/hip_runtime.h>
#include <cstdio>
#include <cstdint>

#define DI __device__ __forceinline__
#define LAS __attribute__((address_space(3)))
typedef unsigned short bf16_t;
typedef short bf16x8 __attribute__((ext_vector_type(8)));
typedef short s16x4 __attribute__((ext_vector_type(4)));
typedef float f32x2 __attribute__((ext_vector_type(2)));
typedef float f32x4 __attribute__((ext_vector_type(4)));
typedef float f32x16 __attribute__((ext_vector_type(16)));
typedef unsigned u32x2 __attribute__((ext_vector_type(2)));
typedef unsigned u32x4 __attribute__((ext_vector_type(4)));
typedef __bf16 bf16x2v __attribute__((ext_vector_type(2)));

DI unsigned pack_bf16(float lo, float hi) { bf16x2v p; p[0] = (__bf16)lo; p[1] = (__bf16)hi; return __builtin_bit_cast(unsigned, p); }
DI float bf_lo(unsigned u) { return __uint_as_float(u << 16); }
DI float bf_hi(unsigned u) { return __uint_as_float(u & 0xffff0000u); }
DI float bf1(bf16_t v) { return __uint_as_float(((unsigned)v) << 16); }
DI float wave_sum(float v) {
#pragma unroll
    for (int o = 32; o > 0; o >>= 1) v += __shfl_xor(v, o);
    return v;
}
DI float sigmoidf_(float x) { return 1.0f / (1.0f + __expf(-x)); }

constexpr int D = 1024, BATCH = 8, SEQ = 2048, T = BATCH * SEQ;
constexpr int IN_W = 2304;
constexpr int NTHREADS = 512, NWAVES = 8;
constexpr int PQ_LD = 2112;
constexpr int N_EXPERTS = 16384;
constexpr float LOG2E = 1.4426950408889634f;
constexpr float QSCALE = 0.125f * LOG2E;
constexpr size_t MiB = 1ull << 20;

constexpr size_t WS_CTL   = 0;
constexpr size_t CTL_ZERO_BYTES = 16384;
constexpr size_t WS_MOD   = 64 * 1024;
constexpr size_t WS_PSC   = 512 * 1024;
constexpr size_t WS_WIN_T = 1 * MiB;
constexpr size_t WS_WOUT_T= 6 * MiB;
constexpr size_t WS_WRW_T = 8 * MiB;
constexpr size_t WS_W2_T  = 22 * MiB;
constexpr size_t WS_SSQ   = 22 * MiB;
constexpr size_t WS_BQ    = 768 * 1024;
constexpr size_t WS_WO_T  = 27 * MiB;
constexpr size_t WS_WQ_T  = 29 * MiB;
constexpr size_t WS_SK    = 37 * MiB;
constexpr size_t WS_PU1   = 38 * MiB;
constexpr size_t WS_PV1   = 54 * MiB;
constexpr size_t WS_XB    = 70 * MiB;
constexpr size_t WS_PU0   = 102 * MiB;
constexpr size_t WS_PV0   = 134 * MiB;
constexpr size_t WS_ACT   = 166 * MiB;
constexpr size_t WS_H     = WS_ACT + 0 * MiB;
constexpr size_t WS_QKV   = WS_ACT + 32 * MiB;
constexpr size_t WS_QA    = WS_ACT + 104 * MiB;
constexpr size_t WS_KA    = WS_ACT + 120 * MiB;
constexpr size_t WS_VAT   = WS_ACT + 136 * MiB;
constexpr size_t WS_QB    = WS_ACT + 152 * MiB;
constexpr size_t WS_KB    = WS_ACT + 168 * MiB;
constexpr size_t WS_VBT   = WS_ACT + 172 * MiB;
constexpr size_t WS_O     = WS_ACT + 176 * MiB;
constexpr size_t WS_PQ    = WS_ACT + 208 * MiB;
constexpr size_t WS_EIDX  = WS_ACT + 276 * MiB;
constexpr size_t WS_GATE  = WS_ACT + 284 * MiB;
constexpr size_t WS_O0S   = WS_ACT + 292 * MiB;
constexpr size_t WS1_RK   = 102 * MiB;
constexpr size_t WS1_DEC  = 222 * MiB;
constexpr size_t WS1_AZ   = 350 * MiB;
constexpr size_t WS1_G    = 414 * MiB;
constexpr size_t WS1_Y    = 446 * MiB;
constexpr size_t WS1_BON  = 510 * MiB;
constexpr size_t WS1_X6   = 222 * MiB;
constexpr size_t WS1_A3   = 222 * MiB;
constexpr size_t WS1_H2   = 254 * MiB;
constexpr size_t WS1_PQ   = 286 * MiB;
constexpr size_t WS1_EIDX = 354 * MiB;
constexpr size_t WS1_GATE = 362 * MiB;
constexpr size_t WS_END   = 512 * MiB;
constexpr int RW_N = 3840, W2_N = 4096, W2_K = 512;
constexpr size_t WS_G2_T  = 26 * MiB;

constexpr int LDS_BYTES = 147456;
constexpr int LDS_BAR_OFF = 147456 - 64;
#define XB_TMO      128
#define XB_XCNT(j)  (256  + 64 * (j))
#define XB_XSUB(j)  (1280 + 64 * (j))
#define XB_XGEN(j)  (2304 + 64 * (j))
#define XB_TOP      3328
#define XB_TOPGEN   3392
#define XCD_BAR_WORDS 3456
#define XB_SPIN_CAP (1u << 18)

__device__ __forceinline__ unsigned xb_ld(unsigned* p)              { return __hip_atomic_load(p, __ATOMIC_RELAXED, __HIP_MEMORY_SCOPE_AGENT); }
__device__ __forceinline__ unsigned xb_add(unsigned* p, unsigned v) { return __hip_atomic_fetch_add(p, v, __ATOMIC_RELAXED, __HIP_MEMORY_SCOPE_AGENT); }
__device__ __forceinline__ unsigned xb_xcc_id() { return (unsigned)__builtin_amdgcn_s_getreg((3 << 11) | 20) & 0xFu; }
#define XB_SPIN(cond, bar) do { unsigned _sp = 0; while (cond) { __builtin_amdgcn_s_sleep(1); \
    if ((++_sp & 255u) == 0u) { if (xb_ld(&(bar)[XB_TMO])) break; if (_sp > XB_SPIN_CAP) { atomicAdd(&(bar)[XB_TMO], 1u); break; } } } } while (0)

struct XcdBarrier { unsigned* bar; unsigned x; volatile LAS unsigned* st; };

__device__ __forceinline__ XcdBarrier xcd_barrier_post(unsigned* bar, volatile LAS unsigned* st) {
    XcdBarrier b; b.bar = bar; b.x = xb_xcc_id(); b.st = st;
    if (threadIdx.x == 0) (void)xb_add(&bar[XB_XCNT(b.x)], 1u);
    return b;
}
__device__ __forceinline__ void xcd_barrier_complete(unsigned* bar, unsigned x, unsigned& nloc, unsigned& nx) {
    const unsigned G = gridDim.x * gridDim.y * gridDim.z;
    unsigned sum, cnt, mine, sp = 0u;
    for (;;) {
        sum = 0u; cnt = 0u; mine = 0u;
#pragma unroll
        for (unsigned j = 0; j < 16; ++j) { const unsigned c = xb_ld(&bar[XB_XCNT(j)]); sum += c; cnt += (c > 0u) ? 1u : 0u; mine = (j == x) ? c : mine; }
        if (sum == G) break;
        __builtin_amdgcn_s_sleep(1);
        if ((++sp & 255u) == 0u) { if (xb_ld(&bar[XB_TMO])) break; if (sp > XB_SPIN_CAP) { atomicAdd(&bar[XB_TMO], 1u); break; } }
    }
    nloc = mine > 0u ? mine : 1u; nx = cnt > 0u ? cnt : 1u;
}
__device__ __forceinline__ void xcd_barrier(const XcdBarrier& b) {
    asm volatile("s_waitcnt vmcnt(0)" ::: "memory");
    __syncthreads();
    if (threadIdx.x == 0) {
        unsigned* bar; { unsigned long long pv = (unsigned long long)b.bar; unsigned plo = (unsigned)pv, phi = (unsigned)(pv >> 32); asm volatile("" : "+s"(plo), "+s"(phi)); bar = (unsigned*)(__attribute__((address_space(1))) unsigned*)(((unsigned long long)phi << 32) | plo); }
        __builtin_amdgcn_s_waitcnt(0);
        unsigned nloc = b.st[0], nx = b.st[1];
        if (nloc == 0u) { xcd_barrier_complete(bar, b.x, nloc, nx); b.st[0] = nloc; b.st[1] = nx; }
        const unsigned old = xb_add(&bar[XB_XSUB(b.x)], 1u);
        const unsigned gen = old / nloc;
        if (old + 1u == (gen + 1u) * nloc) {
            __builtin_amdgcn_fence(__ATOMIC_RELEASE, "agent");
            asm volatile("s_waitcnt vmcnt(0)" ::: "memory");
            const unsigned og = xb_add(&bar[XB_TOP], 1u);
            const unsigned tg = og / nx;
            if (og + 1u == (tg + 1u) * nx) xb_add(&bar[XB_TOPGEN], 1u);
            else XB_SPIN(xb_ld(&bar[XB_TOPGEN]) == tg, bar);
            __builtin_amdgcn_fence(__ATOMIC_ACQUIRE, "agent");
            xb_add(&bar[XB_XGEN(b.x)], 1u);
            asm volatile("s_waitcnt vmcnt(0)" ::: "memory");
        } else {
            XB_SPIN(xb_ld(&bar[XB_XGEN(b.x)]) == gen, bar);
            __builtin_amdgcn_fence(__ATOMIC_ACQUIRE, "agent");
            asm volatile("s_waitcnt vmcnt(0)" ::: "memory");
        }
    }
    __syncthreads();
}
namespace pg8 {
constexpr int BM = 256, BK = 64, HALF = 128, HTB = HALF * BK * 2, STAGE_BYTES = 8 * HTB, NXCD = 8, WGM = 8;
__host__ __device__ __forceinline__ int lds_byte(int r, int c) { const int st = (r >> 4) * 2 + (c >> 5), rr = r & 15, cc = c & 31, ob = rr * 64 + cc * 2; return st * 1024 + (ob ^ (((ob >> 9) & 1) << 5)); }
__host__ __device__ __forceinline__ void stage_rc(int b, int& R, int& C) { const int st = b / 1024, sb = b % 1024, swz = sb ^ (((sb >> 9) & 1) << 5); R = (st >> 1) * 16 + swz / 64; C = (st & 1) * 32 + (swz % 64) / 2; }
__host__ __device__ __forceinline__ int perm32(int rho) { const int n = rho >> 4, i = rho & 15; return 8 * (i >> 2) + 4 * n + (i & 3); }

struct Unit { int pm, pn; };
struct Gemm { const bf16_t* A; const bf16_t* Bt; int M, N, K, lda, ldb; };

struct StaticOrder {
    int nM, nN, nwg, G, c;
    __device__ void init(int M, int N, int G_, int c_) { nM = M / BM; nN = N / BM; nwg = nM * nN; G = G_; c = c_; }
    __device__ __forceinline__ bool next(int i, Unit& u) const {
        const long L = (long)i * G + c; if (L >= nwg) return false;
        int wgid = (int)L; { const int q = nwg / NXCD, r = nwg % NXCD, xcd = wgid % NXCD, off = wgid / NXCD; wgid = (xcd < r ? xcd * (q + 1) : r * (q + 1) + (xcd - r) * q) + off; }
        const int nig = WGM * nN, gid = wgid / nig, fm = gid * WGM, gsz = (nM - fm) < WGM ? (nM - fm) : WGM;
        u.pm = fm + ((wgid % nig) % gsz); u.pn = (wgid % nig) / gsz; return true;
    }
};

struct BatchOrder {
    StaticOrder S;
    __device__ void init(int M, int N, int G_, int c_) { S.init(M, N, G_, c_); }
    __device__ __forceinline__ bool next(int i, Unit& u) const { if (!S.next(i, u)) return false; u.pn += (u.pm / (SEQ / BM)) * S.nN; return true; }
};

struct RwOrder {
    int G, c;
    __device__ void init(int G_, int c_) { G = G_; c = c_; }
    __device__ __forceinline__ bool next(int i, Unit& u) const {
        int grp, pm, pn;
        if ((G & 7) == 0) { const int x = c & 7, n = i * (G >> 3) + (c >> 3); if (n >= 120) return false;
            const int pmh = n / 15, e = n % 15; pm = x + 8 * pmh;
            if (e < 12) { grp = e >> 2; pn = grp * 4 + (e & 3); } else { grp = 3 + (e - 12); pn = 12 + (e - 12); } }
        else { const int L = i * G + c; if (L >= 960) return false;
            if (L < 768) { grp = L >> 8; pm = L & 63; pn = grp * 4 + ((L >> 6) & 3); } else { const int w = L - 768; grp = 3 + (w >> 6); pm = w & 63; pn = 12 + (grp - 3); } }
        u.pm = grp * 64 + pm; u.pn = pn; return true;
    }
};
template <class Epi, class Sched>
__device__ __forceinline__ void gemm_phase(LAS unsigned char* lds, const Gemm g, const Sched& S, const Epi& E) {
    const int tid = threadIdx.x, wid = __builtin_amdgcn_readfirstlane(tid >> 6), lane = tid & 63, wr = wid >> 2, wc = wid & 3, fr = lane & 15, fq = lane >> 4;
    const int K = g.K, nt = K / BK;
    unsigned voffA[2], voffB[2];
#pragma unroll
    for (int i = 0; i < 2; ++i) { int R, C; stage_rc(tid * 16 + i * 8192, R, C); const int Rb = Epi::PERM ? ((R & ~31) + perm32(R & 31)) : R;
        voffA[i] = (unsigned)(R * g.lda + C) * 2u; voffB[i] = (unsigned)(Rb * g.ldb + C) * 2u; }
    const size_t kstep = (size_t)(BK * 2);
    const size_t hstepA = (size_t)HALF * g.lda * 2, hstepB = (size_t)HALF * g.ldb * 2;
    const size_t tstepA = 2 * hstepA, tstepB = 2 * hstepB;
    const unsigned ldsw = (unsigned)wid * 1024u;
    const int aoff = lds_byte(wr * 64 + fr, fq * 8), boff = lds_byte(wc * 32 + fr, fq * 8);
#define PG8_SA(b, h) (((b) * 2 + (h)) * HTB)
#define PG8_SB(b, h) ((4 + (b) * 2 + (h)) * HTB)
#define PG8_STAGE(bufoff, gbase, voff) do { _Pragma("unroll") for (int _i = 0; _i < 2; ++_i) \
        __builtin_amdgcn_global_load_lds((const unsigned*)((const char*)(gbase) + (voff)[_i]), (LAS unsigned*)(lds + (bufoff) + ldsw + _i * 8192), 16, 0, 0); } while (0)
#define PG8_LDA(dst, b, h) do { _Pragma("unroll") for (int m = 0; m < 4; ++m) _Pragma("unroll") for (int k = 0; k < 2; ++k) dst[m][k] = *(const LAS bf16x8*)(lds + PG8_SA(b, h) + aoff + m * 2048 + k * 1024); } while (0)
#define PG8_LDB(dst, b, h) do { _Pragma("unroll") for (int n = 0; n < 2; ++n) _Pragma("unroll") for (int k = 0; k < 2; ++k) dst[n][k] = *(const LAS bf16x8*)(lds + PG8_SB(b, h) + boff + n * 2048 + k * 1024); } while (0)
#define PG8_MMA(ai, bj, At, Bt) do { __builtin_amdgcn_s_setprio(1); _Pragma("unroll") for (int m = 0; m < 4; ++m) _Pragma("unroll") for (int n = 0; n < 2; ++n) _Pragma("unroll") for (int k = 0; k < 2; ++k) \
        acc[ai][bj][m][n] = __builtin_amdgcn_mfma_f32_16x16x32_bf16(Bt[n][k], At[m][k], acc[ai][bj][m][n], 0, 0, 0); __builtin_amdgcn_s_setprio(0); } while (0)
#define PG8_WAIT_V(n) asm volatile("s_waitcnt vmcnt(" #n ")" ::: "memory")
#define PG8_WAIT_L(n) asm volatile("s_waitcnt lgkmcnt(" #n ")" ::: "memory")
#define PG8_BAR __builtin_amdgcn_s_barrier()
#define PG8_SCHED __builtin_amdgcn_sched_barrier(0)
    Unit cur, nxt; int ui = 0;
    if (!S.next(0, cur)) return;
    f32x4 acc[2][2][4][2];
#pragma unroll
    for (int a = 0; a < 2; ++a)
#pragma unroll
        for (int b = 0; b < 2; ++b)
#pragma unroll
            for (int m = 0; m < 4; ++m)
#pragma unroll
                for (int n = 0; n < 2; ++n) acc[a][b][m][n] = (f32x4){0.f, 0.f, 0.f, 0.f};
    bf16x8 At[4][2], B0[2][2], B1[2][2];
    const char* cA = (const char*)g.A + (size_t)cur.pm * tstepA; const char* cB = (const char*)g.Bt + (size_t)cur.pn * tstepB;
    PG8_STAGE(PG8_SB(0, 0), cB, voffB); PG8_STAGE(PG8_SA(0, 0), cA, voffA); PG8_STAGE(PG8_SB(0, 1), cB + hstepB, voffB); PG8_STAGE(PG8_SA(0, 1), cA + hstepA, voffA);
    if (wr == 1) PG8_BAR;
    PG8_WAIT_V(4); PG8_BAR;
    PG8_STAGE(PG8_SB(1, 0), cB + kstep, voffB); PG8_STAGE(PG8_SA(1, 0), cA + kstep, voffA); PG8_STAGE(PG8_SB(1, 1), cB + hstepB + kstep, voffB);
    PG8_WAIT_V(6); PG8_BAR;
    for (;;) {
        const bool has_next = S.next(ui + 1, nxt);
        const char* nA = has_next ? (const char*)g.A + (size_t)nxt.pm * tstepA : cA; const char* nB = has_next ? (const char*)g.Bt + (size_t)nxt.pn * tstepB : cB;
        for (int t = 0; t < nt; t += 2) {
            const bool last = (t == nt - 2);
            const char* a1 = cA + (size_t)(t + 1) * kstep;
            const char* a2 = last ? nA : cA + (size_t)(t + 2) * kstep; const char* b2 = last ? nB : cB + (size_t)(t + 2) * kstep;
            const char* a3 = a2 + kstep; const char* b3 = b2 + kstep;
            PG8_LDB(B0, 0, 0); PG8_SCHED; PG8_LDA(At, 0, 0); PG8_STAGE(PG8_SA(1, 1), a1 + hstepA, voffA);
            PG8_WAIT_L(8); PG8_BAR; PG8_WAIT_L(0); PG8_MMA(0, 0, At, B0); PG8_BAR; PG8_SCHED;
            PG8_LDB(B1, 0, 1); PG8_STAGE(PG8_SB(0, 0), b2, voffB);
            PG8_BAR; PG8_WAIT_L(0); PG8_MMA(0, 1, At, B1); PG8_BAR;
            PG8_LDA(At, 0, 1); PG8_STAGE(PG8_SA(0, 0), a2, voffA);
            PG8_BAR; PG8_WAIT_L(0); PG8_MMA(1, 0, At, B0); PG8_BAR; PG8_SCHED;
            PG8_STAGE(PG8_SB(0, 1), b2 + hstepB, voffB);
            PG8_WAIT_V(6); PG8_BAR; PG8_MMA(1, 1, At, B1); PG8_BAR;
            PG8_LDB(B0, 1, 0); PG8_SCHED; PG8_LDA(At, 1, 0); PG8_STAGE(PG8_SA(0, 1), a2 + hstepA, voffA);
            PG8_WAIT_L(8); PG8_BAR; PG8_WAIT_L(0); PG8_MMA(0, 0, At, B0); PG8_BAR; PG8_SCHED;
            PG8_LDB(B1, 1, 1); PG8_STAGE(PG8_SB(1, 0), b3, voffB);
            PG8_BAR; PG8_WAIT_L(0); PG8_MMA(0, 1, At, B1); PG8_BAR;
            PG8_LDA(At, 1, 1); PG8_STAGE(PG8_SA(1, 0), a3, voffA);
            PG8_BAR; PG8_WAIT_L(0); PG8_MMA(1, 0, At, B0); PG8_BAR; PG8_SCHED;
            PG8_STAGE(PG8_SB(1, 1), b3 + hstepB, voffB);
            PG8_WAIT_V(6); PG8_BAR; PG8_MMA(1, 1, At, B1); PG8_BAR;
        }
        E(acc, cur, wr, wc, fr, fq);
        if (!has_next) break;
#pragma unroll
        for (int a = 0; a < 2; ++a)
#pragma unroll
            for (int b = 0; b < 2; ++b)
#pragma unroll
                for (int m = 0; m < 4; ++m)
#pragma unroll
                    for (int n = 0; n < 2; ++n) acc[a][b][m][n] = (f32x4){0.f, 0.f, 0.f, 0.f};
        cur = nxt; cA = nA; cB = nB; ++ui;
    }
    PG8_WAIT_V(0);
    if (wr == 0) PG8_BAR;
    PG8_BAR;
#undef PG8_SA
#undef PG8_SB
#undef PG8_STAGE
#undef PG8_LDA
#undef PG8_LDB
#undef PG8_MMA
#undef PG8_WAIT_V
#undef PG8_WAIT_L
#undef PG8_BAR
#undef PG8_SCHED
}

template <int ACT> struct EpiBf16 {
    static constexpr bool PERM = true;
    __device__ __forceinline__ void prefetch(LAS unsigned char*, const Unit&, int) const {}
    bf16_t* O; int ldc;
    __device__ __forceinline__ void operator()(const f32x4 (&acc)[2][2][4][2], const Unit& u, int wr, int wc, int fr, int fq) const {
        const int row0 = (ACT == 1 ? (u.pm & 63) : u.pm) * BM + wr * 64 + fr; const int col0 = u.pn * BM + wc * 32 + 8 * fq;
#pragma unroll
        for (int ai = 0; ai < 2; ++ai)
#pragma unroll
            for (int m = 0; m < 4; ++m) { bf16_t* rowp = O + (size_t)(row0 + ai * HALF + m * 16) * ldc + col0;
#pragma unroll
                for (int bj = 0; bj < 2; ++bj) { f32x4 v0 = acc[ai][bj][m][0], v1 = acc[ai][bj][m][1];
                    if (ACT == 1) { const int c = col0 + bj * HALF;
                        if (c >= 3072 && c < 3200) {
#pragma unroll
                            for (int e = 0; e < 4; ++e) { v0[e] = tanhf(v0[e]); v1[e] = tanhf(v1[e]); } }
                        else if (c >= 3584 && c < 3712) {
#pragma unroll
                            for (int e = 0; e < 4; ++e) { v0[e] = sigmoidf_(v0[e]); v1[e] = sigmoidf_(v1[e]); } } }
                    u32x4 w; w.x = pack_bf16(v0[0], v0[1]); w.y = pack_bf16(v0[2], v0[3]); w.z = pack_bf16(v1[0], v1[1]); w.w = pack_bf16(v1[2], v1[3]);
                    *(u32x4*)(rowp + bj * HALF) = w; } }
    }
};
template <bool IN_BF16> struct EpiResid {
    static constexpr bool PERM = false;
    __device__ __forceinline__ void prefetch(LAS unsigned char* lds, const Unit& u, int tid) const {
        constexpr int RB = IN_BF16 ? 512 : 1024, LPR = RB / 128, NL = 256 * LPR;
        const char* base = (const char*)xin + ((size_t)u.pm * BM * D + (size_t)u.pn * BM) * (IN_BF16 ? 2 : 4);
#pragma unroll
        for (int i = 0; i < NL / NTHREADS; ++i) { const int ln = i * NTHREADS + tid, r = ln / LPR, c = ln % LPR;
            __builtin_amdgcn_global_load_lds((const unsigned*)(base + (size_t)r * D * (IN_BF16 ? 2 : 4) + c * 128), (LAS unsigned*)(lds + STAGE_BYTES + 2048 + (tid >> 6) * 256), 4, 0, 0); }
    }
    const void* xin; bf16_t* out; const float* gate; float* ssq;
    __device__ __forceinline__ void operator()(const f32x4 (&acc)[2][2][4][2], const Unit& u, int wr, int wc, int fr, int fq) const {
        const int row0 = u.pm * BM + wr * 64 + fr, col0 = u.pn * BM + wc * 32 + 4 * fq;
        const float* gp = gate + (size_t)((u.pm * BM) / SEQ) * 6144 + col0;
        f32x4 gv[2][2];
#pragma unroll
        for (int bj = 0; bj < 2; ++bj)
#pragma unroll
            for (int n = 0; n < 2; ++n) gv[bj][n] = *(const f32x4*)(gp + bj * HALF + n * 16);
#pragma unroll
        for (int ai = 0; ai < 2; ++ai)
#pragma unroll
            for (int m = 0; m < 4; ++m) { const size_t off = (size_t)(row0 + ai * HALF + m * 16) * D + col0; float ss = 0.f;
#pragma unroll
                for (int bj = 0; bj < 2; ++bj)
#pragma unroll
                    for (int n = 0; n < 2; ++n) { f32x4 xv;
                        if (IN_BF16) { const u32x2 w = *(const u32x2*)((const bf16_t*)xin + off + bj * HALF + n * 16); xv = (f32x4){bf_lo(w.x), bf_hi(w.x), bf_lo(w.y), bf_hi(w.y)}; }
                        else xv = *(const f32x4*)((const float*)xin + off + bj * HALF + n * 16);
                        const f32x4 r = xv + gv[bj][n] * acc[ai][bj][m][n];
                        ss += (r[0] * r[0] + r[1] * r[1]) + (r[2] * r[2] + r[3] * r[3]);
                        *(u32x2*)(out + off + bj * HALF + n * 16) = (u32x2){pack_bf16(r[0], r[1]), pack_bf16(r[2], r[3])}; }
                ss += __shfl_xor(ss, 16); ss += __shfl_xor(ss, 32);
                if (fq == 0) ssq[(size_t)(row0 + ai * HALF + m * 16) * 16 + u.pn * 4 + wc] = ss; }
    }
};
struct EpiQ {
    static constexpr bool PERM = true;
    __device__ __forceinline__ void prefetch(LAS unsigned char*, const Unit&, int) const {}
    bf16_t* O; int ldc; const float* ssq; const float* bq; const LAS float* rl; int pm_l;
    __device__ __forceinline__ void prep(LAS unsigned char* lds, int pm, int tid) { LAS float* w = (LAS float*)(lds + STAGE_BYTES); rl = w; pm_l = pm;
        if (pm >= 0 && tid < BM) { const f32x4* sp = (const f32x4*)(ssq + (size_t)(pm * BM + tid) * 16); const f32x4 s4 = (sp[0] + sp[1]) + (sp[2] + sp[3]);
            w[tid] = rsqrtf(((s4[0] + s4[1]) + (s4[2] + s4[3])) * (1.0f / 1024.0f) + 1e-6f); }
        __syncthreads(); }
    __device__ __forceinline__ void operator()(const f32x4 (&acc)[2][2][4][2], const Unit& u, int wr, int wc, int fr, int fq) const {
        const int row0 = u.pm * BM + wr * 64 + fr; const int col0 = (u.pn & 7) * BM + wc * 32 + 8 * fq;
        const float* bp = bq + (size_t)(u.pn >> 3) * 2048 + col0;
        f32x4 b0[2], b1[2];
#pragma unroll
        for (int bj = 0; bj < 2; ++bj) { b0[bj] = *(const f32x4*)(bp + bj * HALF); b1[bj] = *(const f32x4*)(bp + bj * HALF + 4); }
#pragma unroll
        for (int ai = 0; ai < 2; ++ai)
#pragma unroll
            for (int m = 0; m < 4; ++m) { const int r = row0 + ai * HALF + m * 16; bf16_t* rowp = O + (size_t)r * ldc + col0;
                float rinv;
                if (u.pm == pm_l) rinv = rl[wr * 64 + fr + ai * HALF + m * 16];
                else { const f32x4* sp = (const f32x4*)(ssq + (size_t)r * 16); const f32x4 s4 = (sp[0] + sp[1]) + (sp[2] + sp[3]);
                    rinv = rsqrtf(((s4[0] + s4[1]) + (s4[2] + s4[3])) * (1.0f / 1024.0f) + 1e-6f); }
#pragma unroll
                for (int bj = 0; bj < 2; ++bj) { const f32x4 v0 = acc[ai][bj][m][0] * rinv + b0[bj], v1 = acc[ai][bj][m][1] * rinv + b1[bj];
                    u32x4 w; w.x = pack_bf16(v0[0], v0[1]); w.y = pack_bf16(v0[2], v0[3]); w.z = pack_bf16(v1[0], v1[1]); w.w = pack_bf16(v1[2], v1[3]);
                    *(u32x4*)(rowp + bj * HALF) = w; } }
    }
};
struct EpiRw2 {
    static constexpr bool PERM = true;
    __device__ __forceinline__ void prefetch(LAS unsigned char*, const Unit&, int) const {}
    float* DEC; bf16_t* AZ; bf16_t* G; const float* w0; const float* a0;
    __device__ __forceinline__ void operator()(const f32x4 (&acc)[2][2][4][2], const Unit& u, int wr, int wc, int fr, int fq) const {
        const int row0 = u.pm * BM + wr * 64 + fr; const int col0 = u.pn * BM + wc * 32 + 8 * fq;
        const int cls = u.pn < 8 ? 0 : 1;
#pragma unroll
        for (int bj = 0; bj < 2; ++bj) {
            const int c = col0 + bj * HALF;
            f32x4 b0 = (f32x4){0.f, 0.f, 0.f, 0.f}, b1 = b0;
            if (cls == 0) { b0 = *(const f32x4*)(w0 + c); b1 = *(const f32x4*)(w0 + c + 4); }
            else if (cls == 1) { b0 = *(const f32x4*)(a0 + c - 2048); b1 = *(const f32x4*)(a0 + c - 2048 + 4); }
#pragma unroll
            for (int ai = 0; ai < 2; ++ai)
#pragma unroll
                for (int m = 0; m < 4; ++m) { const size_t r = (size_t)(row0 + ai * HALF + m * 16);
                    f32x4 v0 = acc[ai][bj][m][0] + b0, v1 = acc[ai][bj][m][1] + b1;
                    if (cls == 0) {
#pragma unroll
                        for (int e = 0; e < 4; ++e) { v0[e] = __expf(-0.6065306597126334f * sigmoidf_(v0[e])); v1[e] = __expf(-0.6065306597126334f * sigmoidf_(v1[e])); }
                        *(f32x4*)(DEC + r * 2048 + c) = v0; *(f32x4*)(DEC + r * 2048 + c + 4) = v1;
                    } else {
                        if (cls == 1) {
#pragma unroll
                            for (int e = 0; e < 4; ++e) { v0[e] = sigmoidf_(v0[e]); v1[e] = sigmoidf_(v1[e]); } }
                        u32x4 w; w.x = pack_bf16(v0[0], v0[1]); w.y = pack_bf16(v0[2], v0[3]); w.z = pack_bf16(v1[0], v1[1]); w.w = pack_bf16(v1[2], v1[3]);
                        if (cls == 1) *(u32x4*)(AZ + r * 2048 + (c - 2048)) = w; else *(u32x4*)(G + r * 1024 + (c - 4096)) = w;
                    } }
        }
    }
};
}
struct Params { const float* in[31]; float* out; unsigned char* ws; int ph_lo, ph_hi; };
struct Frame {
    LAS unsigned char* lds; int tid, lane, wave, G, bid;
    const float* const* in; float* out; unsigned char* ws;
};

DI void fp8_row_store(const float (&v)[16], int row, int lane, unsigned char* dst, float* scale);
DI void fp8_row_load(const float* src, int row, int lane, float (&v)[16]);
DI void p0_convert_fp8(const Frame& F, const float* src, unsigned char* dst, float* scale, int widx, int nw);
template <bool SPLIT> DI void p0_mod(const Frame& F) {
    constexpr int NKG = SPLIT ? 21 : 42, NB = SPLIT ? 4 : 2, NTH = NKG * 12;
    const float* c = F.in[1]; const float* ada_w = F.in[2]; const float* ada_b = F.in[3];
    float* mod = (float*)(F.ws + WS_MOD);
    LAS float* sc = (LAS float*)F.lds;
    LAS float* part = (LAS float*)(F.lds + 32768);
    for (int i = F.tid; i < 8 * 1024; i += NTHREADS) { const int b = i >> 10, k = i & 1023; const float v = c[i]; sc[k * 8 + b] = v * sigmoidf_(v); }
    __syncthreads();
    for (int cb = F.bid; cb < 256; cb += F.G) {
        const int colbase = cb * 48, l = colbase / 6144, n0 = colbase % 6144;
        if (F.tid < NTH) {
            const int q = F.tid % 12, kg = F.tid / 12, krot = (cb * 148) & 1023;
            const float* wp = ada_w + (size_t)l * 1024 * 6144 + n0 + 4 * q;
            f32x4 acc[8];
#pragma unroll
            for (int b = 0; b < 8; ++b) acc[b] = (f32x4){0.f, 0.f, 0.f, 0.f};
#pragma unroll
            for (int bt = 0; bt < NB; ++bt) {
                f32x4 w[13];
#pragma unroll
                for (int i = 0; i < 13; ++i) { const int k = kg + NKG * (13 * bt + i), kk = ((k < 1024 ? k : 1023) + krot) & 1023; w[i] = *(const f32x4*)(wp + (size_t)kk * 6144); }
#pragma unroll
                for (int i = 0; i < 13; ++i) { const int k = kg + NKG * (13 * bt + i), kk = ((k < 1024 ? k : 1023) + krot) & 1023;
                    const f32x4 wv = k < 1024 ? w[i] : (f32x4){0.f, 0.f, 0.f, 0.f};
                    const f32x4 s0 = *(const LAS f32x4*)(sc + kk * 8), s1 = *(const LAS f32x4*)(sc + kk * 8 + 4);
                    acc[0] += wv * s0[0]; acc[1] += wv * s0[1]; acc[2] += wv * s0[2]; acc[3] += wv * s0[3];
                    acc[4] += wv * s1[0]; acc[5] += wv * s1[1]; acc[6] += wv * s1[2]; acc[7] += wv * s1[3]; }
            }
#pragma unroll
            for (int e = 0; e < 4; ++e) { LAS float* pp = part + ((size_t)kg * 48 + 4 * q + e) * 8;
                *(LAS f32x4*)pp = (f32x4){acc[0][e], acc[1][e], acc[2][e], acc[3][e]}; *(LAS f32x4*)(pp + 4) = (f32x4){acc[4][e], acc[5][e], acc[6][e], acc[7][e]}; }
        } else if (SPLIT && F.wave >= 4) {
            p0_convert_fp8(F, F.in[29], F.ws + WS_PU0, (float*)(F.ws + WS_PSC), F.bid * 4 + (F.wave - 4), F.G * 4);
        }
        __syncthreads();
        if (F.tid < 256) for (int o = F.tid; o < 384; o += 256) {
            const int cl = o >> 3, b = o & 7; const int col = colbase + cl;
            float s = ada_b[col];
#pragma unroll
            for (int kg = 0; kg < NKG; ++kg) s += part[(kg * 48 + cl) * 8 + b];
            mod[((size_t)l * 8 + b) * 6144 + n0 + cl] = s;
        }
        __syncthreads();
    }
}
DI void p0_transpose(const Frame& F, const float* src, int ld, int K, int N, bf16_t* dst, int ldd, const float* mix) {
    (void)mix;
    LAS float* tiles = (LAS float*)F.lds;
    const int tn = N / 64, nt = (K / 64) * tn;
    for (int t0 = F.bid; t0 < nt; t0 += 4 * F.G) {
        __syncthreads();
        f32x4 v[4][2];
#pragma unroll
        for (int q = 0; q < 4; ++q) { const int tt = t0 + q * F.G, t = tt < nt ? tt : t0; const int k0 = (t / tn) * 64, n0 = (t % tn) * 64;
#pragma unroll
            for (int h = 0; h < 2; ++h) { const int i = F.tid + h * NTHREADS, r = i >> 4, c4 = (i & 15) * 4; v[q][h] = *(const f32x4*)(src + (size_t)(k0 + r) * ld + n0 + c4); } }
#pragma unroll
        for (int q = 0; q < 4; ++q)
#pragma unroll
            for (int h = 0; h < 2; ++h) { const int i = F.tid + h * NTHREADS, r = i >> 4, c4 = (i & 15) * 4; LAS float* tp = tiles + q * 4160 + r * 65 + c4;
                tp[0] = v[q][h][0]; tp[1] = v[q][h][1]; tp[2] = v[q][h][2]; tp[3] = v[q][h][3]; }
        __syncthreads();
#pragma unroll
        for (int q = 0; q < 4; ++q) { const int t = t0 + q * F.G; if (t < nt) { const int k0 = (t / tn) * 64, n0 = (t % tn) * 64;
            const int n = F.tid >> 3, kc = (F.tid & 7) * 8;
            float w8[8];
#pragma unroll
            for (int e = 0; e < 8; ++e) w8[e] = tiles[q * 4160 + (kc + e) * 65 + n];
            u32x4 w; w.x = pack_bf16(w8[0], w8[1]); w.y = pack_bf16(w8[2], w8[3]); w.z = pack_bf16(w8[4], w8[5]); w.w = pack_bf16(w8[6], w8[7]);
            *(u32x4*)(dst + (size_t)(n0 + n) * ldd + k0 + kc) = w; } }
    }
    __syncthreads();
}
DI void p0_wqs(const Frame& F, const float* W, const float* g, const float* modl, bf16_t* dst) {
    LAS float* tiles = (LAS float*)F.lds;
    LAS float* gsl = (LAS float*)(F.lds + 69632);
    const int nt = 16 * 32;
    if (F.bid >= nt) return;
    __syncthreads();
    for (int i = F.tid; i < 8 * 1024; i += NTHREADS) gsl[i] = g[i & 1023] * (1.0f + modl[(size_t)(i >> 10) * 6144 + 4096 + (i & 1023)]);
    for (int t0 = F.bid; t0 < nt; t0 += 4 * F.G) {
        __syncthreads();
        f32x4 v[4][2];
#pragma unroll
        for (int q = 0; q < 4; ++q) { const int tt = t0 + q * F.G, t = tt < nt ? tt : t0; const int k0 = (t / 32) * 64, n0 = (t % 32) * 64;
#pragma unroll
            for (int h = 0; h < 2; ++h) { const int i = F.tid + h * NTHREADS, r = i >> 4, c4 = (i & 15) * 4; v[q][h] = *(const f32x4*)(W + (size_t)(k0 + r) * 2048 + n0 + c4); } }
#pragma unroll
        for (int q = 0; q < 4; ++q)
#pragma unroll
            for (int h = 0; h < 2; ++h) { const int i = F.tid + h * NTHREADS, r = i >> 4, c4 = (i & 15) * 4; LAS float* tp = tiles + q * 4160 + r * 65 + c4;
                tp[0] = v[q][h][0]; tp[1] = v[q][h][1]; tp[2] = v[q][h][2]; tp[3] = v[q][h][3]; }
        __syncthreads();
        for (int q = 0; q < 4; ++q) { const int t = t0 + q * F.G; if (t < nt) { const int k0 = (t / 32) * 64, n0 = (t % 32) * 64;
            const int n = F.tid >> 3, kc = (F.tid & 7) * 8;
            float w8[8];
#pragma unroll
            for (int e = 0; e < 8; ++e) w8[e] = tiles[q * 4160 + (kc + e) * 65 + n];
#pragma unroll
            for (int b = 0; b < 8; ++b) { const f32x4 s0 = *(const LAS f32x4*)(gsl + b * 1024 + k0 + kc), s1 = *(const LAS f32x4*)(gsl + b * 1024 + k0 + kc + 4);
                u32x4 w; w.x = pack_bf16(w8[0] * s0[0], w8[1] * s0[1]); w.y = pack_bf16(w8[2] * s0[2], w8[3] * s0[3]);
                w.z = pack_bf16(w8[4] * s1[0], w8[5] * s1[1]); w.w = pack_bf16(w8[6] * s1[2], w8[7] * s1[3]);
                *(u32x4*)(dst + ((size_t)b * 2048 + n0 + n) * 1024 + k0 + kc) = w; } } }
    }
    __syncthreads();
}
DI void p0_bq(const Frame& F, const float* W, const float* modl, float* bq) {
    LAS float* shl = (LAS float*)F.lds;
    LAS float* part = (LAS float*)(F.lds + 32768);
    if (F.bid >= 128) return;
    __syncthreads();
    for (int i = F.tid; i < 8 * 1024; i += NTHREADS) { const int b = i >> 10, k = i & 1023; shl[k * 8 + b] = modl[(size_t)b * 6144 + 3072 + k]; }
    __syncthreads();
    for (int task = F.bid; task < 128; task += F.G) {
        const int cl = F.tid & 15, kp = F.tid >> 4; const float* wp = W + (size_t)(kp * 32) * 2048 + task * 16 + cl;
        float wv[32];
#pragma unroll
        for (int k = 0; k < 32; ++k) wv[k] = wp[(size_t)k * 2048];
        float a[8];
#pragma unroll
        for (int b = 0; b < 8; ++b) a[b] = 0.f;
#pragma unroll
        for (int k = 0; k < 32; ++k) { const float w = wv[k];
            const f32x4 s0 = *(const LAS f32x4*)(shl + (kp * 32 + k) * 8), s1 = *(const LAS f32x4*)(shl + (kp * 32 + k) * 8 + 4);
            a[0] += w * s0[0]; a[1] += w * s0[1]; a[2] += w * s0[2]; a[3] += w * s0[3]; a[4] += w * s1[0]; a[5] += w * s1[1]; a[6] += w * s1[2]; a[7] += w * s1[3]; }
#pragma unroll
        for (int b = 0; b < 8; ++b) part[(kp * 16 + cl) * 8 + b] = a[b];
        __syncthreads();
        if (F.tid < 128) { const int c2 = F.tid >> 3, b = F.tid & 7; float s = 0.f;
#pragma unroll
            for (int q = 0; q < 32; ++q) s += part[(q * 16 + c2) * 8 + b];
            bq[(size_t)b * 2048 + task * 16 + c2] = s; }
        __syncthreads();
    }
}
DI void p0_convert(const Frame& F, const float* src, bf16_t* dst, size_t n) {
    const size_t n8 = n / 8;
    for (size_t i = (size_t)F.bid * NTHREADS + F.tid; i < n8; i += (size_t)F.G * NTHREADS) {
        const f32x4 a = *(const f32x4*)(src + i * 8), b = *(const f32x4*)(src + i * 8 + 4);
        u32x4 w; w.x = pack_bf16(a[0], a[1]); w.y = pack_bf16(a[2], a[3]); w.z = pack_bf16(b[0], b[1]); w.w = pack_bf16(b[2], b[3]);
        *(u32x4*)(dst + i * 8) = w;
    }
}
DI void fp8_row_store(const float (&v)[16], int row, int lane, unsigned char* dst, float* scale) {
    float am = 0.f;
#pragma unroll
    for (int e = 0; e < 16; ++e) am = fmaxf(am, fabsf(v[e]));
#pragma unroll
    for (int o = 32; o > 0; o >>= 1) am = fmaxf(am, __shfl_xor(am, o));
    const float sc = am > 0.f ? am * (1.0f / 384.0f) : 1.0f, inv = 1.0f / sc;
    u32x4 w;
    { int t0 = 0; t0 = __builtin_amdgcn_cvt_pk_fp8_f32(v[0] * inv, v[1] * inv, t0, false); t0 = __builtin_amdgcn_cvt_pk_fp8_f32(v[2] * inv, v[3] * inv, t0, true); w.x = (unsigned)t0; }
    { int t0 = 0; t0 = __builtin_amdgcn_cvt_pk_fp8_f32(v[4] * inv, v[5] * inv, t0, false); t0 = __builtin_amdgcn_cvt_pk_fp8_f32(v[6] * inv, v[7] * inv, t0, true); w.y = (unsigned)t0; }
    { int t0 = 0; t0 = __builtin_amdgcn_cvt_pk_fp8_f32(v[8] * inv, v[9] * inv, t0, false); t0 = __builtin_amdgcn_cvt_pk_fp8_f32(v[10] * inv, v[11] * inv, t0, true); w.z = (unsigned)t0; }
    { int t0 = 0; t0 = __builtin_amdgcn_cvt_pk_fp8_f32(v[12] * inv, v[13] * inv, t0, false); t0 = __builtin_amdgcn_cvt_pk_fp8_f32(v[14] * inv, v[15] * inv, t0, true); w.w = (unsigned)t0; }
    *(u32x4*)(dst + (size_t)row * 1024 + 16 * lane) = w;
    if (lane == 0) scale[row] = sc;
}
DI void fp8_row_load(const float* src, int row, int lane, float (&v)[16]) {
#pragma unroll
    for (int j = 0; j < 4; ++j) { const f32x4 a = *(const f32x4*)(src + (size_t)row * 1024 + 256 * j + 4 * lane); v[4 * j] = a[0]; v[4 * j + 1] = a[1]; v[4 * j + 2] = a[2]; v[4 * j + 3] = a[3]; }
}
DI void p0_convert_fp8(const Frame& F, const float* src, unsigned char* dst, float* scale, int widx, int nw) {
    const int lane = F.lane;
    for (int row = widx; row < N_EXPERTS; row += 4 * nw) {
        float v0[16], v1[16], v2[16], v3[16];
        const int r1 = row + nw, r2 = row + 2 * nw, r3 = row + 3 * nw;
        fp8_row_load(src, row, lane, v0);
        if (r1 < N_EXPERTS) fp8_row_load(src, r1, lane, v1);
        if (r2 < N_EXPERTS) fp8_row_load(src, r2, lane, v2);
        if (r3 < N_EXPERTS) fp8_row_load(src, r3, lane, v3);
        fp8_row_store(v0, row, lane, dst, scale);
        if (r1 < N_EXPERTS) fp8_row_store(v1, r1, lane, dst, scale);
        if (r2 < N_EXPERTS) fp8_row_store(v2, r2, lane, dst, scale);
        if (r3 < N_EXPERTS) fp8_row_store(v3, r3, lane, dst, scale);
    }
}
DI void p0_prologue(const Frame& F) {
    const bool split = (F.G == 256);
    if (split) p0_mod<true>(F); else p0_mod<false>(F);
    bf16_t* WIN_T = (bf16_t*)(F.ws + WS_WIN_T);
    p0_transpose(F, F.in[5], IN_W, 1024, IN_W, WIN_T, 1024, nullptr);
    float* psc = (float*)(F.ws + WS_PSC);
    if (!split) p0_convert_fp8(F, F.in[29], F.ws + WS_PU0, psc + 0 * N_EXPERTS, F.bid * NWAVES + F.wave, F.G * NWAVES);
    p0_convert_fp8(F, F.in[30], F.ws + WS_PV0, psc + 1 * N_EXPERTS, F.bid * NWAVES + F.wave, F.G * NWAVES);
}
DI void p0_late_weights(const Frame& Fin, int nunits) {
    const int nmax = (nunits + Fin.G - 1) / Fin.G, nfull = nunits - (nmax - 1) * Fin.G;
    Frame F = Fin;
    if (nfull < Fin.G) { if (Fin.bid < nfull) return; F.bid = Fin.bid - nfull; F.G = Fin.G - nfull; }
    bf16_t* WRW_T = (bf16_t*)(F.ws + WS_WRW_T);
    p0_transpose(F, F.in[12] + 0 * 1048576, 1024, 1024, 1024, WRW_T + (size_t)0    * 1024, 1024, nullptr);
    p0_transpose(F, F.in[12] + 1 * 1048576, 1024, 1024, 1024, WRW_T + (size_t)1024 * 1024, 1024, nullptr);
    p0_transpose(F, F.in[12] + 2 * 1048576, 1024, 1024, 1024, WRW_T + (size_t)2048 * 1024, 1024, nullptr);
    p0_transpose(F, F.in[14] + 0 * 65536, 64, 1024, 64, WRW_T + (size_t)3072 * 1024, 1024, nullptr);
    p0_transpose(F, F.in[14] + 1 * 65536, 64, 1024, 64, WRW_T + (size_t)3136 * 1024, 1024, nullptr);
    p0_transpose(F, F.in[17] + 0 * 65536, 64, 1024, 64, WRW_T + (size_t)3328 * 1024, 1024, nullptr);
    p0_transpose(F, F.in[17] + 1 * 65536, 64, 1024, 64, WRW_T + (size_t)3392 * 1024, 1024, nullptr);
    p0_transpose(F, F.in[19], 128, 1024, 128, WRW_T + (size_t)3584 * 1024, 1024, nullptr);
    { const u32x4 z = (u32x4){0u, 0u, 0u, 0u};
      for (int i = F.bid * NTHREADS + F.tid; i < 3 * 128 * 1024 / 8; i += F.G * NTHREADS) { const int blk = i / (128 * 128), r = i % (128 * 128);
          ((u32x4*)(WRW_T + (size_t)(3200 + 256 * blk) * 1024))[r] = z; } }
    { const float* g2 = F.in[20]; bf16_t* G2_T = (bf16_t*)(F.ws + WS_G2_T);
      for (int i = F.bid * NTHREADS + F.tid; i < 1024 * 32; i += F.G * NTHREADS) { const int n = i % 1024, k0 = (i / 1024) * 8;
          float v[8];
#pragma unroll
          for (int e = 0; e < 8; ++e) v[e] = (k0 + e < 128) ? g2[(size_t)(k0 + e) * 1024 + n] : 0.f;
          u32x4 w; w.x = pack_bf16(v[0], v[1]); w.y = pack_bf16(v[2], v[3]); w.z = pack_bf16(v[4], v[5]); w.w = pack_bf16(v[6], v[7]);
          *(u32x4*)(G2_T + (size_t)n * 256 + k0) = w; } }
    p0_transpose(F, F.in[9], 1024, 1024, 1024, (bf16_t*)(F.ws + WS_WOUT_T), 1024, nullptr);
    p0_convert(F, F.in[28], (bf16_t*)(F.ws + WS_SK), (size_t)2 * 16 * 128 * 128);
    const float* mod = (const float*)(F.ws + WS_MOD);
    p0_wqs(F, F.in[27], F.in[4] + 1 * 1024, mod, (bf16_t*)F.out);
    { Frame Fr = F; Fr.bid = F.G - 1 - F.bid;
      p0_bq(Fr, F.in[27], mod, (float*)(F.ws + WS_BQ)); }
}
DI void p0_late_weights2(const Frame& Fin) {
    Frame F = Fin;
    if ((Fin.G & 7) == 0) { const int g8 = Fin.G >> 3, nmax = (120 + g8 - 1) / g8, nfull = 120 - (nmax - 1) * g8;
        if (nfull < g8) { if ((Fin.bid >> 3) < nfull) return; F.bid = ((Fin.bid >> 3) - nfull) * 8 + (Fin.bid & 7); F.G = (g8 - nfull) * 8; } }
    else { const int nmax = (960 + Fin.G - 1) / Fin.G, nfull = 960 - (nmax - 1) * Fin.G;
        if (nfull < Fin.G) { if (Fin.bid < nfull) return; F.bid = Fin.bid - nfull; F.G = Fin.G - nfull; } }
    p0_wqs(F, F.in[27] + (size_t)1024 * 2048, F.in[4] + 3 * 1024, (const float*)(F.ws + WS_MOD) + 8 * 6144, (bf16_t*)F.out + (size_t)8 * 2048 * 1024);
    p0_transpose(F, F.in[26], 1024, 1024, 1024, (bf16_t*)(F.ws + WS_WO_T), 1024, nullptr);
    { Frame Fr = F; Fr.bid = F.G - 1 - F.bid; p0_bq(Fr, F.in[27] + (size_t)1024 * 2048, (const float*)(F.ws + WS_MOD) + 8 * 6144, (float*)(F.ws + WS_BQ) + 8 * 2048); }
}

DI void norm_row16(const float* xr, int lane, float (&v)[16], float& rinv) {
    float ss = 0.f;
#pragma unroll
    for (int j = 0; j < 4; ++j) { const f32x4 a = *(const f32x4*)(xr + j * 256 + lane * 4); v[4 * j] = a[0]; v[4 * j + 1] = a[1]; v[4 * j + 2] = a[2]; v[4 * j + 3] = a[3];
        ss += a[0] * a[0] + a[1] * a[1] + a[2] * a[2] + a[3] * a[3]; }
    ss = wave_sum(ss);
    rinv = rsqrtf(ss * (1.0f / 1024.0f) + 1e-6f);
}
DI void ada_apply(float (&v)[16], float rinv, const float* g, const float* sc, const float* sh, int lane) {
#pragma unroll
    for (int j = 0; j < 4; ++j) { const int c = j * 256 + lane * 4;
        const f32x4 gg = *(const f32x4*)(g + c), s1 = *(const f32x4*)(sc + c), s0 = *(const f32x4*)(sh + c);
#pragma unroll
        for (int e = 0; e < 4; ++e) v[4 * j + e] = v[4 * j + e] * rinv * gg[e] * (1.0f + s1[e]) + s0[e]; }
}
DI void norm_row16_b(const bf16_t* xr, int lane, float (&v)[16], float& rinv) {
    float ss = 0.f;
#pragma unroll
    for (int j = 0; j < 4; ++j) { const u32x2 a = *(const u32x2*)(xr + j * 256 + lane * 4); v[4 * j] = bf_lo(a.x); v[4 * j + 1] = bf_hi(a.x); v[4 * j + 2] = bf_lo(a.y); v[4 * j + 3] = bf_hi(a.y);
        ss += v[4 * j] * v[4 * j] + v[4 * j + 1] * v[4 * j + 1] + v[4 * j + 2] * v[4 * j + 2] + v[4 * j + 3] * v[4 * j + 3]; }
    ss = wave_sum(ss);
    rinv = rsqrtf(ss * (1.0f / 1024.0f) + 1e-6f);
}
template <bool IN_BF16> DI void p_norm(const Frame& F, const void* x, const float* g, const float* modl  , int sh_off, int sc_off, bf16_t* H) {
    for (int r = F.bid * NWAVES + F.wave; r < T; r += F.G * NWAVES) {
        const int b = r / SEQ; float v[16], rinv;
        if (IN_BF16) norm_row16_b((const bf16_t*)x + (size_t)r * D, F.lane, v, rinv); else norm_row16((const float*)x + (size_t)r * D, F.lane, v, rinv);
        ada_apply(v, rinv, g, modl + (size_t)b * 6144 + sc_off, modl + (size_t)b * 6144 + sh_off, F.lane);
#pragma unroll
        for (int j = 0; j < 4; ++j) { u32x2 w; w.x = pack_bf16(v[4 * j], v[4 * j + 1]); w.y = pack_bf16(v[4 * j + 2], v[4 * j + 3]);
            *(u32x2*)(H + (size_t)r * D + j * 256 + F.lane * 4) = w; }
    }
}
DI void p_qkprep(const Frame& F) {
    const bf16_t* QKV = (const bf16_t*)(F.ws + WS_QKV);
    bf16_t* QA = (bf16_t*)(F.ws + WS_QA); bf16_t* KA = (bf16_t*)(F.ws + WS_KA); bf16_t* VAT = (bf16_t*)(F.ws + WS_VAT);
    bf16_t* QB = (bf16_t*)(F.ws + WS_QB); bf16_t* KB = (bf16_t*)(F.ws + WS_KB); bf16_t* VBT = (bf16_t*)(F.ws + WS_VBT);
    const float* qk_g = F.in[6];
    LAS float* cs = (LAS float*)F.lds;
    LAS unsigned short* vt = (LAS unsigned short*)(F.lds + 16384);
    for (int tile = F.bid; tile < T / 64; tile += F.G) {
        const int t0 = tile * 64, b = t0 / SEQ, s0 = t0 % SEQ;
        __syncthreads();
        for (int i = F.tid; i < 64 * 32; i += NTHREADS) { const int tok = i >> 5, ai = i & 31, axis = ai >> 4, ii = ai & 15;
            const int s = s0 + tok; const float pos = (float)(axis == 0 ? (s >> 6) : (s & 63));
            const float inv = exp2f(-(float)ii * (13.287712379549449f / 16.0f));
            float sn, cn; sincosf(pos * inv, &sn, &cn); cs[2 * i] = cn; cs[2 * i + 1] = sn; }
        for (int i = F.tid; i < 64 * 80; i += NTHREADS) { const int tok = i / 80, ch = i % 80; const int col = ch < 64 ? 1024 + 8 * ch : 2176 + 8 * (ch - 64);
            const u32x4 v = *(const u32x4*)(QKV + (size_t)(t0 + tok) * IN_W + col);
            *(LAS u32x4*)(vt + tok * 648 + 8 * ch) = v; }
        __syncthreads();
        const int tok = F.tid >> 3, j = F.tid & 7, s = s0 + tok;
        for (int slot = 0; slot < 26; ++slot) {
            int col, type; bf16_t* dst;
            if (slot < 8)       { col = 64 * slot;               type = 0; dst = QA + ((size_t)(b * 8 + slot) * SEQ + s) * 64; }
            else if (slot < 16) { col = 512 + 64 * (slot - 8);   type = 1; dst = KA + ((size_t)(b * 8 + slot - 8) * SEQ + s) * 64; }
            else if (slot < 24) { col = 1536 + 64 * (slot - 16); type = 2; dst = QB + ((size_t)(b * 8 + slot - 16) * SEQ + s) * 64; }
            else                { col = 2048 + 64 * (slot - 24); type = 3; dst = KB + ((size_t)(b * 2 + slot - 24) * SEQ + s) * 64; }
            const u32x4 raw = *(const u32x4*)(QKV + (size_t)(t0 + tok) * IN_W + col + 8 * j);
            float v[8]; v[0] = bf_lo(raw.x); v[1] = bf_hi(raw.x); v[2] = bf_lo(raw.y); v[3] = bf_hi(raw.y); v[4] = bf_lo(raw.z); v[5] = bf_hi(raw.z); v[6] = bf_lo(raw.w); v[7] = bf_hi(raw.w);
            float ss = 0.f;
#pragma unroll
            for (int e = 0; e < 8; ++e) ss += v[e] * v[e];
            ss += __shfl_xor(ss, 1); ss += __shfl_xor(ss, 2); ss += __shfl_xor(ss, 4);
            const float rinv = rsqrtf(ss * (1.0f / 64.0f) + 1e-6f);
            const f32x4 g0 = *(const f32x4*)(qk_g + type * 64 + 8 * j), g1 = *(const f32x4*)(qk_g + type * 64 + 8 * j + 4);
#pragma unroll
            for (int e = 0; e < 4; ++e) { v[e] = v[e] * rinv * g0[e]; v[4 + e] = v[4 + e] * rinv * g1[e]; }
            if (type >= 2) {
                const int axis = j >> 2; const bool first = (j & 2) == 0;
#pragma unroll
                for (int e = 0; e < 8; ++e) { const float p = __shfl_xor(v[e], 2); const int ii = 8 * (j & 1) + e;
                    const float cn = cs[2 * (tok * 32 + axis * 16 + ii)], sn = cs[2 * (tok * 32 + axis * 16 + ii) + 1];
                    v[e] = first ? (v[e] * cn - p * sn) : (v[e] * cn + p * sn); }
            }
            if (type == 0 || type == 2) {
#pragma unroll
                for (int e = 0; e < 8; ++e) v[e] *= QSCALE; }
            u32x4 w; w.x = pack_bf16(v[0], v[1]); w.y = pack_bf16(v[2], v[3]); w.z = pack_bf16(v[4], v[5]); w.w = pack_bf16(v[6], v[7]);
            *(u32x4*)(dst + 8 * j) = w;
        }
        for (int i = F.tid; i < 640 * 8; i += NTHREADS) { const int c = i & 7, dv = i >> 3;
            unsigned short e[8];
#pragma unroll
            for (int k = 0; k < 8; ++k) e[k] = vt[(16 * (c >> 1) + 4 * (c & 1) + (k & 3) + 8 * (k >> 2)) * 648 + dv];
            u32x4 w; w.x = e[0] | ((unsigned)e[1] << 16); w.y = e[2] | ((unsigned)e[3] << 16); w.z = e[4] | ((unsigned)e[5] << 16); w.w = e[6] | ((unsigned)e[7] << 16);
            bf16_t* dp = dv < 512 ? VAT + ((size_t)b * 512 + dv) * SEQ + s0 + 8 * c : VBT + ((size_t)b * 128 + (dv - 512)) * SEQ + s0 + 8 * c;
            *(u32x4*)dp = w; }
    }
    __syncthreads();
}

DI int t5_bucket(int rel) {
    const int ret = rel > 0 ? 16 : 0; const int n = rel < 0 ? -rel : rel;
    if (n < 8) return ret + n;
    int large = 8 + (n >= 12) + (n >= 16) + (n >= 23) + (n >= 32) + (n >= 46) + (n >= 64) + (n >= 91);
    return ret + large;
}
constexpr int AT_NS = 4, AT_PD = AT_NS - 1, AT_STG = 24576, AT_TB = AT_NS * AT_STG, AT_Q = AT_TB + 3072;
DI void glds16(const void* gsrc, unsigned lds_dst) { unsigned keep;
    asm volatile("s_mov_b32 %0, m0\n\ts_mov_b32 m0, %2\n\ts_nop 0\n\tglobal_load_lds_dwordx4 %1, off\n\ts_mov_b32 m0, %0" : "=&s"(keep) : "v"(gsrc), "s"(lds_dst) : "memory"); }

template <int NC, bool BIAS>
DI void attn_pass(const Frame& F, const bf16_t* Qp, const bf16_t* Kp, const bf16_t* Vt, int q0, const LAS float* tb, float c_neg, float c_pos, f32x16 (&o)[NC], float& l_out) {
    int lane = F.lane, tid_ = F.tid; asm volatile("" : "+v"(lane), "+v"(tid_));
    const int r31 = lane & 31, h = lane >> 5;
    LAS unsigned char* lds = F.lds;
    constexpr int NT = SEQ / 64, PT = 1 + NC / 2;
    __syncthreads();
#pragma unroll
    for (int i = 0; i < 4; ++i) { const int idx = i * NTHREADS + tid_, row = idx >> 3, ch = idx & 7;
        const u32x4 v = *(const u32x4*)(Qp + (size_t)(q0 + row) * 64 + 8 * ch);
        *(LAS u32x4*)(lds + AT_Q + row * 128 + ((ch ^ (row & 7)) << 4)) = v; }
    unsigned koffs[4], qoffs[4], voffs[4];
#pragma unroll
    for (int s_ = 0; s_ < 4; ++s_) { const unsigned sw = (unsigned)(((2 * s_ + h) ^ (r31 & 7)) << 4);
        koffs[s_] = (unsigned)(r31 * 128) + sw; qoffs[s_] = (unsigned)(AT_Q + (32 * F.wave + r31) * 128) + sw;
        voffs[s_] = 8192u + (unsigned)(r31 * 128) + (unsigned)(((2 * s_ + h) ^ ((r31 >> 1) & 7)) << 4); }
#pragma unroll
    for (int c = 0; c < NC; ++c)
#pragma unroll
        for (int r = 0; r < 16; ++r) o[c][r] = 0.f;
    float m = -INFINITY, l = 0.f;
    const int qlo = q0 + 32 * F.wave, qme = qlo + r31;
    const int krow = F.wave * 8 + (lane >> 3);
    const bf16_t* ksrc = Kp + (size_t)krow * 64 + 8 * ((lane & 7) ^ (krow & 7));
    const bf16_t* vsrc[NC / 2];
#pragma unroll
    for (int i = 0; i < NC / 2; ++i) { const int vrow = (i * 8 + F.wave) * 8 + (lane >> 3); vsrc[i] = Vt + (size_t)vrow * SEQ + 8 * ((lane & 7) ^ ((vrow >> 1) & 7)); }
    const unsigned lbase = (unsigned)(size_t)lds;
    const unsigned kdst = lbase + (unsigned)F.wave * 1024u;
#define AT_ISSUE(tt) do { const unsigned sb_ = (unsigned)(((tt) % AT_NS) * AT_STG); \
        glds16(ksrc + (size_t)(tt) * 64 * 64, (unsigned)__builtin_amdgcn_readfirstlane(kdst + sb_)); \
        _Pragma("unroll") for (int i_ = 0; i_ < NC / 2; ++i_) glds16(vsrc[i_] + (size_t)(tt) * 64, (unsigned)__builtin_amdgcn_readfirstlane(kdst + sb_ + 8192u + (unsigned)i_ * 8192u)); } while (0)
    __syncthreads();
    bf16x8 qreg[4];
    {
#pragma unroll
        for (int s = 0; s < 4; ++s) qreg[s] = *(const LAS bf16x8*)(lds + qoffs[s]); }
#pragma unroll
    for (int tt = 0; tt < AT_PD; ++tt) AT_ISSUE(tt);
#pragma unroll 1
    for (int t = 0; t < NT; ++t) {
        const int k0 = t * 64;
        if (t < NT - 2) { if (PT == 3) asm volatile("s_waitcnt vmcnt(6)" ::: "memory"); else asm volatile("s_waitcnt vmcnt(4)" ::: "memory"); }
        else if (t == NT - 2) { if (PT == 3) asm volatile("s_waitcnt vmcnt(3)" ::: "memory"); else asm volatile("s_waitcnt vmcnt(2)" ::: "memory"); }
        else asm volatile("s_waitcnt vmcnt(0)" ::: "memory");
        __builtin_amdgcn_s_barrier();
        asm volatile("" ::: "memory");
        if (t + AT_PD < NT) AT_ISSUE(t + AT_PD);
        const LAS unsigned char* st_ = lds + (t % AT_NS) * AT_STG;
        f32x16 sT[2];
#pragma unroll
        for (int s = 0; s < 4; ++s) { const bf16x8 qf = qreg[s];
#pragma unroll
            for (int kb = 0; kb < 2; ++kb) { const bf16x8 kf = *(const LAS bf16x8*)(st_ + koffs[s] + kb * 4096);
                if (s == 0) sT[kb] = __builtin_amdgcn_mfma_f32_32x32x16_bf16(kf, qf, (f32x16){0.f, 0.f, 0.f, 0.f, 0.f, 0.f, 0.f, 0.f, 0.f, 0.f, 0.f, 0.f, 0.f, 0.f, 0.f, 0.f}, 0, 0, 0);
                else sT[kb] = __builtin_amdgcn_mfma_f32_32x32x16_bf16(kf, qf, sT[kb], 0, 0, 0); } }
        float cb = 0.f;
        if (BIAS) {
            if (k0 + 63 - qlo <= -91) cb = c_neg;
            else if (k0 - (qlo + 31) >= 91) cb = c_pos;
            else {
#pragma unroll
                for (int kb = 0; kb < 2; ++kb)
#pragma unroll
                    for (int r = 0; r < 16; ++r) { const int key = k0 + 32 * kb + (r & 3) + 8 * (r >> 2) + 4 * h; sT[kb][r] += tb[key - qme + 192]; }
            }
        }
        float mx = sT[0][0];
#pragma unroll
        for (int kb = 0; kb < 2; ++kb)
#pragma unroll
            for (int r = 0; r < 16; ++r) mx = fmaxf(mx, sT[kb][r]);
        mx = fmaxf(mx, __shfl_xor(mx, 32)) + cb;
        if (__builtin_amdgcn_ballot_w64(mx > m) != 0ull) {
            const float mn = fmaxf(m, mx), alpha = __builtin_amdgcn_exp2f(m - mn);
            m = mn; l *= alpha;
#pragma unroll
            for (int c = 0; c < NC; ++c)
#pragma unroll
                for (int r = 0; r < 16; ++r) o[c][r] *= alpha;
        }
        const float sh = cb - m;
        float ps = 0.f;
#pragma unroll
        for (int kb = 0; kb < 2; ++kb)
#pragma unroll
            for (int r = 0; r < 16; ++r) { const float p = __builtin_amdgcn_exp2f(sT[kb][r] + sh); sT[kb][r] = p; ps += p; }
        l += ps;
        bf16x8 pf[2][2];
#pragma unroll
        for (int kb = 0; kb < 2; ++kb)
#pragma unroll
            for (int s2 = 0; s2 < 2; ++s2) {
                u32x4 pw; pw.x = pack_bf16(sT[kb][8 * s2 + 0], sT[kb][8 * s2 + 1]); pw.y = pack_bf16(sT[kb][8 * s2 + 2], sT[kb][8 * s2 + 3]);
                pw.z = pack_bf16(sT[kb][8 * s2 + 4], sT[kb][8 * s2 + 5]); pw.w = pack_bf16(sT[kb][8 * s2 + 6], sT[kb][8 * s2 + 7]);
                pf[kb][s2] = __builtin_bit_cast(bf16x8, pw); }
        __builtin_amdgcn_sched_barrier(0);
#pragma unroll
        for (int g = 0; g < 4; ++g) {
#pragma unroll
            for (int c = 0; c < NC; ++c) { const bf16x8 vf = *(const LAS bf16x8*)(st_ + voffs[g] + c * 4096);
                o[c] = __builtin_amdgcn_mfma_f32_32x32x16_bf16(vf, pf[g >> 1][g & 1], o[c], 0, 0, 0); }
        }
    }
#undef AT_ISSUE
    l_out = l + __shfl_xor(l, 32);
}

template <int MODE> DI void p_attention(const Frame& F) {
    const bf16_t* QA = (const bf16_t*)(F.ws + WS_QA); const bf16_t* KA = (const bf16_t*)(F.ws + WS_KA); const bf16_t* VAT = (const bf16_t*)(F.ws + WS_VAT);
    const bf16_t* QB = (const bf16_t*)(F.ws + WS_QB); const bf16_t* KB = (const bf16_t*)(F.ws + WS_KB); const bf16_t* VBT = (const bf16_t*)(F.ws + WS_VBT);
    bf16_t* O = (bf16_t*)(F.ws + WS_O);
    const float* rel_bias = F.in[10]; const float* lv = F.in[7]; const float* subg = F.in[8];
    LAS float* tb = (LAS float*)(F.lds + AT_TB);
    const int lane = F.lane;
    float lam;
    { const float a = lv[lane] * lv[64 + lane], b2 = lv[128 + lane] * lv[192 + lane];
      lam = __expf(wave_sum(a)) - __expf(wave_sum(b2)) + 0.2f; }
    if (MODE & 1) for (int u = F.bid; u < 256; u += F.G) {
        const int b = u >> 5, hd = (u >> 3) & 3, qb = u & 7, q0 = qb * 256;
        __syncthreads();
        for (int i = F.tid; i < 2 * 384; i += NTHREADS) { const int mi = i / 384, ii = i % 384; tb[i] = rel_bias[t5_bucket(ii - 192) * 8 + 2 * hd + mi] * LOG2E; }
        __syncthreads();
        const bf16_t* Vt = VAT + (size_t)(b * 4 + hd) * 128 * SEQ;
        unsigned* o0s = (unsigned*)(F.ws + WS_O0S) + (size_t)F.bid * NTHREADS + F.tid;
        const size_t o0p = (size_t)F.G * NTHREADS;
        f32x16 o[4]; float l;
        { const int mp = 2 * hd;
          attn_pass<4, true>(F, QA + (size_t)(b * 8 + mp) * SEQ * 64, KA + (size_t)(b * 8 + mp) * SEQ * 64, Vt, q0, tb, rel_bias[15 * 8 + mp] * LOG2E, rel_bias[31 * 8 + mp] * LOG2E, o, l);
          const float il = 1.0f / l;
#pragma unroll
          for (int c = 0; c < 4; ++c)
#pragma unroll
              for (int r = 0; r < 8; ++r) o0s[(c * 8 + r) * o0p] = pack_bf16(o[c][2 * r] * il, o[c][2 * r + 1] * il); }
        { const int mp = 2 * hd + 1;
          attn_pass<4, true>(F, QA + (size_t)(b * 8 + mp) * SEQ * 64, KA + (size_t)(b * 8 + mp) * SEQ * 64, Vt, q0, tb + 384, rel_bias[15 * 8 + mp] * LOG2E, rel_bias[31 * 8 + mp] * LOG2E, o, l);
          int ln = F.lane; asm volatile("" : "+v"(ln)); const int r31 = ln & 31, h = ln >> 5;
          const float il = lam / l; float ss = 0.f;
#pragma unroll
          for (int c = 0; c < 4; ++c)
#pragma unroll
              for (int r = 0; r < 8; ++r) { const unsigned pk = __hip_atomic_load(o0s + (c * 8 + r) * o0p, __ATOMIC_RELAXED, __HIP_MEMORY_SCOPE_AGENT); const float d0 = bf_lo(pk) - o[c][2 * r] * il, d1 = bf_hi(pk) - o[c][2 * r + 1] * il; o[c][2 * r] = d0; o[c][2 * r + 1] = d1; ss += d0 * d0 + d1 * d1; }
          ss += __shfl_xor(ss, 32);
          const float rinv = rsqrtf(ss * (1.0f / 128.0f) + 1e-6f) * 0.8f;
          bf16_t* op = O + (size_t)(b * SEQ + q0 + 32 * F.wave + r31) * D + hd * 128;
#pragma unroll
          for (int c = 0; c < 4; ++c)
#pragma unroll
              for (int g = 0; g < 4; ++g) { const int dv = 32 * c + 8 * g + 4 * h; const f32x4 sg = *(const f32x4*)(subg + dv);
                  u32x2 w; w.x = pack_bf16(o[c][4 * g] * rinv * sg[0], o[c][4 * g + 1] * rinv * sg[1]); w.y = pack_bf16(o[c][4 * g + 2] * rinv * sg[2], o[c][4 * g + 3] * rinv * sg[3]);
                  *(u32x2*)(op + dv) = w; } }
    }
    if (MODE & 2) for (int u = F.bid; u < 512; u += F.G) {
        const int b = u >> 6, hq = (u >> 3) & 7, qb = u & 7, q0 = qb * 256, kv = hq >> 2;
        f32x16 o[2]; float l;
        attn_pass<2, false>(F, QB + (size_t)(b * 8 + hq) * SEQ * 64, KB + (size_t)(b * 2 + kv) * SEQ * 64, VBT + (size_t)(b * 2 + kv) * 64 * SEQ, q0, tb, 0.f, 0.f, o, l);
        int ln = F.lane; asm volatile("" : "+v"(ln)); const int r31 = ln & 31, h = ln >> 5;
        const float il = 1.0f / l;
        bf16_t* op = O + (size_t)(b * SEQ + q0 + 32 * F.wave + r31) * D + 512 + hq * 64;
#pragma unroll
        for (int c = 0; c < 2; ++c)
#pragma unroll
            for (int g = 0; g < 4; ++g) { const int dv = 32 * c + 8 * g + 4 * h;
                u32x2 w; w.x = pack_bf16(o[c][4 * g] * il, o[c][4 * g + 1] * il); w.y = pack_bf16(o[c][4 * g + 2] * il, o[c][4 * g + 3] * il);
                *(u32x2*)(op + dv) = w; }
    }
    __syncthreads();
}
#define CE_DESC(ka, pa, kb, pb) do { const bool _sw = (kb) > (ka); const float _k0 = _sw ? (kb) : (ka), _k1 = _sw ? (ka) : (kb); const int _p0 = _sw ? (pb) : (pa), _p1 = _sw ? (pa) : (pb); \
    (ka) = _k0; (kb) = _k1; (pa) = _p0; (pb) = _p1; } while (0)
template <int BASE> DI void sort16_desc(float (&k)[64], int (&p)[64]) {
#pragma unroll
    for (int k2 = 2; k2 <= 16; k2 <<= 1)
#pragma unroll
        for (int j = k2 >> 1; j > 0; j >>= 1)
#pragma unroll
            for (int i = 0; i < 16; ++i) { const int l = i ^ j;
                if (l > i) { if ((i & k2) == 0 || k2 == 16) CE_DESC(k[BASE + i], p[BASE + i], k[BASE + l], p[BASE + l]); else CE_DESC(k[BASE + l], p[BASE + l], k[BASE + i], p[BASE + i]); } }
}
template <int BA, int BB> DI void merge_top16(float (&k)[64], int (&p)[64]) {
#pragma unroll
    for (int i = 0; i < 16; ++i) { const bool sw = k[BB + 15 - i] > k[BA + i]; k[BA + i] = sw ? k[BB + 15 - i] : k[BA + i]; p[BA + i] = sw ? p[BB + 15 - i] : p[BA + i]; }
#pragma unroll
    for (int j = 8; j > 0; j >>= 1)
#pragma unroll
        for (int i = 0; i < 16; ++i) { const int l = i ^ j; if (l > i) CE_DESC(k[BA + i], p[BA + i], k[BA + l], p[BA + l]); }
}
DI void top16_of_64(float (&k)[64], int (&p)[64]) {
    sort16_desc<0>(k, p); sort16_desc<16>(k, p); sort16_desc<32>(k, p); sort16_desc<48>(k, p);
    merge_top16<0, 16>(k, p); merge_top16<32, 48>(k, p); merge_top16<0, 32>(k, p);
}
#define CEK_DESC(ka, kb) do { const float _h = fmaxf((ka), (kb)), _l = fminf((ka), (kb)); (ka) = _h; (kb) = _l; } while (0)
template <int BASE> DI void sort16k_desc(float (&k)[64]) {
#pragma unroll
    for (int k2 = 2; k2 <= 16; k2 <<= 1)
#pragma unroll
        for (int j = k2 >> 1; j > 0; j >>= 1)
#pragma unroll
            for (int i = 0; i < 16; ++i) { const int l = i ^ j;
                if (l > i) { if ((i & k2) == 0) CEK_DESC(k[BASE + i], k[BASE + l]); else CEK_DESC(k[BASE + l], k[BASE + i]); } }
}
template <int BA, int BB> DI void merge_top16k(float (&k)[64]) {
#pragma unroll
    for (int i = 0; i < 16; ++i) k[BA + i] = fmaxf(k[BA + i], k[BB + 15 - i]);
#pragma unroll
    for (int j = 8; j > 0; j >>= 1)
#pragma unroll
        for (int i = 0; i < 16; ++i) { const int l = i ^ j; if (l > i) CEK_DESC(k[BA + i], k[BA + l]); }
}
DI void top16k_of_64(float (&k)[64]) {
    sort16k_desc<0>(k); sort16k_desc<16>(k); sort16k_desc<32>(k); sort16k_desc<48>(k);
    merge_top16k<0, 16>(k); merge_top16k<32, 48>(k); merge_top16k<0, 32>(k);
}
constexpr int cand_off(int a) { int s = 0; for (int i = 0; i < a; ++i) s += 16 / (i + 1); return s; }

DI void p_peer_topk(const Frame& F, const bf16_t* PQ, const bf16_t* SK  , int* EIDX, float* GATE) {
    const int lane = F.lane, r31 = lane & 31, h = lane >> 5, w = F.wave;
    for (int tile = F.bid; tile < T / 64; tile += F.G) {
        for (int tt = 0; tt < 2; ++tt) {
            const int tok = tile * 64 + tt * 32 + r31;
            float lv[2][16];
#pragma unroll
            for (int p = 0; p < 2; ++p) {
                const int hp = 2 * w + p;
                f32x16 acc[4];
#pragma unroll
                for (int nb = 0; nb < 4; ++nb)
#pragma unroll
                    for (int r = 0; r < 16; ++r) acc[nb][r] = 0.f;
                const bf16_t* qp = PQ + (size_t)tok * PQ_LD + hp * 128 + 8 * h;
                const bf16_t* sp = SK + ((size_t)hp * 128 + r31) * 128 + 8 * h;
#pragma unroll 4
                for (int s = 0; s < 8; ++s) { const bf16x8 qf = *(const bf16x8*)(qp + 16 * s);
#pragma unroll
                    for (int nb = 0; nb < 4; ++nb) { const bf16x8 af = *(const bf16x8*)(sp + (size_t)nb * 32 * 128 + 16 * s);
                        acc[nb] = __builtin_amdgcn_mfma_f32_32x32x16_bf16(af, qf, acc[nb], 0, 0, 0); } }
                float k[64];
#pragma unroll
                for (int nb = 0; nb < 4; ++nb)
#pragma unroll
                    for (int r = 0; r < 16; ++r) { const int n = 32 * nb + (r & 3) + 8 * (r >> 2) + 4 * h;
                        k[16 * nb + r] = __uint_as_float((__float_as_uint(acc[nb][r]) & 0xFFFFFF80u) | (unsigned)(127 - n)); }
                top16k_of_64(k);
#pragma unroll
                for (int i = 0; i < 16; ++i) k[16 + i] = __shfl_xor(k[i], 32);
                merge_top16k<0, 16>(k);
#pragma unroll
                for (int i = 0; i < 16; ++i) lv[p][i] = k[i];
                __builtin_amdgcn_sched_barrier(0);
            }
            float ck[64];
#pragma unroll
            for (int i = 0; i < 64; ++i) ck[i] = -INFINITY;
#pragma unroll
            for (int a = 0; a < 16; ++a) {
#pragma unroll
                for (int b2 = 0; b2 < 16 / (a + 1); ++b2) ck[cand_off(a) + b2] = __uint_as_float((__float_as_uint(lv[0][a] + lv[1][b2]) & 0xFFFFFF00u) | (unsigned)(a * 16 + b2)); }
            LAS float* lst = (LAS float*)F.lds + F.tid;
#pragma unroll
            for (int i = 0; i < 16; ++i) { lst[i * NTHREADS] = lv[0][i]; lst[(16 + i) * NTHREADS] = lv[1][i]; }
            top16k_of_64(ck);
            float den = 0.f, ex[16]; int cp[16];
#pragma unroll
            for (int i = 0; i < 16; ++i) { ex[i] = __expf(ck[i] - ck[0]); den += ex[i];
                const unsigned cb = __float_as_uint(ck[i]); const int a = (cb >> 4) & 15, b2 = cb & 15;
                const unsigned u0 = __float_as_uint(lst[a * NTHREADS]), u1 = __float_as_uint(lst[(16 + b2) * NTHREADS]);
                cp[i] = (127 - (int)(u0 & 127u)) * 128 + (127 - (int)(u1 & 127u)); }
            const float iden = 1.0f / den;
            if (h == 0) {
                int* ep = EIDX + (size_t)tok * 128 + w * 16; float* gp = GATE + (size_t)tok * 128 + w * 16;
#pragma unroll
                for (int i = 0; i < 4; ++i) { *(u32x4*)(ep + 4 * i) = (u32x4){(unsigned)cp[4 * i], (unsigned)cp[4 * i + 1], (unsigned)cp[4 * i + 2], (unsigned)cp[4 * i + 3]};
                    *(f32x4*)(gp + 4 * i) = (f32x4){ex[4 * i] * iden, ex[4 * i + 1] * iden, ex[4 * i + 2] * iden, ex[4 * i + 3] * iden}; }
            }
        }
    }
}

DI void fp8x16_to_f32(const u32x4 w, float (&o)[16]) {
    f32x2 t;
    t = __builtin_amdgcn_cvt_pk_f32_fp8((int)w.x, false); o[0] = t[0]; o[1] = t[1];  t = __builtin_amdgcn_cvt_pk_f32_fp8((int)w.x, true); o[2] = t[0]; o[3] = t[1];
    t = __builtin_amdgcn_cvt_pk_f32_fp8((int)w.y, false); o[4] = t[0]; o[5] = t[1];  t = __builtin_amdgcn_cvt_pk_f32_fp8((int)w.y, true); o[6] = t[0]; o[7] = t[1];
    t = __builtin_amdgcn_cvt_pk_f32_fp8((int)w.z, false); o[8] = t[0]; o[9] = t[1];  t = __builtin_amdgcn_cvt_pk_f32_fp8((int)w.z, true); o[10] = t[0]; o[11] = t[1];
    t = __builtin_amdgcn_cvt_pk_f32_fp8((int)w.w, false); o[12] = t[0]; o[13] = t[1]; t = __builtin_amdgcn_cvt_pk_f32_fp8((int)w.w, true); o[14] = t[0]; o[15] = t[1];
}
DI float gelu_tanh_fast(float x) { const float z2 = 2.302208198f * (x + 0.044715f * x * x * x);
    return x * __builtin_amdgcn_rcpf(1.0f + __builtin_amdgcn_exp2f(-z2)); }
constexpr int PB = 4;
DI void peer_load(const unsigned char* PU, const unsigned char* PV, int ev, int base, int lane, u32x4 (&U)[PB], u32x4 (&V)[PB]) {
#pragma unroll
    for (int q = 0; q < PB; ++q) { const int e = __builtin_amdgcn_readlane(ev, base + q);
        U[q] = *(const u32x4*)(PU + (size_t)e * 1024 + 16 * lane); V[q] = *(const u32x4*)(PV + (size_t)e * 1024 + 16 * lane); }
}
struct RsMap { unsigned tag; int l0, l1, l2, l3; };
DI unsigned swp32(unsigned a, unsigned b, unsigned& other) { auto r = __builtin_amdgcn_permlane32_swap(a, b, false, false); other = r[1]; return r[0]; }
DI unsigned swp16(unsigned a, unsigned b, unsigned& other) { auto r = __builtin_amdgcn_permlane16_swap(a, b, false, false); other = r[1]; return r[0]; }
DI RsMap rs_map_init() {
    unsigned o, t0 = 0u, t1 = 1u, t2 = 2u, t3 = 3u;
    asm volatile("" : "+v"(t0), "+v"(t1), "+v"(t2), "+v"(t3));
    const unsigned ta = swp32(t0, t2, o), tb = swp32(t1, t3, o);
    RsMap m; m.tag = swp16(ta, tb, o);
    m.l0 = __builtin_ctzll(__builtin_amdgcn_ballot_w64(m.tag == 0u)); m.l1 = __builtin_ctzll(__builtin_amdgcn_ballot_w64(m.tag == 1u));
    m.l2 = __builtin_ctzll(__builtin_amdgcn_ballot_w64(m.tag == 2u)); m.l3 = __builtin_ctzll(__builtin_amdgcn_ballot_w64(m.tag == 3u));
    return m;
}
template <int CTRL> DI float dpp_g(float v) { return __builtin_bit_cast(float, __builtin_amdgcn_update_dpp(0, __builtin_bit_cast(int, v), CTRL, 0xF, 0xF, true)); }
DI void peer_comp(const u32x4 (&U)[PB], const u32x4 (&V)[PB], float su, float gvs, int base, const RsMap& M, const float (&x)[16], float (&y)[16]) {
    float d[PB];
#pragma unroll
    for (int q = 0; q < PB; ++q) { float u[16]; fp8x16_to_f32(U[q], u);
        float a0 = u[0] * x[0], a1 = u[1] * x[1], a2 = u[2] * x[2], a3 = u[3] * x[3];
#pragma unroll
        for (int i = 4; i < 16; i += 4) { a0 += u[i] * x[i]; a1 += u[i + 1] * x[i + 1]; a2 += u[i + 2] * x[i + 2]; a3 += u[i + 3] * x[i + 3]; }
        d[q] = (a0 + a1) + (a2 + a3); }
    unsigned o;
    const float f0a = __uint_as_float(swp32(__float_as_uint(d[0]), __float_as_uint(d[2]), o)); const float f0 = f0a + __uint_as_float(o);
    const float f1a = __uint_as_float(swp32(__float_as_uint(d[1]), __float_as_uint(d[3]), o)); const float f1 = f1a + __uint_as_float(o);
    const float ga = __uint_as_float(swp16(__float_as_uint(f0), __float_as_uint(f1), o)); float g = ga + __uint_as_float(o);
    g += dpp_g<0xB1>(g); g += dpp_g<0x4E>(g); g += dpp_g<0x141>(g); g += dpp_g<0x140>(g);
    const int src = (base + (int)M.tag) * 4;
    const float su_b = __uint_as_float(__builtin_amdgcn_ds_bpermute(src, __float_as_uint(su))), gv_b = __uint_as_float(__builtin_amdgcn_ds_bpermute(src, __float_as_uint(gvs)));
    const float c = gv_b * gelu_tanh_fast(g * su_b);
    const float c0 = __uint_as_float(__builtin_amdgcn_readlane(__float_as_uint(c), M.l0)), c1 = __uint_as_float(__builtin_amdgcn_readlane(__float_as_uint(c), M.l1));
    const float c2 = __uint_as_float(__builtin_amdgcn_readlane(__float_as_uint(c), M.l2)), c3 = __uint_as_float(__builtin_amdgcn_readlane(__float_as_uint(c), M.l3));
    const float cq[4] = {c0, c1, c2, c3};
#pragma unroll
    for (int q = 0; q < PB; ++q) { float v[16]; fp8x16_to_f32(V[q], v);
#pragma unroll
        for (int i = 0; i < 16; ++i) y[i] += cq[q] * v[i]; }
}
constexpr int PM_SHIFT = 11, PM_NP = 16384 >> PM_SHIFT;
struct PBatch { u32x4 U[4], V[4]; float su[4], gv[4]; int n; };
DI void pm_fetch(PBatch& B, unsigned long long& mA, unsigned long long& mB, int e0, int e1, float su0, float su1, float gv0, float gv1, const unsigned char* PU, const unsigned char* PV, int lane) {
    B.n = 0;
    if ((mA | mB) == 0ull) return;
    int eid[4];
#pragma unroll
    for (int q = 0; q < 4; ++q) {
        if (mA != 0ull) { const int l = __builtin_ctzll(mA); mA &= mA - 1ull;
            eid[q] = __builtin_amdgcn_readlane(e0, l); B.su[q] = __uint_as_float(__builtin_amdgcn_readlane(__float_as_uint(su0), l)); B.gv[q] = __uint_as_float(__builtin_amdgcn_readlane(__float_as_uint(gv0), l)); B.n = q + 1; }
        else if (mB != 0ull) { const int l = __builtin_ctzll(mB); mB &= mB - 1ull;
            eid[q] = __builtin_amdgcn_readlane(e1, l); B.su[q] = __uint_as_float(__builtin_amdgcn_readlane(__float_as_uint(su1), l)); B.gv[q] = __uint_as_float(__builtin_amdgcn_readlane(__float_as_uint(gv1), l)); B.n = q + 1; }
        else { eid[q] = eid[0]; B.su[q] = 0.f; B.gv[q] = 0.f; }
        B.U[q] = *(const u32x4*)(PU + (size_t)eid[q] * 1024 + 16 * lane); B.V[q] = *(const u32x4*)(PV + (size_t)eid[q] * 1024 + 16 * lane);
    }
}
DI void pm_comp(const PBatch& B, const RsMap& M, const float (&x)[16], float (&y)[16]) {
    float d[4];
#pragma unroll
    for (int q = 0; q < 4; ++q) { float u[16]; fp8x16_to_f32(B.U[q], u);
        f32x2 a0 = (f32x2){u[0], u[1]} * (f32x2){x[0], x[1]}, a1 = (f32x2){u[2], u[3]} * (f32x2){x[2], x[3]};
#pragma unroll
        for (int i = 4; i < 16; i += 4) { a0 = __builtin_elementwise_fma((f32x2){u[i], u[i + 1]}, (f32x2){x[i], x[i + 1]}, a0); a1 = __builtin_elementwise_fma((f32x2){u[i + 2], u[i + 3]}, (f32x2){x[i + 2], x[i + 3]}, a1); }
        const f32x2 as = a0 + a1; d[q] = as[0] + as[1]; }
    unsigned o;
    const float f0a = __uint_as_float(swp32(__float_as_uint(d[0]), __float_as_uint(d[2]), o)); const float f0 = f0a + __uint_as_float(o);
    const float f1a = __uint_as_float(swp32(__float_as_uint(d[1]), __float_as_uint(d[3]), o)); const float f1 = f1a + __uint_as_float(o);
    const float ga = __uint_as_float(swp16(__float_as_uint(f0), __float_as_uint(f1), o)); float g = ga + __uint_as_float(o);
    g += dpp_g<0xB1>(g); g += dpp_g<0x4E>(g); g += dpp_g<0x141>(g); g += dpp_g<0x140>(g);
    const float su_b = M.tag == 0u ? B.su[0] : (M.tag == 1u ? B.su[1] : (M.tag == 2u ? B.su[2] : B.su[3]));
    const float gv_b = M.tag == 0u ? B.gv[0] : (M.tag == 1u ? B.gv[1] : (M.tag == 2u ? B.gv[2] : B.gv[3]));
    const float c = gv_b * gelu_tanh_fast(g * su_b);
    const float cq[4] = {__uint_as_float(__builtin_amdgcn_readlane(__float_as_uint(c), M.l0)), __uint_as_float(__builtin_amdgcn_readlane(__float_as_uint(c), M.l1)),
                         __uint_as_float(__builtin_amdgcn_readlane(__float_as_uint(c), M.l2)), __uint_as_float(__builtin_amdgcn_readlane(__float_as_uint(c), M.l3))};
#pragma unroll
    for (int q = 0; q < 4; ++q) { float v[16]; fp8x16_to_f32(B.V[q], v);
#pragma unroll
        for (int i = 0; i < 16; ++i) y[i] += cq[q] * v[i]; }
}
template <bool FINAL> DI void p_peer_gather(const Frame& F, const float* gn  , const float* modl  , const unsigned char* PU, const unsigned char* PV, const float* SU, const float* SV, const int* EIDX, const float* GATE, const float* gt2  , bf16_t* xb, float* out) {
    const int lane = F.lane;
    const RsMap M = rs_map_init();
    for (int tile = F.bid; tile < T / 64; tile += F.G) {
        for (int grp = 0; grp < 4; ++grp) {
            const int tb = tile * 64 + F.wave * 8 + grp * 2;
            float x[2][16], y[2][16]; int e0[2], e1[2]; float su0[2], su1[2], gv0[2], gv1[2];
#pragma unroll
            for (int i = 0; i < 2; ++i) { const int t = tb + i;
                { float rinv; norm_row16_b(xb + (size_t)t * D, lane, x[i], rinv);
                  ada_apply(x[i], rinv, gn, modl + (size_t)(t / SEQ) * 6144 + 4096, modl + (size_t)(t / SEQ) * 6144 + 3072, lane); }
#pragma unroll
                for (int k = 0; k < 16; ++k) y[i][k] = 0.f;
                e0[i] = EIDX[(size_t)t * 128 + lane]; e1[i] = EIDX[(size_t)t * 128 + 64 + lane];
                su0[i] = SU[e0[i]]; su1[i] = SU[e1[i]]; gv0[i] = GATE[(size_t)t * 128 + lane] * SV[e0[i]]; gv1[i] = GATE[(size_t)t * 128 + 64 + lane] * SV[e1[i]]; }
            for (int p = 0; p < PM_NP; ++p) {
#pragma unroll
                for (int i = 0; i < 2; ++i) {
                    unsigned long long mA = __builtin_amdgcn_ballot_w64((e0[i] >> PM_SHIFT) == p), mB = __builtin_amdgcn_ballot_w64((e1[i] >> PM_SHIFT) == p);
                    PBatch A, B;
                    pm_fetch(A, mA, mB, e0[i], e1[i], su0[i], su1[i], gv0[i], gv1[i], PU, PV, lane);
                    while (A.n > 0) {
                        pm_fetch(B, mA, mB, e0[i], e1[i], su0[i], su1[i], gv0[i], gv1[i], PU, PV, lane);
                        pm_comp(A, M, x[i], y[i]);
                        if (B.n == 0) break;
                        pm_fetch(A, mA, mB, e0[i], e1[i], su0[i], su1[i], gv0[i], gv1[i], PU, PV, lane);
                        pm_comp(B, M, x[i], y[i]);
                    }
                }
            }
#pragma unroll
            for (int i = 0; i < 2; ++i) { const int t = tb + i; const int b = t / SEQ; const float* gp = gt2 + (size_t)b * 6144; bf16_t* xp = xb + (size_t)t * D;
#pragma unroll
                for (int j = 0; j < 4; ++j) { const int c = 256 * j + 4 * lane; const f32x4 g = *(const f32x4*)(gp + c); const u32x2 xw = *(const u32x2*)(xp + c);
                    f32x4 xo = (f32x4){bf_lo(xw.x), bf_hi(xw.x), bf_lo(xw.y), bf_hi(xw.y)};
                    xo[0] += g[0] * y[i][4 * j]; xo[1] += g[1] * y[i][4 * j + 1]; xo[2] += g[2] * y[i][4 * j + 2]; xo[3] += g[3] * y[i][4 * j + 3];
                    if (FINAL) *(f32x4*)(out + (size_t)t * D + c) = xo; else *(u32x2*)(xp + c) = (u32x2){pack_bf16(xo[0], xo[1]), pack_bf16(xo[2], xo[3])}; } }
        }
    }
}
DI void norm_row16c(const float* xr, int lane, float (&v)[16], float& rinv) {
    float ss = 0.f;
#pragma unroll
    for (int j = 0; j < 2; ++j)
#pragma unroll
        for (int q = 0; q < 2; ++q) { const f32x4 a = *(const f32x4*)(xr + 512 * j + 8 * lane + 4 * q); v[8 * j + 4 * q] = a[0]; v[8 * j + 4 * q + 1] = a[1]; v[8 * j + 4 * q + 2] = a[2]; v[8 * j + 4 * q + 3] = a[3];
            ss += a[0] * a[0] + a[1] * a[1] + a[2] * a[2] + a[3] * a[3]; }
    ss = wave_sum(ss);
    rinv = rsqrtf(ss * (1.0f / 1024.0f) + 1e-6f);
}
DI void ada_apply_c(float (&v)[16], float rinv, const float* g, const float* sc, const float* sh, int lane) {
#pragma unroll
    for (int j = 0; j < 2; ++j)
#pragma unroll
        for (int q = 0; q < 2; ++q) { const int c = 512 * j + 8 * lane + 4 * q;
            const f32x4 gg = *(const f32x4*)(g + c), s1 = *(const f32x4*)(sc + c), s0 = *(const f32x4*)(sh + c);
#pragma unroll
            for (int e = 0; e < 4; ++e) v[8 * j + 4 * q + e] = v[8 * j + 4 * q + e] * rinv * gg[e] * (1.0f + s1[e]) + s0[e]; }
}
DI void row_load(const bf16_t* xr, int lane, float (&v)[16]) {
#pragma unroll
    for (int j = 0; j < 2; ++j) { const u32x4 a = *(const u32x4*)(xr + 512 * j + 8 * lane);
        v[8 * j] = bf_lo(a.x); v[8 * j + 1] = bf_hi(a.x); v[8 * j + 2] = bf_lo(a.y); v[8 * j + 3] = bf_hi(a.y); v[8 * j + 4] = bf_lo(a.z); v[8 * j + 5] = bf_hi(a.z); v[8 * j + 6] = bf_lo(a.w); v[8 * j + 7] = bf_hi(a.w); }
}
DI void row_finish(const float (&raw)[16], int lane, const LAS float* ga, const LAS float* sh, float (&v)[16]) {
    float ss = 0.f;
#pragma unroll
    for (int e = 0; e < 16; ++e) ss += raw[e] * raw[e];
    ss = wave_sum(ss);
    const float rinv = rsqrtf(ss * (1.0f / 1024.0f) + 1e-6f);
#pragma unroll
    for (int j = 0; j < 2; ++j)
#pragma unroll
        for (int q = 0; q < 2; ++q) { const int c = 512 * j + 8 * lane + 4 * q; const f32x4 gg = *(const LAS f32x4*)(ga + c), s0 = *(const LAS f32x4*)(sh + c);
#pragma unroll
            for (int e = 0; e < 4; ++e) v[8 * j + 4 * q + e] = raw[8 * j + 4 * q + e] * rinv * gg[e] + s0[e]; }
}
DI void p_rwkv_prep(const Frame& F, const bf16_t* x, const float* g, const float* modl, const float* mix, bf16_t* X6) {
    const int lane = F.lane;
    LAS float* ga = (LAS float*)F.lds; LAS float* shl = ga + 1024; LAS float* mixl = ga + 2048;
    int cur_b = -1;
    for (int run0 = F.bid * NWAVES; run0 < T / 8; run0 += F.G * NWAVES) {
        const int run = run0 + F.wave;
        const int bb = (run0 * 8) / SEQ;
        if (bb != cur_b) { __syncthreads();
            for (int i = F.tid; i < 1024; i += NTHREADS) { ga[i] = g[i] * (1.0f + modl[(size_t)bb * 6144 + 1024 + i]); shl[i] = modl[(size_t)bb * 6144 + i]; }
            if (cur_b < 0) for (int i = F.tid; i < 6 * 1024; i += NTHREADS) mixl[i] = mix[i];
            cur_b = bb; __syncthreads(); }
        const int r0 = run * 8, s0 = r0 % SEQ;
        float hp[16], hc[16], hn[16], ra[16], rb[16];
        if (s0 > 0) row_load(x + (size_t)(r0 - 1) * D, lane, ra);
        row_load(x + (size_t)r0 * D, lane, rb);
        if (s0 > 0) row_finish(ra, lane, ga, shl, hp);
        else {
#pragma unroll
            for (int i = 0; i < 16; ++i) hp[i] = 0.f; }
        if (s0 + 1 < SEQ) row_load(x + (size_t)(r0 + 1) * D, lane, ra);
        row_finish(rb, lane, ga, shl, hc);
        for (int i = 0; i < 8; ++i) {
            const int s = s0 + i;
            if (i + 1 < 8 && s + 2 < SEQ) row_load(x + (size_t)(r0 + i + 2) * D, lane, rb);
            if (s + 1 < SEQ) row_finish(ra, lane, ga, shl, hn);
            else {
#pragma unroll
                for (int e = 0; e < 16; ++e) hn[e] = 0.f; }
#pragma unroll
            for (int e = 0; e < 16; ++e) ra[e] = rb[e];
            float xx[16];
#pragma unroll
            for (int e = 0; e < 16; ++e) xx[e] = 0.5f * (hp[e] + hn[e]) - hc[e];
#pragma unroll
            for (int grp = 0; grp < 6; ++grp) { const int mi = grp == 0 ? 0 : (grp == 1 ? 2 : (grp == 2 ? 3 : (grp == 3 ? 1 : grp)));
                bf16_t* op = X6 + ((size_t)grp * T + r0 + i) * D;
#pragma unroll
                for (int j = 0; j < 2; ++j) { const f32x4 m0 = *(const LAS f32x4*)(mixl + mi * 1024 + 512 * j + 8 * lane), m1 = *(const LAS f32x4*)(mixl + mi * 1024 + 512 * j + 8 * lane + 4);
                    u32x4 w; w.x = pack_bf16(hc[8 * j] + xx[8 * j] * m0[0], hc[8 * j + 1] + xx[8 * j + 1] * m0[1]); w.y = pack_bf16(hc[8 * j + 2] + xx[8 * j + 2] * m0[2], hc[8 * j + 3] + xx[8 * j + 3] * m0[3]);
                    w.z = pack_bf16(hc[8 * j + 4] + xx[8 * j + 4] * m1[0], hc[8 * j + 5] + xx[8 * j + 5] * m1[1]); w.w = pack_bf16(hc[8 * j + 6] + xx[8 * j + 6] * m1[2], hc[8 * j + 7] + xx[8 * j + 7] * m1[3]);
                    *(u32x4*)(op + 512 * j + 8 * lane) = w; } }
#pragma unroll
            for (int e = 0; e < 16; ++e) { hp[e] = hc[e]; hc[e] = hn[e]; }
        }
    }
    __syncthreads();
}

constexpr int SC_L = 16;
constexpr int SC_NB = 5;
constexpr int SCP = 272;
constexpr int SCB_W = 0, SCB_BKZ = 16 * SCP, SCB_VV = 32 * SCP, SCB_AR = 48 * SCP, SCB_SIZE = 64 * SCP;
constexpr int SC_Y = SC_NB * SCB_SIZE;
constexpr int SC_CST = SC_Y + SC_NB * 4096;
constexpr int SC_AFR = SC_CST + 1280;
constexpr int SC_PS = SC_AFR + 16384;
constexpr int SC_SCR = SC_PS + SC_NB * 512;
constexpr int SC_FLG = SC_SCR + 16384;
constexpr int SC_CY = SC_FLG + 64;
static_assert(SC_CY + SC_NB * 256 <= LDS_BAR_OFF, "scan LDS map overflows");
DI void lds_wait_ge(volatile LAS int* p, int v) { while (*p < v) __builtin_amdgcn_s_sleep(1); asm volatile("" ::: "memory"); }
DI void p_rwkv_scan(const Frame& F) {
    const bf16_t* RK = (const bf16_t*)(F.ws + WS1_RK);
    bf16_t* Y = (bf16_t*)(F.ws + WS1_Y); float* BON = (float*)(F.ws + WS1_BON);
    const float* k_k = F.in[21]; const float* k_a = F.in[22]; const float* r_k = F.in[23];
    LAS unsigned char* lds = F.lds;
    const int tid = F.tid, lane = F.lane;
    constexpr int NCH = SEQ / SC_L;
    for (int u = F.bid; u < 256; u += F.G) {
        const int b = u >> 5, hd = (u >> 1) & 15, z = u & 1;
        __syncthreads();
        if (tid < 16) ((volatile LAS int*)(lds + SC_FLG))[tid] = 0;
        { const float* w2 = F.in[15] + (size_t)z * 65536 + hd * 64; const float* a2 = F.in[18] + (size_t)z * 65536 + hd * 64;
          LAS unsigned short* stw = (LAS unsigned short*)(lds + SC_AFR);
          for (int idx = tid; idx < 8192; idx += NTHREADS) { const int mat = idx >> 12, i = (idx >> 6) & 63, c = idx & 63;
              const float v = (mat ? a2 : w2)[(size_t)i * 1024 + c]; stw[mat * 4096 + c * 64 + i] = (unsigned short)(pack_bf16(v, 0.f) & 0xffffu); } }
        __syncthreads();
        if (F.wave >= 4) {
            const int pw = F.wave - 4, s16 = lane & 15, q = lane >> 4;
            const int chb = hd * 64 + 4 * q;
            const LAS unsigned short* stg = (const LAS unsigned short*)(lds + SC_AFR);
            LAS float* cst = (LAS float*)(lds + SC_CST);
            { cst[lane] = F.in[13][z * 1024 + hd * 64 + lane]; cst[64 + lane] = F.in[16][z * 1024 + hd * 64 + lane]; cst[128 + lane] = k_k[hd * 64 + lane]; cst[192 + lane] = k_a[hd * 64 + lane]; cst[256 + lane] = r_k[hd * 64 + lane]; }
            u32x2 rr[4], kr[4], vr[4]; u32x4 Bw[2], Ba[2];
#define SC_ROW(i_) ((size_t)(b * SEQ + (z ? (SEQ - 1 - (i_)) : (i_))))
#define SC_LOADC(cc) do { int s16l_ = s16, ql_ = q; asm volatile("" : "+v"(s16l_), "+v"(ql_)); const int chb_ = hd * 64 + 4 * ql_;     \
        const bf16_t* rp_ = RK + SC_ROW((cc) * SC_L + s16l_) * RW_N; \
        _Pragma("unroll") for (int cb = 0; cb < 4; ++cb) { rr[cb] = *(const u32x2*)(rp_ + chb_ + 16 * cb); kr[cb] = *(const u32x2*)(rp_ + 1024 + chb_ + 16 * cb); vr[cb] = *(const u32x2*)(rp_ + 2048 + chb_ + 16 * cb); } \
        _Pragma("unroll") for (int ks = 0; ks < 2; ++ks) { Bw[ks] = *(const u32x4*)(rp_ + 3072 + 64 * z + 32 * ks + 8 * ql_); Ba[ks] = *(const u32x4*)(rp_ + 3328 + 64 * z + 32 * ks + 8 * ql_); } } while (0)
#define SC_XFORM(cc_, buf_) do { \
            int s16_ = s16, q_ = q; asm volatile("" : "+v"(s16_), "+v"(q_));     \
            LAS unsigned char* bp = lds + (buf_) * SCB_SIZE; const int t_ = s16_; const bool odd_ = (s16_ & 1) != 0; \
            float ss = 0.f, bs = 0.f; LAS float* scr_ = (LAS float*)(lds + SC_SCR) + (pw * 4) * 256 + (q_ * 16 + s16_) * 4;     \
            _Pragma("unroll") for (int cb = 0; cb < 4; ++cb) { \
                f32x4 dw = __builtin_amdgcn_mfma_f32_16x16x32_bf16(*(const LAS bf16x8*)(stg + (16 * cb + s16_) * 64 + 8 * q_), __builtin_bit_cast(bf16x8, Bw[0]), (f32x4){0.f, 0.f, 0.f, 0.f}, 0, 0, 0); \
                dw = __builtin_amdgcn_mfma_f32_16x16x32_bf16(*(const LAS bf16x8*)(stg + (16 * cb + s16_) * 64 + 32 + 8 * q_), __builtin_bit_cast(bf16x8, Bw[1]), dw, 0, 0, 0); \
                f32x4 da = __builtin_amdgcn_mfma_f32_16x16x32_bf16(*(const LAS bf16x8*)(stg + 4096 + (16 * cb + s16_) * 64 + 8 * q_), __builtin_bit_cast(bf16x8, Ba[0]), (f32x4){0.f, 0.f, 0.f, 0.f}, 0, 0, 0); \
                da = __builtin_amdgcn_mfma_f32_16x16x32_bf16(*(const LAS bf16x8*)(stg + 4096 + (16 * cb + s16_) * 64 + 32 + 8 * q_), __builtin_bit_cast(bf16x8, Ba[1]), da, 0, 0, 0); \
                const f32x4 w0v = *(const LAS f32x4*)(cst + 16 * cb + 4 * q_), a0v = *(const LAS f32x4*)(cst + 64 + 16 * cb + 4 * q_); \
                const f32x4 kkw = *(const LAS f32x4*)(cst + 128 + 16 * cb + 4 * q_), kaw = *(const LAS f32x4*)(cst + 192 + 16 * cb + 4 * q_), rkw = *(const LAS f32x4*)(cst + 256 + 16 * cb + 4 * q_); \
                const float r4[4] = {bf_lo(rr[cb].x), bf_hi(rr[cb].x), bf_lo(rr[cb].y), bf_hi(rr[cb].y)}, k4[4] = {bf_lo(kr[cb].x), bf_hi(kr[cb].x), bf_lo(kr[cb].y), bf_hi(kr[cb].y)}; \
                f32x4 dec, azq, kzq; \
                _Pragma("unroll") for (int e = 0; e < 4; ++e) { \
                    const float sgw = __builtin_amdgcn_rcpf(1.0f + __builtin_amdgcn_exp2f(-1.4426950408889634f * (dw[e] + w0v[e])));     \
                    dec[e] = __builtin_amdgcn_exp2f(-0.8750387749f * sgw);                                                     \
                    const float az = __builtin_amdgcn_rcpf(1.0f + __builtin_amdgcn_exp2f(-1.4426950408889634f * (da[e] + a0v[e]))); azq[e] = az; \
                    { const float kk_ = k4[e] * kkw[e]; ss += kk_ * kk_; } kzq[e] = k4[e] * (1.0f + (az - 1.0f) * kaw[e]); bs += r4[e] * kzq[e] * rkw[e]; } \
                { const int o = t_ * SCP + (16 * cb + 4 * q_) * 4; \
                    *(LAS f32x4*)(scr_ + cb * 256) = azq; *(LAS f32x4*)(bp + SCB_BKZ + o) = kzq;     \
                    *(LAS f32x4*)(bp + SCB_W + o) = dec;                        \
                    *(LAS f32x4*)(bp + SCB_VV + o) = (f32x4){bf_lo(vr[cb].x), bf_hi(vr[cb].x), bf_lo(vr[cb].y), bf_hi(vr[cb].y)}; } } \
            ss += __shfl_xor(ss, 16); ss += __shfl_xor(ss, 32); bs += __shfl_xor(bs, 16); bs += __shfl_xor(bs, 32); \
            const float inv = __builtin_amdgcn_rsqf(fmaxf(ss, 1e-24f));     \
              \
            float s_bb = 0.f, s_kk = 0.f, c_g = 0.f, c_h = 0.f, c_br = 0.f, c_kr = 0.f; const bool pB_ = (s16_ & 2) != 0;     \
            f32x4 Ga = (f32x4){0.f, 0.f, 0.f, 0.f}, Gr = Ga;     \
            _Pragma("unroll") for (int cb = 0; cb < 4; ++cb) { float kn[4], bo[4], bq[4], kq[4]; \
                const float r4[4] = {bf_lo(rr[cb].x), bf_hi(rr[cb].x), bf_lo(rr[cb].y), bf_hi(rr[cb].y)}, k4[4] = {bf_lo(kr[cb].x), bf_hi(kr[cb].x), bf_lo(kr[cb].y), bf_hi(kr[cb].y)}; \
                const f32x4 kkw = *(const LAS f32x4*)(cst + 128 + 16 * cb + 4 * q_); \
                const f32x4 dcv = *(const LAS f32x4*)(bp + SCB_W + t_ * SCP + (16 * cb + 4 * q_) * 4), wp = *(const LAS f32x4*)(bp + SCB_W + (t_ ^ 1) * SCP + (16 * cb + 4 * q_) * 4);     \
                const f32x4 azq = *(const LAS f32x4*)(scr_ + cb * 256), kzq = *(const LAS f32x4*)(bp + SCB_BKZ + t_ * SCP + (16 * cb + 4 * q_) * 4); \
                _Pragma("unroll") for (int e = 0; e < 4; ++e) { kn[e] = k4[e] * kkw[e] * inv; bo[e] = kn[e] * azq[e]; \
                    bq[e] = dpp_g<0xB1>(bo[e]); kq[e] = dpp_g<0xB1>(kzq[e]); \
                    const float ao = -kn[e], rd = r4[e] * dcv[e]; \
                    s_bb += bo[e] * r4[e]; s_kk += kzq[e] * r4[e]; c_g += bq[e] * ao; c_h += kq[e] * ao; c_br += bq[e] * rd; c_kr += kq[e] * rd; } \
                float fb[4], fk[4], xa[4], xr[4], wq[4], sA[4], sB[4]; \
                _Pragma("unroll") for (int e = 0; e < 4; ++e) { const float wpr = dcv[e] * wp[e], wo = dpp_g<0x4E>(wpr);     \
                    const float mb = odd_ ? 1.0f : wp[e], ma = odd_ ? -wp[e] : -1.0f, mr = odd_ ? wpr : dcv[e]; \
                    fb[e] = bo[e] * mb; fk[e] = kzq[e] * mb; xa[e] = kn[e] * ma; xr[e] = r4[e] * mr; wq[e] = wpr * wo; sA[e] = pB_ ? 1.0f : wo; sB[e] = pB_ ? wo : 1.0f; \
                    const float fb0 = dpp_g<0x00>(fb[e]), fk0 = dpp_g<0x00>(fk[e]), fb1 = dpp_g<0x55>(fb[e]), fk1 = dpp_g<0x55>(fk[e]);     \
                    Ga[0] += fb0 * xa[e]; Ga[1] += fk0 * xa[e]; Ga[2] += fb1 * xa[e]; Ga[3] += fk1 * xa[e]; Gr[0] += fb0 * xr[e]; Gr[1] += fk0 * xr[e]; Gr[2] += fb1 * xr[e]; Gr[3] += fk1 * xr[e]; } \
                *(LAS f32x4*)(bp + SCB_W + t_ * SCP + (16 * cb + 4 * q_) * 4) = (f32x4){wq[0], wq[1], wq[2], wq[3]};            \
                *(LAS u32x4*)(bp + SCB_BKZ + t_ * SCP + (16 * cb + 4 * q_) * 4) = (u32x4){pack_bf16(fb[0] * sA[0], fk[0] * sA[0]), pack_bf16(fb[1] * sA[1], fk[1] * sA[1]), pack_bf16(fb[2] * sA[2], fk[2] * sA[2]), pack_bf16(fb[3] * sA[3], fk[3] * sA[3])};     \
                *(LAS u32x2*)(bp + SCB_AR + t_ * SCP + ((cb >> 1) * 4 + q_) * 16 + (cb & 1) * 8) = (u32x2){pack_bf16(xa[0] * sB[0], xa[1] * sB[1]), pack_bf16(xa[2] * sB[2], xa[3] * sB[3])};            \
                *(LAS u32x2*)(bp + SCB_AR + t_ * SCP + 128 + ((cb >> 1) * 4 + q_) * 16 + (cb & 1) * 8) = (u32x2){pack_bf16(xr[0] * sB[0], xr[1] * sB[1]), pack_bf16(xr[2] * sB[2], xr[3] * sB[3])}; }   \
            s_bb += __shfl_xor(s_bb, 16); s_bb += __shfl_xor(s_bb, 32); s_kk += __shfl_xor(s_kk, 16); s_kk += __shfl_xor(s_kk, 32); \
            c_g += __shfl_xor(c_g, 16); c_g += __shfl_xor(c_g, 32); c_h += __shfl_xor(c_h, 16); c_h += __shfl_xor(c_h, 32); \
            c_br += __shfl_xor(c_br, 16); c_br += __shfl_xor(c_br, 32); c_kr += __shfl_xor(c_kr, 16); c_kr += __shfl_xor(c_kr, 32); \
            _Pragma("unroll") for (int e = 0; e < 4; ++e) { Ga[e] += __shfl_xor(Ga[e], 16); Ga[e] += __shfl_xor(Ga[e], 32); Gr[e] += __shfl_xor(Gr[e], 16); Gr[e] += __shfl_xor(Gr[e], 32); } \
            if (q_ == 0) { LAS float* ps_ = (LAS float*)(lds + SC_PS + (buf_) * 512) + (t_ >> 1) * 8;     \
                if (odd_) { ps_[0] = c_g; ps_[1] = c_h; } \
                if (pB_) { LAS float* pq_ = (LAS float*)(lds + SC_PS + (buf_) * 512) + 64 + (t_ >> 2) * 16 + (odd_ ? 4 : 0); *(LAS f32x4*)pq_ = Ga; } \
                  \
                const float o0_ = odd_ ? c_br : s_bb, o1_ = odd_ ? c_kr : s_kk, o2_ = odd_ ? s_bb : 0.f, o3_ = odd_ ? s_kk : 0.f; \
                const unsigned ow0_ = pack_bf16(o0_, o1_), ow1_ = pack_bf16(o2_, o3_), gw0_ = pack_bf16(Gr[0], Gr[1]), gw1_ = pack_bf16(Gr[2], Gr[3]); \
                *(LAS u32x4*)(lds + SC_CY + (buf_) * 256 + (t_ >> 2) * 64 + (t_ & 3) * 16) = pB_ ? (u32x4){gw0_, gw1_, ow0_, ow1_} : (u32x4){ow0_, ow1_, 0u, 0u}; \
                BON[((size_t)z * T + SC_ROW((cc_) * SC_L + t_)) * 16 + hd] = bs; } } while (0)
#define SC_FLUSH(cc, slot_) do { const LAS float* yb_ = (const LAS float*)(lds + SC_Y + (slot_) * 4096); const int ft_ = lane >> 2, fj_ = (lane & 3) * 16;     \
            const f32x4 y0_ = *(const LAS f32x4*)(yb_ + ft_ * 64 + fj_), y1_ = *(const LAS f32x4*)(yb_ + ft_ * 64 + fj_ + 4), y2_ = *(const LAS f32x4*)(yb_ + ft_ * 64 + fj_ + 8), y3_ = *(const LAS f32x4*)(yb_ + ft_ * 64 + fj_ + 12); \
            bf16_t* yp_ = Y + ((size_t)z * T + SC_ROW((cc) * SC_L + ft_)) * D + hd * 64 + fj_; \
            *(u32x4*)yp_ = (u32x4){pack_bf16(y0_[0], y0_[1]), pack_bf16(y0_[2], y0_[3]), pack_bf16(y1_[0], y1_[1]), pack_bf16(y1_[2], y1_[3])}; \
            *(u32x4*)(yp_ + 8) = (u32x4){pack_bf16(y2_[0], y2_[1]), pack_bf16(y2_[2], y2_[3]), pack_bf16(y3_[0], y3_[1]), pack_bf16(y3_[2], y3_[3])}; } while (0)
            volatile LAS int* rdy = (volatile LAS int*)(lds + SC_FLG); volatile LAS int* prog = rdy + 8;
            SC_LOADC(pw);
            for (int n = pw; n < NCH; n += 4) {
                const int buf = n % SC_NB;
                if (n >= SC_NB) { lds_wait_ge(prog + 0, n - 4); lds_wait_ge(prog + 1, n - 4); lds_wait_ge(prog + 2, n - 4); lds_wait_ge(prog + 3, n - 4); SC_FLUSH(n - SC_NB, buf); }
                SC_XFORM(n, buf);
                asm volatile("s_waitcnt lgkmcnt(0)" ::: "memory");
                if (lane == 0) rdy[buf] = n + 1;
                if (n + 4 < NCH) SC_LOADC(n + 4);
            }
            for (int c = NCH - SC_NB; c < NCH; ++c) if (((c + SC_NB) & 3) == pw) {
                lds_wait_ge(prog + 0, c + 1); lds_wait_ge(prog + 1, c + 1); lds_wait_ge(prog + 2, c + 1); lds_wait_ge(prog + 3, c + 1); SC_FLUSH(c, c % SC_NB); }
#undef SC_ROW
#undef SC_LOADC
#undef SC_XFORM
#undef SC_FLUSH
        } else {
            const int w = F.wave, i16 = lane & 15, q = lane >> 4;
            f32x4 Sd[4];
#pragma unroll
            for (int k = 0; k < 4; ++k) Sd[k] = (f32x4){0.f, 0.f, 0.f, 0.f};
            const int m4 = i16 & 3;
            const int w_off = (4 * q) * 4, bkz_off = i16 * 4, vv_off = (16 * w + i16) * 4, ar_off = (m4 & 1) * SCP + (m4 >> 1) * 128 + q * 16;
            const bool qodd = (q & 1) != 0; const unsigned qmask = (q & 2) ? 0u : 0xffffffffu;
            const int bkq_off = (2 * (q & 1)) * SCP + i16 * 4;
            __builtin_amdgcn_s_setprio(3);
            typedef short s16x4v __attribute__((ext_vector_type(4)));
#define ST_LD(o_, Q_) do { _Pragma("unroll") for (int j = 0; j < 4; ++j) o_.vv[j] = *(const LAS float*)(bp + SCB_VV + (4 * (Q_) + j) * SCP + vv_off); \
        o_.a1lo = *(const LAS bf16x8*)(bp + SCB_AR + (4 * (Q_)) * SCP + ar_off); o_.a1hi = *(const LAS bf16x8*)(bp + SCB_AR + (4 * (Q_)) * SCP + 64 + ar_off); \
        o_.a2lo = *(const LAS bf16x8*)(bp + SCB_AR + (4 * (Q_) + 2) * SCP + ar_off); o_.a2hi = *(const LAS bf16x8*)(bp + SCB_AR + (4 * (Q_) + 2) * SCP + 64 + ar_off); } while (0)
#define ST_STEP(o_, Q_) do { \
        const bf16x8 Bd0 = __builtin_bit_cast(bf16x8, (u32x4){pack_bf16(Sd[0][0], Sd[0][1]), pack_bf16(Sd[0][2], Sd[0][3]), pack_bf16(Sd[1][0], Sd[1][1]), pack_bf16(Sd[1][2], Sd[1][3])}); \
        const bf16x8 Bd1 = __builtin_bit_cast(bf16x8, (u32x4){pack_bf16(Sd[2][0], Sd[2][1]), pack_bf16(Sd[2][2], Sd[2][3]), pack_bf16(Sd[3][0], Sd[3][1]), pack_bf16(Sd[3][2], Sd[3][3])}); \
        const f32x4 d1a = __builtin_amdgcn_mfma_f32_16x16x32_bf16(o_.a1lo, Bd0, (f32x4){0.f, 0.f, 0.f, 0.f}, 0, 0, 0); \
        const f32x4 e1a = __builtin_amdgcn_mfma_f32_16x16x32_bf16(o_.a2lo, Bd0, (f32x4){0.f, 0.f, 0.f, 0.f}, 0, 0, 0); \
        const f32x4 dd = __builtin_amdgcn_mfma_f32_16x16x32_bf16(o_.a1hi, Bd1, d1a, 0, 0, 0); \
        const f32x4 ee = __builtin_amdgcn_mfma_f32_16x16x32_bf16(o_.a2hi, Bd1, e1a, 0, 0, 0); \
        const LAS float* pa_ = psp + (2 * (Q_)) * 8; const LAS float* pg_ = psp + 64 + (Q_) * 16; \
        const f32x4 pA0 = *(const LAS f32x4*)pa_, pB0 = *(const LAS f32x4*)(pa_ + 8), g0 = *(const LAS f32x4*)pg_, g1 = *(const LAS f32x4*)(pg_ + 4); \
        const u32x2 cyw = *(const LAS u32x2*)(cyp + (Q_) * 64); \
        f32x4 wv[4]; u32x2 bk[4]; \
        _Pragma("unroll") for (int k = 0; k < 4; ++k) { wv[k] = *(const LAS f32x4*)(bp + SCB_W + (4 * (Q_)) * SCP + 64 * k + w_off); \
            bk[k] = (u32x2){*(const LAS unsigned*)(bkp + (4 * (Q_)) * SCP + 64 * k), *(const LAS unsigned*)(bkp + (4 * (Q_) + 1) * SCP + 64 * k)}; } \
        const float v1 = o_.vv[0], v2 = o_.vv[1], v3 = o_.vv[2], v4 = o_.vv[3]; \
        const float u1 = dd[0]; \
        const float u2 = dd[1] + u1 * pA0[0] + v1 * pA0[1]; \
        const float u3 = ee[0] + u1 * g0[0] + v1 * g0[1] + u2 * g0[2] + v2 * g0[3]; \
        const float u4 = ee[1] + u1 * g1[0] + v1 * g1[1] + u2 * g1[2] + v2 * g1[3] + u3 * pB0[0] + v3 * pB0[1]; \
        const float x0_ = qodd ? u3 : u1, x1_ = qodd ? v3 : v1, x2_ = qodd ? u4 : u2, x3_ = qodd ? v4 : v2;     \
        const unsigned b2lo = pack_bf16(x0_, x1_) & qmask, b2hi = pack_bf16(x2_, x3_) & qmask;     \
        const s16x4v B2 = __builtin_bit_cast(s16x4v, (u32x2){b2lo, b2hi}); \
        _Pragma("unroll") for (int k = 0; k < 4; ++k) Sd[k] = __builtin_amdgcn_mfma_f32_16x16x16bf16_1k(__builtin_bit_cast(s16x4v, bk[k]), B2, Sd[k] * wv[k], 0, 0, 0); \
        const f32x4 yv = __builtin_amdgcn_mfma_f32_16x16x16bf16_1k(__builtin_bit_cast(s16x4v, cyw), B2, (f32x4){dd[2], dd[3], ee[2], ee[3]}, 0, 0, 0);     \
        yb[(4 * (Q_)) * 64 + 16 * w + i16] = yv[0]; yb[(4 * (Q_) + 1) * 64 + 16 * w + i16] = yv[1]; yb[(4 * (Q_) + 2) * 64 + 16 * w + i16] = yv[2]; yb[(4 * (Q_) + 3) * 64 + 16 * w + i16] = yv[3]; } while (0)
            struct StepOps { float vv[4]; bf16x8 a1lo, a1hi, a2lo, a2hi; };
            volatile LAS int* rdy = (volatile LAS int*)(lds + SC_FLG); volatile LAS int* prog = rdy + 8;
            int buf = 0;
            for (int c = 0; c < NCH; ++c) {
                const LAS unsigned char* bp = lds + buf * SCB_SIZE; LAS float* yb = (LAS float*)(lds + SC_Y + buf * 4096);
                const LAS unsigned char* bkp = bp + SCB_BKZ + bkq_off;
                const LAS float* psp = (const LAS float*)(lds + SC_PS + buf * 512);
                const LAS unsigned char* cyp = lds + SC_CY + buf * 256 + (i16 & 3) * 16 + (q & 1) * 8;
                lds_wait_ge(rdy + buf, c + 1);
                const bool conv = (c & 3) == w; float tv[16]; const int tr = u * NCH + c, ttab = tr >> 14, trow = tr & 16383;
                int ln2 = lane; asm volatile("" : "+v"(ln2));
                if (conv) fp8_row_load(F.in[ttab ? 30 : 29] + (size_t)N_EXPERTS * 1024, trow, ln2, tv);
                else {
#pragma unroll
                    for (int i = 0; i < 16; ++i) tv[i] = 0.f; }
                StepOps oa, ob; ST_LD(oa, 0);
                ST_LD(ob, 1); ST_STEP(oa, 0);
                ST_LD(oa, 2); ST_STEP(ob, 1);
                ST_LD(ob, 3); ST_STEP(oa, 2);
                ST_STEP(ob, 3);
                asm volatile("s_waitcnt lgkmcnt(0)" ::: "memory");
                if (lane == 0) prog[w] = c + 1;
                if (conv) fp8_row_store(tv, trow, ln2, F.ws + (ttab ? WS_PV1 : WS_PU1), (float*)(F.ws + WS_PSC) + (2 + ttab) * N_EXPERTS);
                buf = (buf + 1 == SC_NB) ? 0 : buf + 1;
            }
#undef ST_LD
#undef ST_STEP
            __builtin_amdgcn_s_setprio(0);
            __builtin_amdgcn_s_setprio(0);
        }
    }
    __syncthreads();
}

DI void unpack8(const u32x4 w, float* o) { o[0] = bf_lo(w.x); o[1] = bf_hi(w.x); o[2] = bf_lo(w.y); o[3] = bf_hi(w.y); o[4] = bf_lo(w.z); o[5] = bf_hi(w.z); o[6] = bf_lo(w.w); o[7] = bf_hi(w.w); }
DI void p_rwkv_post(const Frame& F) {
    const bf16_t* RK = (const bf16_t*)(F.ws + WS1_RK); const bf16_t* Y = (const bf16_t*)(F.ws + WS1_Y); const float* BON = (const float*)(F.ws + WS1_BON);
    const bf16_t* G = (const bf16_t*)(F.ws + WS1_G); bf16_t* A3 = (bf16_t*)(F.ws + WS1_A3);
    const float* ln_g = F.in[24]; const float* ln_b = F.in[25];
    const int lane = F.lane, c0 = 16 * lane, hd = lane >> 2;
    for (int t = F.bid * NWAVES + F.wave; t < T; t += F.G * NWAVES) {
        float y[16], tmp[16], vv[16], gg[16];
        unpack8(*(const u32x4*)(Y + (size_t)t * D + c0), y); unpack8(*(const u32x4*)(Y + (size_t)t * D + c0 + 8), y + 8);
        unpack8(*(const u32x4*)(Y + ((size_t)T + t) * D + c0), tmp); unpack8(*(const u32x4*)(Y + ((size_t)T + t) * D + c0 + 8), tmp + 8);
        unpack8(*(const u32x4*)(RK + (size_t)t * RW_N + 2048 + c0), vv); unpack8(*(const u32x4*)(RK + (size_t)t * RW_N + 2048 + c0 + 8), vv + 8);
        unpack8(*(const u32x4*)(G + (size_t)t * D + c0), gg); unpack8(*(const u32x4*)(G + (size_t)t * D + c0 + 8), gg + 8);
        const float bon = BON[(size_t)t * 16 + hd] + BON[((size_t)T + t) * 16 + hd];
        float sm = 0.f;
#pragma unroll
        for (int e = 0; e < 16; ++e) { y[e] += tmp[e]; sm += y[e]; }
        sm += __shfl_xor(sm, 1); sm += __shfl_xor(sm, 2);
        const float mu = sm * (1.0f / 64.0f);
        float vr = 0.f;
#pragma unroll
        for (int e = 0; e < 16; ++e) { const float d = y[e] - mu; vr += d * d; }
        vr += __shfl_xor(vr, 1); vr += __shfl_xor(vr, 2);
        const float rs = rsqrtf(vr * (1.0f / 64.0f) + 64e-5f);
        float o[16];
#pragma unroll
        for (int q = 0; q < 4; ++q) { const f32x4 lg = *(const f32x4*)(ln_g + c0 + 4 * q), lb = *(const f32x4*)(ln_b + c0 + 4 * q);
#pragma unroll
            for (int e = 0; e < 4; ++e) { const int i = 4 * q + e; o[i] = ((y[i] - mu) * rs * lg[e] + lb[e] + bon * vv[i]) * gg[i]; } }
        u32x4 w0, w1; w0.x = pack_bf16(o[0], o[1]); w0.y = pack_bf16(o[2], o[3]); w0.z = pack_bf16(o[4], o[5]); w0.w = pack_bf16(o[6], o[7]);
        w1.x = pack_bf16(o[8], o[9]); w1.y = pack_bf16(o[10], o[11]); w1.z = pack_bf16(o[12], o[13]); w1.w = pack_bf16(o[14], o[15]);
        *(u32x4*)(A3 + (size_t)t * D + c0) = w0; *(u32x4*)(A3 + (size_t)t * D + c0 + 8) = w1;
    }
}
__global__ void __launch_bounds__(NTHREADS, 2) mega_fwd(Params P) {
    extern __shared__ __attribute__((aligned(16))) unsigned char lds_raw[];
    Frame F;
    F.lds = (LAS unsigned char*)lds_raw;
    F.tid = threadIdx.x; F.lane = F.tid & 63; F.wave = __builtin_amdgcn_readfirstlane(F.tid >> 6);
    F.G = gridDim.x; F.bid = blockIdx.x; F.in = P.in; F.out = P.out; F.ws = P.ws;
    volatile LAS unsigned* bst = (volatile LAS unsigned*)(F.lds + LDS_BAR_OFF);
    if (F.tid == 0) { bst[0] = 0u; bst[1] = 0u; bst[2] = 0u; bst[3] = 0u; }
    __syncthreads();
    XcdBarrier bar = xcd_barrier_post((unsigned*)(P.ws + WS_CTL), bst);
    const int lo = P.ph_lo, hi = P.ph_hi;
#ifdef ONLY_PHASE
#define IN(k) ((k) == ONLY_PHASE && lo <= (k) && (k) < hi)
#else
#define IN(k) (lo <= (k) && (k) < hi)
#endif
#define SEAM(k) do { if (IN(k) && IN((k) + 1)) xcd_barrier(bar); } while (0)
#define LSEAM(k) do { if (IN(k) && IN((k) + 1)) __syncthreads(); } while (0)
#define LAUNDER(T, dst, src) T dst; { unsigned long long _v = (unsigned long long)(src); unsigned _lo = (unsigned)_v, _hi = (unsigned)(_v >> 32); asm volatile("" : "+s"(_lo), "+s"(_hi)); dst = (T)(__attribute__((address_space(1))) unsigned char*)(((unsigned long long)_hi << 32) | _lo); }
#define PH_BEGIN LAUNDER(unsigned char*, ws, P.ws) LAUNDER(float*, outp, P.out) F.ws = ws; F.out = outp; \
    const float* mod0 = (const float*)(ws + WS_MOD); const float* mod1 = mod0 + 8 * 6144; const float* norm_g = P.in[4]; bf16_t* H = (bf16_t*)(ws + WS_H); bf16_t* H2 = (bf16_t*)(ws + WS1_H2); \
    (void)mod0; (void)mod1; (void)norm_g; (void)H; (void)H2;

    if (IN(0)) { PH_BEGIN p0_prologue(F); } SEAM(0);
    if (IN(1)) { PH_BEGIN p_norm<false>(F, P.in[0], norm_g + 0 * 1024, mod0, 0, 1024, H); } SEAM(1);
    if (IN(2)) { PH_BEGIN pg8::Gemm g{H, (const bf16_t*)(ws + WS_WIN_T), T, IN_W, 1024, 1024, 1024}; pg8::StaticOrder S; S.init(T, IN_W, F.G, F.bid);
        pg8::EpiBf16<0> E{(bf16_t*)(ws + WS_QKV), IN_W}; pg8::gemm_phase(F.lds, g, S, E);
        p0_late_weights(F, (T / 256) * (IN_W / 256)); } SEAM(2);
    if (IN(3)) { PH_BEGIN p_qkprep(F); } SEAM(3);
    if (IN(4)) { PH_BEGIN p_attention<3>(F); } SEAM(4);
    if (IN(5)) { PH_BEGIN pg8::Gemm g{(const bf16_t*)(ws + WS_O), (const bf16_t*)(ws + WS_WOUT_T), T, 1024, 1024, 1024, 1024}; pg8::StaticOrder S; S.init(T, 1024, F.G, F.bid);
        pg8::EpiResid<false> E{P.in[0], (bf16_t*)(ws + WS_XB), mod0 + 2048, (float*)(ws + WS_SSQ)}; pg8::gemm_phase(F.lds, g, S, E); } SEAM(5);
    if (IN(7)) { PH_BEGIN pg8::Gemm g{(const bf16_t*)(ws + WS_XB), (const bf16_t*)outp, T, 2048, 1024, 1024, 1024}; pg8::BatchOrder S; S.init(T, 2048, F.G, F.bid);
        pg8::EpiQ E{(bf16_t*)(ws + WS_PQ), PQ_LD, (const float*)(ws + WS_SSQ), (const float*)(ws + WS_BQ), nullptr, -1}; { pg8::Unit u0; E.prep(F.lds, S.next(0, u0) ? u0.pm : -1, F.tid); } pg8::gemm_phase(F.lds, g, S, E); } SEAM(7);
    if (IN(8)) { PH_BEGIN p_peer_topk(F, (const bf16_t*)(ws + WS_PQ), (const bf16_t*)(ws + WS_SK), (int*)(ws + WS_EIDX), (float*)(ws + WS_GATE)); } LSEAM(8);
    if (IN(9)) { PH_BEGIN p_peer_gather<false>(F, norm_g + 1 * 1024, mod0, ws + WS_PU0, ws + WS_PV0, (const float*)(ws + WS_PSC), (const float*)(ws + WS_PSC) + N_EXPERTS, (const int*)(ws + WS_EIDX), (const float*)(ws + WS_GATE), mod0 + 5120, (bf16_t*)(ws + WS_XB), outp); } SEAM(9);
    if (IN(10)) { PH_BEGIN p_rwkv_prep(F, (const bf16_t*)(ws + WS_XB), norm_g + 2 * 1024, mod1, P.in[11], (bf16_t*)(ws + WS1_X6)); } SEAM(10);
    if (IN(11)) { PH_BEGIN pg8::Gemm g{(const bf16_t*)(ws + WS1_X6), (const bf16_t*)(ws + WS_WRW_T), 6 * T, RW_N, 1024, 1024, 1024}; pg8::RwOrder S; S.init(F.G, F.bid);
        pg8::EpiBf16<1> E{(bf16_t*)(ws + WS1_RK), RW_N}; pg8::gemm_phase(F.lds, g, S, E);
        p0_late_weights2(F); } SEAM(11);
    if (IN(12)) { PH_BEGIN pg8::Gemm g{(const bf16_t*)(ws + WS1_RK) + 3584, (const bf16_t*)(ws + WS_G2_T), T, 1024, 256, RW_N, 256}; pg8::StaticOrder S; S.init(T, 1024, F.G, F.bid);
        pg8::EpiBf16<0> E{(bf16_t*)(ws + WS1_G), 1024}; pg8::gemm_phase(F.lds, g, S, E); }
    if (IN(13)) { PH_BEGIN p_rwkv_scan(F); } SEAM(13);
    if (IN(14)) { PH_BEGIN p_rwkv_post(F); } SEAM(14);
    if (IN(15)) { PH_BEGIN pg8::Gemm g{(const bf16_t*)(ws + WS1_A3), (const bf16_t*)(ws + WS_WO_T), T, 1024, 1024, 1024, 1024}; pg8::StaticOrder S; S.init(T, 1024, F.G, F.bid);
        pg8::EpiResid<true> E{ws + WS_XB, (bf16_t*)(ws + WS_XB), mod1 + 2048, (float*)(ws + WS_SSQ)}; pg8::gemm_phase(F.lds, g, S, E); } SEAM(15);
    if (IN(17)) { PH_BEGIN pg8::Gemm g{(const bf16_t*)(ws + WS_XB), (const bf16_t*)outp + (size_t)8 * 2048 * 1024, T, 2048, 1024, 1024, 1024}; pg8::BatchOrder S; S.init(T, 2048, F.G, F.bid);
        pg8::EpiQ E{(bf16_t*)(ws + WS1_PQ), PQ_LD, (const float*)(ws + WS_SSQ), (const float*)(ws + WS_BQ) + 8 * 2048, nullptr, -1}; { pg8::Unit u0; E.prep(F.lds, S.next(0, u0) ? u0.pm : -1, F.tid); } pg8::gemm_phase(F.lds, g, S, E); } SEAM(17);
    if (IN(18)) { PH_BEGIN p_peer_topk(F, (const bf16_t*)(ws + WS1_PQ), (const bf16_t*)(ws + WS_SK) + (size_t)16 * 128 * 128, (int*)(ws + WS1_EIDX), (float*)(ws + WS1_GATE)); } LSEAM(18);
    if (IN(19)) { PH_BEGIN p_peer_gather<true>(F, norm_g + 3 * 1024, mod1, ws + WS_PU1, ws + WS_PV1, (const float*)(ws + WS_PSC) + 2 * N_EXPERTS, (const float*)(ws + WS_PSC) + 3 * N_EXPERTS, (const int*)(ws + WS1_EIDX), (const float*)(ws + WS1_GATE), mod1 + 5120, (bf16_t*)(ws + WS_XB), outp); }
    if (hi <= 5) { const f32x4* s = (const f32x4*)P.in[0]; f32x4* d = (f32x4*)P.out;
        for (size_t i = (size_t)F.bid * NTHREADS + F.tid; i < (size_t)T * D / 4; i += (size_t)F.G * NTHREADS) d[i] = s[i]; }
#undef IN
#undef SEAM
#undef LSEAM
}

#ifndef PH_HI
#define PH_HI 20
#endif
extern "C" void kernel_launch(void* const* d_in, const int* in_sizes, int n_in, void* d_out, int out_size, void* d_ws, size_t ws_size, hipStream_t stream) {
    static int grid = 0;
    if (grid == 0) {
        if (n_in != 31 || out_size != T * D || ws_size < WS_END) { fprintf(stderr, "kernel_launch: unexpected shapes (n_in %d, out %d, ws %zu)\n", n_in, out_size, ws_size); grid = -1; return; }
        int dev = 0, cus = 0, per_cu = 0;
        if (hipGetDevice(&dev) != hipSuccess || hipDeviceGetAttribute(&cus, hipDeviceAttributeMultiprocessorCount, dev) != hipSuccess) { grid = -1; return; }
        if (hipFuncSetAttribute((const void*)mega_fwd, hipFuncAttributeMaxDynamicSharedMemorySize, LDS_BYTES) != hipSuccess) { fprintf(stderr, "kernel_launch: hipFuncSetAttribute failed\n"); grid = -1; return; }
        if (hipOccupancyMaxActiveBlocksPerMultiprocessor(&per_cu, (const void*)mega_fwd, NTHREADS, LDS_BYTES) != hipSuccess || per_cu < 1) { fprintf(stderr, "kernel_launch: occupancy query says %d\n", per_cu); (void)hipGetLastError(); grid = -1; return; }
        grid = cus;
    }
    if (grid < 0) return;
    (void)hipMemsetAsync((char*)d_ws + WS_CTL, 0, CTL_ZERO_BYTES, stream);
    Params p{};
    for (int i = 0; i < 31; ++i) p.in[i] = (const float*)d_in[i];
    p.out = (float*)d_out; p.ws = (unsigned char*)d_ws; p.ph_lo = 0; p.ph_hi = PH_HI;
    hipLaunchKernelGGL(mega_fwd, dim3(grid), dim3(NTHREADS), LDS_BYTES, stream, p);
}
```

```cpp
#include <hip/hip_runtime.h>
#include <cstdio>
#include <cstdint>

#define DI __device__ __forceinline__
#define LAS __attribute__((address_space(3)))
typedef unsigned short bf16_t;
typedef short bf16x8 __attribute__((ext_vector_type(8)));
typedef short s16x4 __attribute__((ext_vector_type(4)));
typedef float f32x2 __attribute__((ext_vector_type(2)));
typedef float f32x4 __attribute__((ext_vector_type(4)));
typedef float f32x16 __attribute__((ext_vector_type(16)));
typedef unsigned u32x2 __attribute__((ext_vector_type(2)));
typedef unsigned u32x4 __attribute__((ext_vector_type(4)));
typedef __bf16 bf16x2v __attribute__((ext_vector_type(2)));

DI unsigned pack_bf16(float lo, float hi) { bf16x2v p; p[0] = (__bf16)lo; p[1] = (__bf16)hi; return __builtin_bit_cast(unsigned, p); }
DI float bf_lo(unsigned u) { return __uint_as_float(u << 16); }
DI float bf_hi(unsigned u) { return __uint_as_float(u & 0xffff0000u); }
DI float bf1(bf16_t v) { return __uint_as_float(((unsigned)v) << 16); }
DI float wave_sum(float v) {
#pragma unroll
    for (int o = 32; o > 0; o >>= 1) v += __shfl_xor(v, o);
    return v;
}
DI float sigmoidf_(float x) { return 1.0f / (1.0f + __expf(-x)); }

constexpr int D = 1024, BATCH = 8, SEQ = 2048, T = BATCH * SEQ;
constexpr int IN_W = 2304;
constexpr int NTHREADS = 512, NWAVES = 8;
constexpr int PQ_LD = 2112;
constexpr int N_EXPERTS = 16384;
constexpr float LOG2E = 1.4426950408889634f;
constexpr float QSCALE = 0.125f * LOG2E;
constexpr size_t MiB = 1ull << 20;

constexpr size_t WS_CTL   = 0;
constexpr size_t CTL_ZERO_BYTES = 16384;
constexpr size_t WS_MOD   = 64 * 1024;
constexpr size_t WS_PSC   = 512 * 1024;
constexpr size_t WS_WIN_T = 1 * MiB;
constexpr size_t WS_WOUT_T= 6 * MiB;
constexpr size_t WS_WRW_T = 8 * MiB;
constexpr size_t WS_W2_T  = 22 * MiB;
constexpr size_t WS_SSQ   = 22 * MiB;
constexpr size_t WS_BQ    = 768 * 1024;
constexpr size_t WS_WO_T  = 27 * MiB;
constexpr size_t WS_WQ_T  = 29 * MiB;
constexpr size_t WS_SK    = 37 * MiB;
constexpr size_t WS_PU1   = 38 * MiB;
constexpr size_t WS_PV1   = 54 * MiB;
constexpr size_t WS_XB    = 70 * MiB;
constexpr size_t WS_PU0   = 102 * MiB;
constexpr size_t WS_PV0   = 134 * MiB;
constexpr size_t WS_ACT   = 166 * MiB;
constexpr size_t WS_H     = WS_ACT + 0 * MiB;
constexpr size_t WS_QKV   = WS_ACT + 32 * MiB;
constexpr size_t WS_QA    = WS_ACT + 104 * MiB;
constexpr size_t WS_KA    = WS_ACT + 120 * MiB;
constexpr size_t WS_VAT   = WS_ACT + 136 * MiB;
constexpr size_t WS_QB    = WS_ACT + 152 * MiB;
constexpr size_t WS_KB    = WS_ACT + 168 * MiB;
constexpr size_t WS_VBT   = WS_ACT + 172 * MiB;
constexpr size_t WS_O     = WS_ACT + 176 * MiB;
constexpr size_t WS_PQ    = WS_ACT + 208 * MiB;
constexpr size_t WS_EIDX  = WS_ACT + 276 * MiB;
constexpr size_t WS_GATE  = WS_ACT + 284 * MiB;
constexpr size_t WS_O0S   = WS_ACT + 292 * MiB;
constexpr size_t WS1_RK   = 102 * MiB;
constexpr size_t WS1_DEC  = 222 * MiB;
constexpr size_t WS1_AZ   = 350 * MiB;
constexpr size_t WS1_G    = 414 * MiB;
constexpr size_t WS1_Y    = 446 * MiB;
constexpr size_t WS1_BON  = 510 * MiB;
constexpr size_t WS1_X6   = 222 * MiB;
constexpr size_t WS1_A3   = 222 * MiB;
constexpr size_t WS1_H2   = 254 * MiB;
constexpr size_t WS1_PQ   = 286 * MiB;
constexpr size_t WS1_EIDX = 354 * MiB;
constexpr size_t WS1_GATE = 362 * MiB;
constexpr size_t WS_END   = 512 * MiB;
constexpr int RW_N = 3840, W2_N = 4096, W2_K = 512;
constexpr size_t WS_G2_T  = 26 * MiB;

constexpr int LDS_BYTES = 147456;
constexpr int LDS_BAR_OFF = 147456 - 64;
#define XB_TMO      128
#define XB_XCNT(j)  (256  + 64 * (j))
#define XB_XSUB(j)  (1280 + 64 * (j))
#define XB_XGEN(j)  (2304 + 64 * (j))
#define XB_TOP      3328
#define XB_TOPGEN   3392
#define XCD_BAR_WORDS 3456
#define XB_SPIN_CAP (1u << 18)

__device__ __forceinline__ unsigned xb_ld(unsigned* p)              { return __hip_atomic_load(p, __ATOMIC_RELAXED, __HIP_MEMORY_SCOPE_AGENT); }
__device__ __forceinline__ unsigned xb_add(unsigned* p, unsigned v) { return __hip_atomic_fetch_add(p, v, __ATOMIC_RELAXED, __HIP_MEMORY_SCOPE_AGENT); }
__device__ __forceinline__ unsigned xb_xcc_id() { return (unsigned)__builtin_amdgcn_s_getreg((3 << 11) | 20) & 0xFu; }
#define XB_SPIN(cond, bar) do { unsigned _sp = 0; while (cond) { __builtin_amdgcn_s_sleep(1); \
    if ((++_sp & 255u) == 0u) { if (xb_ld(&(bar)[XB_TMO])) break; if (_sp > XB_SPIN_CAP) { atomicAdd(&(bar)[XB_TMO], 1u); break; } } } } while (0)

struct XcdBarrier { unsigned* bar; unsigned x; volatile LAS unsigned* st; };

__device__ __forceinline__ XcdBarrier xcd_barrier_post(unsigned* bar, volatile LAS unsigned* st) {
    XcdBarrier b; b.bar = bar; b.x = xb_xcc_id(); b.st = st;
    if (threadIdx.x == 0) (void)xb_add(&bar[XB_XCNT(b.x)], 1u);
    return b;
}
__device__ __forceinline__ void xcd_barrier_complete(unsigned* bar, unsigned x, unsigned& nloc, unsigned& nx) {
    const unsigned G = gridDim.x * gridDim.y * gridDim.z;
    unsigned sum, cnt, mine, sp = 0u;
    for (;;) {
        sum = 0u; cnt = 0u; mine = 0u;
#pragma unroll
        for (unsigned j = 0; j < 16; ++j) { const unsigned c = xb_ld(&bar[XB_XCNT(j)]); sum += c; cnt += (c > 0u) ? 1u : 0u; mine = (j == x) ? c : mine; }
        if (sum == G) break;
        __builtin_amdgcn_s_sleep(1);
        if ((++sp & 255u) == 0u) { if (xb_ld(&bar[XB_TMO])) break; if (sp > XB_SPIN_CAP) { atomicAdd(&bar[XB_TMO], 1u); break; } }
    }
    nloc = mine > 0u ? mine : 1u; nx = cnt > 0u ? cnt : 1u;
}
__device__ __forceinline__ void xcd_barrier(const XcdBarrier& b) {
    asm volatile("s_waitcnt vmcnt(0)" ::: "memory");
    __syncthreads();
    if (threadIdx.x == 0) {
        unsigned* bar; { unsigned long long pv = (unsigned long long)b.bar; unsigned plo = (unsigned)pv, phi = (unsigned)(pv >> 32); asm volatile("" : "+s"(plo), "+s"(phi)); bar = (unsigned*)(__attribute__((address_space(1))) unsigned*)(((unsigned long long)phi << 32) | plo); }
        __builtin_amdgcn_s_waitcnt(0);
        unsigned nloc = b.st[0], nx = b.st[1];
        if (nloc == 0u) { xcd_barrier_complete(bar, b.x, nloc, nx); b.st[0] = nloc; b.st[1] = nx; }
        const unsigned old = xb_add(&bar[XB_XSUB(b.x)], 1u);
        const unsigned gen = old / nloc;
        if (old + 1u == (gen + 1u) * nloc) {
            __builtin_amdgcn_fence(__ATOMIC_RELEASE, "agent");
            asm volatile("s_waitcnt vmcnt(0)" ::: "memory");
            const unsigned og = xb_add(&bar[XB_TOP], 1u);
            const unsigned tg = og / nx;
            if (og + 1u == (tg + 1u) * nx) xb_add(&bar[XB_TOPGEN], 1u);
            else XB_SPIN(xb_ld(&bar[XB_TOPGEN]) == tg, bar);
            __builtin_amdgcn_fence(__ATOMIC_ACQUIRE, "agent");
            xb_add(&bar[XB_XGEN(b.x)], 1u);
            asm volatile("s_waitcnt vmcnt(0)" ::: "memory");
        } else {
            XB_SPIN(xb_ld(&bar[XB_XGEN(b.x)]) == gen, bar);
            __builtin_amdgcn_fence(__ATOMIC_ACQUIRE, "agent");
            asm volatile("s_waitcnt vmcnt(0)" ::: "memory");
        }
    }
    __syncthreads();
}
namespace pg8 {
constexpr int BM = 256, BK = 64, HALF = 128, HTB = HALF * BK * 2, STAGE_BYTES = 8 * HTB, NXCD = 8, WGM = 8;
__host__ __device__ __forceinline__ int lds_byte(int r, int c) { const int st = (r >> 4) * 2 + (c >> 5), rr = r & 15, cc = c & 31, ob = rr * 64 + cc * 2; return st * 1024 + (ob ^ (((ob >> 9) & 1) << 5)); }
__host__ __device__ __forceinline__ void stage_rc(int b, int& R, int& C) { const int st = b / 1024, sb = b % 1024, swz = sb ^ (((sb >> 9) & 1) << 5); R = (st >> 1) * 16 + swz / 64; C = (st & 1) * 32 + (swz % 64) / 2; }
__host__ __device__ __forceinline__ int perm32(int rho) { const int n = rho >> 4, i = rho & 15; return 8 * (i >> 2) + 4 * n + (i & 3); }

struct Unit { int pm, pn; };
struct Gemm { const bf16_t* A; const bf16_t* Bt; int M, N, K, lda, ldb; };

struct StaticOrder {
    int nM, nN, nwg, G, c;
    __device__ void init(int M, int N, int G_, int c_) { nM = M / BM; nN = N / BM; nwg = nM * nN; G = G_; c = c_; }
    __device__ __forceinline__ bool next(int i, Unit& u) const {
        const long L = (long)i * G + c; if (L >= nwg) return false;
        int wgid = (int)L; { const int q = nwg / NXCD, r = nwg % NXCD, xcd = wgid % NXCD, off = wgid / NXCD; wgid = (xcd < r ? xcd * (q + 1) : r * (q + 1) + (xcd - r) * q) + off; }
        const int nig = WGM * nN, gid = wgid / nig, fm = gid * WGM, gsz = (nM - fm) < WGM ? (nM - fm) : WGM;
        u.pm = fm + ((wgid % nig) % gsz); u.pn = (wgid % nig) / gsz; return true;
    }
};

struct BatchOrder {
    StaticOrder S;
    __device__ void init(int M, int N, int G_, int c_) { S.init(M, N, G_, c_); }
    __device__ __forceinline__ bool next(int i, Unit& u) const { if (!S.next(i, u)) return false; u.pn += (u.pm / (SEQ / BM)) * S.nN; return true; }
};

struct RwOrder {
    int G, c;
    __device__ void init(int G_, int c_) { G = G_; c = c_; }
    __device__ __forceinline__ bool next(int i, Unit& u) const {
        int grp, pm, pn;
        if ((G & 7) == 0) { const int x = c & 7, n = i * (G >> 3) + (c >> 3); if (n >= 120) return false;
            const int pmh = n / 15, e = n % 15; pm = x + 8 * pmh;
            if (e < 12) { grp = e >> 2; pn = grp * 4 + (e & 3); } else { grp = 3 + (e - 12); pn = 12 + (e - 12); } }
        else { const int L = i * G + c; if (L >= 960) return false;
            if (L < 768) { grp = L >> 8; pm = L & 63; pn = grp * 4 + ((L >> 6) & 3); } else { const int w = L - 768; grp = 3 + (w >> 6); pm = w & 63; pn = 12 + (grp - 3); } }
        u.pm = grp * 64 + pm; u.pn = pn; return true;
    }
};
template <class Epi, class Sched>
__device__ __forceinline__ void gemm_phase(LAS unsigned char* lds, const Gemm g, const Sched& S, const Epi& E) {
    const int tid = threadIdx.x, wid = __builtin_amdgcn_readfirstlane(tid >> 6), lane = tid & 63, wr = wid >> 2, wc = wid & 3, fr = lane & 15, fq = lane >> 4;
    const int K = g.K, nt = K / BK;
    unsigned voffA[2], voffB[2];
#pragma unroll
    for (int i = 0; i < 2; ++i) { int R, C; stage_rc(tid * 16 + i * 8192, R, C); const int Rb = Epi::PERM ? ((R & ~31) + perm32(R & 31)) : R;
        voffA[i] = (unsigned)(R * g.lda + C) * 2u; voffB[i] = (unsigned)(Rb * g.ldb + C) * 2u; }
    const size_t kstep = (size_t)(BK * 2);
    const size_t hstepA = (size_t)HALF * g.lda * 2, hstepB = (size_t)HALF * g.ldb * 2;
    const size_t tstepA = 2 * hstepA, tstepB = 2 * hstepB;
    const unsigned ldsw = (unsigned)wid * 1024u;
    const int aoff = lds_byte(wr * 64 + fr, fq * 8), boff = lds_byte(wc * 32 + fr, fq * 8);
#define PG8_SA(b, h) (((b) * 2 + (h)) * HTB)
#define PG8_SB(b, h) ((4 + (b) * 2 + (h)) * HTB)
#define PG8_STAGE(bufoff, gbase, voff) do { _Pragma("unroll") for (int _i = 0; _i < 2; ++_i) \
        __builtin_amdgcn_global_load_lds((const unsigned*)((const char*)(gbase) + (voff)[_i]), (LAS unsigned*)(lds + (bufoff) + ldsw + _i * 8192), 16, 0, 0); } while (0)
#define PG8_LDA(dst, b, h) do { _Pragma("unroll") for (int m = 0; m < 4; ++m) _Pragma("unroll") for (int k = 0; k < 2; ++k) dst[m][k] = *(const LAS bf16x8*)(lds + PG8_SA(b, h) + aoff + m * 2048 + k * 1024); } while (0)
#define PG8_LDB(dst, b, h) do { _Pragma("unroll") for (int n = 0; n < 2; ++n) _Pragma("unroll") for (int k = 0; k < 2; ++k) dst[n][k] = *(const LAS bf16x8*)(lds + PG8_SB(b, h) + boff + n * 2048 + k * 1024); } while (0)
#define PG8_MMA(ai, bj, At, Bt) do { __builtin_amdgcn_s_setprio(1); _Pragma("unroll") for (int m = 0; m < 4; ++m) _Pragma("unroll") for (int n = 0; n < 2; ++n) _Pragma("unroll") for (int k = 0; k < 2; ++k) \
        acc[ai][bj][m][n] = __builtin_amdgcn_mfma_f32_16x16x32_bf16(Bt[n][k], At[m][k], acc[ai][bj][m][n], 0, 0, 0); __builtin_amdgcn_s_setprio(0); } while (0)
#define PG8_WAIT_V(n) asm volatile("s_waitcnt vmcnt(" #n ")" ::: "memory")
#define PG8_WAIT_L(n) asm volatile("s_waitcnt lgkmcnt(" #n ")" ::: "memory")
#define PG8_BAR __builtin_amdgcn_s_barrier()
#define PG8_SCHED __builtin_amdgcn_sched_barrier(0)
    Unit cur, nxt; int ui = 0;
    if (!S.next(0, cur)) return;
    f32x4 acc[2][2][4][2];
#pragma unroll
    for (int a = 0; a < 2; ++a)
#pragma unroll
        for (int b = 0; b < 2; ++b)
#pragma unroll
            for (int m = 0; m < 4; ++m)
#pragma unroll
                for (int n = 0; n < 2; ++n) acc[a][b][m][n] = (f32x4){0.f, 0.f, 0.f, 0.f};
    bf16x8 At[4][2], B0[2][2], B1[2][2];
    const char* cA = (const char*)g.A + (size_t)cur.pm * tstepA; const char* cB = (const char*)g.Bt + (size_t)cur.pn * tstepB;
    PG8_STAGE(PG8_SB(0, 0), cB, voffB); PG8_STAGE(PG8_SA(0, 0), cA, voffA); PG8_STAGE(PG8_SB(0, 1), cB + hstepB, voffB); PG8_STAGE(PG8_SA(0, 1), cA + hstepA, voffA);
    if (wr == 1) PG8_BAR;
    PG8_WAIT_V(4); PG8_BAR;
    PG8_STAGE(PG8_SB(1, 0), cB + kstep, voffB); PG8_STAGE(PG8_SA(1, 0), cA + kstep, voffA); PG8_STAGE(PG8_SB(1, 1), cB + hstepB + kstep, voffB);
    PG8_WAIT_V(6); PG8_BAR;
    for (;;) {
        const bool has_next = S.next(ui + 1, nxt);
        const char* nA = has_next ? (const char*)g.A + (size_t)nxt.pm * tstepA : cA; const char* nB = has_next ? (const char*)g.Bt + (size_t)nxt.pn * tstepB : cB;
        for (int t = 0; t < nt; t += 2) {
            const bool last = (t == nt - 2);
            const char* a1 = cA + (size_t)(t + 1) * kstep;
            const char* a2 = last ? nA : cA + (size_t)(t + 2) * kstep; const char* b2 = last ? nB : cB + (size_t)(t + 2) * kstep;
            const char* a3 = a2 + kstep; const char* b3 = b2 + kstep;
            PG8_LDB(B0, 0, 0); PG8_SCHED; PG8_LDA(At, 0, 0); PG8_STAGE(PG8_SA(1, 1), a1 + hstepA, voffA);
            PG8_WAIT_L(8); PG8_BAR; PG8_WAIT_L(0); PG8_MMA(0, 0, At, B0); PG8_BAR; PG8_SCHED;
            PG8_LDB(B1, 0, 1); PG8_STAGE(PG8_SB(0, 0), b2, voffB);
            PG8_BAR; PG8_WAIT_L(0); PG8_MMA(0, 1, At, B1); PG8_BAR;
            PG8_LDA(At, 0, 1); PG8_STAGE(PG8_SA(0, 0), a2, voffA);
            PG8_BAR; PG8_WAIT_L(0); PG8_MMA(1, 0, At, B0); PG8_BAR; PG8_SCHED;
            PG8_STAGE(PG8_SB(0, 1), b2 + hstepB, voffB);
            PG8_WAIT_V(6); PG8_BAR; PG8_MMA(1, 1, At, B1); PG8_BAR;
            PG8_LDB(B0, 1, 0); PG8_SCHED; PG8_LDA(At, 1, 0); PG8_STAGE(PG8_SA(0, 1), a2 + hstepA, voffA);
            PG8_WAIT_L(8); PG8_BAR; PG8_WAIT_L(0); PG8_MMA(0, 0, At, B0); PG8_BAR; PG8_SCHED;
            PG8_LDB(B1, 1, 1); PG8_STAGE(PG8_SB(1, 0), b3, voffB);
            PG8_BAR; PG8_WAIT_L(0); PG8_MMA(0, 1, At, B1); PG8_BAR;
            PG8_LDA(At, 1, 1); PG8_STAGE(PG8_SA(1, 0), a3, voffA);
            PG8_BAR; PG8_WAIT_L(0); PG8_MMA(1, 0, At, B0); PG8_BAR; PG8_SCHED;
            PG8_STAGE(PG8_SB(1, 1), b3 + hstepB, voffB);
            PG8_WAIT_V(6); PG8_BAR; PG8_MMA(1, 1, At, B1); PG8_BAR;
        }
        E(acc, cur, wr, wc, fr, fq);
        if (!has_next) break;
#pragma unroll
        for (int a = 0; a < 2; ++a)
#pragma unroll
            for (int b = 0; b < 2; ++b)
#pragma unroll
                for (int m = 0; m < 4; ++m)
#pragma unroll
                    for (int n = 0; n < 2; ++n) acc[a][b][m][n] = (f32x4){0.f, 0.f, 0.f, 0.f};
        cur = nxt; cA = nA; cB = nB; ++ui;
    }
    PG8_WAIT_V(0);
    if (wr == 0) PG8_BAR;
    PG8_BAR;
#undef PG8_SA
#undef PG8_SB
#undef PG8_STAGE
#undef PG8_LDA
#undef PG8_LDB
#undef PG8_MMA
#undef PG8_WAIT_V
#undef PG8_WAIT_L
#undef PG8_BAR
#undef PG8_SCHED
}

template <int ACT> struct EpiBf16 {
    static constexpr bool PERM = true;
    __device__ __forceinline__ void prefetch(LAS unsigned char*, const Unit&, int) const {}
    bf16_t* O; int ldc;
    __device__ __forceinline__ void operator()(const f32x4 (&acc)[2][2][4][2], const Unit& u, int wr, int wc, int fr, int fq) const {
        const int row0 = (ACT == 1 ? (u.pm & 63) : u.pm) * BM + wr * 64 + fr; const int col0 = u.pn * BM + wc * 32 + 8 * fq;
#pragma unroll
        for (int ai = 0; ai < 2; ++ai)
#pragma unroll
            for (int m = 0; m < 4; ++m) { bf16_t* rowp = O + (size_t)(row0 + ai * HALF + m * 16) * ldc + col0;
#pragma unroll
                for (int bj = 0; bj < 2; ++bj) { f32x4 v0 = acc[ai][bj][m][0], v1 = acc[ai][bj][m][1];
                    if (ACT == 1) { const int c = col0 + bj * HALF;
                        if (c >= 3072 && c < 3200) {
#pragma unroll
                            for (int e = 0; e < 4; ++e) { v0[e] = tanhf(v0[e]); v1[e] = tanhf(v1[e]); } }
                        else if (c >= 3584 && c < 3712) {
#pragma unroll
                            for (int e = 0; e < 4; ++e) { v0[e] = sigmoidf_(v0[e]); v1[e] = sigmoidf_(v1[e]); } } }
                    u32x4 w; w.x = pack_bf16(v0[0], v0[1]); w.y = pack_bf16(v0[2], v0[3]); w.z = pack_bf16(v1[0], v1[1]); w.w = pack_bf16(v1[2], v1[3]);
                    *(u32x4*)(rowp + bj * HALF) = w; } }
    }
};
template <bool IN_BF16> struct EpiResid {
    static constexpr bool PERM = false;
    __device__ __forceinline__ void prefetch(LAS unsigned char* lds, const Unit& u, int tid) const {
        constexpr int RB = IN_BF16 ? 512 : 1024, LPR = RB / 128, NL = 256 * LPR;
        const char* base = (const char*)xin + ((size_t)u.pm * BM * D + (size_t)u.pn * BM) * (IN_BF16 ? 2 : 4);
#pragma unroll
        for (int i = 0; i < NL / NTHREADS; ++i) { const int ln = i * NTHREADS + tid, r = ln / LPR, c = ln % LPR;
            __builtin_amdgcn_global_load_lds((const unsigned*)(base + (size_t)r * D * (IN_BF16 ? 2 : 4) + c * 128), (LAS unsigned*)(lds + STAGE_BYTES + 2048 + (tid >> 6) * 256), 4, 0, 0); }
    }
    const void* xin; bf16_t* out; const float* gate; float* ssq;
    __device__ __forceinline__ void operator()(const f32x4 (&acc)[2][2][4][2], const Unit& u, int wr, int wc, int fr, int fq) const {
        const int row0 = u.pm * BM + wr * 64 + fr, col0 = u.pn * BM + wc * 32 + 4 * fq;
        const float* gp = gate + (size_t)((u.pm * BM) / SEQ) * 6144 + col0;
        f32x4 gv[2][2];
#pragma unroll
        for (int bj = 0; bj < 2; ++bj)
#pragma unroll
            for (int n = 0; n < 2; ++n) gv[bj][n] = *(const f32x4*)(gp + bj * HALF + n * 16);
#pragma unroll
        for (int ai = 0; ai < 2; ++ai)
#pragma unroll
            for (int m = 0; m < 4; ++m) { const size_t off = (size_t)(row0 + ai * HALF + m * 16) * D + col0; float ss = 0.f;
#pragma unroll
                for (int bj = 0; bj < 2; ++bj)
#pragma unroll
                    for (int n = 0; n < 2; ++n) { f32x4 xv;
                        if (IN_BF16) { const u32x2 w = *(const u32x2*)((const bf16_t*)xin + off + bj * HALF + n * 16); xv = (f32x4){bf_lo(w.x), bf_hi(w.x), bf_lo(w.y), bf_hi(w.y)}; }
                        else xv = *(const f32x4*)((const float*)xin + off + bj * HALF + n * 16);
                        const f32x4 r = xv + gv[bj][n] * acc[ai][bj][m][n];
                        ss += (r[0] * r[0] + r[1] * r[1]) + (r[2] * r[2] + r[3] * r[3]);
                        *(u32x2*)(out + off + bj * HALF + n * 16) = (u32x2){pack_bf16(r[0], r[1]), pack_bf16(r[2], r[3])}; }
                ss += __shfl_xor(ss, 16); ss += __shfl_xor(ss, 32);
                if (fq == 0) ssq[(size_t)(row0 + ai * HALF + m * 16) * 16 + u.pn * 4 + wc] = ss; }
    }
};
struct EpiQ {
    static constexpr bool PERM = true;
    __device__ __forceinline__ void prefetch(LAS unsigned char*, const Unit&, int) const {}
    bf16_t* O; int ldc; const float* ssq; const float* bq; const LAS float* rl; int pm_l;
    __device__ __forceinline__ void prep(LAS unsigned char* lds, int pm, int tid) { LAS float* w = (LAS float*)(lds + STAGE_BYTES); rl = w; pm_l = pm;
        if (pm >= 0 && tid < BM) { const f32x4* sp = (const f32x4*)(ssq + (size_t)(pm * BM + tid) * 16); const f32x4 s4 = (sp[0] + sp[1]) + (sp[2] + sp[3]);
            w[tid] = rsqrtf(((s4[0] + s4[1]) + (s4[2] + s4[3])) * (1.0f / 1024.0f) + 1e-6f); }
        __syncthreads(); }
    __device__ __forceinline__ void operator()(const f32x4 (&acc)[2][2][4][2], const Unit& u, int wr, int wc, int fr, int fq) const {
        const int row0 = u.pm * BM + wr * 64 + fr; const int col0 = (u.pn & 7) * BM + wc * 32 + 8 * fq;
        const float* bp = bq + (size_t)(u.pn >> 3) * 2048 + col0;
        f32x4 b0[2], b1[2];
#pragma unroll
        for (int bj = 0; bj < 2; ++bj) { b0[bj] = *(const f32x4*)(bp + bj * HALF); b1[bj] = *(const f32x4*)(bp + bj * HALF + 4); }
#pragma unroll
        for (int ai = 0; ai < 2; ++ai)
#pragma unroll
            for (int m = 0; m < 4; ++m) { const int r = row0 + ai * HALF + m * 16; bf16_t* rowp = O + (size_t)r * ldc + col0;
                float rinv;
                if (u.pm == pm_l) rinv = rl[wr * 64 + fr + ai * HALF + m * 16];
                else { const f32x4* sp = (const f32x4*)(ssq + (size_t)r * 16); const f32x4 s4 = (sp[0] + sp[1]) + (sp[2] + sp[3]);
                    rinv = rsqrtf(((s4[0] + s4[1]) + (s4[2] + s4[3])) * (1.0f / 1024.0f) + 1e-6f); }
#pragma unroll
                for (int bj = 0; bj < 2; ++bj) { const f32x4 v0 = acc[ai][bj][m][0] * rinv + b0[bj], v1 = acc[ai][bj][m][1] * rinv + b1[bj];
                    u32x4 w; w.x = pack_bf16(v0[0], v0[1]); w.y = pack_bf16(v0[2], v0[3]); w.z = pack_bf16(v1[0], v1[1]); w.w = pack_bf16(v1[2], v1[3]);
                    *(u32x4*)(rowp + bj * HALF) = w; } }
    }
};
struct EpiRw2 {
    static constexpr bool PERM = true;
    __device__ __forceinline__ void prefetch(LAS unsigned char*, const Unit&, int) const {}
    float* DEC; bf16_t* AZ; bf16_t* G; const float* w0; const float* a0;
    __device__ __forceinline__ void operator()(const f32x4 (&acc)[2][2][4][2], const Unit& u, int wr, int wc, int fr, int fq) const {
        const int row0 = u.pm * BM + wr * 64 + fr; const int col0 = u.pn * BM + wc * 32 + 8 * fq;
        const int cls = u.pn < 8 ? 0 : 1;
#pragma unroll
        for (int bj = 0; bj < 2; ++bj) {
            const int c = col0 + bj * HALF;
            f32x4 b0 = (f32x4){0.f, 0.f, 0.f, 0.f}, b1 = b0;
            if (cls == 0) { b0 = *(const f32x4*)(w0 + c); b1 = *(const f32x4*)(w0 + c + 4); }
            else if (cls == 1) { b0 = *(const f32x4*)(a0 + c - 2048); b1 = *(const f32x4*)(a0 + c - 2048 + 4); }
#pragma unroll
            for (int ai = 0; ai < 2; ++ai)
#pragma unroll
                for (int m = 0; m < 4; ++m) { const size_t r = (size_t)(row0 + ai * HALF + m * 16);
                    f32x4 v0 = acc[ai][bj][m][0] + b0, v1 = acc[ai][bj][m][1] + b1;
                    if (cls == 0) {
#pragma unroll
                        for (int e = 0; e < 4; ++e) { v0[e] = __expf(-0.6065306597126334f * sigmoidf_(v0[e])); v1[e] = __expf(-0.6065306597126334f * sigmoidf_(v1[e])); }
                        *(f32x4*)(DEC + r * 2048 + c) = v0; *(f32x4*)(DEC + r * 2048 + c + 4) = v1;
                    } else {
                        if (cls == 1) {
#pragma unroll
                            for (int e = 0; e < 4; ++e) { v0[e] = sigmoidf_(v0[e]); v1[e] = sigmoidf_(v1[e]); } }
                        u32x4 w; w.x = pack_bf16(v0[0], v0[1]); w.y = pack_bf16(v0[2], v0[3]); w.z = pack_bf16(v1[0], v1[1]); w.w = pack_bf16(v1[2], v1[3]);
                        if (cls == 1) *(u32x4*)(AZ + r * 2048 + (c - 2048)) = w; else *(u32x4*)(G + r * 1024 + (c - 4096)) = w;
                    } }
        }
    }
};
}
struct Params { const float* in[31]; float* out; unsigned char* ws; int ph_lo, ph_hi; };
struct Frame {
    LAS unsigned char* lds; int tid, lane, wave, G, bid;
    const float* const* in; float* out; unsigned char* ws;
};

DI void fp8_row_store(const float (&v)[16], int row, int lane, unsigned char* dst, float* scale);
DI void fp8_row_load(const float* src, int row, int lane, float (&v)[16]);
DI void p0_convert_fp8(const Frame& F, const float* src, unsigned char* dst, float* scale, int widx, int nw);
template <bool SPLIT> DI void p0_mod(const Frame& F) {
    constexpr int NKG = SPLIT ? 21 : 42, NB = SPLIT ? 4 : 2, NTH = NKG * 12;
    const float* c = F.in[1]; const float* ada_w = F.in[2]; const float* ada_b = F.in[3];
    float* mod = (float*)(F.ws + WS_MOD);
    LAS float* sc = (LAS float*)F.lds;
    LAS float* part = (LAS float*)(F.lds + 32768);
    for (int i = F.tid; i < 8 * 1024; i += NTHREADS) { const int b = i >> 10, k = i & 1023; const float v = c[i]; sc[k * 8 + b] = v * sigmoidf_(v); }
    __syncthreads();
    for (int cb = F.bid; cb < 256; cb += F.G) {
        const int colbase = cb * 48, l = colbase / 6144, n0 = colbase % 6144;
        if (F.tid < NTH) {
            const int q = F.tid % 12, kg = F.tid / 12, krot = (cb * 148) & 1023;
            const float* wp = ada_w + (size_t)l * 1024 * 6144 + n0 + 4 * q;
            f32x4 acc[8];
#pragma unroll
            for (int b = 0; b < 8; ++b) acc[b] = (f32x4){0.f, 0.f, 0.f, 0.f};
#pragma unroll
            for (int bt = 0; bt < NB; ++bt) {
                f32x4 w[13];
#pragma unroll
                for (int i = 0; i < 13; ++i) { const int k = kg + NKG * (13 * bt + i), kk = ((k < 1024 ? k : 1023) + krot) & 1023; w[i] = *(const f32x4*)(wp + (size_t)kk * 6144); }
#pragma unroll
                for (int i = 0; i < 13; ++i) { const int k = kg + NKG * (13 * bt + i), kk = ((k < 1024 ? k : 1023) + krot) & 1023;
                    const f32x4 wv = k < 1024 ? w[i] : (f32x4){0.f, 0.f, 0.f, 0.f};
                    const f32x4 s0 = *(const LAS f32x4*)(sc + kk * 8), s1 = *(const LAS f32x4*)(sc + kk * 8 + 4);
                    acc[0] += wv * s0[0]; acc[1] += wv * s0[1]; acc[2] += wv * s0[2]; acc[3] += wv * s0[3];
                    acc[4] += wv * s1[0]; acc[5] += wv * s1[1]; acc[6] += wv * s1[2]; acc[7] += wv * s1[3]; }
            }
#pragma unroll
            for (int e = 0; e < 4; ++e) { LAS float* pp = part + ((size_t)kg * 48 + 4 * q + e) * 8;
                *(LAS f32x4*)pp = (f32x4){acc[0][e], acc[1][e], acc[2][e], acc[3][e]}; *(LAS f32x4*)(pp + 4) = (f32x4){acc[4][e], acc[5][e], acc[6][e], acc[7][e]}; }
        } else if (SPLIT && F.wave >= 4) {
            p0_convert_fp8(F, F.in[29], F.ws + WS_PU0, (float*)(F.ws + WS_PSC), F.bid * 4 + (F.wave - 4), F.G * 4);
        }
        __syncthreads();
        if (F.tid < 256) for (int o = F.tid; o < 384; o += 256) {
            const int cl = o >> 3, b = o & 7; const int col = colbase + cl;
            float s = ada_b[col];
#pragma unroll
            for (int kg = 0; kg < NKG; ++kg) s += part[(kg * 48 + cl) * 8 + b];
            mod[((size_t)l * 8 + b) * 6144 + n0 + cl] = s;
        }
        __syncthreads();
    }
}
DI void p0_transpose(const Frame& F, const float* src, int ld, int K, int N, bf16_t* dst, int ldd, const float* mix) {
    (void)mix;
    LAS float* tiles = (LAS float*)F.lds;
    const int tn = N / 64, nt = (K / 64) * tn;
    for (int t0 = F.bid; t0 < nt; t0 += 4 * F.G) {
        __syncthreads();
        f32x4 v[4][2];
#pragma unroll
        for (int q = 0; q < 4; ++q) { const int tt = t0 + q * F.G, t = tt < nt ? tt : t0; const int k0 = (t / tn) * 64, n0 = (t % tn) * 64;
#pragma unroll
            for (int h = 0; h < 2; ++h) { const int i = F.tid + h * NTHREADS, r = i >> 4, c4 = (i & 15) * 4; v[q][h] = *(const f32x4*)(src + (size_t)(k0 + r) * ld + n0 + c4); } }
#pragma unroll
        for (int q = 0; q < 4; ++q)
#pragma unroll
            for (int h = 0; h < 2; ++h) { const int i = F.tid + h * NTHREADS, r = i >> 4, c4 = (i & 15) * 4; LAS float* tp = tiles + q * 4160 + r * 65 + c4;
                tp[0] = v[q][h][0]; tp[1] = v[q][h][1]; tp[2] = v[q][h][2]; tp[3] = v[q][h][3]; }
        __syncthreads();
#pragma unroll
        for (int q = 0; q < 4; ++q) { const int t = t0 + q * F.G; if (t < nt) { const int k0 = (t / tn) * 64, n0 = (t % tn) * 64;
            const int n = F.tid >> 3, kc = (F.tid & 7) * 8;
            float w8[8];
#pragma unroll
            for (int e = 0; e < 8; ++e) w8[e] = tiles[q * 4160 + (kc + e) * 65 + n];
            u32x4 w; w.x = pack_bf16(w8[0], w8[1]); w.y = pack_bf16(w8[2], w8[3]); w.z = pack_bf16(w8[4], w8[5]); w.w = pack_bf16(w8[6], w8[7]);
            *(u32x4*)(dst + (size_t)(n0 + n) * ldd + k0 + kc) = w; } }
    }
    __syncthreads();
}
DI void p0_wqs(const Frame& F, const float* W, const float* g, const float* modl, bf16_t* dst) {
    LAS float* tiles = (LAS float*)F.lds;
    LAS float* gsl = (LAS float*)(F.lds + 69632);
    const int nt = 16 * 32;
    if (F.bid >= nt) return;
    __syncthreads();
    for (int i = F.tid; i < 8 * 1024; i += NTHREADS) gsl[i] = g[i & 1023] * (1.0f + modl[(size_t)(i >> 10) * 6144 + 4096 + (i & 1023)]);
    for (int t0 = F.bid; t0 < nt; t0 += 4 * F.G) {
        __syncthreads();
        f32x4 v[4][2];
#pragma unroll
        for (int q = 0; q < 4; ++q) { const int tt = t0 + q * F.G, t = tt < nt ? tt : t0; const int k0 = (t / 32) * 64, n0 = (t % 32) * 64;
#pragma unroll
            for (int h = 0; h < 2; ++h) { const int i = F.tid + h * NTHREADS, r = i >> 4, c4 = (i & 15) * 4; v[q][h] = *(const f32x4*)(W + (size_t)(k0 + r) * 2048 + n0 + c4); } }
#pragma unroll
        for (int q = 0; q < 4; ++q)
#pragma unroll
            for (int h = 0; h < 2; ++h) { const int i = F.tid + h * NTHREADS, r = i >> 4, c4 = (i & 15) * 4; LAS float* tp = tiles + q * 4160 + r * 65 + c4;
                tp[0] = v[q][h][0]; tp[1] = v[q][h][1]; tp[2] = v[q][h][2]; tp[3] = v[q][h][3]; }
        __syncthreads();
        for (int q = 0; q < 4; ++q) { const int t = t0 + q * F.G; if (t < nt) { const int k0 = (t / 32) * 64, n0 = (t % 32) * 64;
            const int n = F.tid >> 3, kc = (F.tid & 7) * 8;
            float w8[8];
#pragma unroll
            for (int e = 0; e < 8; ++e) w8[e] = tiles[q * 4160 + (kc + e) * 65 + n];
#pragma unroll
            for (int b = 0; b < 8; ++b) { const f32x4 s0 = *(const LAS f32x4*)(gsl + b * 1024 + k0 + kc), s1 = *(const LAS f32x4*)(gsl + b * 1024 + k0 + kc + 4);
                u32x4 w; w.x = pack_bf16(w8[0] * s0[0], w8[1] * s0[1]); w.y = pack_bf16(w8[2] * s0[2], w8[3] * s0[3]);
                w.z = pack_bf16(w8[4] * s1[0], w8[5] * s1[1]); w.w = pack_bf16(w8[6] * s1[2], w8[7] * s1[3]);
                *(u32x4*)(dst + ((size_t)b * 2048 + n0 + n) * 1024 + k0 + kc) = w; } } }
    }
    __syncthreads();
}
DI void p0_bq(const Frame& F, const float* W, const float* modl, float* bq) {
    LAS float* shl = (LAS float*)F.lds;
    LAS float* part = (LAS float*)(F.lds + 32768);
    if (F.bid >= 128) return;
    __syncthreads();
    for (int i = F.tid; i < 8 * 1024; i += NTHREADS) { const int b = i >> 10, k = i & 1023; shl[k * 8 + b] = modl[(size_t)b * 6144 + 3072 + k]; }
    __syncthreads();
    for (int task = F.bid; task < 128; task += F.G) {
        const int cl = F.tid & 15, kp = F.tid >> 4; const float* wp = W + (size_t)(kp * 32) * 2048 + task * 16 + cl;
        float wv[32];
#pragma unroll
        for (int k = 0; k < 32; ++k) wv[k] = wp[(size_t)k * 2048];
        float a[8];
#pragma unroll
        for (int b = 0; b < 8; ++b) a[b] = 0.f;
#pragma unroll
        for (int k = 0; k < 32; ++k) { const float w = wv[k];
            const f32x4 s0 = *(const LAS f32x4*)(shl + (kp * 32 + k) * 8), s1 = *(const LAS f32x4*)(shl + (kp * 32 + k) * 8 + 4);
            a[0] += w * s0[0]; a[1] += w * s0[1]; a[2] += w * s0[2]; a[3] += w * s0[3]; a[4] += w * s1[0]; a[5] += w * s1[1]; a[6] += w * s1[2]; a[7] += w * s1[3]; }
#pragma unroll
        for (int b = 0; b < 8; ++b) part[(kp * 16 + cl) * 8 + b] = a[b];
        __syncthreads();
        if (F.tid < 128) { const int c2 = F.tid >> 3, b = F.tid & 7; float s = 0.f;
#pragma unroll
            for (int q = 0; q < 32; ++q) s += part[(q * 16 + c2) * 8 + b];
            bq[(size_t)b * 2048 + task * 16 + c2] = s; }
        __syncthreads();
    }
}
DI void p0_convert(const Frame& F, const float* src, bf16_t* dst, size_t n) {
    const size_t n8 = n / 8;
    for (size_t i = (size_t)F.bid * NTHREADS + F.tid; i < n8; i += (size_t)F.G * NTHREADS) {
        const f32x4 a = *(const f32x4*)(src + i * 8), b = *(const f32x4*)(src + i * 8 + 4);
        u32x4 w; w.x = pack_bf16(a[0], a[1]); w.y = pack_bf16(a[2], a[3]); w.z = pack_bf16(b[0], b[1]); w.w = pack_bf16(b[2], b[3]);
        *(u32x4*)(dst + i * 8) = w;
    }
}
DI void fp8_row_store(const float (&v)[16], int row, int lane, unsigned char* dst, float* scale) {
    float am = 0.f;
#pragma unroll
    for (int e = 0; e < 16; ++e) am = fmaxf(am, fabsf(v[e]));
#pragma unroll
    for (int o = 32; o > 0; o >>= 1) am = fmaxf(am, __shfl_xor(am, o));
    const float sc = am > 0.f ? am * (1.0f / 384.0f) : 1.0f, inv = 1.0f / sc;
    u32x4 w;
    { int t0 = 0; t0 = __builtin_amdgcn_cvt_pk_fp8_f32(v[0] * inv, v[1] * inv, t0, false); t0 = __builtin_amdgcn_cvt_pk_fp8_f32(v[2] * inv, v[3] * inv, t0, true); w.x = (unsigned)t0; }
    { int t0 = 0; t0 = __builtin_amdgcn_cvt_pk_fp8_f32(v[4] * inv, v[5] * inv, t0, false); t0 = __builtin_amdgcn_cvt_pk_fp8_f32(v[6] * inv, v[7] * inv, t0, true); w.y = (unsigned)t0; }
    { int t0 = 0; t0 = __builtin_amdgcn_cvt_pk_fp8_f32(v[8] * inv, v[9] * inv, t0, false); t0 = __builtin_amdgcn_cvt_pk_fp8_f32(v[10] * inv, v[11] * inv, t0, true); w.z = (unsigned)t0; }
    { int t0 = 0; t0 = __builtin_amdgcn_cvt_pk_fp8_f32(v[12] * inv, v[13] * inv, t0, false); t0 = __builtin_amdgcn_cvt_pk_fp8_f32(v[14] * inv, v[15] * inv, t0, true); w.w = (unsigned)t0; }
    *(u32x4*)(dst + (size_t)row * 1024 + 16 * lane) = w;
    if (lane == 0) scale[row] = sc;
}
DI void fp8_row_load(const float* src, int row, int lane, float (&v)[16]) {
#pragma unroll
    for (int j = 0; j < 4; ++j) { const f32x4 a = *(const f32x4*)(src + (size_t)row * 1024 + 256 * j + 4 * lane); v[4 * j] = a[0]; v[4 * j + 1] = a[1]; v[4 * j + 2] = a[2]; v[4 * j + 3] = a[3]; }
}
DI void p0_convert_fp8(const Frame& F, const float* src, unsigned char* dst, float* scale, int widx, int nw) {
    const int lane = F.lane;
    for (int row = widx; row < N_EXPERTS; row += 4 * nw) {
        float v0[16], v1[16], v2[16], v3[16];
        const int r1 = row + nw, r2 = row + 2 * nw, r3 = row + 3 * nw;
        fp8_row_load(src, row, lane, v0);
        if (r1 < N_EXPERTS) fp8_row_load(src, r1, lane, v1);
        if (r2 < N_EXPERTS) fp8_row_load(src, r2, lane, v2);
        if (r3 < N_EXPERTS) fp8_row_load(src, r3, lane, v3);
        fp8_row_store(v0, row, lane, dst, scale);
        if (r1 < N_EXPERTS) fp8_row_store(v1, r1, lane, dst, scale);
        if (r2 < N_EXPERTS) fp8_row_store(v2, r2, lane, dst, scale);
        if (r3 < N_EXPERTS) fp8_row_store(v3, r3, lane, dst, scale);
    }
}
DI void p0_prologue(const Frame& F) {
    const bool split = (F.G == 256);
    if (split) p0_mod<true>(F); else p0_mod<false>(F);
    bf16_t* WIN_T = (bf16_t*)(F.ws + WS_WIN_T);
    p0_transpose(F, F.in[5], IN_W, 1024, IN_W, WIN_T, 1024, nullptr);
    float* psc = (float*)(F.ws + WS_PSC);
    if (!split) p0_convert_fp8(F, F.in[29], F.ws + WS_PU0, psc + 0 * N_EXPERTS, F.bid * NWAVES + F.wave, F.G * NWAVES);
    p0_convert_fp8(F, F.in[30], F.ws + WS_PV0, psc + 1 * N_EXPERTS, F.bid * NWAVES + F.wave, F.G * NWAVES);
}
DI void p0_late_weights(const Frame& Fin, int nunits) {
    const int nmax = (nunits + Fin.G - 1) / Fin.G, nfull = nunits - (nmax - 1) * Fin.G;
    Frame F = Fin;
    if (nfull < Fin.G) { if (Fin.bid < nfull) return; F.bid = Fin.bid - nfull; F.G = Fin.G - nfull; }
    bf16_t* WRW_T = (bf16_t*)(F.ws + WS_WRW_T);
    p0_transpose(F, F.in[12] + 0 * 1048576, 1024, 1024, 1024, WRW_T + (size_t)0    * 1024, 1024, nullptr);
    p0_transpose(F, F.in[12] + 1 * 1048576, 1024, 1024, 1024, WRW_T + (size_t)1024 * 1024, 1024, nullptr);
    p0_transpose(F, F.in[12] + 2 * 1048576, 1024, 1024, 1024, WRW_T + (size_t)2048 * 1024, 1024, nullptr);
    p0_transpose(F, F.in[14] + 0 * 65536, 64, 1024, 64, WRW_T + (size_t)3072 * 1024, 1024, nullptr);
    p0_transpose(F, F.in[14] + 1 * 65536, 64, 1024, 64, WRW_T + (size_t)3136 * 1024, 1024, nullptr);
    p0_transpose(F, F.in[17] + 0 * 65536, 64, 1024, 64, WRW_T + (size_t)3328 * 1024, 1024, nullptr);
    p0_transpose(F, F.in[17] + 1 * 65536, 64, 1024, 64, WRW_T + (size_t)3392 * 1024, 1024, nullptr);
    p0_transpose(F, F.in[19], 128, 1024, 128, WRW_T + (size_t)3584 * 1024, 1024, nullptr);
    { const u32x4 z = (u32x4){0u, 0u, 0u, 0u};
      for (int i = F.bid * NTHREADS + F.tid; i < 3 * 128 * 1024 / 8; i += F.G * NTHREADS) { const int blk = i / (128 * 128), r = i % (128 * 128);
          ((u32x4*)(WRW_T + (size_t)(3200 + 256 * blk) * 1024))[r] = z; } }
    { const float* g2 = F.in[20]; bf16_t* G2_T = (bf16_t*)(F.ws + WS_G2_T);
      for (int i = F.bid * NTHREADS + F.tid; i < 1024 * 32; i += F.G * NTHREADS) { const int n = i % 1024, k0 = (i / 1024) * 8;
          float v[8];
#pragma unroll
          for (int e = 0; e < 8; ++e) v[e] = (k0 + e < 128) ? g2[(size_t)(k0 + e) * 1024 + n] : 0.f;
          u32x4 w; w.x = pack_bf16(v[0], v[1]); w.y = pack_bf16(v[2], v[3]); w.z = pack_bf16(v[4], v[5]); w.w = pack_bf16(v[6], v[7]);
          *(u32x4*)(G2_T + (size_t)n * 256 + k0) = w; } }
    p0_transpose(F, F.in[9], 1024, 1024, 1024, (bf16_t*)(F.ws + WS_WOUT_T), 1024, nullptr);
    p0_convert(F, F.in[28], (bf16_t*)(F.ws + WS_SK), (size_t)2 * 16 * 128 * 128);
    const float* mod = (const float*)(F.ws + WS_MOD);
    p0_wqs(F, F.in[27], F.in[4] + 1 * 1024, mod, (bf16_t*)F.out);
    { Frame Fr = F; Fr.bid = F.G - 1 - F.bid;
      p0_bq(Fr, F.in[27], mod, (float*)(F.ws + WS_BQ)); }
}
DI void p0_late_weights2(const Frame& Fin) {
    Frame F = Fin;
    if ((Fin.G & 7) == 0) { const int g8 = Fin.G >> 3, nmax = (120 + g8 - 1) / g8, nfull = 120 - (nmax - 1) * g8;
        if (nfull < g8) { if ((Fin.bid >> 3) < nfull) return; F.bid = ((Fin.bid >> 3) - nfull) * 8 + (Fin.bid & 7); F.G = (g8 - nfull) * 8; } }
    else { const int nmax = (960 + Fin.G - 1) / Fin.G, nfull = 960 - (nmax - 1) * Fin.G;
        if (nfull < Fin.G) { if (Fin.bid < nfull) return; F.bid = Fin.bid - nfull; F.G = Fin.G - nfull; } }
    p0_wqs(F, F.in[27] + (size_t)1024 * 2048, F.in[4] + 3 * 1024, (const float*)(F.ws + WS_MOD) + 8 * 6144, (bf16_t*)F.out + (size_t)8 * 2048 * 1024);
    p0_transpose(F, F.in[26], 1024, 1024, 1024, (bf16_t*)(F.ws + WS_WO_T), 1024, nullptr);
    { Frame Fr = F; Fr.bid = F.G - 1 - F.bid; p0_bq(Fr, F.in[27] + (size_t)1024 * 2048, (const float*)(F.ws + WS_MOD) + 8 * 6144, (float*)(F.ws + WS_BQ) + 8 * 2048); }
}

DI void norm_row16(const float* xr, int lane, float (&v)[16], float& rinv) {
    float ss = 0.f;
#pragma unroll
    for (int j = 0; j < 4; ++j) { const f32x4 a = *(const f32x4*)(xr + j * 256 + lane * 4); v[4 * j] = a[0]; v[4 * j + 1] = a[1]; v[4 * j + 2] = a[2]; v[4 * j + 3] = a[3];
        ss += a[0] * a[0] + a[1] * a[1] + a[2] * a[2] + a[3] * a[3]; }
    ss = wave_sum(ss);
    rinv = rsqrtf(ss * (1.0f / 1024.0f) + 1e-6f);
}
DI void ada_apply(float (&v)[16], float rinv, const float* g, const float* sc, const float* sh, int lane) {
#pragma unroll
    for (int j = 0; j < 4; ++j) { const int c = j * 256 + lane * 4;
        const f32x4 gg = *(const f32x4*)(g + c), s1 = *(const f32x4*)(sc + c), s0 = *(const f32x4*)(sh + c);
#pragma unroll
        for (int e = 0; e < 4; ++e) v[4 * j + e] = v[4 * j + e] * rinv * gg[e] * (1.0f + s1[e]) + s0[e]; }
}
DI void norm_row16_b(const bf16_t* xr, int lane, float (&v)[16], float& rinv) {
    float ss = 0.f;
#pragma unroll
    for (int j = 0; j < 4; ++j) { const u32x2 a = *(const u32x2*)(xr + j * 256 + lane * 4); v[4 * j] = bf_lo(a.x); v[4 * j + 1] = bf_hi(a.x); v[4 * j + 2] = bf_lo(a.y); v[4 * j + 3] = bf_hi(a.y);
        ss += v[4 * j] * v[4 * j] + v[4 * j + 1] * v[4 * j + 1] + v[4 * j + 2] * v[4 * j + 2] + v[4 * j + 3] * v[4 * j + 3]; }
    ss = wave_sum(ss);
    rinv = rsqrtf(ss * (1.0f / 1024.0f) + 1e-6f);
}
template <bool IN_BF16> DI void p_norm(const Frame& F, const void* x, const float* g, const float* modl  , int sh_off, int sc_off, bf16_t* H) {
    for (int r = F.bid * NWAVES + F.wave; r < T; r += F.G * NWAVES) {
        const int b = r / SEQ; float v[16], rinv;
        if (IN_BF16) norm_row16_b((const bf16_t*)x + (size_t)r * D, F.lane, v, rinv); else norm_row16((const float*)x + (size_t)r * D, F.lane, v, rinv);
        ada_apply(v, rinv, g, modl + (size_t)b * 6144 + sc_off, modl + (size_t)b * 6144 + sh_off, F.lane);
#pragma unroll
        for (int j = 0; j < 4; ++j) { u32x2 w; w.x = pack_bf16(v[4 * j], v[4 * j + 1]); w.y = pack_bf16(v[4 * j + 2], v[4 * j + 3]);
            *(u32x2*)(H + (size_t)r * D + j * 256 + F.lane * 4) = w; }
    }
}
DI void p_qkprep(const Frame& F) {
    const bf16_t* QKV = (const bf16_t*)(F.ws + WS_QKV);
    bf16_t* QA = (bf16_t*)(F.ws + WS_QA); bf16_t* KA = (bf16_t*)(F.ws + WS_KA); bf16_t* VAT = (bf16_t*)(F.ws + WS_VAT);
    bf16_t* QB = (bf16_t*)(F.ws + WS_QB); bf16_t* KB = (bf16_t*)(F.ws + WS_KB); bf16_t* VBT = (bf16_t*)(F.ws + WS_VBT);
    const float* qk_g = F.in[6];
    LAS float* cs = (LAS float*)F.lds;
    LAS unsigned short* vt = (LAS unsigned short*)(F.lds + 16384);
    for (int tile = F.bid; tile < T / 64; tile += F.G) {
        const int t0 = tile * 64, b = t0 / SEQ, s0 = t0 % SEQ;
        __syncthreads();
        for (int i = F.tid; i < 64 * 32; i += NTHREADS) { const int tok = i >> 5, ai = i & 31, axis = ai >> 4, ii = ai & 15;
            const int s = s0 + tok; const float pos = (float)(axis == 0 ? (s >> 6) : (s & 63));
            const float inv = exp2f(-(float)ii * (13.287712379549449f / 16.0f));
            float sn, cn; sincosf(pos * inv, &sn, &cn); cs[2 * i] = cn; cs[2 * i + 1] = sn; }
        for (int i = F.tid; i < 64 * 80; i += NTHREADS) { const int tok = i / 80, ch = i % 80; const int col = ch < 64 ? 1024 + 8 * ch : 2176 + 8 * (ch - 64);
            const u32x4 v = *(const u32x4*)(QKV + (size_t)(t0 + tok) * IN_W + col);
            *(LAS u32x4*)(vt + tok * 648 + 8 * ch) = v; }
        __syncthreads();
        const int tok = F.tid >> 3, j = F.tid & 7, s = s0 + tok;
        for (int slot = 0; slot < 26; ++slot) {
            int col, type; bf16_t* dst;
            if (slot < 8)       { col = 64 * slot;               type = 0; dst = QA + ((size_t)(b * 8 + slot) * SEQ + s) * 64; }
            else if (slot < 16) { col = 512 + 64 * (slot - 8);   type = 1; dst = KA + ((size_t)(b * 8 + slot - 8) * SEQ + s) * 64; }
            else if (slot < 24) { col = 1536 + 64 * (slot - 16); type = 2; dst = QB + ((size_t)(b * 8 + slot - 16) * SEQ + s) * 64; }
            else                { col = 2048 + 64 * (slot - 24); type = 3; dst = KB + ((size_t)(b * 2 + slot - 24) * SEQ + s) * 64; }
            const u32x4 raw = *(const u32x4*)(QKV + (size_t)(t0 + tok) * IN_W + col + 8 * j);
            float v[8]; v[0] = bf_lo(raw.x); v[1] = bf_hi(raw.x); v[2] = bf_lo(raw.y); v[3] = bf_hi(raw.y); v[4] = bf_lo(raw.z); v[5] = bf_hi(raw.z); v[6] = bf_lo(raw.w); v[7] = bf_hi(raw.w);
            float ss = 0.f;
#pragma unroll
            for (int e = 0; e < 8; ++e) ss += v[e] * v[e];
            ss += __shfl_xor(ss, 1); ss += __shfl_xor(ss, 2); ss += __shfl_xor(ss, 4);
            const float rinv = rsqrtf(ss * (1.0f / 64.0f) + 1e-6f);
            const f32x4 g0 = *(const f32x4*)(qk_g + type * 64 + 8 * j), g1 = *(const f32x4*)(qk_g + type * 64 + 8 * j + 4);
#pragma unroll
            for (int e = 0; e < 4; ++e) { v[e] = v[e] * rinv * g0[e]; v[4 + e] = v[4 + e] * rinv * g1[e]; }
            if (type >= 2) {
                const int axis = j >> 2; const bool first = (j & 2) == 0;
#pragma unroll
                for (int e = 0; e < 8; ++e) { const float p = __shfl_xor(v[e], 2); const int ii = 8 * (j & 1) + e;
                    const float cn = cs[2 * (tok * 32 + axis * 16 + ii)], sn = cs[2 * (tok * 32 + axis * 16 + ii) + 1];
                    v[e] = first ? (v[e] * cn - p * sn) : (v[e] * cn + p * sn); }
            }
            if (type == 0 || type == 2) {
#pragma unroll
                for (int e = 0; e < 8; ++e) v[e] *= QSCALE; }
            u32x4 w; w.x = pack_bf16(v[0], v[1]); w.y = pack_bf16(v[2], v[3]); w.z = pack_bf16(v[4], v[5]); w.w = pack_bf16(v[6], v[7]);
            *(u32x4*)(dst + 8 * j) = w;
        }
        for (int i = F.tid; i < 640 * 8; i += NTHREADS) { const int c = i & 7, dv = i >> 3;
            unsigned short e[8];
#pragma unroll
            for (int k = 0; k < 8; ++k) e[k] = vt[(16 * (c >> 1) + 4 * (c & 1) + (k & 3) + 8 * (k >> 2)) * 648 + dv];
            u32x4 w; w.x = e[0] | ((unsigned)e[1] << 16); w.y = e[2] | ((unsigned)e[3] << 16); w.z = e[4] | ((unsigned)e[5] << 16); w.w = e[6] | ((unsigned)e[7] << 16);
            bf16_t* dp = dv < 512 ? VAT + ((size_t)b * 512 + dv) * SEQ + s0 + 8 * c : VBT + ((size_t)b * 128 + (dv - 512)) * SEQ + s0 + 8 * c;
            *(u32x4*)dp = w; }
    }
    __syncthreads();
}

DI int t5_bucket(int rel) {
    const int ret = rel > 0 ? 16 : 0; const int n = rel < 0 ? -rel : rel;
    if (n < 8) return ret + n;
    int large = 8 + (n >= 12) + (n >= 16) + (n >= 23) + (n >= 32) + (n >= 46) + (n >= 64) + (n >= 91);
    return ret + large;
}
constexpr int AT_NS = 4, AT_PD = AT_NS - 1, AT_STG = 24576, AT_TB = AT_NS * AT_STG, AT_Q = AT_TB + 3072;
DI void glds16(const void* gsrc, unsigned lds_dst) { unsigned keep;
    asm volatile("s_mov_b32 %0, m0\n\ts_mov_b32 m0, %2\n\ts_nop 0\n\tglobal_load_lds_dwordx4 %1, off\n\ts_mov_b32 m0, %0" : "=&s"(keep) : "v"(gsrc), "s"(lds_dst) : "memory"); }

template <int NC, bool BIAS>
DI void attn_pass(const Frame& F, const bf16_t* Qp, const bf16_t* Kp, const bf16_t* Vt, int q0, const LAS float* tb, float c_neg, float c_pos, f32x16 (&o)[NC], float& l_out) {
    int lane = F.lane, tid_ = F.tid; asm volatile("" : "+v"(lane), "+v"(tid_));
    const int r31 = lane & 31, h = lane >> 5;
    LAS unsigned char* lds = F.lds;
    constexpr int NT = SEQ / 64, PT = 1 + NC / 2;
    __syncthreads();
#pragma unroll
    for (int i = 0; i < 4; ++i) { const int idx = i * NTHREADS + tid_, row = idx >> 3, ch = idx & 7;
        const u32x4 v = *(const u32x4*)(Qp + (size_t)(q0 + row) * 64 + 8 * ch);
        *(LAS u32x4*)(lds + AT_Q + row * 128 + ((ch ^ (row & 7)) << 4)) = v; }
    unsigned koffs[4], qoffs[4], voffs[4];
#pragma unroll
    for (int s_ = 0; s_ < 4; ++s_) { const unsigned sw = (unsigned)(((2 * s_ + h) ^ (r31 & 7)) << 4);
        koffs[s_] = (unsigned)(r31 * 128) + sw; qoffs[s_] = (unsigned)(AT_Q + (32 * F.wave + r31) * 128) + sw;
        voffs[s_] = 8192u + (unsigned)(r31 * 128) + (unsigned)(((2 * s_ + h) ^ ((r31 >> 1) & 7)) << 4); }
#pragma unroll
    for (int c = 0; c < NC; ++c)
#pragma unroll
        for (int r = 0; r < 16; ++r) o[c][r] = 0.f;
    float m = -INFINITY, l = 0.f;
    const int qlo = q0 + 32 * F.wave, qme = qlo + r31;
    const int krow = F.wave * 8 + (lane >> 3);
    const bf16_t* ksrc = Kp + (size_t)krow * 64 + 8 * ((lane & 7) ^ (krow & 7));
    const bf16_t* vsrc[NC / 2];
#pragma unroll
    for (int i = 0; i < NC / 2; ++i) { const int vrow = (i * 8 + F.wave) * 8 + (lane >> 3); vsrc[i] = Vt + (size_t)vrow * SEQ + 8 * ((lane & 7) ^ ((vrow >> 1) & 7)); }
    const unsigned lbase = (unsigned)(size_t)lds;
    const unsigned kdst = lbase + (unsigned)F.wave * 1024u;
#define AT_ISSUE(tt) do { const unsigned sb_ = (unsigned)(((tt) % AT_NS) * AT_STG); \
        glds16(ksrc + (size_t)(tt) * 64 * 64, (unsigned)__builtin_amdgcn_readfirstlane(kdst + sb_)); \
        _Pragma("unroll") for (int i_ = 0; i_ < NC / 2; ++i_) glds16(vsrc[i_] + (size_t)(tt) * 64, (unsigned)__builtin_amdgcn_readfirstlane(kdst + sb_ + 8192u + (unsigned)i_ * 8192u)); } while (0)
    __syncthreads();
    bf16x8 qreg[4];
    {
#pragma unroll
        for (int s = 0; s < 4; ++s) qreg[s] = *(const LAS bf16x8*)(lds + qoffs[s]); }
#pragma unroll
    for (int tt = 0; tt < AT_PD; ++tt) AT_ISSUE(tt);
#pragma unroll 1
    for (int t = 0; t < NT; ++t) {
        const int k0 = t * 64;
        if (t < NT - 2) { if (PT == 3) asm volatile("s_waitcnt vmcnt(6)" ::: "memory"); else asm volatile("s_waitcnt vmcnt(4)" ::: "memory"); }
        else if (t == NT - 2) { if (PT == 3) asm volatile("s_waitcnt vmcnt(3)" ::: "memory"); else asm volatile("s_waitcnt vmcnt(2)" ::: "memory"); }
        else asm volatile("s_waitcnt vmcnt(0)" ::: "memory");
        __builtin_amdgcn_s_barrier();
        asm volatile("" ::: "memory");
        if (t + AT_PD < NT) AT_ISSUE(t + AT_PD);
        const LAS unsigned char* st_ = lds + (t % AT_NS) * AT_STG;
        f32x16 sT[2];
#pragma unroll
        for (int s = 0; s < 4; ++s) { const bf16x8 qf = qreg[s];
#pragma unroll
            for (int kb = 0; kb < 2; ++kb) { const bf16x8 kf = *(const LAS bf16x8*)(st_ + koffs[s] + kb * 4096);
                if (s == 0) sT[kb] = __builtin_amdgcn_mfma_f32_32x32x16_bf16(kf, qf, (f32x16){0.f, 0.f, 0.f, 0.f, 0.f, 0.f, 0.f, 0.f, 0.f, 0.f, 0.f, 0.f, 0.f, 0.f, 0.f, 0.f}, 0, 0, 0);
                else sT[kb] = __builtin_amdgcn_mfma_f32_32x32x16_bf16(kf, qf, sT[kb], 0, 0, 0); } }
        float cb = 0.f;
        if (BIAS) {
            if (k0 + 63 - qlo <= -91) cb = c_neg;
            else if (k0 - (qlo + 31) >= 91) cb = c_pos;
            else {
#pragma unroll
                for (int kb = 0; kb < 2; ++kb)
#pragma unroll
                    for (int r = 0; r < 16; ++r) { const int key = k0 + 32 * kb + (r & 3) + 8 * (r >> 2) + 4 * h; sT[kb][r] += tb[key - qme + 192]; }
            }
        }
        float mx = sT[0][0];
#pragma unroll
        for (int kb = 0; kb < 2; ++kb)
#pragma unroll
            for (int r = 0; r < 16; ++r) mx = fmaxf(mx, sT[kb][r]);
        mx = fmaxf(mx, __shfl_xor(mx, 32)) + cb;
        if (__builtin_amdgcn_ballot_w64(mx > m) != 0ull) {
            const float mn = fmaxf(m, mx), alpha = __builtin_amdgcn_exp2f(m - mn);
            m = mn; l *= alpha;
#pragma unroll
            for (int c = 0; c < NC; ++c)
#pragma unroll
                for (int r = 0; r < 16; ++r) o[c][r] *= alpha;
        }
        const float sh = cb - m;
        float ps = 0.f;
#pragma unroll
        for (int kb = 0; kb < 2; ++kb)
#pragma unroll
            for (int r = 0; r < 16; ++r) { const float p = __builtin_amdgcn_exp2f(sT[kb][r] + sh); sT[kb][r] = p; ps += p; }
        l += ps;
        bf16x8 pf[2][2];
#pragma unroll
        for (int kb = 0; kb < 2; ++kb)
#pragma unroll
            for (int s2 = 0; s2 < 2; ++s2) {
                u32x4 pw; pw.x = pack_bf16(sT[kb][8 * s2 + 0], sT[kb][8 * s2 + 1]); pw.y = pack_bf16(sT[kb][8 * s2 + 2], sT[kb][8 * s2 + 3]);
                pw.z = pack_bf16(sT[kb][8 * s2 + 4], sT[kb][8 * s2 + 5]); pw.w = pack_bf16(sT[kb][8 * s2 + 6], sT[kb][8 * s2 + 7]);
                pf[kb][s2] = __builtin_bit_cast(bf16x8, pw); }
        __builtin_amdgcn_sched_barrier(0);
#pragma unroll
        for (int g = 0; g < 4; ++g) {
#pragma unroll
            for (int c = 0; c < NC; ++c) { const bf16x8 vf = *(const LAS bf16x8*)(st_ + voffs[g] + c * 4096);
                o[c] = __builtin_amdgcn_mfma_f32_32x32x16_bf16(vf, pf[g >> 1][g & 1], o[c], 0, 0, 0); }
        }
    }
#undef AT_ISSUE
    l_out = l + __shfl_xor(l, 32);
}

template <int MODE> DI void p_attention(const Frame& F) {
    const bf16_t* QA = (const bf16_t*)(F.ws + WS_QA); const bf16_t* KA = (const bf16_t*)(F.ws + WS_KA); const bf16_t* VAT = (const bf16_t*)(F.ws + WS_VAT);
    const bf16_t* QB = (const bf16_t*)(F.ws + WS_QB); const bf16_t* KB = (const bf16_t*)(F.ws + WS_KB); const bf16_t* VBT = (const bf16_t*)(F.ws + WS_VBT);
    bf16_t* O = (bf16_t*)(F.ws + WS_O);
    const float* rel_bias = F.in[10]; const float* lv = F.in[7]; const float* subg = F.in[8];
    LAS float* tb = (LAS float*)(F.lds + AT_TB);
    const int lane = F.lane;
    float lam;
    { const float a = lv[lane] * lv[64 + lane], b2 = lv[128 + lane] * lv[192 + lane];
      lam = __expf(wave_sum(a)) - __expf(wave_sum(b2)) + 0.2f; }
    if (MODE & 1) for (int u = F.bid; u < 256; u += F.G) {
        const int b = u >> 5, hd = (u >> 3) & 3, qb = u & 7, q0 = qb * 256;
        __syncthreads();
        for (int i = F.tid; i < 2 * 384; i += NTHREADS) { const int mi = i / 384, ii = i % 384; tb[i] = rel_bias[t5_bucket(ii - 192) * 8 + 2 * hd + mi] * LOG2E; }
        __syncthreads();
        const bf16_t* Vt = VAT + (size_t)(b * 4 + hd) * 128 * SEQ;
        unsigned* o0s = (unsigned*)(F.ws + WS_O0S) + (size_t)F.bid * NTHREADS + F.tid;
        const size_t o0p = (size_t)F.G * NTHREADS;
        f32x16 o[4]; float l;
        { const int mp = 2 * hd;
          attn_pass<4, true>(F, QA + (size_t)(b * 8 + mp) * SEQ * 64, KA + (size_t)(b * 8 + mp) * SEQ * 64, Vt, q0, tb, rel_bias[15 * 8 + mp] * LOG2E, rel_bias[31 * 8 + mp] * LOG2E, o, l);
          const float il = 1.0f / l;
#pragma unroll
          for (int c = 0; c < 4; ++c)
#pragma unroll
              for (int r = 0; r < 8; ++r) o0s[(c * 8 + r) * o0p] = pack_bf16(o[c][2 * r] * il, o[c][2 * r + 1] * il); }
        { const int mp = 2 * hd + 1;
          attn_pass<4, true>(F, QA + (size_t)(b * 8 + mp) * SEQ * 64, KA + (size_t)(b * 8 + mp) * SEQ * 64, Vt, q0, tb + 384, rel_bias[15 * 8 + mp] * LOG2E, rel_bias[31 * 8 + mp] * LOG2E, o, l);
          int ln = F.lane; asm volatile("" : "+v"(ln)); const int r31 = ln & 31, h = ln >> 5;
          const float il = lam / l; float ss = 0.f;
#pragma unroll
          for (int c = 0; c < 4; ++c)
#pragma unroll
              for (int r = 0; r < 8; ++r) { const unsigned pk = __hip_atomic_load(o0s + (c * 8 + r) * o0p, __ATOMIC_RELAXED, __HIP_MEMORY_SCOPE_AGENT); const float d0 = bf_lo(pk) - o[c][2 * r] * il, d1 = bf_hi(pk) - o[c][2 * r + 1] * il; o[c][2 * r] = d0; o[c][2 * r + 1] = d1; ss += d0 * d0 + d1 * d1; }
          ss += __shfl_xor(ss, 32);
          const float rinv = rsqrtf(ss * (1.0f / 128.0f) + 1e-6f) * 0.8f;
          bf16_t* op = O + (size_t)(b * SEQ + q0 + 32 * F.wave + r31) * D + hd * 128;
#pragma unroll
          for (int c = 0; c < 4; ++c)
#pragma unroll
              for (int g = 0; g < 4; ++g) { const int dv = 32 * c + 8 * g + 4 * h; const f32x4 sg = *(const f32x4*)(subg + dv);
                  u32x2 w; w.x = pack_bf16(o[c][4 * g] * rinv * sg[0], o[c][4 * g + 1] * rinv * sg[1]); w.y = pack_bf16(o[c][4 * g + 2] * rinv * sg[2], o[c][4 * g + 3] * rinv * sg[3]);
                  *(u32x2*)(op + dv) = w; } }
    }
    if (MODE & 2) for (int u = F.bid; u < 512; u += F.G) {
        const int b = u >> 6, hq = (u >> 3) & 7, qb = u & 7, q0 = qb * 256, kv = hq >> 2;
        f32x16 o[2]; float l;
        attn_pass<2, false>(F, QB + (size_t)(b * 8 + hq) * SEQ * 64, KB + (size_t)(b * 2 + kv) * SEQ * 64, VBT + (size_t)(b * 2 + kv) * 64 * SEQ, q0, tb, 0.f, 0.f, o, l);
        int ln = F.lane; asm volatile("" : "+v"(ln)); const int r31 = ln & 31, h = ln >> 5;
        const float il = 1.0f / l;
        bf16_t* op = O + (size_t)(b * SEQ + q0 + 32 * F.wave + r31) * D + 512 + hq * 64;
#pragma unroll
        for (int c = 0; c < 2; ++c)
#pragma unroll
            for (int g = 0; g < 4; ++g) { const int dv = 32 * c + 8 * g + 4 * h;
                u32x2 w; w.x = pack_bf16(o[c][4 * g] * il, o[c][4 * g + 1] * il); w.y = pack_bf16(o[c][4 * g + 2] * il, o[c][4 * g + 3] * il);
                *(u32x2*)(op + dv) = w; }
    }
    __syncthreads();
}
#define CE_DESC(ka, pa, kb, pb) do { const bool _sw = (kb) > (ka); const float _k0 = _sw ? (kb) : (ka), _k1 = _sw ? (ka) : (kb); const int _p0 = _sw ? (pb) : (pa), _p1 = _sw ? (pa) : (pb); \
    (ka) = _k0; (kb) = _k1; (pa) = _p0; (pb) = _p1; } while (0)
template <int BASE> DI void sort16_desc(float (&k)[64], int (&p)[64]) {
#pragma unroll
    for (int k2 = 2; k2 <= 16; k2 <<= 1)
#pragma unroll
        for (int j = k2 >> 1; j > 0; j >>= 1)
#pragma unroll
            for (int i = 0; i < 16; ++i) { const int l = i ^ j;
                if (l > i) { if ((i & k2) == 0 || k2 == 16) CE_DESC(k[BASE + i], p[BASE + i], k[BASE + l], p[BASE + l]); else CE_DESC(k[BASE + l], p[BASE + l], k[BASE + i], p[BASE + i]); } }
}
template <int BA, int BB> DI void merge_top16(float (&k)[64], int (&p)[64]) {
#pragma unroll
    for (int i = 0; i < 16; ++i) { const bool sw = k[BB + 15 - i] > k[BA + i]; k[BA + i] = sw ? k[BB + 15 - i] : k[BA + i]; p[BA + i] = sw ? p[BB + 15 - i] : p[BA + i]; }
#pragma unroll
    for (int j = 8; j > 0; j >>= 1)
#pragma unroll
        for (int i = 0; i < 16; ++i) { const int l = i ^ j; if (l > i) CE_DESC(k[BA + i], p[BA + i], k[BA + l], p[BA + l]); }
}
DI void top16_of_64(float (&k)[64], int (&p)[64]) {
    sort16_desc<0>(k, p); sort16_desc<16>(k, p); sort16_desc<32>(k, p); sort16_desc<48>(k, p);
    merge_top16<0, 16>(k, p); merge_top16<32, 48>(k, p); merge_top16<0, 32>(k, p);
}
#define CEK_DESC(ka, kb) do { const float _h = fmaxf((ka), (kb)), _l = fminf((ka), (kb)); (ka) = _h; (kb) = _l; } while (0)
template <int BASE> DI void sort16k_desc(float (&k)[64]) {
#pragma unroll
    for (int k2 = 2; k2 <= 16; k2 <<= 1)
#pragma unroll
        for (int j = k2 >> 1; j > 0; j >>= 1)
#pragma unroll
            for (int i = 0; i < 16; ++i) { const int l = i ^ j;
                if (l > i) { if ((i & k2) == 0) CEK_DESC(k[BASE + i], k[BASE + l]); else CEK_DESC(k[BASE + l], k[BASE + i]); } }
}
template <int BA, int BB> DI void merge_top16k(float (&k)[64]) {
#pragma unroll
    for (int i = 0; i < 16; ++i) k[BA + i] = fmaxf(k[BA + i], k[BB + 15 - i]);
#pragma unroll
    for (int j = 8; j > 0; j >>= 1)
#pragma unroll
        for (int i = 0; i < 16; ++i) { const int l = i ^ j; if (l > i) CEK_DESC(k[BA + i], k[BA + l]); }
}
DI void top16k_of_64(float (&k)[64]) {
    sort16k_desc<0>(k); sort16k_desc<16>(k); sort16k_desc<32>(k); sort16k_desc<48>(k);
    merge_top16k<0, 16>(k); merge_top16k<32, 48>(k); merge_top16k<0, 32>(k);
}
constexpr int cand_off(int a) { int s = 0; for (int i = 0; i < a; ++i) s += 16 / (i + 1); return s; }

DI void p_peer_topk(const Frame& F, const bf16_t* PQ, const bf16_t* SK  , int* EIDX, float* GATE) {
    const int lane = F.lane, r31 = lane & 31, h = lane >> 5, w = F.wave;
    for (int tile = F.bid; tile < T / 64; tile += F.G) {
        for (int tt = 0; tt < 2; ++tt) {
            const int tok = tile * 64 + tt * 32 + r31;
            float lv[2][16];
#pragma unroll
            for (int p = 0; p < 2; ++p) {
                const int hp = 2 * w + p;
                f32x16 acc[4];
#pragma unroll
                for (int nb = 0; nb < 4; ++nb)
#pragma unroll
                    for (int r = 0; r < 16; ++r) acc[nb][r] = 0.f;
                const bf16_t* qp = PQ + (size_t)tok * PQ_LD + hp * 128 + 8 * h;
                const bf16_t* sp = SK + ((size_t)hp * 128 + r31) * 128 + 8 * h;
#pragma unroll 4
                for (int s = 0; s < 8; ++s) { const bf16x8 qf = *(const bf16x8*)(qp + 16 * s);
#pragma unroll
                    for (int nb = 0; nb < 4; ++nb) { const bf16x8 af = *(const bf16x8*)(sp + (size_t)nb * 32 * 128 + 16 * s);
                        acc[nb] = __builtin_amdgcn_mfma_f32_32x32x16_bf16(af, qf, acc[nb], 0, 0, 0); } }
                float k[64];
#pragma unroll
                for (int nb = 0; nb < 4; ++nb)
#pragma unroll
                    for (int r = 0; r < 16; ++r) { const int n = 32 * nb + (r & 3) + 8 * (r >> 2) + 4 * h;
                        k[16 * nb + r] = __uint_as_float((__float_as_uint(acc[nb][r]) & 0xFFFFFF80u) | (unsigned)(127 - n)); }
                top16k_of_64(k);
#pragma unroll
                for (int i = 0; i < 16; ++i) k[16 + i] = __shfl_xor(k[i], 32);
                merge_top16k<0, 16>(k);
#pragma unroll
                for (int i = 0; i < 16; ++i) lv[p][i] = k[i];
                __builtin_amdgcn_sched_barrier(0);
            }
            float ck[64];
#pragma unroll
            for (int i = 0; i < 64; ++i) ck[i] = -INFINITY;
#pragma unroll
            for (int a = 0; a < 16; ++a) {
#pragma unroll
                for (int b2 = 0; b2 < 16 / (a + 1); ++b2) ck[cand_off(a) + b2] = __uint_as_float((__float_as_uint(lv[0][a] + lv[1][b2]) & 0xFFFFFF00u) | (unsigned)(a * 16 + b2)); }
            LAS float* lst = (LAS float*)F.lds + F.tid;
#pragma unroll
            for (int i = 0; i < 16; ++i) { lst[i * NTHREADS] = lv[0][i]; lst[(16 + i) * NTHREADS] = lv[1][i]; }
            top16k_of_64(ck);
            float den = 0.f, ex[16]; int cp[16];
#pragma unroll
            for (int i = 0; i < 16; ++i) { ex[i] = __expf(ck[i] - ck[0]); den += ex[i];
                const unsigned cb = __float_as_uint(ck[i]); const int a = (cb >> 4) & 15, b2 = cb & 15;
                const unsigned u0 = __float_as_uint(lst[a * NTHREADS]), u1 = __float_as_uint(lst[(16 + b2) * NTHREADS]);
                cp[i] = (127 - (int)(u0 & 127u)) * 128 + (127 - (int)(u1 & 127u)); }
            const float iden = 1.0f / den;
            if (h == 0) {
                int* ep = EIDX + (size_t)tok * 128 + w * 16; float* gp = GATE + (size_t)tok * 128 + w * 16;
#pragma unroll
                for (int i = 0; i < 4; ++i) { *(u32x4*)(ep + 4 * i) = (u32x4){(unsigned)cp[4 * i], (unsigned)cp[4 * i + 1], (unsigned)cp[4 * i + 2], (unsigned)cp[4 * i + 3]};
                    *(f32x4*)(gp + 4 * i) = (f32x4){ex[4 * i] * iden, ex[4 * i + 1] * iden, ex[4 * i + 2] * iden, ex[4 * i + 3] * iden}; }
            }
        }
    }
}

DI void fp8x16_to_f32(const u32x4 w, float (&o)[16]) {
    f32x2 t;
    t = __builtin_amdgcn_cvt_pk_f32_fp8((int)w.x, false); o[0] = t[0]; o[1] = t[1];  t = __builtin_amdgcn_cvt_pk_f32_fp8((int)w.x, true); o[2] = t[0]; o[3] = t[1];
    t = __builtin_amdgcn_cvt_pk_f32_fp8((int)w.y, false); o[4] = t[0]; o[5] = t[1];  t = __builtin_amdgcn_cvt_pk_f32_fp8((int)w.y, true); o[6] = t[0]; o[7] = t[1];
    t = __builtin_amdgcn_cvt_pk_f32_fp8((int)w.z, false); o[8] = t[0]; o[9] = t[1];  t = __builtin_amdgcn_cvt_pk_f32_fp8((int)w.z, true); o[10] = t[0]; o[11] = t[1];
    t = __builtin_amdgcn_cvt_pk_f32_fp8((int)w.w, false); o[12] = t[0]; o[13] = t[1]; t = __builtin_amdgcn_cvt_pk_f32_fp8((int)w.w, true); o[14] = t[0]; o[15] = t[1];
}
DI float gelu_tanh_fast(float x) { const float z2 = 2.302208198f * (x + 0.044715f * x * x * x);
    return x * __builtin_amdgcn_rcpf(1.0f + __builtin_amdgcn_exp2f(-z2)); }
constexpr int PB = 4;
DI void peer_load(const unsigned char* PU, const unsigned char* PV, int ev, int base, int lane, u32x4 (&U)[PB], u32x4 (&V)[PB]) {
#pragma unroll
    for (int q = 0; q < PB; ++q) { const int e = __builtin_amdgcn_readlane(ev, base + q);
        U[q] = *(const u32x4*)(PU + (size_t)e * 1024 + 16 * lane); V[q] = *(const u32x4*)(PV + (size_t)e * 1024 + 16 * lane); }
}
struct RsMap { unsigned tag; int l0, l1, l2, l3; };
DI unsigned swp32(unsigned a, unsigned b, unsigned& other) { auto r = __builtin_amdgcn_permlane32_swap(a, b, false, false); other = r[1]; return r[0]; }
DI unsigned swp16(unsigned a, unsigned b, unsigned& other) { auto r = __builtin_amdgcn_permlane16_swap(a, b, false, false); other = r[1]; return r[0]; }
DI RsMap rs_map_init() {
    unsigned o, t0 = 0u, t1 = 1u, t2 = 2u, t3 = 3u;
    asm volatile("" : "+v"(t0), "+v"(t1), "+v"(t2), "+v"(t3));
    const unsigned ta = swp32(t0, t2, o), tb = swp32(t1, t3, o);
    RsMap m; m.tag = swp16(ta, tb, o);
    m.l0 = __builtin_ctzll(__builtin_amdgcn_ballot_w64(m.tag == 0u)); m.l1 = __builtin_ctzll(__builtin_amdgcn_ballot_w64(m.tag == 1u));
    m.l2 = __builtin_ctzll(__builtin_amdgcn_ballot_w64(m.tag == 2u)); m.l3 = __builtin_ctzll(__builtin_amdgcn_ballot_w64(m.tag == 3u));
    return m;
}
template <int CTRL> DI float dpp_g(float v) { return __builtin_bit_cast(float, __builtin_amdgcn_update_dpp(0, __builtin_bit_cast(int, v), CTRL, 0xF, 0xF, true)); }
DI void peer_comp(const u32x4 (&U)[PB], const u32x4 (&V)[PB], float su, float gvs, int base, const RsMap& M, const float (&x)[16], float (&y)[16]) {
    float d[PB];
#pragma unroll
    for (int q = 0; q < PB; ++q) { float u[16]; fp8x16_to_f32(U[q], u);
        float a0 = u[0] * x[0], a1 = u[1] * x[1], a2 = u[2] * x[2], a3 = u[3] * x[3];
#pragma unroll
        for (int i = 4; i < 16; i += 4) { a0 += u[i] * x[i]; a1 += u[i + 1] * x[i + 1]; a2 += u[i + 2] * x[i + 2]; a3 += u[i + 3] * x[i + 3]; }
        d[q] = (a0 + a1) + (a2 + a3); }
    unsigned o;
    const float f0a = __uint_as_float(swp32(__float_as_uint(d[0]), __float_as_uint(d[2]), o)); const float f0 = f0a + __uint_as_float(o);
    const float f1a = __uint_as_float(swp32(__float_as_uint(d[1]), __float_as_uint(d[3]), o)); const float f1 = f1a + __uint_as_float(o);
    const float ga = __uint_as_float(swp16(__float_as_uint(f0), __float_as_uint(f1), o)); float g = ga + __uint_as_float(o);
    g += dpp_g<0xB1>(g); g += dpp_g<0x4E>(g); g += dpp_g<0x141>(g); g += dpp_g<0x140>(g);
    const int src = (base + (int)M.tag) * 4;
    const float su_b = __uint_as_float(__builtin_amdgcn_ds_bpermute(src, __float_as_uint(su))), gv_b = __uint_as_float(__builtin_amdgcn_ds_bpermute(src, __float_as_uint(gvs)));
    const float c = gv_b * gelu_tanh_fast(g * su_b);
    const float c0 = __uint_as_float(__builtin_amdgcn_readlane(__float_as_uint(c), M.l0)), c1 = __uint_as_float(__builtin_amdgcn_readlane(__float_as_uint(c), M.l1));
    const float c2 = __uint_as_float(__builtin_amdgcn_readlane(__float_as_uint(c), M.l2)), c3 = __uint_as_float(__builtin_amdgcn_readlane(__float_as_uint(c), M.l3));
    const float cq[4] = {c0, c1, c2, c3};
#pragma unroll
    for (int q = 0; q < PB; ++q) { float v[16]; fp8x16_to_f32(V[q], v);
#pragma unroll
        for (int i = 0; i < 16; ++i) y[i] += cq[q] * v[i]; }
}
constexpr int PM_SHIFT = 11, PM_NP = 16384 >> PM_SHIFT;
struct PBatch { u32x4 U[4], V[4]; float su[4], gv[4]; int n; };
DI void pm_fetch(PBatch& B, unsigned long long& mA, unsigned long long& mB, int e0, int e1, float su0, float su1, float gv0, float gv1, const unsigned char* PU, const unsigned char* PV, int lane) {
    B.n = 0;
    if ((mA | mB) == 0ull) return;
    int eid[4];
#pragma unroll
    for (int q = 0; q < 4; ++q) {
        if (mA != 0ull) { const int l = __builtin_ctzll(mA); mA &= mA - 1ull;
            eid[q] = __builtin_amdgcn_readlane(e0, l); B.su[q] = __uint_as_float(__builtin_amdgcn_readlane(__float_as_uint(su0), l)); B.gv[q] = __uint_as_float(__builtin_amdgcn_readlane(__float_as_uint(gv0), l)); B.n = q + 1; }
        else if (mB != 0ull) { const int l = __builtin_ctzll(mB); mB &= mB - 1ull;
            eid[q] = __builtin_amdgcn_readlane(e1, l); B.su[q] = __uint_as_float(__builtin_amdgcn_readlane(__float_as_uint(su1), l)); B.gv[q] = __uint_as_float(__builtin_amdgcn_readlane(__float_as_uint(gv1), l)); B.n = q + 1; }
        else { eid[q] = eid[0]; B.su[q] = 0.f; B.gv[q] = 0.f; }
        B.U[q] = *(const u32x4*)(PU + (size_t)eid[q] * 1024 + 16 * lane); B.V[q] = *(const u32x4*)(PV + (size_t)eid[q] * 1024 + 16 * lane);
    }
}
DI void pm_comp(const PBatch& B, const RsMap& M, const float (&x)[16], float (&y)[16]) {
    float d[4];
#pragma unroll
    for (int q = 0; q < 4; ++q) { float u[16]; fp8x16_to_f32(B.U[q], u);
        f32x2 a0 = (f32x2){u[0], u[1]} * (f32x2){x[0], x[1]}, a1 = (f32x2){u[2], u[3]} * (f32x2){x[2], x[3]};
#pragma unroll
        for (int i = 4; i < 16; i += 4) { a0 = __builtin_elementwise_fma((f32x2){u[i], u[i + 1]}, (f32x2){x[i], x[i + 1]}, a0); a1 = __builtin_elementwise_fma((f32x2){u[i + 2], u[i + 3]}, (f32x2){x[i + 2], x[i + 3]}, a1); }
        const f32x2 as = a0 + a1; d[q] = as[0] + as[1]; }
    unsigned o;
    const float f0a = __uint_as_float(swp32(__float_as_uint(d[0]), __float_as_uint(d[2]), o)); const float f0 = f0a + __uint_as_float(o);
    const float f1a = __uint_as_float(swp32(__float_as_uint(d[1]), __float_as_uint(d[3]), o)); const float f1 = f1a + __uint_as_float(o);
    const float ga = __uint_as_float(swp16(__float_as_uint(f0), __float_as_uint(f1), o)); float g = ga + __uint_as_float(o);
    g += dpp_g<0xB1>(g); g += dpp_g<0x4E>(g); g += dpp_g<0x141>(g); g += dpp_g<0x140>(g);
    const float su_b = M.tag == 0u ? B.su[0] : (M.tag == 1u ? B.su[1] : (M.tag == 2u ? B.su[2] : B.su[3]));
    const float gv_b = M.tag == 0u ? B.gv[0] : (M.tag == 1u ? B.gv[1] : (M.tag == 2u ? B.gv[2] : B.gv[3]));
    const float c = gv_b * gelu_tanh_fast(g * su_b);
    const float cq[4] = {__uint_as_float(__builtin_amdgcn_readlane(__float_as_uint(c), M.l0)), __uint_as_float(__builtin_amdgcn_readlane(__float_as_uint(c), M.l1)),
                         __uint_as_float(__builtin_amdgcn_readlane(__float_as_uint(c), M.l2)), __uint_as_float(__builtin_amdgcn_readlane(__float_as_uint(c), M.l3))};
#pragma unroll
    for (int q = 0; q < 4; ++q) { float v[16]; fp8x16_to_f32(B.V[q], v);
#pragma unroll
        for (int i = 0; i < 16; ++i) y[i] += cq[q] * v[i]; }
}
template <bool FINAL> DI void p_peer_gather(const Frame& F, const float* gn  , const float* modl  , const unsigned char* PU, const unsigned char* PV, const float* SU, const float* SV, const int* EIDX, const float* GATE, const float* gt2  , bf16_t* xb, float* out) {
    const int lane = F.lane;
    const RsMap M = rs_map_init();
    for (int tile = F.bid; tile < T / 64; tile += F.G) {
        for (int grp = 0; grp < 4; ++grp) {
            const int tb = tile * 64 + F.wave * 8 + grp * 2;
            float x[2][16], y[2][16]; int e0[2], e1[2]; float su0[2], su1[2], gv0[2], gv1[2];
#pragma unroll
            for (int i = 0; i < 2; ++i) { const int t = tb + i;
                { float rinv; norm_row16_b(xb + (size_t)t * D, lane, x[i], rinv);
                  ada_apply(x[i], rinv, gn, modl + (size_t)(t / SEQ) * 6144 + 4096, modl + (size_t)(t / SEQ) * 6144 + 3072, lane); }
#pragma unroll
                for (int k = 0; k < 16; ++k) y[i][k] = 0.f;
                e0[i] = __builtin_nontemporal_load(EIDX + (size_t)t * 128 + lane); e1[i] = __builtin_nontemporal_load(EIDX + (size_t)t * 128 + 64 + lane);
                su0[i] = SU[e0[i]]; su1[i] = SU[e1[i]]; gv0[i] = __builtin_nontemporal_load(GATE + (size_t)t * 128 + lane) * SV[e0[i]]; gv1[i] = __builtin_nontemporal_load(GATE + (size_t)t * 128 + 64 + lane) * SV[e1[i]]; }
            for (int p = 0; p < PM_NP; ++p) {
#pragma unroll
                for (int i = 0; i < 2; ++i) {
                    unsigned long long mA = __builtin_amdgcn_ballot_w64((e0[i] >> PM_SHIFT) == p), mB = __builtin_amdgcn_ballot_w64((e1[i] >> PM_SHIFT) == p);
                    PBatch A, B;
                    pm_fetch(A, mA, mB, e0[i], e1[i], su0[i], su1[i], gv0[i], gv1[i], PU, PV, lane);
                    while (A.n > 0) {
                        pm_fetch(B, mA, mB, e0[i], e1[i], su0[i], su1[i], gv0[i], gv1[i], PU, PV, lane);
                        pm_comp(A, M, x[i], y[i]);
                        if (B.n == 0) break;
                        pm_fetch(A, mA, mB, e0[i], e1[i], su0[i], su1[i], gv0[i], gv1[i], PU, PV, lane);
                        pm_comp(B, M, x[i], y[i]);
                    }
                }
            }
#pragma unroll
            for (int i = 0; i < 2; ++i) { const int t = tb + i; const int b = t / SEQ; const float* gp = gt2 + (size_t)b * 6144; bf16_t* xp = xb + (size_t)t * D;
#pragma unroll
                for (int j = 0; j < 4; ++j) { const int c = 256 * j + 4 * lane; const f32x4 g = *(const f32x4*)(gp + c); const u32x2 xw = *(const u32x2*)(xp + c);
                    f32x4 xo = (f32x4){bf_lo(xw.x), bf_hi(xw.x), bf_lo(xw.y), bf_hi(xw.y)};
                    xo[0] += g[0] * y[i][4 * j]; xo[1] += g[1] * y[i][4 * j + 1]; xo[2] += g[2] * y[i][4 * j + 2]; xo[3] += g[3] * y[i][4 * j + 3];
                    if (FINAL) __builtin_nontemporal_store(xo, (f32x4*)(out + (size_t)t * D + c)); else *(u32x2*)(xp + c) = (u32x2){pack_bf16(xo[0], xo[1]), pack_bf16(xo[2], xo[3])}; } }
        }
    }
}
DI void norm_row16c(const float* xr, int lane, float (&v)[16], float& rinv) {
    float ss = 0.f;
#pragma unroll
    for (int j = 0; j < 2; ++j)
#pragma unroll
        for (int q = 0; q < 2; ++q) { const f32x4 a = *(const f32x4*)(xr + 512 * j + 8 * lane + 4 * q); v[8 * j + 4 * q] = a[0]; v[8 * j + 4 * q + 1] = a[1]; v[8 * j + 4 * q + 2] = a[2]; v[8 * j + 4 * q + 3] = a[3];
            ss += a[0] * a[0] + a[1] * a[1] + a[2] * a[2] + a[3] * a[3]; }
    ss = wave_sum(ss);
    rinv = rsqrtf(ss * (1.0f / 1024.0f) + 1e-6f);
}
DI void ada_apply_c(float (&v)[16], float rinv, const float* g, const float* sc, const float* sh, int lane) {
#pragma unroll
    for (int j = 0; j < 2; ++j)
#pragma unroll
        for (int q = 0; q < 2; ++q) { const int c = 512 * j + 8 * lane + 4 * q;
            const f32x4 gg = *(const f32x4*)(g + c), s1 = *(const f32x4*)(sc + c), s0 = *(const f32x4*)(sh + c);
#pragma unroll
            for (int e = 0; e < 4; ++e) v[8 * j + 4 * q + e] = v[8 * j + 4 * q + e] * rinv * gg[e] * (1.0f + s1[e]) + s0[e]; }
}
DI void row_load(const bf16_t* xr, int lane, float (&v)[16]) {
#pragma unroll
    for (int j = 0; j < 2; ++j) { const u32x4 a = *(const u32x4*)(xr + 512 * j + 8 * lane);
        v[8 * j] = bf_lo(a.x); v[8 * j + 1] = bf_hi(a.x); v[8 * j + 2] = bf_lo(a.y); v[8 * j + 3] = bf_hi(a.y); v[8 * j + 4] = bf_lo(a.z); v[8 * j + 5] = bf_hi(a.z); v[8 * j + 6] = bf_lo(a.w); v[8 * j + 7] = bf_hi(a.w); }
}
DI void row_finish(const float (&raw)[16], int lane, const LAS float* ga, const LAS float* sh, float (&v)[16]) {
    float ss = 0.f;
#pragma unroll
    for (int e = 0; e < 16; ++e) ss += raw[e] * raw[e];
    ss = wave_sum(ss);
    const float rinv = rsqrtf(ss * (1.0f / 1024.0f) + 1e-6f);
#pragma unroll
    for (int j = 0; j < 2; ++j)
#pragma unroll
        for (int q = 0; q < 2; ++q) { const int c = 512 * j + 8 * lane + 4 * q; const f32x4 gg = *(const LAS f32x4*)(ga + c), s0 = *(const LAS f32x4*)(sh + c);
#pragma unroll
            for (int e = 0; e < 4; ++e) v[8 * j + 4 * q + e] = raw[8 * j + 4 * q + e] * rinv * gg[e] + s0[e]; }
}
DI void p_rwkv_prep(const Frame& F, const bf16_t* x, const float* g, const float* modl, const float* mix, bf16_t* X6) {
    const int lane = F.lane;
    LAS float* ga = (LAS float*)F.lds; LAS float* shl = ga + 1024; LAS float* mixl = ga + 2048;
    int cur_b = -1;
    for (int run0 = F.bid * NWAVES; run0 < T / 8; run0 += F.G * NWAVES) {
        const int run = run0 + F.wave;
        const int bb = (run0 * 8) / SEQ;
        if (bb != cur_b) { __syncthreads();
            for (int i = F.tid; i < 1024; i += NTHREADS) { ga[i] = g[i] * (1.0f + modl[(size_t)bb * 6144 + 1024 + i]); shl[i] = modl[(size_t)bb * 6144 + i]; }
            if (cur_b < 0) for (int i = F.tid; i < 6 * 1024; i += NTHREADS) mixl[i] = mix[i];
            cur_b = bb; __syncthreads(); }
        const int r0 = run * 8, s0 = r0 % SEQ;
        float hp[16], hc[16], hn[16], ra[16], rb[16];
        if (s0 > 0) row_load(x + (size_t)(r0 - 1) * D, lane, ra);
        row_load(x + (size_t)r0 * D, lane, rb);
        if (s0 > 0) row_finish(ra, lane, ga, shl, hp);
        else {
#pragma unroll
            for (int i = 0; i < 16; ++i) hp[i] = 0.f; }
        if (s0 + 1 < SEQ) row_load(x + (size_t)(r0 + 1) * D, lane, ra);
        row_finish(rb, lane, ga, shl, hc);
        for (int i = 0; i < 8; ++i) {
            const int s = s0 + i;
            if (i + 1 < 8 && s + 2 < SEQ) row_load(x + (size_t)(r0 + i + 2) * D, lane, rb);
            if (s + 1 < SEQ) row_finish(ra, lane, ga, shl, hn);
            else {
#pragma unroll
                for (int e = 0; e < 16; ++e) hn[e] = 0.f; }
#pragma unroll
            for (int e = 0; e < 16; ++e) ra[e] = rb[e];
            float xx[16];
#pragma unroll
            for (int e = 0; e < 16; ++e) xx[e] = 0.5f * (hp[e] + hn[e]) - hc[e];
#pragma unroll
            for (int grp = 0; grp < 6; ++grp) { const int mi = grp == 0 ? 0 : (grp == 1 ? 2 : (grp == 2 ? 3 : (grp == 3 ? 1 : grp)));
                bf16_t* op = X6 + ((size_t)grp * T + r0 + i) * D;
#pragma unroll
                for (int j = 0; j < 2; ++j) { const f32x4 m0 = *(const LAS f32x4*)(mixl + mi * 1024 + 512 * j + 8 * lane), m1 = *(const LAS f32x4*)(mixl + mi * 1024 + 512 * j + 8 * lane + 4);
                    u32x4 w; w.x = pack_bf16(hc[8 * j] + xx[8 * j] * m0[0], hc[8 * j + 1] + xx[8 * j + 1] * m0[1]); w.y = pack_bf16(hc[8 * j + 2] + xx[8 * j + 2] * m0[2], hc[8 * j + 3] + xx[8 * j + 3] * m0[3]);
                    w.z = pack_bf16(hc[8 * j + 4] + xx[8 * j + 4] * m1[0], hc[8 * j + 5] + xx[8 * j + 5] * m1[1]); w.w = pack_bf16(hc[8 * j + 6] + xx[8 * j + 6] * m1[2], hc[8 * j + 7] + xx[8 * j + 7] * m1[3]);
                    *(u32x4*)(op + 512 * j + 8 * lane) = w; } }
#pragma unroll
            for (int e = 0; e < 16; ++e) { hp[e] = hc[e]; hc[e] = hn[e]; }
        }
    }
    __syncthreads();
}

constexpr int SC_L = 16;
constexpr int SC_NB = 5;
constexpr int SCP = 272;
constexpr int SCB_W = 0, SCB_BKZ = 16 * SCP, SCB_VV = 32 * SCP, SCB_AR = 48 * SCP, SCB_SIZE = 64 * SCP;
constexpr int SC_Y = SC_NB * SCB_SIZE;
constexpr int SC_CST = SC_Y + SC_NB * 4096;
constexpr int SC_AFR = SC_CST + 1280;
constexpr int SC_PS = SC_AFR + 16384;
constexpr int SC_SCR = SC_PS + SC_NB * 512;
constexpr int SC_FLG = SC_SCR + 16384;
constexpr int SC_CY = SC_FLG + 64;
static_assert(SC_CY + SC_NB * 256 <= LDS_BAR_OFF, "scan LDS map overflows");
DI void lds_wait_ge(volatile LAS int* p, int v) { while (*p < v) __builtin_amdgcn_s_sleep(1); asm volatile("" ::: "memory"); }
DI void p_rwkv_scan(const Frame& F) {
    const bf16_t* RK = (const bf16_t*)(F.ws + WS1_RK);
    bf16_t* Y = (bf16_t*)(F.ws + WS1_Y); float* BON = (float*)(F.ws + WS1_BON);
    const float* k_k = F.in[21]; const float* k_a = F.in[22]; const float* r_k = F.in[23];
    LAS unsigned char* lds = F.lds;
    const int tid = F.tid, lane = F.lane;
    constexpr int NCH = SEQ / SC_L;
    for (int u = F.bid; u < 256; u += F.G) {
        const int b = u >> 5, hd = (u >> 1) & 15, z = u & 1;
        __syncthreads();
        if (tid < 16) ((volatile LAS int*)(lds + SC_FLG))[tid] = 0;
        { const float* w2 = F.in[15] + (size_t)z * 65536 + hd * 64; const float* a2 = F.in[18] + (size_t)z * 65536 + hd * 64;
          LAS unsigned short* stw = (LAS unsigned short*)(lds + SC_AFR);
          for (int idx = tid; idx < 8192; idx += NTHREADS) { const int mat = idx >> 12, i = (idx >> 6) & 63, c = idx & 63;
              const float v = (mat ? a2 : w2)[(size_t)i * 1024 + c]; stw[mat * 4096 + c * 64 + i] = (unsigned short)(pack_bf16(v, 0.f) & 0xffffu); } }
        __syncthreads();
        if (F.wave >= 4) {
            const int pw = F.wave - 4, s16 = lane & 15, q = lane >> 4;
            const int chb = hd * 64 + 4 * q;
            const LAS unsigned short* stg = (const LAS unsigned short*)(lds + SC_AFR);
            LAS float* cst = (LAS float*)(lds + SC_CST);
            { cst[lane] = F.in[13][z * 1024 + hd * 64 + lane]; cst[64 + lane] = F.in[16][z * 1024 + hd * 64 + lane]; cst[128 + lane] = k_k[hd * 64 + lane]; cst[192 + lane] = k_a[hd * 64 + lane]; cst[256 + lane] = r_k[hd * 64 + lane]; }
            u32x2 rr[4], kr[4], vr[4]; u32x4 Bw[2], Ba[2];
#define SC_ROW(i_) ((size_t)(b * SEQ + (z ? (SEQ - 1 - (i_)) : (i_))))
#define SC_LOADC(cc) do { int s16l_ = s16, ql_ = q; asm volatile("" : "+v"(s16l_), "+v"(ql_)); const int chb_ = hd * 64 + 4 * ql_;     \
        const bf16_t* rp_ = RK + SC_ROW((cc) * SC_L + s16l_) * RW_N; \
        _Pragma("unroll") for (int cb = 0; cb < 4; ++cb) { rr[cb] = *(const u32x2*)(rp_ + chb_ + 16 * cb); kr[cb] = *(const u32x2*)(rp_ + 1024 + chb_ + 16 * cb); vr[cb] = *(const u32x2*)(rp_ + 2048 + chb_ + 16 * cb); } \
        _Pragma("unroll") for (int ks = 0; ks < 2; ++ks) { Bw[ks] = *(const u32x4*)(rp_ + 3072 + 64 * z + 32 * ks + 8 * ql_); Ba[ks] = *(const u32x4*)(rp_ + 3328 + 64 * z + 32 * ks + 8 * ql_); } } while (0)
#define SC_XFORM(cc_, buf_) do { \
            int s16_ = s16, q_ = q; asm volatile("" : "+v"(s16_), "+v"(q_));     \
            LAS unsigned char* bp = lds + (buf_) * SCB_SIZE; const int t_ = s16_; const bool odd_ = (s16_ & 1) != 0; \
            float ss = 0.f, bs = 0.f; LAS float* scr_ = (LAS float*)(lds + SC_SCR) + (pw * 4) * 256 + (q_ * 16 + s16_) * 4;     \
            _Pragma("unroll") for (int cb = 0; cb < 4; ++cb) { \
                f32x4 dw = __builtin_amdgcn_mfma_f32_16x16x32_bf16(*(const LAS bf16x8*)(stg + (16 * cb + s16_) * 64 + 8 * q_), __builtin_bit_cast(bf16x8, Bw[0]), (f32x4){0.f, 0.f, 0.f, 0.f}, 0, 0, 0); \
                dw = __builtin_amdgcn_mfma_f32_16x16x32_bf16(*(const LAS bf16x8*)(stg + (16 * cb + s16_) * 64 + 32 + 8 * q_), __builtin_bit_cast(bf16x8, Bw[1]), dw, 0, 0, 0); \
                f32x4 da = __builtin_amdgcn_mfma_f32_16x16x32_bf16(*(const LAS bf16x8*)(stg + 4096 + (16 * cb + s16_) * 64 + 8 * q_), __builtin_bit_cast(bf16x8, Ba[0]), (f32x4){0.f, 0.f, 0.f, 0.f}, 0, 0, 0); \
                da = __builtin_amdgcn_mfma_f32_16x16x32_bf16(*(const LAS bf16x8*)(stg + 4096 + (16 * cb + s16_) * 64 + 32 + 8 * q_), __builtin_bit_cast(bf16x8, Ba[1]), da, 0, 0, 0); \
                const f32x4 w0v = *(const LAS f32x4*)(cst + 16 * cb + 4 * q_), a0v = *(const LAS f32x4*)(cst + 64 + 16 * cb + 4 * q_); \
                const f32x4 kkw = *(const LAS f32x4*)(cst + 128 + 16 * cb + 4 * q_), kaw = *(const LAS f32x4*)(cst + 192 + 16 * cb + 4 * q_), rkw = *(const LAS f32x4*)(cst + 256 + 16 * cb + 4 * q_); \
                const float r4[4] = {bf_lo(rr[cb].x), bf_hi(rr[cb].x), bf_lo(rr[cb].y), bf_hi(rr[cb].y)}, k4[4] = {bf_lo(kr[cb].x), bf_hi(kr[cb].x), bf_lo(kr[cb].y), bf_hi(kr[cb].y)}; \
                f32x4 dec, azq, kzq; \
                _Pragma("unroll") for (int e = 0; e < 4; ++e) { \
                    const float sgw = __builtin_amdgcn_rcpf(1.0f + __builtin_amdgcn_exp2f(-1.4426950408889634f * (dw[e] + w0v[e])));     \
                    dec[e] = __builtin_amdgcn_exp2f(-0.8750387749f * sgw);                                                     \
                    const float az = __builtin_amdgcn_rcpf(1.0f + __builtin_amdgcn_exp2f(-1.4426950408889634f * (da[e] + a0v[e]))); azq[e] = az; \
                    { const float kk_ = k4[e] * kkw[e]; ss += kk_ * kk_; } kzq[e] = k4[e] * (1.0f + (az - 1.0f) * kaw[e]); bs += r4[e] * kzq[e] * rkw[e]; } \
                { const int o = t_ * SCP + (16 * cb + 4 * q_) * 4; \
                    *(LAS f32x4*)(scr_ + cb * 256) = azq; *(LAS f32x4*)(bp + SCB_BKZ + o) = kzq;     \
                    *(LAS f32x4*)(bp + SCB_W + o) = dec;                        \
                    *(LAS f32x4*)(bp + SCB_VV + o) = (f32x4){bf_lo(vr[cb].x), bf_hi(vr[cb].x), bf_lo(vr[cb].y), bf_hi(vr[cb].y)}; } } \
            ss += __shfl_xor(ss, 16); ss += __shfl_xor(ss, 32); bs += __shfl_xor(bs, 16); bs += __shfl_xor(bs, 32); \
            const float inv = __builtin_amdgcn_rsqf(fmaxf(ss, 1e-24f));     \
              \
            float s_bb = 0.f, s_kk = 0.f, c_g = 0.f, c_h = 0.f, c_br = 0.f, c_kr = 0.f; const bool pB_ = (s16_ & 2) != 0;     \
            f32x4 Ga = (f32x4){0.f, 0.f, 0.f, 0.f}, Gr = Ga;     \
            _Pragma("unroll") for (int cb = 0; cb < 4; ++cb) { float kn[4], bo[4], bq[4], kq[4]; \
                const float r4[4] = {bf_lo(rr[cb].x), bf_hi(rr[cb].x), bf_lo(rr[cb].y), bf_hi(rr[cb].y)}, k4[4] = {bf_lo(kr[cb].x), bf_hi(kr[cb].x), bf_lo(kr[cb].y), bf_hi(kr[cb].y)}; \
                const f32x4 kkw = *(const LAS f32x4*)(cst + 128 + 16 * cb + 4 * q_); \
                const f32x4 dcv = *(const LAS f32x4*)(bp + SCB_W + t_ * SCP + (16 * cb + 4 * q_) * 4), wp = *(const LAS f32x4*)(bp + SCB_W + (t_ ^ 1) * SCP + (16 * cb + 4 * q_) * 4);     \
                const f32x4 azq = *(const LAS f32x4*)(scr_ + cb * 256), kzq = *(const LAS f32x4*)(bp + SCB_BKZ + t_ * SCP + (16 * cb + 4 * q_) * 4); \
                _Pragma("unroll") for (int e = 0; e < 4; ++e) { kn[e] = k4[e] * kkw[e] * inv; bo[e] = kn[e] * azq[e]; \
                    bq[e] = dpp_g<0xB1>(bo[e]); kq[e] = dpp_g<0xB1>(kzq[e]); \
                    const float ao = -kn[e], rd = r4[e] * dcv[e]; \
                    s_bb += bo[e] * r4[e]; s_kk += kzq[e] * r4[e]; c_g += bq[e] * ao; c_h += kq[e] * ao; c_br += bq[e] * rd; c_kr += kq[e] * rd; } \
                float fb[4], fk[4], xa[4], xr[4], wq[4], sA[4], sB[4]; \
                _Pragma("unroll") for (int e = 0; e < 4; ++e) { const float wpr = dcv[e] * wp[e], wo = dpp_g<0x4E>(wpr);     \
                    const float mb = odd_ ? 1.0f : wp[e], ma = odd_ ? -wp[e] : -1.0f, mr = odd_ ? wpr : dcv[e]; \
                    fb[e] = bo[e] * mb; fk[e] = kzq[e] * mb; xa[e] = kn[e] * ma; xr[e] = r4[e] * mr; wq[e] = wpr * wo; sA[e] = pB_ ? 1.0f : wo; sB[e] = pB_ ? wo : 1.0f; \
                    const float fb0 = dpp_g<0x00>(fb[e]), fk0 = dpp_g<0x00>(fk[e]), fb1 = dpp_g<0x55>(fb[e]), fk1 = dpp_g<0x55>(fk[e]);     \
                    Ga[0] += fb0 * xa[e]; Ga[1] += fk0 * xa[e]; Ga[2] += fb1 * xa[e]; Ga[3] += fk1 * xa[e]; Gr[0] += fb0 * xr[e]; Gr[1] += fk0 * xr[e]; Gr[2] += fb1 * xr[e]; Gr[3] += fk1 * xr[e]; } \
                *(LAS f32x4*)(bp + SCB_W + t_ * SCP + (16 * cb + 4 * q_) * 4) = (f32x4){wq[0], wq[1], wq[2], wq[3]};            \
                *(LAS u32x4*)(bp + SCB_BKZ + t_ * SCP + (16 * cb + 4 * q_) * 4) = (u32x4){pack_bf16(fb[0] * sA[0], fk[0] * sA[0]), pack_bf16(fb[1] * sA[1], fk[1] * sA[1]), pack_bf16(fb[2] * sA[2], fk[2] * sA[2]), pack_bf16(fb[3] * sA[3], fk[3] * sA[3])};     \
                *(LAS u32x2*)(bp + SCB_AR + t_ * SCP + ((cb >> 1) * 4 + q_) * 16 + (cb & 1) * 8) = (u32x2){pack_bf16(xa[0] * sB[0], xa[1] * sB[1]), pack_bf16(xa[2] * sB[2], xa[3] * sB[3])};            \
                *(LAS u32x2*)(bp + SCB_AR + t_ * SCP + 128 + ((cb >> 1) * 4 + q_) * 16 + (cb & 1) * 8) = (u32x2){pack_bf16(xr[0] * sB[0], xr[1] * sB[1]), pack_bf16(xr[2] * sB[2], xr[3] * sB[3])}; }   \
            s_bb += __shfl_xor(s_bb, 16); s_bb += __shfl_xor(s_bb, 32); s_kk += __shfl_xor(s_kk, 16); s_kk += __shfl_xor(s_kk, 32); \
            c_g += __shfl_xor(c_g, 16); c_g += __shfl_xor(c_g, 32); c_h += __shfl_xor(c_h, 16); c_h += __shfl_xor(c_h, 32); \
            c_br += __shfl_xor(c_br, 16); c_br += __shfl_xor(c_br, 32); c_kr += __shfl_xor(c_kr, 16); c_kr += __shfl_xor(c_kr, 32); \
            _Pragma("unroll") for (int e = 0; e < 4; ++e) { Ga[e] += __shfl_xor(Ga[e], 16); Ga[e] += __shfl_xor(Ga[e], 32); Gr[e] += __shfl_xor(Gr[e], 16); Gr[e] += __shfl_xor(Gr[e], 32); } \
            if (q_ == 0) { LAS float* ps_ = (LAS float*)(lds + SC_PS + (buf_) * 512) + (t_ >> 1) * 8;     \
                if (odd_) { ps_[0] = c_g; ps_[1] = c_h; } \
                if (pB_) { LAS float* pq_ = (LAS float*)(lds + SC_PS + (buf_) * 512) + 64 + (t_ >> 2) * 16 + (odd_ ? 4 : 0); *(LAS f32x4*)pq_ = Ga; } \
                  \
                const float o0_ = odd_ ? c_br : s_bb, o1_ = odd_ ? c_kr : s_kk, o2_ = odd_ ? s_bb : 0.f, o3_ = odd_ ? s_kk : 0.f; \
                const unsigned ow0_ = pack_bf16(o0_, o1_), ow1_ = pack_bf16(o2_, o3_), gw0_ = pack_bf16(Gr[0], Gr[1]), gw1_ = pack_bf16(Gr[2], Gr[3]); \
                *(LAS u32x4*)(lds + SC_CY + (buf_) * 256 + (t_ >> 2) * 64 + (t_ & 3) * 16) = pB_ ? (u32x4){gw0_, gw1_, ow0_, ow1_} : (u32x4){ow0_, ow1_, 0u, 0u}; \
                BON[((size_t)z * T + SC_ROW((cc_) * SC_L + t_)) * 16 + hd] = bs; } } while (0)
#define SC_FLUSH(cc, slot_) do { const LAS float* yb_ = (const LAS float*)(lds + SC_Y + (slot_) * 4096); const int ft_ = lane >> 2, fj_ = (lane & 3) * 16;     \
            const f32x4 y0_ = *(const LAS f32x4*)(yb_ + ft_ * 64 + fj_), y1_ = *(const LAS f32x4*)(yb_ + ft_ * 64 + fj_ + 4), y2_ = *(const LAS f32x4*)(yb_ + ft_ * 64 + fj_ + 8), y3_ = *(const LAS f32x4*)(yb_ + ft_ * 64 + fj_ + 12); \
            bf16_t* yp_ = Y + ((size_t)z * T + SC_ROW((cc) * SC_L + ft_)) * D + hd * 64 + fj_; \
            *(u32x4*)yp_ = (u32x4){pack_bf16(y0_[0], y0_[1]), pack_bf16(y0_[2], y0_[3]), pack_bf16(y1_[0], y1_[1]), pack_bf16(y1_[2], y1_[3])}; \
            *(u32x4*)(yp_ + 8) = (u32x4){pack_bf16(y2_[0], y2_[1]), pack_bf16(y2_[2], y2_[3]), pack_bf16(y3_[0], y3_[1]), pack_bf16(y3_[2], y3_[3])}; } while (0)
            volatile LAS int* rdy = (volatile LAS int*)(lds + SC_FLG); volatile LAS int* prog = rdy + 8;
            SC_LOADC(pw);
            for (int n = pw; n < NCH; n += 4) {
                const int buf = n % SC_NB;
                if (n >= SC_NB) { lds_wait_ge(prog + 0, n - 4); lds_wait_ge(prog + 1, n - 4); lds_wait_ge(prog + 2, n - 4); lds_wait_ge(prog + 3, n - 4); SC_FLUSH(n - SC_NB, buf); }
                SC_XFORM(n, buf);
                asm volatile("s_waitcnt lgkmcnt(0)" ::: "memory");
                if (lane == 0) rdy[buf] = n + 1;
                if (n + 4 < NCH) SC_LOADC(n + 4);
            }
            for (int c = NCH - SC_NB; c < NCH; ++c) if (((c + SC_NB) & 3) == pw) {
                lds_wait_ge(prog + 0, c + 1); lds_wait_ge(prog + 1, c + 1); lds_wait_ge(prog + 2, c + 1); lds_wait_ge(prog + 3, c + 1); SC_FLUSH(c, c % SC_NB); }
#undef SC_ROW
#undef SC_LOADC
#undef SC_XFORM
#undef SC_FLUSH
        } else {
            const int w = F.wave, i16 = lane & 15, q = lane >> 4;
            f32x4 Sd[4];
#pragma unroll
            for (int k = 0; k < 4; ++k) Sd[k] = (f32x4){0.f, 0.f, 0.f, 0.f};
            const int m4 = i16 & 3;
            const int w_off = (4 * q) * 4, bkz_off = i16 * 4, vv_off = (16 * w + i16) * 4, ar_off = (m4 & 1) * SCP + (m4 >> 1) * 128 + q * 16;
            const bool qodd = (q & 1) != 0; const unsigned qmask = (q & 2) ? 0u : 0xffffffffu;
            const int bkq_off = (2 * (q & 1)) * SCP + i16 * 4;
            __builtin_amdgcn_s_setprio(3);
            typedef short s16x4v __attribute__((ext_vector_type(4)));
#define ST_LD(o_, Q_) do { _Pragma("unroll") for (int j = 0; j < 4; ++j) o_.vv[j] = *(const LAS float*)(bp + SCB_VV + (4 * (Q_) + j) * SCP + vv_off); \
        o_.a1lo = *(const LAS bf16x8*)(bp + SCB_AR + (4 * (Q_)) * SCP + ar_off); o_.a1hi = *(const LAS bf16x8*)(bp + SCB_AR + (4 * (Q_)) * SCP + 64 + ar_off); \
        o_.a2lo = *(const LAS bf16x8*)(bp + SCB_AR + (4 * (Q_) + 2) * SCP + ar_off); o_.a2hi = *(const LAS bf16x8*)(bp + SCB_AR + (4 * (Q_) + 2) * SCP + 64 + ar_off); } while (0)
#define ST_STEP(o_, Q_) do { \
        const bf16x8 Bd0 = __builtin_bit_cast(bf16x8, (u32x4){pack_bf16(Sd[0][0], Sd[0][1]), pack_bf16(Sd[0][2], Sd[0][3]), pack_bf16(Sd[1][0], Sd[1][1]), pack_bf16(Sd[1][2], Sd[1][3])}); \
        const bf16x8 Bd1 = __builtin_bit_cast(bf16x8, (u32x4){pack_bf16(Sd[2][0], Sd[2][1]), pack_bf16(Sd[2][2], Sd[2][3]), pack_bf16(Sd[3][0], Sd[3][1]), pack_bf16(Sd[3][2], Sd[3][3])}); \
        const f32x4 d1a = __builtin_amdgcn_mfma_f32_16x16x32_bf16(o_.a1lo, Bd0, (f32x4){0.f, 0.f, 0.f, 0.f}, 0, 0, 0); \
        const f32x4 e1a = __builtin_amdgcn_mfma_f32_16x16x32_bf16(o_.a2lo, Bd0, (f32x4){0.f, 0.f, 0.f, 0.f}, 0, 0, 0); \
        const f32x4 dd = __builtin_amdgcn_mfma_f32_16x16x32_bf16(o_.a1hi, Bd1, d1a, 0, 0, 0); \
        const f32x4 ee = __builtin_amdgcn_mfma_f32_16x16x32_bf16(o_.a2hi, Bd1, e1a, 0, 0, 0); \
        const LAS float* pa_ = psp + (2 * (Q_)) * 8; const LAS float* pg_ = psp + 64 + (Q_) * 16; \
        const f32x4 pA0 = *(const LAS f32x4*)pa_, pB0 = *(const LAS f32x4*)(pa_ + 8), g0 = *(const LAS f32x4*)pg_, g1 = *(const LAS f32x4*)(pg_ + 4); \
        const u32x2 cyw = *(const LAS u32x2*)(cyp + (Q_) * 64); \
        f32x4 wv[4]; u32x2 bk[4]; \
        _Pragma("unroll") for (int k = 0; k < 4; ++k) { wv[k] = *(const LAS f32x4*)(bp + SCB_W + (4 * (Q_)) * SCP + 64 * k + w_off); \
            bk[k] = (u32x2){*(const LAS unsigned*)(bkp + (4 * (Q_)) * SCP + 64 * k), *(const LAS unsigned*)(bkp + (4 * (Q_) + 1) * SCP + 64 * k)}; } \
        const float v1 = o_.vv[0], v2 = o_.vv[1], v3 = o_.vv[2], v4 = o_.vv[3]; \
        const float u1 = dd[0]; \
        const float u2 = dd[1] + u1 * pA0[0] + v1 * pA0[1]; \
        const float u3 = ee[0] + u1 * g0[0] + v1 * g0[1] + u2 * g0[2] + v2 * g0[3]; \
        const float u4 = ee[1] + u1 * g1[0] + v1 * g1[1] + u2 * g1[2] + v2 * g1[3] + u3 * pB0[0] + v3 * pB0[1]; \
        const float x0_ = qodd ? u3 : u1, x1_ = qodd ? v3 : v1, x2_ = qodd ? u4 : u2, x3_ = qodd ? v4 : v2;     \
        const unsigned b2lo = pack_bf16(x0_, x1_) & qmask, b2hi = pack_bf16(x2_, x3_) & qmask;     \
        const s16x4v B2 = __builtin_bit_cast(s16x4v, (u32x2){b2lo, b2hi}); \
        _Pragma("unroll") for (int k = 0; k < 4; ++k) Sd[k] = __builtin_amdgcn_mfma_f32_16x16x16bf16_1k(__builtin_bit_cast(s16x4v, bk[k]), B2, Sd[k] * wv[k], 0, 0, 0); \
        const f32x4 yv = __builtin_amdgcn_mfma_f32_16x16x16bf16_1k(__builtin_bit_cast(s16x4v, cyw), B2, (f32x4){dd[2], dd[3], ee[2], ee[3]}, 0, 0, 0);     \
        yb[(4 * (Q_)) * 64 + 16 * w + i16] = yv[0]; yb[(4 * (Q_) + 1) * 64 + 16 * w + i16] = yv[1]; yb[(4 * (Q_) + 2) * 64 + 16 * w + i16] = yv[2]; yb[(4 * (Q_) + 3) * 64 + 16 * w + i16] = yv[3]; } while (0)
            struct StepOps { float vv[4]; bf16x8 a1lo, a1hi, a2lo, a2hi; };
            volatile LAS int* rdy = (volatile LAS int*)(lds + SC_FLG); volatile LAS int* prog = rdy + 8;
            int buf = 0;
            for (int c = 0; c < NCH; ++c) {
                const LAS unsigned char* bp = lds + buf * SCB_SIZE; LAS float* yb = (LAS float*)(lds + SC_Y + buf * 4096);
                const LAS unsigned char* bkp = bp + SCB_BKZ + bkq_off;
                const LAS float* psp = (const LAS float*)(lds + SC_PS + buf * 512);
                const LAS unsigned char* cyp = lds + SC_CY + buf * 256 + (i16 & 3) * 16 + (q & 1) * 8;
                lds_wait_ge(rdy + buf, c + 1);
                const bool conv = (c & 3) == w; float tv[16]; const int tr = u * NCH + c, ttab = tr >> 14, trow = tr & 16383;
                int ln2 = lane; asm volatile("" : "+v"(ln2));
                if (conv) fp8_row_load(F.in[ttab ? 30 : 29] + (size_t)N_EXPERTS * 1024, trow, ln2, tv);
                else {
#pragma unroll
                    for (int i = 0; i < 16; ++i) tv[i] = 0.f; }
                StepOps oa, ob; ST_LD(oa, 0);
                ST_LD(ob, 1); ST_STEP(oa, 0);
                ST_LD(oa, 2); ST_STEP(ob, 1);
                ST_LD(ob, 3); ST_STEP(oa, 2);
                ST_STEP(ob, 3);
                asm volatile("s_waitcnt lgkmcnt(0)" ::: "memory");
                if (lane == 0) prog[w] = c + 1;
                if (conv) fp8_row_store(tv, trow, ln2, F.ws + (ttab ? WS_PV1 : WS_PU1), (float*)(F.ws + WS_PSC) + (2 + ttab) * N_EXPERTS);
                buf = (buf + 1 == SC_NB) ? 0 : buf + 1;
            }
#undef ST_LD
#undef ST_STEP
            __builtin_amdgcn_s_setprio(0);
            __builtin_amdgcn_s_setprio(0);
        }
    }
    __syncthreads();
}

DI void unpack8(const u32x4 w, float* o) { o[0] = bf_lo(w.x); o[1] = bf_hi(w.x); o[2] = bf_lo(w.y); o[3] = bf_hi(w.y); o[4] = bf_lo(w.z); o[5] = bf_hi(w.z); o[6] = bf_lo(w.w); o[7] = bf_hi(w.w); }
DI void p_rwkv_post(const Frame& F) {
    const bf16_t* RK = (const bf16_t*)(F.ws + WS1_RK); const bf16_t* Y = (const bf16_t*)(F.ws + WS1_Y); const float* BON = (const float*)(F.ws + WS1_BON);
    const bf16_t* G = (const bf16_t*)(F.ws + WS1_G); bf16_t* A3 = (bf16_t*)(F.ws + WS1_A3);
    const float* ln_g = F.in[24]; const float* ln_b = F.in[25];
    const int lane = F.lane, c0 = 16 * lane, hd = lane >> 2;
    for (int t = F.bid * NWAVES + F.wave; t < T; t += F.G * NWAVES) {
        float y[16], tmp[16], vv[16], gg[16];
        unpack8(*(const u32x4*)(Y + (size_t)t * D + c0), y); unpack8(*(const u32x4*)(Y + (size_t)t * D + c0 + 8), y + 8);
        unpack8(*(const u32x4*)(Y + ((size_t)T + t) * D + c0), tmp); unpack8(*(const u32x4*)(Y + ((size_t)T + t) * D + c0 + 8), tmp + 8);
        unpack8(*(const u32x4*)(RK + (size_t)t * RW_N + 2048 + c0), vv); unpack8(*(const u32x4*)(RK + (size_t)t * RW_N + 2048 + c0 + 8), vv + 8);
        unpack8(*(const u32x4*)(G + (size_t)t * D + c0), gg); unpack8(*(const u32x4*)(G + (size_t)t * D + c0 + 8), gg + 8);
        const float bon = BON[(size_t)t * 16 + hd] + BON[((size_t)T + t) * 16 + hd];
        float sm = 0.f;
#pragma unroll
        for (int e = 0; e < 16; ++e) { y[e] += tmp[e]; sm += y[e]; }
        sm += __shfl_xor(sm, 1); sm += __shfl_xor(sm, 2);
        const float mu = sm * (1.0f / 64.0f);
        float vr = 0.f;
#pragma unroll
        for (int e = 0; e < 16; ++e) { const float d = y[e] - mu; vr += d * d; }
        vr += __shfl_xor(vr, 1); vr += __shfl_xor(vr, 2);
        const float rs = rsqrtf(vr * (1.0f / 64.0f) + 64e-5f);
        float o[16];
#pragma unroll
        for (int q = 0; q < 4; ++q) { const f32x4 lg = *(const f32x4*)(ln_g + c0 + 4 * q), lb = *(const f32x4*)(ln_b + c0 + 4 * q);
#pragma unroll
            for (int e = 0; e < 4; ++e) { const int i = 4 * q + e; o[i] = ((y[i] - mu) * rs * lg[e] + lb[e] + bon * vv[i]) * gg[i]; } }
        u32x4 w0, w1; w0.x = pack_bf16(o[0], o[1]); w0.y = pack_bf16(o[2], o[3]); w0.z = pack_bf16(o[4], o[5]); w0.w = pack_bf16(o[6], o[7]);
        w1.x = pack_bf16(o[8], o[9]); w1.y = pack_bf16(o[10], o[11]); w1.z = pack_bf16(o[12], o[13]); w1.w = pack_bf16(o[14], o[15]);
        *(u32x4*)(A3 + (size_t)t * D + c0) = w0; *(u32x4*)(A3 + (size_t)t * D + c0 + 8) = w1;
    }
}
__global__ void __launch_bounds__(NTHREADS, 2) mega_fwd(Params P) {
    extern __shared__ __attribute__((aligned(16))) unsigned char lds_raw[];
    Frame F;
    F.lds = (LAS unsigned char*)lds_raw;
    F.tid = threadIdx.x; F.lane = F.tid & 63; F.wave = __builtin_amdgcn_readfirstlane(F.tid >> 6);
    F.G = gridDim.x; F.bid = blockIdx.x; F.in = P.in; F.out = P.out; F.ws = P.ws;
    volatile LAS unsigned* bst = (volatile LAS unsigned*)(F.lds + LDS_BAR_OFF);
    if (F.tid == 0) { bst[0] = 0u; bst[1] = 0u; bst[2] = 0u; bst[3] = 0u; }
    __syncthreads();
    XcdBarrier bar = xcd_barrier_post((unsigned*)(P.ws + WS_CTL), bst);
    const int lo = P.ph_lo, hi = P.ph_hi;
#ifdef ONLY_PHASE
#define IN(k) ((k) == ONLY_PHASE && lo <= (k) && (k) < hi)
#else
#define IN(k) (lo <= (k) && (k) < hi)
#endif
#define SEAM(k) do { if (IN(k) && IN((k) + 1)) xcd_barrier(bar); } while (0)
#define LSEAM(k) do { if (IN(k) && IN((k) + 1)) __syncthreads(); } while (0)
#define LAUNDER(T, dst, src) T dst; { unsigned long long _v = (unsigned long long)(src); unsigned _lo = (unsigned)_v, _hi = (unsigned)(_v >> 32); asm volatile("" : "+s"(_lo), "+s"(_hi)); dst = (T)(__attribute__((address_space(1))) unsigned char*)(((unsigned long long)_hi << 32) | _lo); }
#define PH_BEGIN LAUNDER(unsigned char*, ws, P.ws) LAUNDER(float*, outp, P.out) F.ws = ws; F.out = outp; \
    const float* mod0 = (const float*)(ws + WS_MOD); const float* mod1 = mod0 + 8 * 6144; const float* norm_g = P.in[4]; bf16_t* H = (bf16_t*)(ws + WS_H); bf16_t* H2 = (bf16_t*)(ws + WS1_H2); \
    (void)mod0; (void)mod1; (void)norm_g; (void)H; (void)H2;

    if (IN(0)) { PH_BEGIN p0_prologue(F); } SEAM(0);
    if (IN(1)) { PH_BEGIN p_norm<false>(F, P.in[0], norm_g + 0 * 1024, mod0, 0, 1024, H); } SEAM(1);
    if (IN(2)) { PH_BEGIN pg8::Gemm g{H, (const bf16_t*)(ws + WS_WIN_T), T, IN_W, 1024, 1024, 1024}; pg8::StaticOrder S; S.init(T, IN_W, F.G, F.bid);
        pg8::EpiBf16<0> E{(bf16_t*)(ws + WS_QKV), IN_W}; pg8::gemm_phase(F.lds, g, S, E);
        p0_late_weights(F, (T / 256) * (IN_W / 256)); } SEAM(2);
    if (IN(3)) { PH_BEGIN p_qkprep(F); } SEAM(3);
    if (IN(4)) { PH_BEGIN p_attention<3>(F); } SEAM(4);
    if (IN(5)) { PH_BEGIN pg8::Gemm g{(const bf16_t*)(ws + WS_O), (const bf16_t*)(ws + WS_WOUT_T), T, 1024, 1024, 1024, 1024}; pg8::StaticOrder S; S.init(T, 1024, F.G, F.bid);
        pg8::EpiResid<false> E{P.in[0], (bf16_t*)(ws + WS_XB), mod0 + 2048, (float*)(ws + WS_SSQ)}; pg8::gemm_phase(F.lds, g, S, E); } SEAM(5);
    if (IN(7)) { PH_BEGIN pg8::Gemm g{(const bf16_t*)(ws + WS_XB), (const bf16_t*)outp, T, 2048, 1024, 1024, 1024}; pg8::BatchOrder S; S.init(T, 2048, F.G, F.bid);
        pg8::EpiQ E{(bf16_t*)(ws + WS_PQ), PQ_LD, (const float*)(ws + WS_SSQ), (const float*)(ws + WS_BQ), nullptr, -1}; { pg8::Unit u0; E.prep(F.lds, S.next(0, u0) ? u0.pm : -1, F.tid); } pg8::gemm_phase(F.lds, g, S, E); } SEAM(7);
    if (IN(8)) { PH_BEGIN p_peer_topk(F, (const bf16_t*)(ws + WS_PQ), (const bf16_t*)(ws + WS_SK), (int*)(ws + WS_EIDX), (float*)(ws + WS_GATE)); } LSEAM(8);
    if (IN(9)) { PH_BEGIN p_peer_gather<false>(F, norm_g + 1 * 1024, mod0, ws + WS_PU0, ws + WS_PV0, (const float*)(ws + WS_PSC), (const float*)(ws + WS_PSC) + N_EXPERTS, (const int*)(ws + WS_EIDX), (const float*)(ws + WS_GATE), mod0 + 5120, (bf16_t*)(ws + WS_XB), outp); } SEAM(9);
    if (IN(10)) { PH_BEGIN p_rwkv_prep(F, (const bf16_t*)(ws + WS_XB), norm_g + 2 * 1024, mod1, P.in[11], (bf16_t*)(ws + WS1_X6)); } SEAM(10);
    if (IN(11)) { PH_BEGIN pg8::Gemm g{(const bf16_t*)(ws + WS1_X6), (const bf16_t*)(ws + WS_WRW_T), 6 * T, RW_N, 1024, 1024, 1024}; pg8::RwOrder S; S.init(F.G, F.bid);
        pg8::EpiBf16<1> E{(bf16_t*)(ws + WS1_RK), RW_N}; pg8::gemm_phase(F.lds, g, S, E);
        p0_late_weights2(F); } SEAM(11);
    if (IN(12)) { PH_BEGIN pg8::Gemm g{(const bf16_t*)(ws + WS1_RK) + 3584, (const bf16_t*)(ws + WS_G2_T), T, 1024, 256, RW_N, 256}; pg8::StaticOrder S; S.init(T, 1024, F.G, F.bid);
        pg8::EpiBf16<0> E{(bf16_t*)(ws + WS1_G), 1024}; pg8::gemm_phase(F.lds, g, S, E); }
    if (IN(13)) { PH_BEGIN p_rwkv_scan(F); } SEAM(13);
    if (IN(14)) { PH_BEGIN p_rwkv_post(F); } SEAM(14);
    if (IN(15)) { PH_BEGIN pg8::Gemm g{(const bf16_t*)(ws + WS1_A3), (const bf16_t*)(ws + WS_WO_T), T, 1024, 1024, 1024, 1024}; pg8::StaticOrder S; S.init(T, 1024, F.G, F.bid);
        pg8::EpiResid<true> E{ws + WS_XB, (bf16_t*)(ws + WS_XB), mod1 + 2048, (float*)(ws + WS_SSQ)}; pg8::gemm_phase(F.lds, g, S, E); } SEAM(15);
    if (IN(17)) { PH_BEGIN pg8::Gemm g{(const bf16_t*)(ws + WS_XB), (const bf16_t*)outp + (size_t)8 * 2048 * 1024, T, 2048, 1024, 1024, 1024}; pg8::BatchOrder S; S.init(T, 2048, F.G, F.bid);
        pg8::EpiQ E{(bf16_t*)(ws + WS1_PQ), PQ_LD, (const float*)(ws + WS_SSQ), (const float*)(ws + WS_BQ) + 8 * 2048, nullptr, -1}; { pg8::Unit u0; E.prep(F.lds, S.next(0, u0) ? u0.pm : -1, F.tid); } pg8::gemm_phase(F.lds, g, S, E); } SEAM(17);
    if (IN(18)) { PH_BEGIN p_peer_topk(F, (const bf16_t*)(ws + WS1_PQ), (const bf16_t*)(ws + WS_SK) + (size_t)16 * 128 * 128, (int*)(ws + WS1_EIDX), (float*)(ws + WS1_GATE)); } LSEAM(18);
    if (IN(19)) { PH_BEGIN p_peer_gather<true>(F, norm_g + 3 * 1024, mod1, ws + WS_PU1, ws + WS_PV1, (const float*)(ws + WS_PSC) + 2 * N_EXPERTS, (const float*)(ws + WS_PSC) + 3 * N_EXPERTS, (const int*)(ws + WS1_EIDX), (const float*)(ws + WS1_GATE), mod1 + 5120, (bf16_t*)(ws + WS_XB), outp); }
    if (hi <= 5) { const f32x4* s = (const f32x4*)P.in[0]; f32x4* d = (f32x4*)P.out;
        for (size_t i = (size_t)F.bid * NTHREADS + F.tid; i < (size_t)T * D / 4; i += (size_t)F.G * NTHREADS) d[i] = s[i]; }
#undef IN
#undef SEAM
#undef LSEAM
}

#ifndef PH_HI
#define PH_HI 20
#endif
extern "C" void kernel_launch(void* const* d_in, const int* in_sizes, int n_in, void* d_out, int out_size, void* d_ws, size_t ws_size, hipStream_t stream) {
    static int grid = 0;
    if (grid == 0) {
        if (n_in != 31 || out_size != T * D || ws_size < WS_END) { fprintf(stderr, "kernel_launch: unexpected shapes (n_in %d, out %d, ws %zu)\n", n_in, out_size, ws_size); grid = -1; return; }
        int dev = 0, cus = 0, per_cu = 0;
        if (hipGetDevice(&dev) != hipSuccess || hipDeviceGetAttribute(&cus, hipDeviceAttributeMultiprocessorCount, dev) != hipSuccess) { grid = -1; return; }
        if (hipFuncSetAttribute((const void*)mega_fwd, hipFuncAttributeMaxDynamicSharedMemorySize, LDS_BYTES) != hipSuccess) { fprintf(stderr, "kernel_launch: hipFuncSetAttribute failed\n"); grid = -1; return; }
        if (hipOccupancyMaxActiveBlocksPerMultiprocessor(&per_cu, (const void*)mega_fwd, NTHREADS, LDS_BYTES) != hipSuccess || per_cu < 1) { fprintf(stderr, "kernel_launch: occupancy query says %d\n", per_cu); (void)hipGetLastError(); grid = -1; return; }
        grid = cus;
    }
    if (grid < 0) return;
    (void)hipMemsetAsync((char*)d_ws + WS_CTL, 0, CTL_ZERO_BYTES, stream);
    Params p{};
    for (int i = 0; i < 31; ++i) p.in[i] = (const float*)d_in[i];
    p.out = (float*)d_out; p.ws = (unsigned char*)d_ws; p.ph_lo = 0; p.ph_hi = PH_HI;
    hipLaunchKernelGGL(mega_fwd, dim3(grid), dim3(NTHREADS), LDS_BYTES, stream, p);
}
```

```cpp
#include <hip/hip_runtime.h>
#include <cstdio>
#include <cstdint>

#define DI __device__ __forceinline__
#define LAS __attribute__((address_space(3)))
typedef unsigned short bf16_t;
typedef short bf16x8 __attribute__((ext_vector_type(8)));
typedef short s16x4 __attribute__((ext_vector_type(4)));
typedef float f32x2 __attribute__((ext_vector_type(2)));
typedef float f32x4 __attribute__((ext_vector_type(4)));
typedef float f32x16 __attribute__((ext_vector_type(16)));
typedef unsigned u32x2 __attribute__((ext_vector_type(2)));
typedef unsigned u32x4 __attribute__((ext_vector_type(4)));
typedef __bf16 bf16x2v __attribute__((ext_vector_type(2)));

DI unsigned pack_bf16(float lo, float hi) { bf16x2v p; p[0] = (__bf16)lo; p[1] = (__bf16)hi; return __builtin_bit_cast(unsigned, p); }
DI float bf_lo(unsigned u) { return __uint_as_float(u << 16); }
DI float bf_hi(unsigned u) { return __uint_as_float(u & 0xffff0000u); }
DI float bf1(bf16_t v) { return __uint_as_float(((unsigned)v) << 16); }
DI float wave_sum(float v) {
#pragma unroll
    for (int o = 32; o > 0; o >>= 1) v += __shfl_xor(v, o);
    return v;
}
DI float sigmoidf_(float x) { return 1.0f / (1.0f + __expf(-x)); }

constexpr int D = 1024, BATCH = 8, SEQ = 2048, T = BATCH * SEQ;
constexpr int IN_W = 2304;
constexpr int NTHREADS = 512, NWAVES = 8;
constexpr int PQ_LD = 2112;
constexpr int N_EXPERTS = 16384;
constexpr float LOG2E = 1.4426950408889634f;
constexpr float QSCALE = 0.125f * LOG2E;
constexpr size_t MiB = 1ull << 20;

constexpr size_t WS_CTL   = 0;
constexpr size_t CTL_ZERO_BYTES = 16384;
constexpr size_t WS_MOD   = 64 * 1024;
constexpr size_t WS_PSC   = 512 * 1024;
constexpr size_t WS_WIN_T = 1 * MiB;
constexpr size_t WS_WOUT_T= 6 * MiB;
constexpr size_t WS_WRW_T = 8 * MiB;
constexpr size_t WS_W2_T  = 22 * MiB;
constexpr size_t WS_SSQ   = 22 * MiB;
constexpr size_t WS_BQ    = 768 * 1024;
constexpr size_t WS_WO_T  = 27 * MiB;
constexpr size_t WS_WQ_T  = 29 * MiB;
constexpr size_t WS_SK    = 37 * MiB;
constexpr size_t WS_PU1   = 38 * MiB;
constexpr size_t WS_PV1   = 54 * MiB;
constexpr size_t WS_XB    = 70 * MiB;
constexpr size_t WS_PU0   = 102 * MiB;
constexpr size_t WS_PV0   = 134 * MiB;
constexpr size_t WS_ACT   = 166 * MiB;
constexpr size_t WS_H     = WS_ACT + 0 * MiB;
constexpr size_t WS_QKV   = WS_ACT + 32 * MiB;
constexpr size_t WS_QA    = WS_ACT + 104 * MiB;
constexpr size_t WS_KA    = WS_ACT + 120 * MiB;
constexpr size_t WS_VAT   = WS_ACT + 136 * MiB;
constexpr size_t WS_QB    = WS_ACT + 152 * MiB;
constexpr size_t WS_KB    = WS_ACT + 168 * MiB;
constexpr size_t WS_VBT   = WS_ACT + 172 * MiB;
constexpr size_t WS_O     = WS_ACT + 176 * MiB;
constexpr size_t WS_PQ    = WS_ACT + 208 * MiB;
constexpr size_t WS_EIDX  = WS_ACT + 276 * MiB;
constexpr size_t WS_GATE  = WS_ACT + 284 * MiB;
constexpr size_t WS_O0S   = WS_ACT + 292 * MiB;
constexpr size_t WS1_RK   = 102 * MiB;
constexpr size_t WS1_DEC  = 222 * MiB;
constexpr size_t WS1_AZ   = 350 * MiB;
constexpr size_t WS1_G    = 414 * MiB;
constexpr size_t WS1_Y    = 446 * MiB;
constexpr size_t WS1_BON  = 510 * MiB;
constexpr size_t WS1_X6   = 222 * MiB;
constexpr size_t WS1_A3   = 222 * MiB;
constexpr size_t WS1_H2   = 254 * MiB;
constexpr size_t WS1_PQ   = 286 * MiB;
constexpr size_t WS1_EIDX = 354 * MiB;
constexpr size_t WS1_GATE = 362 * MiB;
constexpr size_t WS_END   = 512 * MiB;
constexpr int RW_N = 3840, W2_N = 4096, W2_K = 512;
constexpr size_t WS_G2_T  = 26 * MiB;

constexpr int LDS_BYTES = 147456;
constexpr int LDS_BAR_OFF = 147456 - 64;
#define XB_TMO      128
#define XB_XCNT(j)  (256  + 64 * (j))
#define XB_XSUB(j)  (1280 + 64 * (j))
#define XB_XGEN(j)  (2304 + 64 * (j))
#define XB_TOP      3328
#define XB_TOPGEN   3392
#define XCD_BAR_WORDS 3456
#define XB_SPIN_CAP (1u << 18)

__device__ __forceinline__ unsigned xb_ld(unsigned* p)              { return __hip_atomic_load(p, __ATOMIC_RELAXED, __HIP_MEMORY_SCOPE_AGENT); }
__device__ __forceinline__ unsigned xb_add(unsigned* p, unsigned v) { return __hip_atomic_fetch_add(p, v, __ATOMIC_RELAXED, __HIP_MEMORY_SCOPE_AGENT); }
__device__ __forceinline__ unsigned xb_xcc_id() { return (unsigned)__builtin_amdgcn_s_getreg((3 << 11) | 20) & 0xFu; }
#define XB_SPIN(cond, bar) do { unsigned _sp = 0; while (cond) { __builtin_amdgcn_s_sleep(1); \
    if ((++_sp & 255u) == 0u) { if (xb_ld(&(bar)[XB_TMO])) break; if (_sp > XB_SPIN_CAP) { atomicAdd(&(bar)[XB_TMO], 1u); break; } } } } while (0)

struct XcdBarrier { unsigned* bar; unsigned x; volatile LAS unsigned* st; };

__device__ __forceinline__ XcdBarrier xcd_barrier_post(unsigned* bar, volatile LAS unsigned* st) {
    XcdBarrier b; b.bar = bar; b.x = xb_xcc_id(); b.st = st;
    if (threadIdx.x == 0) (void)xb_add(&bar[XB_XCNT(b.x)], 1u);
    return b;
}
__device__ __forceinline__ void xcd_barrier_complete(unsigned* bar, unsigned x, unsigned& nloc, unsigned& nx) {
    const unsigned G = gridDim.x * gridDim.y * gridDim.z;
    unsigned sum, cnt, mine, sp = 0u;
    for (;;) {
        sum = 0u; cnt = 0u; mine = 0u;
#pragma unroll
        for (unsigned j = 0; j < 16; ++j) { const unsigned c = xb_ld(&bar[XB_XCNT(j)]); sum += c; cnt += (c > 0u) ? 1u : 0u; mine = (j == x) ? c : mine; }
        if (sum == G) break;
        __builtin_amdgcn_s_sleep(1);
        if ((++sp & 255u) == 0u) { if (xb_ld(&bar[XB_TMO])) break; if (sp > XB_SPIN_CAP) { atomicAdd(&bar[XB_TMO], 1u); break; } }
    }
    nloc = mine > 0u ? mine : 1u; nx = cnt > 0u ? cnt : 1u;
}
__device__ __forceinline__ void xcd_barrier(const XcdBarrier& b) {
    asm volatile("s_waitcnt vmcnt(0)" ::: "memory");
    __syncthreads();
    if (threadIdx.x == 0) {
        unsigned* bar; { unsigned long long pv = (unsigned long long)b.bar; unsigned plo = (unsigned)pv, phi = (unsigned)(pv >> 32); asm volatile("" : "+s"(plo), "+s"(phi)); bar = (unsigned*)(__attribute__((address_space(1))) unsigned*)(((unsigned long long)phi << 32) | plo); }
        __builtin_amdgcn_s_waitcnt(0);
        unsigned nloc = b.st[0], nx = b.st[1];
        if (nloc == 0u) { xcd_barrier_complete(bar, b.x, nloc, nx); b.st[0] = nloc; b.st[1] = nx; }
        const unsigned old = xb_add(&bar[XB_XSUB(b.x)], 1u);
        const unsigned gen = old / nloc;
        if (old + 1u == (gen + 1u) * nloc) {
            __builtin_amdgcn_fence(__ATOMIC_RELEASE, "agent");
            asm volatile("s_waitcnt vmcnt(0)" ::: "memory");
            const unsigned og = xb_add(&bar[XB_TOP], 1u);
            const unsigned tg = og / nx;
            if (og + 1u == (tg + 1u) * nx) xb_add(&bar[XB_TOPGEN], 1u);
            else XB_SPIN(xb_ld(&bar[XB_TOPGEN]) == tg, bar);
            __builtin_amdgcn_fence(__ATOMIC_ACQUIRE, "agent");
            xb_add(&bar[XB_XGEN(b.x)], 1u);
            asm volatile("s_waitcnt vmcnt(0)" ::: "memory");
        } else {
            XB_SPIN(xb_ld(&bar[XB_XGEN(b.x)]) == gen, bar);
            __builtin_amdgcn_fence(__ATOMIC_ACQUIRE, "agent");
            asm volatile("s_waitcnt vmcnt(0)" ::: "memory");
        }
    }
    __syncthreads();
}
namespace pg8 {
constexpr int BM = 256, BK = 64, HALF = 128, HTB = HALF * BK * 2, STAGE_BYTES = 8 * HTB, NXCD = 8, WGM = 8;
__host__ __device__ __forceinline__ int lds_byte(int r, int c) { const int st = (r >> 4) * 2 + (c >> 5), rr = r & 15, cc = c & 31, ob = rr * 64 + cc * 2; return st * 1024 + (ob ^ (((ob >> 9) & 1) << 5)); }
__host__ __device__ __forceinline__ void stage_rc(int b, int& R, int& C) { const int st = b / 1024, sb = b % 1024, swz = sb ^ (((sb >> 9) & 1) << 5); R = (st >> 1) * 16 + swz / 64; C = (st & 1) * 32 + (swz % 64) / 2; }
__host__ __device__ __forceinline__ int perm32(int rho) { const int n = rho >> 4, i = rho & 15; return 8 * (i >> 2) + 4 * n + (i & 3); }

struct Unit { int pm, pn; };
struct Gemm { const bf16_t* A; const bf16_t* Bt; int M, N, K, lda, ldb; };

struct StaticOrder {
    int nM, nN, nwg, G, c;
    __device__ void init(int M, int N, int G_, int c_) { nM = M / BM; nN = N / BM; nwg = nM * nN; G = G_; c = c_; }
    __device__ __forceinline__ bool next(int i, Unit& u) const {
        const long L = (long)i * G + c; if (L >= nwg) return false;
        int wgid = (int)L; { const int q = nwg / NXCD, r = nwg % NXCD, xcd = wgid % NXCD, off = wgid / NXCD; wgid = (xcd < r ? xcd * (q + 1) : r * (q + 1) + (xcd - r) * q) + off; }
        const int nig = WGM * nN, gid = wgid / nig, fm = gid * WGM, gsz = (nM - fm) < WGM ? (nM - fm) : WGM;
        u.pm = fm + ((wgid % nig) % gsz); u.pn = (wgid % nig) / gsz; return true;
    }
};

struct BatchOrder {
    StaticOrder S;
    __device__ void init(int M, int N, int G_, int c_) { S.init(M, N, G_, c_); }
    __device__ __forceinline__ bool next(int i, Unit& u) const { if (!S.next(i, u)) return false; u.pn += (u.pm / (SEQ / BM)) * S.nN; return true; }
};

struct RwOrder {
    int G, c;
    __device__ void init(int G_, int c_) { G = G_; c = c_; }
    __device__ __forceinline__ bool next(int i, Unit& u) const {
        int grp, pm, pn;
        if ((G & 7) == 0) { const int x = c & 7, n = i * (G >> 3) + (c >> 3); if (n >= 120) return false;
            const int pmh = n / 15, e = n % 15; pm = x + 8 * pmh;
            if (e < 12) { grp = e >> 2; pn = grp * 4 + (e & 3); } else { grp = 3 + (e - 12); pn = 12 + (e - 12); } }
        else { const int L = i * G + c; if (L >= 960) return false;
            if (L < 768) { grp = L >> 8; pm = L & 63; pn = grp * 4 + ((L >> 6) & 3); } else { const int w = L - 768; grp = 3 + (w >> 6); pm = w & 63; pn = 12 + (grp - 3); } }
        u.pm = grp * 64 + pm; u.pn = pn; return true;
    }
};
template <class Epi, class Sched>
__device__ __forceinline__ void gemm_phase(LAS unsigned char* lds, const Gemm g, const Sched& S, const Epi& E) {
    const int tid = threadIdx.x, wid = __builtin_amdgcn_readfirstlane(tid >> 6), lane = tid & 63, wr = wid >> 2, wc = wid & 3, fr = lane & 15, fq = lane >> 4;
    const int K = g.K, nt = K / BK;
    unsigned voffA[2], voffB[2];
#pragma unroll
    for (int i = 0; i < 2; ++i) { int R, C; stage_rc(tid * 16 + i * 8192, R, C); const int Rb = Epi::PERM ? ((R & ~31) + perm32(R & 31)) : R;
        voffA[i] = (unsigned)(R * g.lda + C) * 2u; voffB[i] = (unsigned)(Rb * g.ldb + C) * 2u; }
    const size_t kstep = (size_t)(BK * 2);
    const size_t hstepA = (size_t)HALF * g.lda * 2, hstepB = (size_t)HALF * g.ldb * 2;
    const size_t tstepA = 2 * hstepA, tstepB = 2 * hstepB;
    const unsigned ldsw = (unsigned)wid * 1024u;
    const int aoff = lds_byte(wr * 64 + fr, fq * 8), boff = lds_byte(wc * 32 + fr, fq * 8);
#define PG8_SA(b, h) (((b) * 2 + (h)) * HTB)
#define PG8_SB(b, h) ((4 + (b) * 2 + (h)) * HTB)
#define PG8_STAGE(bufoff, gbase, voff) do { _Pragma("unroll") for (int _i = 0; _i < 2; ++_i) \
        __builtin_amdgcn_global_load_lds((const unsigned*)((const char*)(gbase) + (voff)[_i]), (LAS unsigned*)(lds + (bufoff) + ldsw + _i * 8192), 16, 0, 0); } while (0)
#define PG8_LDA(dst, b, h) do { _Pragma("unroll") for (int m = 0; m < 4; ++m) _Pragma("unroll") for (int k = 0; k < 2; ++k) dst[m][k] = *(const LAS bf16x8*)(lds + PG8_SA(b, h) + aoff + m * 2048 + k * 1024); } while (0)
#define PG8_LDB(dst, b, h) do { _Pragma("unroll") for (int n = 0; n < 2; ++n) _Pragma("unroll") for (int k = 0; k < 2; ++k) dst[n][k] = *(const LAS bf16x8*)(lds + PG8_SB(b, h) + boff + n * 2048 + k * 1024); } while (0)
#define PG8_MMA(ai, bj, At, Bt) do { __builtin_amdgcn_s_setprio(1); _Pragma("unroll") for (int m = 0; m < 4; ++m) _Pragma("unroll") for (int n = 0; n < 2; ++n) _Pragma("unroll") for (int k = 0; k < 2; ++k) \
        acc[ai][bj][m][n] = __builtin_amdgcn_mfma_f32_16x16x32_bf16(Bt[n][k], At[m][k], acc[ai][bj][m][n], 0, 0, 0); __builtin_amdgcn_s_setprio(0); } while (0)
#define PG8_WAIT_V(n) asm volatile("s_waitcnt vmcnt(" #n ")" ::: "memory")
#define PG8_WAIT_L(n) asm volatile("s_waitcnt lgkmcnt(" #n ")" ::: "memory")
#define PG8_BAR __builtin_amdgcn_s_barrier()
#define PG8_SCHED __builtin_amdgcn_sched_barrier(0)
    Unit cur, nxt; int ui = 0;
    if (!S.next(0, cur)) return;
    f32x4 acc[2][2][4][2];
#pragma unroll
    for (int a = 0; a < 2; ++a)
#pragma unroll
        for (int b = 0; b < 2; ++b)
#pragma unroll
            for (int m = 0; m < 4; ++m)
#pragma unroll
                for (int n = 0; n < 2; ++n) acc[a][b][m][n] = (f32x4){0.f, 0.f, 0.f, 0.f};
    bf16x8 At[4][2], B0[2][2], B1[2][2];
    const char* cA = (const char*)g.A + (size_t)cur.pm * tstepA; const char* cB = (const char*)g.Bt + (size_t)cur.pn * tstepB;
    PG8_STAGE(PG8_SB(0, 0), cB, voffB); PG8_STAGE(PG8_SA(0, 0), cA, voffA); PG8_STAGE(PG8_SB(0, 1), cB + hstepB, voffB); PG8_STAGE(PG8_SA(0, 1), cA + hstepA, voffA);
    if (wr == 1) PG8_BAR;
    PG8_WAIT_V(4); PG8_BAR;
    PG8_STAGE(PG8_SB(1, 0), cB + kstep, voffB); PG8_STAGE(PG8_SA(1, 0), cA + kstep, voffA); PG8_STAGE(PG8_SB(1, 1), cB + hstepB + kstep, voffB);
    PG8_WAIT_V(6); PG8_BAR;
    for (;;) {
        const bool has_next = S.next(ui + 1, nxt);
        const char* nA = has_next ? (const char*)g.A + (size_t)nxt.pm * tstepA : cA; const char* nB = has_next ? (const char*)g.Bt + (size_t)nxt.pn * tstepB : cB;
        for (int t = 0; t < nt; t += 2) {
            const bool last = (t == nt - 2);
            const char* a1 = cA + (size_t)(t + 1) * kstep;
            const char* a2 = last ? nA : cA + (size_t)(t + 2) * kstep; const char* b2 = last ? nB : cB + (size_t)(t + 2) * kstep;
            const char* a3 = a2 + kstep; const char* b3 = b2 + kstep;
            PG8_LDB(B0, 0, 0); PG8_SCHED; PG8_LDA(At, 0, 0); PG8_STAGE(PG8_SA(1, 1), a1 + hstepA, voffA);
            PG8_WAIT_L(8); PG8_BAR; PG8_WAIT_L(0); PG8_MMA(0, 0, At, B0); PG8_BAR; PG8_SCHED;
            PG8_LDB(B1, 0, 1); PG8_STAGE(PG8_SB(0, 0), b2, voffB);
            PG8_BAR; PG8_WAIT_L(0); PG8_MMA(0, 1, At, B1); PG8_BAR;
            PG8_LDA(At, 0, 1); PG8_STAGE(PG8_SA(0, 0), a2, voffA);
            PG8_BAR; PG8_WAIT_L(0); PG8_MMA(1, 0, At, B0); PG8_BAR; PG8_SCHED;
            PG8_STAGE(PG8_SB(0, 1), b2 + hstepB, voffB);
            PG8_WAIT_V(6); PG8_BAR; PG8_MMA(1, 1, At, B1); PG8_BAR;
            PG8_LDB(B0, 1, 0); PG8_SCHED; PG8_LDA(At, 1, 0); PG8_STAGE(PG8_SA(0, 1), a2 + hstepA, voffA);
            PG8_WAIT_L(8); PG8_BAR; PG8_WAIT_L(0); PG8_MMA(0, 0, At, B0); PG8_BAR; PG8_SCHED;
            PG8_LDB(B1, 1, 1); PG8_STAGE(PG8_SB(1, 0), b3, voffB);
            PG8_BAR; PG8_WAIT_L(0); PG8_MMA(0, 1, At, B1); PG8_BAR;
            PG8_LDA(At, 1, 1); PG8_STAGE(PG8_SA(1, 0), a3, voffA);
            PG8_BAR; PG8_WAIT_L(0); PG8_MMA(1, 0, At, B0); PG8_BAR; PG8_SCHED;
            PG8_STAGE(PG8_SB(1, 1), b3 + hstepB, voffB);
            PG8_WAIT_V(6); PG8_BAR; PG8_MMA(1, 1, At, B1); PG8_BAR;
        }
        E(acc, cur, wr, wc, fr, fq);
        if (!has_next) break;
#pragma unroll
        for (int a = 0; a < 2; ++a)
#pragma unroll
            for (int b = 0; b < 2; ++b)
#pragma unroll
                for (int m = 0; m < 4; ++m)
#pragma unroll
                    for (int n = 0; n < 2; ++n) acc[a][b][m][n] = (f32x4){0.f, 0.f, 0.f, 0.f};
        cur = nxt; cA = nA; cB = nB; ++ui;
    }
    PG8_WAIT_V(0);
    if (wr == 0) PG8_BAR;
    PG8_BAR;
#undef PG8_SA
#undef PG8_SB
#undef PG8_STAGE
#undef PG8_LDA
#undef PG8_LDB
#undef PG8_MMA
#undef PG8_WAIT_V
#undef PG8_WAIT_L
#undef PG8_BAR
#undef PG8_SCHED
}

template <int ACT> struct EpiBf16 {
    static constexpr bool PERM = true;
    __device__ __forceinline__ void prefetch(LAS unsigned char*, const Unit&, int) const {}
    bf16_t* O; int ldc;
    __device__ __forceinline__ void operator()(const f32x4 (&acc)[2][2][4][2], const Unit& u, int wr, int wc, int fr, int fq) const {
        const int row0 = (ACT == 1 ? (u.pm & 63) : u.pm) * BM + wr * 64 + fr; const int col0 = u.pn * BM + wc * 32 + 8 * fq;
#pragma unroll
        for (int ai = 0; ai < 2; ++ai)
#pragma unroll
            for (int m = 0; m < 4; ++m) { bf16_t* rowp = O + (size_t)(row0 + ai * HALF + m * 16) * ldc + col0;
#pragma unroll
                for (int bj = 0; bj < 2; ++bj) { f32x4 v0 = acc[ai][bj][m][0], v1 = acc[ai][bj][m][1];
                    if (ACT == 1) { const int c = col0 + bj * HALF;
                        if (c >= 3072 && c < 3200) {
#pragma unroll
                            for (int e = 0; e < 4; ++e) { v0[e] = tanhf(v0[e]); v1[e] = tanhf(v1[e]); } }
                        else if (c >= 3584 && c < 3712) {
#pragma unroll
                            for (int e = 0; e < 4; ++e) { v0[e] = sigmoidf_(v0[e]); v1[e] = sigmoidf_(v1[e]); } } }
                    u32x4 w; w.x = pack_bf16(v0[0], v0[1]); w.y = pack_bf16(v0[2], v0[3]); w.z = pack_bf16(v1[0], v1[1]); w.w = pack_bf16(v1[2], v1[3]);
                    *(u32x4*)(rowp + bj * HALF) = w; } }
    }
};
template <bool IN_BF16> struct EpiResid {
    static constexpr bool PERM = false;
    __device__ __forceinline__ void prefetch(LAS unsigned char* lds, const Unit& u, int tid) const {
        constexpr int RB = IN_BF16 ? 512 : 1024, LPR = RB / 128, NL = 256 * LPR;
        const char* base = (const char*)xin + ((size_t)u.pm * BM * D + (size_t)u.pn * BM) * (IN_BF16 ? 2 : 4);
#pragma unroll
        for (int i = 0; i < NL / NTHREADS; ++i) { const int ln = i * NTHREADS + tid, r = ln / LPR, c = ln % LPR;
            __builtin_amdgcn_global_load_lds((const unsigned*)(base + (size_t)r * D * (IN_BF16 ? 2 : 4) + c * 128), (LAS unsigned*)(lds + STAGE_BYTES + 2048 + (tid >> 6) * 256), 4, 0, 0); }
    }
    const void* xin; bf16_t* out; const float* gate; float* ssq;
    __device__ __forceinline__ void operator()(const f32x4 (&acc)[2][2][4][2], const Unit& u, int wr, int wc, int fr, int fq) const {
        const int row0 = u.pm * BM + wr * 64 + fr, col0 = u.pn * BM + wc * 32 + 4 * fq;
        const float* gp = gate + (size_t)((u.pm * BM) / SEQ) * 6144 + col0;
        f32x4 gv[2][2];
#pragma unroll
        for (int bj = 0; bj < 2; ++bj)
#pragma unroll
            for (int n = 0; n < 2; ++n) gv[bj][n] = *(const f32x4*)(gp + bj * HALF + n * 16);
#pragma unroll
        for (int ai = 0; ai < 2; ++ai)
#pragma unroll
            for (int m = 0; m < 4; ++m) { const size_t off = (size_t)(row0 + ai * HALF + m * 16) * D + col0; float ss = 0.f;
#pragma unroll
                for (int bj = 0; bj < 2; ++bj)
#pragma unroll
                    for (int n = 0; n < 2; ++n) { f32x4 xv;
                        if (IN_BF16) { const u32x2 w = *(const u32x2*)((const bf16_t*)xin + off + bj * HALF + n * 16); xv = (f32x4){bf_lo(w.x), bf_hi(w.x), bf_lo(w.y), bf_hi(w.y)}; }
                        else xv = *(const f32x4*)((const float*)xin + off + bj * HALF + n * 16);
                        const f32x4 r = xv + gv[bj][n] * acc[ai][bj][m][n];
                        ss += (r[0] * r[0] + r[1] * r[1]) + (r[2] * r[2] + r[3] * r[3]);
                        *(u32x2*)(out + off + bj * HALF + n * 16) = (u32x2){pack_bf16(r[0], r[1]), pack_bf16(r[2], r[3])}; }
                ss += __shfl_xor(ss, 16); ss += __shfl_xor(ss, 32);
                if (fq == 0) ssq[(size_t)(row0 + ai * HALF + m * 16) * 16 + u.pn * 4 + wc] = ss; }
    }
};
struct EpiQ {
    static constexpr bool PERM = true;
    __device__ __forceinline__ void prefetch(LAS unsigned char*, const Unit&, int) const {}
    bf16_t* O; int ldc; const float* ssq; const float* bq; const LAS float* rl; int pm_l;
    __device__ __forceinline__ void prep(LAS unsigned char* lds, int pm, int tid) { LAS float* w = (LAS float*)(lds + STAGE_BYTES); rl = w; pm_l = pm;
        if (pm >= 0 && tid < BM) { const f32x4* sp = (const f32x4*)(ssq + (size_t)(pm * BM + tid) * 16); const f32x4 s4 = (sp[0] + sp[1]) + (sp[2] + sp[3]);
            w[tid] = rsqrtf(((s4[0] + s4[1]) + (s4[2] + s4[3])) * (1.0f / 1024.0f) + 1e-6f); }
        __syncthreads(); }
    __device__ __forceinline__ void operator()(const f32x4 (&acc)[2][2][4][2], const Unit& u, int wr, int wc, int fr, int fq) const {
        const int row0 = u.pm * BM + wr * 64 + fr; const int col0 = (u.pn & 7) * BM + wc * 32 + 8 * fq;
        const float* bp = bq + (size_t)(u.pn >> 3) * 2048 + col0;
        f32x4 b0[2], b1[2];
#pragma unroll
        for (int bj = 0; bj < 2; ++bj) { b0[bj] = *(const f32x4*)(bp + bj * HALF); b1[bj] = *(const f32x4*)(bp + bj * HALF + 4); }
#pragma unroll
        for (int ai = 0; ai < 2; ++ai)
#pragma unroll
            for (int m = 0; m < 4; ++m) { const int r = row0 + ai * HALF + m * 16; bf16_t* rowp = O + (size_t)r * ldc + col0;
                float rinv;
                if (u.pm == pm_l) rinv = rl[wr * 64 + fr + ai * HALF + m * 16];
                else { const f32x4* sp = (const f32x4*)(ssq + (size_t)r * 16); const f32x4 s4 = (sp[0] + sp[1]) + (sp[2] + sp[3]);
                    rinv = rsqrtf(((s4[0] + s4[1]) + (s4[2] + s4[3])) * (1.0f / 1024.0f) + 1e-6f); }
#pragma unroll
                for (int bj = 0; bj < 2; ++bj) { const f32x4 v0 = acc[ai][bj][m][0] * rinv + b0[bj], v1 = acc[ai][bj][m][1] * rinv + b1[bj];
                    u32x4 w; w.x = pack_bf16(v0[0], v0[1]); w.y = pack_bf16(v0[2], v0[3]); w.z = pack_bf16(v1[0], v1[1]); w.w = pack_bf16(v1[2], v1[3]);
                    *(u32x4*)(rowp + bj * HALF) = w; } }
    }
};
struct EpiRw2 {
    static constexpr bool PERM = true;
    __device__ __forceinline__ void prefetch(LAS unsigned char*, const Unit&, int) const {}
    float* DEC; bf16_t* AZ; bf16_t* G; const float* w0; const float* a0;
    __device__ __forceinline__ void operator()(const f32x4 (&acc)[2][2][4][2], const Unit& u, int wr, int wc, int fr, int fq) const {
        const int row0 = u.pm * BM + wr * 64 + fr; const int col0 = u.pn * BM + wc * 32 + 8 * fq;
        const int cls = u.pn < 8 ? 0 : 1;
#pragma unroll
        for (int bj = 0; bj < 2; ++bj) {
            const int c = col0 + bj * HALF;
            f32x4 b0 = (f32x4){0.f, 0.f, 0.f, 0.f}, b1 = b0;
            if (cls == 0) { b0 = *(const f32x4*)(w0 + c); b1 = *(const f32x4*)(w0 + c + 4); }
            else if (cls == 1) { b0 = *(const f32x4*)(a0 + c - 2048); b1 = *(const f32x4*)(a0 + c - 2048 + 4); }
#pragma unroll
            for (int ai = 0; ai < 2; ++ai)
#pragma unroll
                for (int m = 0; m < 4; ++m) { const size_t r = (size_t)(row0 + ai * HALF + m * 16);
                    f32x4 v0 = acc[ai][bj][m][0] + b0, v1 = acc[ai][bj][m][1] + b1;
                    if (cls == 0) {
#pragma unroll
                        for (int e = 0; e < 4; ++e) { v0[e] = __expf(-0.6065306597126334f * sigmoidf_(v0[e])); v1[e] = __expf(-0.6065306597126334f * sigmoidf_(v1[e])); }
                        *(f32x4*)(DEC + r * 2048 + c) = v0; *(f32x4*)(DEC + r * 2048 + c + 4) = v1;
                    } else {
                        if (cls == 1) {
#pragma unroll
                            for (int e = 0; e < 4; ++e) { v0[e] = sigmoidf_(v0[e]); v1[e] = sigmoidf_(v1[e]); } }
                        u32x4 w; w.x = pack_bf16(v0[0], v0[1]); w.y = pack_bf16(v0[2], v0[3]); w.z = pack_bf16(v1[0], v1[1]); w.w = pack_bf16(v1[2], v1[3]);
                        if (cls == 1) *(u32x4*)(AZ + r * 2048 + (c - 2048)) = w; else *(u32x4*)(G + r * 1024 + (c - 4096)) = w;
                    } }
        }
    }
};
}
struct Params { const float* in[31]; float* out; unsigned char* ws; int ph_lo, ph_hi; };
struct Frame {
    LAS unsigned char* lds; int tid, lane, wave, G, bid;
    const float* const* in; float* out; unsigned char* ws;
};

DI void fp8_row_store(const float (&v)[16], int row, int lane, unsigned char* dst, float* scale);
DI void fp8_row_load(const float* src, int row, int lane, float (&v)[16]);
DI void p0_convert_fp8(const Frame& F, const float* src, unsigned char* dst, float* scale, int widx, int nw);
template <bool SPLIT> DI void p0_mod(const Frame& F) {
    constexpr int NKG = SPLIT ? 21 : 42, NB = SPLIT ? 4 : 2, NTH = NKG * 12;
    const float* c = F.in[1]; const float* ada_w = F.in[2]; const float* ada_b = F.in[3];
    float* mod = (float*)(F.ws + WS_MOD);
    LAS float* sc = (LAS float*)F.lds;
    LAS float* part = (LAS float*)(F.lds + 32768);
    for (int i = F.tid; i < 8 * 1024; i += NTHREADS) { const int b = i >> 10, k = i & 1023; const float v = c[i]; sc[k * 8 + b] = v * sigmoidf_(v); }
    __syncthreads();
    for (int cb = F.bid; cb < 256; cb += F.G) {
        const int colbase = cb * 48, l = colbase / 6144, n0 = colbase % 6144;
        if (F.tid < NTH) {
            const int q = F.tid % 12, kg = F.tid / 12, krot = (cb * 148) & 1023;
            const float* wp = ada_w + (size_t)l * 1024 * 6144 + n0 + 4 * q;
            f32x4 acc[8];
#pragma unroll
            for (int b = 0; b < 8; ++b) acc[b] = (f32x4){0.f, 0.f, 0.f, 0.f};
#pragma unroll
            for (int bt = 0; bt < NB; ++bt) {
                f32x4 w[13];
#pragma unroll
                for (int i = 0; i < 13; ++i) { const int k = kg + NKG * (13 * bt + i), kk = ((k < 1024 ? k : 1023) + krot) & 1023; w[i] = *(const f32x4*)(wp + (size_t)kk * 6144); }
#pragma unroll
                for (int i = 0; i < 13; ++i) { const int k = kg + NKG * (13 * bt + i), kk = ((k < 1024 ? k : 1023) + krot) & 1023;
                    const f32x4 wv = k < 1024 ? w[i] : (f32x4){0.f, 0.f, 0.f, 0.f};
                    const f32x4 s0 = *(const LAS f32x4*)(sc + kk * 8), s1 = *(const LAS f32x4*)(sc + kk * 8 + 4);
                    acc[0] += wv * s0[0]; acc[1] += wv * s0[1]; acc[2] += wv * s0[2]; acc[3] += wv * s0[3];
                    acc[4] += wv * s1[0]; acc[5] += wv * s1[1]; acc[6] += wv * s1[2]; acc[7] += wv * s1[3]; }
            }
#pragma unroll
            for (int e = 0; e < 4; ++e) { LAS float* pp = part + ((size_t)kg * 48 + 4 * q + e) * 8;
                *(LAS f32x4*)pp = (f32x4){acc[0][e], acc[1][e], acc[2][e], acc[3][e]}; *(LAS f32x4*)(pp + 4) = (f32x4){acc[4][e], acc[5][e], acc[6][e], acc[7][e]}; }
        } else if (SPLIT && F.wave >= 4) {
            p0_convert_fp8(F, F.in[29], F.ws + WS_PU0, (float*)(F.ws + WS_PSC), F.bid * 4 + (F.wave - 4), F.G * 4);
        }
        __syncthreads();
        if (F.tid < 256) for (int o = F.tid; o < 384; o += 256) {
            const int cl = o >> 3, b = o & 7; const int col = colbase + cl;
            float s = ada_b[col];
#pragma unroll
            for (int kg = 0; kg < NKG; ++kg) s += part[(kg * 48 + cl) * 8 + b];
            mod[((size_t)l * 8 + b) * 6144 + n0 + cl] = s;
        }
        __syncthreads();
    }
}
DI void p0_transpose(const Frame& F, const float* src, int ld, int K, int N, bf16_t* dst, int ldd, const float* mix) {
    (void)mix;
    LAS float* tiles = (LAS float*)F.lds;
    const int tn = N / 64, nt = (K / 64) * tn;
    for (int t0 = F.bid; t0 < nt; t0 += 4 * F.G) {
        __syncthreads();
        f32x4 v[4][2];
#pragma unroll
        for (int q = 0; q < 4; ++q) { const int tt = t0 + q * F.G, t = tt < nt ? tt : t0; const int k0 = (t / tn) * 64, n0 = (t % tn) * 64;
#pragma unroll
            for (int h = 0; h < 2; ++h) { const int i = F.tid + h * NTHREADS, r = i >> 4, c4 = (i & 15) * 4; v[q][h] = *(const f32x4*)(src + (size_t)(k0 + r) * ld + n0 + c4); } }
#pragma unroll
        for (int q = 0; q < 4; ++q)
#pragma unroll
            for (int h = 0; h < 2; ++h) { const int i = F.tid + h * NTHREADS, r = i >> 4, c4 = (i & 15) * 4; LAS float* tp = tiles + q * 4160 + r * 65 + c4;
                tp[0] = v[q][h][0]; tp[1] = v[q][h][1]; tp[2] = v[q][h][2]; tp[3] = v[q][h][3]; }
        __syncthreads();
#pragma unroll
        for (int q = 0; q < 4; ++q) { const int t = t0 + q * F.G; if (t < nt) { const int k0 = (t / tn) * 64, n0 = (t % tn) * 64;
            const int n = F.tid >> 3, kc = (F.tid & 7) * 8;
            float w8[8];
#pragma unroll
            for (int e = 0; e < 8; ++e) w8[e] = tiles[q * 4160 + (kc + e) * 65 + n];
            u32x4 w; w.x = pack_bf16(w8[0], w8[1]); w.y = pack_bf16(w8[2], w8[3]); w.z = pack_bf16(w8[4], w8[5]); w.w = pack_bf16(w8[6], w8[7]);
            *(u32x4*)(dst + (size_t)(n0 + n) * ldd + k0 + kc) = w; } }
    }
    __syncthreads();
}
DI void p0_wqs(const Frame& F, const float* W, const float* g, const float* modl, bf16_t* dst) {
    LAS float* tiles = (LAS float*)F.lds;
    LAS float* gsl = (LAS float*)(F.lds + 69632);
    const int nt = 16 * 32;
    if (F.bid >= nt) return;
    __syncthreads();
    for (int i = F.tid; i < 8 * 1024; i += NTHREADS) gsl[i] = g[i & 1023] * (1.0f + modl[(size_t)(i >> 10) * 6144 + 4096 + (i & 1023)]);
    for (int t0 = F.bid; t0 < nt; t0 += 4 * F.G) {
        __syncthreads();
        f32x4 v[4][2];
#pragma unroll
        for (int q = 0; q < 4; ++q) { const int tt = t0 + q * F.G, t = tt < nt ? tt : t0; const int k0 = (t / 32) * 64, n0 = (t % 32) * 64;
#pragma unroll
            for (int h = 0; h < 2; ++h) { const int i = F.tid + h * NTHREADS, r = i >> 4, c4 = (i & 15) * 4; v[q][h] = *(const f32x4*)(W + (size_t)(k0 + r) * 2048 + n0 + c4); } }
#pragma unroll
        for (int q = 0; q < 4; ++q)
#pragma unroll
            for (int h = 0; h < 2; ++h) { const int i = F.tid + h * NTHREADS, r = i >> 4, c4 = (i & 15) * 4; LAS float* tp = tiles + q * 4160 + r * 65 + c4;
                tp[0] = v[q][h][0]; tp[1] = v[q][h][1]; tp[2] = v[q][h][2]; tp[3] = v[q][h][3]; }
        __syncthreads();
        for (int q = 0; q < 4; ++q) { const int t = t0 + q * F.G; if (t < nt) { const int k0 = (t / 32) * 64, n0 = (t % 32) * 64;
            const int n = F.tid >> 3, kc = (F.tid & 7) * 8;
            float w8[8];
#pragma unroll
            for (int e = 0; e < 8; ++e) w8[e] = tiles[q * 4160 + (kc + e) * 65 + n];
#pragma unroll
            for (int b = 0; b < 8; ++b) { const f32x4 s0 = *(const LAS f32x4*)(gsl + b * 1024 + k0 + kc), s1 = *(const LAS f32x4*)(gsl + b * 1024 + k0 + kc + 4);
                u32x4 w; w.x = pack_bf16(w8[0] * s0[0], w8[1] * s0[1]); w.y = pack_bf16(w8[2] * s0[2], w8[3] * s0[3]);
                w.z = pack_bf16(w8[4] * s1[0], w8[5] * s1[1]); w.w = pack_bf16(w8[6] * s1[2], w8[7] * s1[3]);
                *(u32x4*)(dst + ((size_t)b * 2048 + n0 + n) * 1024 + k0 + kc) = w; } } }
    }
    __syncthreads();
}
DI void p0_bq(const Frame& F, const float* W, const float* modl, float* bq) {
    LAS float* shl = (LAS float*)F.lds;
    LAS float* part = (LAS float*)(F.lds + 32768);
    if (F.bid >= 128) return;
    __syncthreads();
    for (int i = F.tid; i < 8 * 1024; i += NTHREADS) { const int b = i >> 10, k = i & 1023; shl[k * 8 + b] = modl[(size_t)b * 6144 + 3072 + k]; }
    __syncthreads();
    for (int task = F.bid; task < 128; task += F.G) {
        const int cl = F.tid & 15, kp = F.tid >> 4; const float* wp = W + (size_t)(kp * 32) * 2048 + task * 16 + cl;
        float wv[32];
#pragma unroll
        for (int k = 0; k < 32; ++k) wv[k] = wp[(size_t)k * 2048];
        float a[8];
#pragma unroll
        for (int b = 0; b < 8; ++b) a[b] = 0.f;
#pragma unroll
        for (int k = 0; k < 32; ++k) { const float w = wv[k];
            const f32x4 s0 = *(const LAS f32x4*)(shl + (kp * 32 + k) * 8), s1 = *(const LAS f32x4*)(shl + (kp * 32 + k) * 8 + 4);
            a[0] += w * s0[0]; a[1] += w * s0[1]; a[2] += w * s0[2]; a[3] += w * s0[3]; a[4] += w * s1[0]; a[5] += w * s1[1]; a[6] += w * s1[2]; a[7] += w * s1[3]; }
#pragma unroll
        for (int b = 0; b < 8; ++b) part[(kp * 16 + cl) * 8 + b] = a[b];
        __syncthreads();
        if (F.tid < 128) { const int c2 = F.tid >> 3, b = F.tid & 7; float s = 0.f;
#pragma unroll
            for (int q = 0; q < 32; ++q) s += part[(q * 16 + c2) * 8 + b];
            bq[(size_t)b * 2048 + task * 16 + c2] = s; }
        __syncthreads();
    }
}
DI void p0_convert(const Frame& F, const float* src, bf16_t* dst, size_t n) {
    const size_t n8 = n / 8;
    for (size_t i = (size_t)F.bid * NTHREADS + F.tid; i < n8; i += (size_t)F.G * NTHREADS) {
        const f32x4 a = *(const f32x4*)(src + i * 8), b = *(const f32x4*)(src + i * 8 + 4);
        u32x4 w; w.x = pack_bf16(a[0], a[1]); w.y = pack_bf16(a[2], a[3]); w.z = pack_bf16(b[0], b[1]); w.w = pack_bf16(b[2], b[3]);
        *(u32x4*)(dst + i * 8) = w;
    }
}
DI void fp8_row_store(const float (&v)[16], int row, int lane, unsigned char* dst, float* scale) {
    float am = 0.f;
#pragma unroll
    for (int e = 0; e < 16; ++e) am = fmaxf(am, fabsf(v[e]));
#pragma unroll
    for (int o = 32; o > 0; o >>= 1) am = fmaxf(am, __shfl_xor(am, o));
    const float sc = am > 0.f ? am * (1.0f / 384.0f) : 1.0f, inv = 1.0f / sc;
    u32x4 w;
    { int t0 = 0; t0 = __builtin_amdgcn_cvt_pk_fp8_f32(v[0] * inv, v[1] * inv, t0, false); t0 = __builtin_amdgcn_cvt_pk_fp8_f32(v[2] * inv, v[3] * inv, t0, true); w.x = (unsigned)t0; }
    { int t0 = 0; t0 = __builtin_amdgcn_cvt_pk_fp8_f32(v[4] * inv, v[5] * inv, t0, false); t0 = __builtin_amdgcn_cvt_pk_fp8_f32(v[6] * inv, v[7] * inv, t0, true); w.y = (unsigned)t0; }
    { int t0 = 0; t0 = __builtin_amdgcn_cvt_pk_fp8_f32(v[8] * inv, v[9] * inv, t0, false); t0 = __builtin_amdgcn_cvt_pk_fp8_f32(v[10] * inv, v[11] * inv, t0, true); w.z = (unsigned)t0; }
    { int t0 = 0; t0 = __builtin_amdgcn_cvt_pk_fp8_f32(v[12] * inv, v[13] * inv, t0, false); t0 = __builtin_amdgcn_cvt_pk_fp8_f32(v[14] * inv, v[15] * inv, t0, true); w.w = (unsigned)t0; }
    *(u32x4*)(dst + (size_t)row * 1024 + 16 * lane) = w;
    if (lane == 0) scale[row] = sc;
}
DI void fp8_row_load(const float* src, int row, int lane, float (&v)[16]) {
#pragma unroll
    for (int j = 0; j < 4; ++j) { const f32x4 a = *(const f32x4*)(src + (size_t)row * 1024 + 256 * j + 4 * lane); v[4 * j] = a[0]; v[4 * j + 1] = a[1]; v[4 * j + 2] = a[2]; v[4 * j + 3] = a[3]; }
}
DI void p0_convert_fp8(const Frame& F, const float* src, unsigned char* dst, float* scale, int widx, int nw) {
    const int lane = F.lane;
    for (int row = widx; row < N_EXPERTS; row += 4 * nw) {
        float v0[16], v1[16], v2[16], v3[16];
        const int r1 = row + nw, r2 = row + 2 * nw, r3 = row + 3 * nw;
        fp8_row_load(src, row, lane, v0);
        if (r1 < N_EXPERTS) fp8_row_load(src, r1, lane, v1);
        if (r2 < N_EXPERTS) fp8_row_load(src, r2, lane, v2);
        if (r3 < N_EXPERTS) fp8_row_load(src, r3, lane, v3);
        fp8_row_store(v0, row, lane, dst, scale);
        if (r1 < N_EXPERTS) fp8_row_store(v1, r1, lane, dst, scale);
        if (r2 < N_EXPERTS) fp8_row_store(v2, r2, lane, dst, scale);
        if (r3 < N_EXPERTS) fp8_row_store(v3, r3, lane, dst, scale);
    }
}
DI void p0_prologue(const Frame& F) {
    const bool split = (F.G == 256);
    if (split) p0_mod<true>(F); else p0_mod<false>(F);
    bf16_t* WIN_T = (bf16_t*)(F.ws + WS_WIN_T);
    p0_transpose(F, F.in[5], IN_W, 1024, IN_W, WIN_T, 1024, nullptr);
    float* psc = (float*)(F.ws + WS_PSC);
    if (!split) p0_convert_fp8(F, F.in[29], F.ws + WS_PU0, psc + 0 * N_EXPERTS, F.bid * NWAVES + F.wave, F.G * NWAVES);
    p0_convert_fp8(F, F.in[30], F.ws + WS_PV0, psc + 1 * N_EXPERTS, F.bid * NWAVES + F.wave, F.G * NWAVES);
}
DI void p0_late_weights(const Frame& Fin, int nunits) {
    const int nmax = (nunits + Fin.G - 1) / Fin.G, nfull = nunits - (nmax - 1) * Fin.G;
    Frame F = Fin;
    if (nfull < Fin.G) { if (Fin.bid < nfull) return; F.bid = Fin.bid - nfull; F.G = Fin.G - nfull; }
    bf16_t* WRW_T = (bf16_t*)(F.ws + WS_WRW_T);
    p0_transpose(F, F.in[12] + 0 * 1048576, 1024, 1024, 1024, WRW_T + (size_t)0    * 1024, 1024, nullptr);
    p0_transpose(F, F.in[12] + 1 * 1048576, 1024, 1024, 1024, WRW_T + (size_t)1024 * 1024, 1024, nullptr);
    p0_transpose(F, F.in[12] + 2 * 1048576, 1024, 1024, 1024, WRW_T + (size_t)2048 * 1024, 1024, nullptr);
    p0_transpose(F, F.in[14] + 0 * 65536, 64, 1024, 64, WRW_T + (size_t)3072 * 1024, 1024, nullptr);
    p0_transpose(F, F.in[14] + 1 * 65536, 64, 1024, 64, WRW_T + (size_t)3136 * 1024, 1024, nullptr);
    p0_transpose(F, F.in[17] + 0 * 65536, 64, 1024, 64, WRW_T + (size_t)3328 * 1024, 1024, nullptr);
    p0_transpose(F, F.in[17] + 1 * 65536, 64, 1024, 64, WRW_T + (size_t)3392 * 1024, 1024, nullptr);
    p0_transpose(F, F.in[19], 128, 1024, 128, WRW_T + (size_t)3584 * 1024, 1024, nullptr);
    { const u32x4 z = (u32x4){0u, 0u, 0u, 0u};
      for (int i = F.bid * NTHREADS + F.tid; i < 3 * 128 * 1024 / 8; i += F.G * NTHREADS) { const int blk = i / (128 * 128), r = i % (128 * 128);
          ((u32x4*)(WRW_T + (size_t)(3200 + 256 * blk) * 1024))[r] = z; } }
    { const float* g2 = F.in[20]; bf16_t* G2_T = (bf16_t*)(F.ws + WS_G2_T);
      for (int i = F.bid * NTHREADS + F.tid; i < 1024 * 32; i += F.G * NTHREADS) { const int n = i % 1024, k0 = (i / 1024) * 8;
          float v[8];
#pragma unroll
          for (int e = 0; e < 8; ++e) v[e] = (k0 + e < 128) ? g2[(size_t)(k0 + e) * 1024 + n] : 0.f;
          u32x4 w; w.x = pack_bf16(v[0], v[1]); w.y = pack_bf16(v[2], v[3]); w.z = pack_bf16(v[4], v[5]); w.w = pack_bf16(v[6], v[7]);
          *(u32x4*)(G2_T + (size_t)n * 256 + k0) = w; } }
    p0_transpose(F, F.in[9], 1024, 1024, 1024, (bf16_t*)(F.ws + WS_WOUT_T), 1024, nullptr);
    p0_convert(F, F.in[28], (bf16_t*)(F.ws + WS_SK), (size_t)2 * 16 * 128 * 128);
    const float* mod = (const float*)(F.ws + WS_MOD);
    p0_wqs(F, F.in[27], F.in[4] + 1 * 1024, mod, (bf16_t*)F.out);
    { Frame Fr = F; Fr.bid = F.G - 1 - F.bid;
      p0_bq(Fr, F.in[27], mod, (float*)(F.ws + WS_BQ)); }
}
DI void p0_late_weights2(const Frame& Fin) {
    Frame F = Fin;
    if ((Fin.G & 7) == 0) { const int g8 = Fin.G >> 3, nmax = (120 + g8 - 1) / g8, nfull = 120 - (nmax - 1) * g8;
        if (nfull < g8) { if ((Fin.bid >> 3) < nfull) return; F.bid = ((Fin.bid >> 3) - nfull) * 8 + (Fin.bid & 7); F.G = (g8 - nfull) * 8; } }
    else { const int nmax = (960 + Fin.G - 1) / Fin.G, nfull = 960 - (nmax - 1) * Fin.G;
        if (nfull < Fin.G) { if (Fin.bid < nfull) return; F.bid = Fin.bid - nfull; F.G = Fin.G - nfull; } }
    p0_wqs(F, F.in[27] + (size_t)1024 * 2048, F.in[4] + 3 * 1024, (const float*)(F.ws + WS_MOD) + 8 * 6144, (bf16_t*)F.out + (size_t)8 * 2048 * 1024);
    p0_transpose(F, F.in[26], 1024, 1024, 1024, (bf16_t*)(F.ws + WS_WO_T), 1024, nullptr);
    { Frame Fr = F; Fr.bid = F.G - 1 - F.bid; p0_bq(Fr, F.in[27] + (size_t)1024 * 2048, (const float*)(F.ws + WS_MOD) + 8 * 6144, (float*)(F.ws + WS_BQ) + 8 * 2048); }
}

DI void norm_row16(const float* xr, int lane, float (&v)[16], float& rinv) {
    float ss = 0.f;
#pragma unroll
    for (int j = 0; j < 4; ++j) { const f32x4 a = *(const f32x4*)(xr + j * 256 + lane * 4); v[4 * j] = a[0]; v[4 * j + 1] = a[1]; v[4 * j + 2] = a[2]; v[4 * j + 3] = a[3];
        ss += a[0] * a[0] + a[1] * a[1] + a[2] * a[2] + a[3] * a[3]; }
    ss = wave_sum(ss);
    rinv = rsqrtf(ss * (1.0f / 1024.0f) + 1e-6f);
}
DI void ada_apply(float (&v)[16], float rinv, const float* g, const float* sc, const float* sh, int lane) {
#pragma unroll
    for (int j = 0; j < 4; ++j) { const int c = j * 256 + lane * 4;
        const f32x4 gg = *(const f32x4*)(g + c), s1 = *(const f32x4*)(sc + c), s0 = *(const f32x4*)(sh + c);
#pragma unroll
        for (int e = 0; e < 4; ++e) v[4 * j + e] = v[4 * j + e] * rinv * gg[e] * (1.0f + s1[e]) + s0[e]; }
}
DI void norm_row16_b(const bf16_t* xr, int lane, float (&v)[16], float& rinv) {
    float ss = 0.f;
#pragma unroll
    for (int j = 0; j < 4; ++j) { const u32x2 a = *(const u32x2*)(xr + j * 256 + lane * 4); v[4 * j] = bf_lo(a.x); v[4 * j + 1] = bf_hi(a.x); v[4 * j + 2] = bf_lo(a.y); v[4 * j + 3] = bf_hi(a.y);
        ss += v[4 * j] * v[4 * j] + v[4 * j + 1] * v[4 * j + 1] + v[4 * j + 2] * v[4 * j + 2] + v[4 * j + 3] * v[4 * j + 3]; }
    ss = wave_sum(ss);
    rinv = rsqrtf(ss * (1.0f / 1024.0f) + 1e-6f);
}
template <bool IN_BF16> DI void p_norm(const Frame& F, const void* x, const float* g, const float* modl  , int sh_off, int sc_off, bf16_t* H) {
    for (int r = F.bid * NWAVES + F.wave; r < T; r += F.G * NWAVES) {
        const int b = r / SEQ; float v[16], rinv;
        if (IN_BF16) norm_row16_b((const bf16_t*)x + (size_t)r * D, F.lane, v, rinv); else norm_row16((const float*)x + (size_t)r * D, F.lane, v, rinv);
        ada_apply(v, rinv, g, modl + (size_t)b * 6144 + sc_off, modl + (size_t)b * 6144 + sh_off, F.lane);
#pragma unroll
        for (int j = 0; j < 4; ++j) { u32x2 w; w.x = pack_bf16(v[4 * j], v[4 * j + 1]); w.y = pack_bf16(v[4 * j + 2], v[4 * j + 3]);
            *(u32x2*)(H + (size_t)r * D + j * 256 + F.lane * 4) = w; }
    }
}
DI void p_qkprep(const Frame& F) {
    const bf16_t* QKV = (const bf16_t*)(F.ws + WS_QKV);
    bf16_t* QA = (bf16_t*)(F.ws + WS_QA); bf16_t* KA = (bf16_t*)(F.ws + WS_KA); bf16_t* VAT = (bf16_t*)(F.ws + WS_VAT);
    bf16_t* QB = (bf16_t*)(F.ws + WS_QB); bf16_t* KB = (bf16_t*)(F.ws + WS_KB); bf16_t* VBT = (bf16_t*)(F.ws + WS_VBT);
    const float* qk_g = F.in[6];
    LAS float* cs = (LAS float*)F.lds;
    LAS unsigned short* vt = (LAS unsigned short*)(F.lds + 16384);
    for (int tile = F.bid; tile < T / 64; tile += F.G) {
        const int t0 = tile * 64, b = t0 / SEQ, s0 = t0 % SEQ;
        __syncthreads();
        for (int i = F.tid; i < 64 * 32; i += NTHREADS) { const int tok = i >> 5, ai = i & 31, axis = ai >> 4, ii = ai & 15;
            const int s = s0 + tok; const float pos = (float)(axis == 0 ? (s >> 6) : (s & 63));
            const float inv = exp2f(-(float)ii * (13.287712379549449f / 16.0f));
            float sn, cn; sincosf(pos * inv, &sn, &cn); cs[2 * i] = cn; cs[2 * i + 1] = sn; }
        for (int i = F.tid; i < 64 * 80; i += NTHREADS) { const int tok = i / 80, ch = i % 80; const int col = ch < 64 ? 1024 + 8 * ch : 2176 + 8 * (ch - 64);
            const u32x4 v = *(const u32x4*)(QKV + (size_t)(t0 + tok) * IN_W + col);
            *(LAS u32x4*)(vt + tok * 648 + 8 * ch) = v; }
        __syncthreads();
        const int tok = F.tid >> 3, j = F.tid & 7, s = s0 + tok;
        for (int slot = 0; slot < 26; ++slot) {
            int col, type; bf16_t* dst;
            if (slot < 8)       { col = 64 * slot;               type = 0; dst = QA + ((size_t)(b * 8 + slot) * SEQ + s) * 64; }
            else if (slot < 16) { col = 512 + 64 * (slot - 8);   type = 1; dst = KA + ((size_t)(b * 8 + slot - 8) * SEQ + s) * 64; }
            else if (slot < 24) { col = 1536 + 64 * (slot - 16); type = 2; dst = QB + ((size_t)(b * 8 + slot - 16) * SEQ + s) * 64; }
            else                { col = 2048 + 64 * (slot - 24); type = 3; dst = KB + ((size_t)(b * 2 + slot - 24) * SEQ + s) * 64; }
            const u32x4 raw = *(const u32x4*)(QKV + (size_t)(t0 + tok) * IN_W + col + 8 * j);
            float v[8]; v[0] = bf_lo(raw.x); v[1] = bf_hi(raw.x); v[2] = bf_lo(raw.y); v[3] = bf_hi(raw.y); v[4] = bf_lo(raw.z); v[5] = bf_hi(raw.z); v[6] = bf_lo(raw.w); v[7] = bf_hi(raw.w);
            float ss = 0.f;
#pragma unroll
            for (int e = 0; e < 8; ++e) ss += v[e] * v[e];
            ss += __shfl_xor(ss, 1); ss += __shfl_xor(ss, 2); ss += __shfl_xor(ss, 4);
            const float rinv = rsqrtf(ss * (1.0f / 64.0f) + 1e-6f);
            const f32x4 g0 = *(const f32x4*)(qk_g + type * 64 + 8 * j), g1 = *(const f32x4*)(qk_g + type * 64 + 8 * j + 4);
#pragma unroll
            for (int e = 0; e < 4; ++e) { v[e] = v[e] * rinv * g0[e]; v[4 + e] = v[4 + e] * rinv * g1[e]; }
            if (type >= 2) {
                const int axis = j >> 2; const bool first = (j & 2) == 0;
#pragma unroll
                for (int e = 0; e < 8; ++e) { const float p = __shfl_xor(v[e], 2); const int ii = 8 * (j & 1) + e;
                    const float cn = cs[2 * (tok * 32 + axis * 16 + ii)], sn = cs[2 * (tok * 32 + axis * 16 + ii) + 1];
                    v[e] = first ? (v[e] * cn - p * sn) : (v[e] * cn + p * sn); }
            }
            if (type == 0 || type == 2) {
#pragma unroll
                for (int e = 0; e < 8; ++e) v[e] *= QSCALE; }
            u32x4 w; w.x = pack_bf16(v[0], v[1]); w.y = pack_bf16(v[2], v[3]); w.z = pack_bf16(v[4], v[5]); w.w = pack_bf16(v[6], v[7]);
            *(u32x4*)(dst + 8 * j) = w;
        }
        for (int i = F.tid; i < 640 * 8; i += NTHREADS) { const int c = i & 7, dv = i >> 3;
            unsigned short e[8];
#pragma unroll
            for (int k = 0; k < 8; ++k) e[k] = vt[(16 * (c >> 1) + 4 * (c & 1) + (k & 3) + 8 * (k >> 2)) * 648 + dv];
            u32x4 w; w.x = e[0] | ((unsigned)e[1] << 16); w.y = e[2] | ((unsigned)e[3] << 16); w.z = e[4] | ((unsigned)e[5] << 16); w.w = e[6] | ((unsigned)e[7] << 16);
            bf16_t* dp = dv < 512 ? VAT + ((size_t)b * 512 + dv) * SEQ + s0 + 8 * c : VBT + ((size_t)b * 128 + (dv - 512)) * SEQ + s0 + 8 * c;
            *(u32x4*)dp = w; }
    }
    __syncthreads();
}

DI int t5_bucket(int rel) {
    const int ret = rel > 0 ? 16 : 0; const int n = rel < 0 ? -rel : rel;
    if (n < 8) return ret + n;
    int large = 8 + (n >= 12) + (n >= 16) + (n >= 23) + (n >= 32) + (n >= 46) + (n >= 64) + (n >= 91);
    return ret + large;
}
constexpr int AT_NS = 4, AT_PD = 2, AT_STG = 24576, AT_TB = AT_NS * AT_STG, AT_Q = AT_TB + 3072;
DI void glds16(const void* gsrc, unsigned lds_dst) { unsigned keep;
    asm volatile("s_mov_b32 %0, m0\n\ts_mov_b32 m0, %2\n\ts_nop 0\n\tglobal_load_lds_dwordx4 %1, off\n\ts_mov_b32 m0, %0" : "=&s"(keep) : "v"(gsrc), "s"(lds_dst) : "memory"); }

template <int NC, bool BIAS>
DI void attn_pass(const Frame& F, const bf16_t* Qp, const bf16_t* Kp, const bf16_t* Vt, int q0, const LAS float* tb, float c_neg, float c_pos, f32x16 (&o)[NC], float& l_out) {
    int lane = F.lane, tid_ = F.tid; asm volatile("" : "+v"(lane), "+v"(tid_));
    const int r31 = lane & 31, h = lane >> 5;
    LAS unsigned char* lds = F.lds;
    constexpr int NT = SEQ / 64, PT = 1 + NC / 2;
    __syncthreads();
#pragma unroll
    for (int i = 0; i < 4; ++i) { const int idx = i * NTHREADS + tid_, row = idx >> 3, ch = idx & 7;
        const u32x4 v = *(const u32x4*)(Qp + (size_t)(q0 + row) * 64 + 8 * ch);
        *(LAS u32x4*)(lds + AT_Q + row * 128 + ((ch ^ (row & 7)) << 4)) = v; }
    unsigned koffs[4], qoffs[4], voffs[4];
#pragma unroll
    for (int s_ = 0; s_ < 4; ++s_) { const unsigned sw = (unsigned)(((2 * s_ + h) ^ (r31 & 7)) << 4);
        koffs[s_] = (unsigned)(r31 * 128) + sw; qoffs[s_] = (unsigned)(AT_Q + (32 * F.wave + r31) * 128) + sw;
        voffs[s_] = 8192u + (unsigned)(r31 * 128) + (unsigned)(((2 * s_ + h) ^ ((r31 >> 1) & 7)) << 4); }
#pragma unroll
    for (int c = 0; c < NC; ++c)
#pragma unroll
        for (int r = 0; r < 16; ++r) o[c][r] = 0.f;
    float m = -INFINITY, l = 0.f;
    const int qlo = q0 + 32 * F.wave, qme = qlo + r31;
    const int krow = F.wave * 8 + (lane >> 3);
    const bf16_t* ksrc = Kp + (size_t)krow * 64 + 8 * ((lane & 7) ^ (krow & 7));
    const bf16_t* vsrc[NC / 2];
#pragma unroll
    for (int i = 0; i < NC / 2; ++i) { const int vrow = (i * 8 + F.wave) * 8 + (lane >> 3); vsrc[i] = Vt + (size_t)vrow * SEQ + 8 * ((lane & 7) ^ ((vrow >> 1) & 7)); }
    const unsigned lbase = (unsigned)(size_t)lds;
    const unsigned kdst = lbase + (unsigned)F.wave * 1024u;
#define AT_ISSUE(tt) do { const unsigned sb_ = (unsigned)(((tt) % AT_NS) * AT_STG); \
        glds16(ksrc + (size_t)(tt) * 64 * 64, (unsigned)__builtin_amdgcn_readfirstlane(kdst + sb_)); \
        _Pragma("unroll") for (int i_ = 0; i_ < NC / 2; ++i_) glds16(vsrc[i_] + (size_t)(tt) * 64, (unsigned)__builtin_amdgcn_readfirstlane(kdst + sb_ + 8192u + (unsigned)i_ * 8192u)); } while (0)
    __syncthreads();
    bf16x8 qreg[4];
    {
#pragma unroll
        for (int s = 0; s < 4; ++s) qreg[s] = *(const LAS bf16x8*)(lds + qoffs[s]); }
#pragma unroll
    for (int tt = 0; tt < AT_PD; ++tt) AT_ISSUE(tt);
#define AT_WAITP() do { if (PT == 3) asm volatile("s_waitcnt vmcnt(3)" ::: "memory"); else asm volatile("s_waitcnt vmcnt(2)" ::: "memory"); } while (0)
    const bool late_half = F.wave >= 4;
    if (late_half) { AT_WAITP(); __builtin_amdgcn_s_barrier(); asm volatile("" ::: "memory"); }
#pragma unroll 1
    for (int t = 0; t < NT; ++t) {
        const int k0 = t * 64;
        if (t + 1 < NT) AT_WAITP(); else asm volatile("s_waitcnt vmcnt(0)" ::: "memory");
        __builtin_amdgcn_s_barrier();
        asm volatile("" ::: "memory");
        if (t + AT_PD < NT) AT_ISSUE(t + AT_PD);
        const LAS unsigned char* st_ = lds + (t % AT_NS) * AT_STG;
        f32x16 sT[2];
#pragma unroll
        for (int s = 0; s < 4; ++s) { const bf16x8 qf = qreg[s];
#pragma unroll
            for (int kb = 0; kb < 2; ++kb) { const bf16x8 kf = *(const LAS bf16x8*)(st_ + koffs[s] + kb * 4096);
                if (s == 0) sT[kb] = __builtin_amdgcn_mfma_f32_32x32x16_bf16(kf, qf, (f32x16){0.f, 0.f, 0.f, 0.f, 0.f, 0.f, 0.f, 0.f, 0.f, 0.f, 0.f, 0.f, 0.f, 0.f, 0.f, 0.f}, 0, 0, 0);
                else sT[kb] = __builtin_amdgcn_mfma_f32_32x32x16_bf16(kf, qf, sT[kb], 0, 0, 0); } }
        float cb = 0.f;
        if (BIAS) {
            if (k0 + 63 - qlo <= -91) cb = c_neg;
            else if (k0 - (qlo + 31) >= 91) cb = c_pos;
            else {
#pragma unroll
                for (int kb = 0; kb < 2; ++kb)
#pragma unroll
                    for (int r = 0; r < 16; ++r) { const int key = k0 + 32 * kb + (r & 3) + 8 * (r >> 2) + 4 * h; sT[kb][r] += tb[key - qme + 192]; }
            }
        }
        float mx = sT[0][0];
#pragma unroll
        for (int kb = 0; kb < 2; ++kb)
#pragma unroll
            for (int r = 0; r < 16; ++r) mx = fmaxf(mx, sT[kb][r]);
        mx = fmaxf(mx, __shfl_xor(mx, 32)) + cb;
        if (__builtin_amdgcn_ballot_w64(mx > m) != 0ull) {
            const float mn = fmaxf(m, mx), alpha = __builtin_amdgcn_exp2f(m - mn);
            m = mn; l *= alpha;
#pragma unroll
            for (int c = 0; c < NC; ++c)
#pragma unroll
                for (int r = 0; r < 16; ++r) o[c][r] *= alpha;
        }
        const float sh = cb - m;
        float ps = 0.f;
#pragma unroll
        for (int kb = 0; kb < 2; ++kb)
#pragma unroll
            for (int r = 0; r < 16; ++r) { const float p = __builtin_amdgcn_exp2f(sT[kb][r] + sh); sT[kb][r] = p; ps += p; }
        l += ps;
        bf16x8 pf[2][2];
#pragma unroll
        for (int kb = 0; kb < 2; ++kb)
#pragma unroll
            for (int s2 = 0; s2 < 2; ++s2) {
                u32x4 pw; pw.x = pack_bf16(sT[kb][8 * s2 + 0], sT[kb][8 * s2 + 1]); pw.y = pack_bf16(sT[kb][8 * s2 + 2], sT[kb][8 * s2 + 3]);
                pw.z = pack_bf16(sT[kb][8 * s2 + 4], sT[kb][8 * s2 + 5]); pw.w = pack_bf16(sT[kb][8 * s2 + 6], sT[kb][8 * s2 + 7]);
                pf[kb][s2] = __builtin_bit_cast(bf16x8, pw); }
        __builtin_amdgcn_sched_barrier(0);
        if (t + 2 < NT) AT_WAITP(); else asm volatile("s_waitcnt vmcnt(0)" ::: "memory");
        __builtin_amdgcn_s_barrier();
        asm volatile("" ::: "memory");
#pragma unroll
        for (int g = 0; g < 4; ++g) {
#pragma unroll
            for (int c = 0; c < NC; ++c) { const bf16x8 vf = *(const LAS bf16x8*)(st_ + voffs[g] + c * 4096);
                o[c] = __builtin_amdgcn_mfma_f32_32x32x16_bf16(vf, pf[g >> 1][g & 1], o[c], 0, 0, 0); }
        }
    }
    if (!late_half) __builtin_amdgcn_s_barrier();
#undef AT_WAITP
#undef AT_ISSUE
    l_out = l + __shfl_xor(l, 32);
}

template <int MODE> DI void p_attention(const Frame& F) {
    const bf16_t* QA = (const bf16_t*)(F.ws + WS_QA); const bf16_t* KA = (const bf16_t*)(F.ws + WS_KA); const bf16_t* VAT = (const bf16_t*)(F.ws + WS_VAT);
    const bf16_t* QB = (const bf16_t*)(F.ws + WS_QB); const bf16_t* KB = (const bf16_t*)(F.ws + WS_KB); const bf16_t* VBT = (const bf16_t*)(F.ws + WS_VBT);
    bf16_t* O = (bf16_t*)(F.ws + WS_O);
    const float* rel_bias = F.in[10]; const float* lv = F.in[7]; const float* subg = F.in[8];
    LAS float* tb = (LAS float*)(F.lds + AT_TB);
    const int lane = F.lane;
    float lam;
    { const float a = lv[lane] * lv[64 + lane], b2 = lv[128 + lane] * lv[192 + lane];
      lam = __expf(wave_sum(a)) - __expf(wave_sum(b2)) + 0.2f; }
    if (MODE & 1) for (int u = F.bid; u < 256; u += F.G) {
        const int b = u >> 5, hd = (u >> 3) & 3, qb = u & 7, q0 = qb * 256;
        __syncthreads();
        for (int i = F.tid; i < 2 * 384; i += NTHREADS) { const int mi = i / 384, ii = i % 384; tb[i] = rel_bias[t5_bucket(ii - 192) * 8 + 2 * hd + mi] * LOG2E; }
        __syncthreads();
        const bf16_t* Vt = VAT + (size_t)(b * 4 + hd) * 128 * SEQ;
        unsigned* o0s = (unsigned*)(F.ws + WS_O0S) + (size_t)F.bid * NTHREADS + F.tid;
        const size_t o0p = (size_t)F.G * NTHREADS;
        f32x16 o[4]; float l;
        { const int mp = 2 * hd;
          attn_pass<4, true>(F, QA + (size_t)(b * 8 + mp) * SEQ * 64, KA + (size_t)(b * 8 + mp) * SEQ * 64, Vt, q0, tb, rel_bias[15 * 8 + mp] * LOG2E, rel_bias[31 * 8 + mp] * LOG2E, o, l);
          const float il = 1.0f / l;
#pragma unroll
          for (int c = 0; c < 4; ++c)
#pragma unroll
              for (int r = 0; r < 8; ++r) o0s[(c * 8 + r) * o0p] = pack_bf16(o[c][2 * r] * il, o[c][2 * r + 1] * il); }
        { const int mp = 2 * hd + 1;
          attn_pass<4, true>(F, QA + (size_t)(b * 8 + mp) * SEQ * 64, KA + (size_t)(b * 8 + mp) * SEQ * 64, Vt, q0, tb + 384, rel_bias[15 * 8 + mp] * LOG2E, rel_bias[31 * 8 + mp] * LOG2E, o, l);
          int ln = F.lane; asm volatile("" : "+v"(ln)); const int r31 = ln & 31, h = ln >> 5;
          const float il = lam / l; float ss = 0.f;
#pragma unroll
          for (int c = 0; c < 4; ++c)
#pragma unroll
              for (int r = 0; r < 8; ++r) { const unsigned pk = __hip_atomic_load(o0s + (c * 8 + r) * o0p, __ATOMIC_RELAXED, __HIP_MEMORY_SCOPE_AGENT); const float d0 = bf_lo(pk) - o[c][2 * r] * il, d1 = bf_hi(pk) - o[c][2 * r + 1] * il; o[c][2 * r] = d0; o[c][2 * r + 1] = d1; ss += d0 * d0 + d1 * d1; }
          ss += __shfl_xor(ss, 32);
          const float rinv = rsqrtf(ss * (1.0f / 128.0f) + 1e-6f) * 0.8f;
          bf16_t* op = O + (size_t)(b * SEQ + q0 + 32 * F.wave + r31) * D + hd * 128;
#pragma unroll
          for (int c = 0; c < 4; ++c)
#pragma unroll
              for (int g = 0; g < 4; ++g) { const int dv = 32 * c + 8 * g + 4 * h; const f32x4 sg = *(const f32x4*)(subg + dv);
                  u32x2 w; w.x = pack_bf16(o[c][4 * g] * rinv * sg[0], o[c][4 * g + 1] * rinv * sg[1]); w.y = pack_bf16(o[c][4 * g + 2] * rinv * sg[2], o[c][4 * g + 3] * rinv * sg[3]);
                  *(u32x2*)(op + dv) = w; } }
    }
    if (MODE & 2) for (int u = F.bid; u < 512; u += F.G) {
        const int b = u >> 6, hq = (u >> 3) & 7, qb = u & 7, q0 = qb * 256, kv = hq >> 2;
        f32x16 o[2]; float l;
        attn_pass<2, false>(F, QB + (size_t)(b * 8 + hq) * SEQ * 64, KB + (size_t)(b * 2 + kv) * SEQ * 64, VBT + (size_t)(b * 2 + kv) * 64 * SEQ, q0, tb, 0.f, 0.f, o, l);
        int ln = F.lane; asm volatile("" : "+v"(ln)); const int r31 = ln & 31, h = ln >> 5;
        const float il = 1.0f / l;
        bf16_t* op = O + (size_t)(b * SEQ + q0 + 32 * F.wave + r31) * D + 512 + hq * 64;
#pragma unroll
        for (int c = 0; c < 2; ++c)
#pragma unroll
            for (int g = 0; g < 4; ++g) { const int dv = 32 * c + 8 * g + 4 * h;
                u32x2 w; w.x = pack_bf16(o[c][4 * g] * il, o[c][4 * g + 1] * il); w.y = pack_bf16(o[c][4 * g + 2] * il, o[c][4 * g + 3] * il);
                *(u32x2*)(op + dv) = w; }
    }
    __syncthreads();
}
#define CE_DESC(ka, pa, kb, pb) do { const bool _sw = (kb) > (ka); const float _k0 = _sw ? (kb) : (ka), _k1 = _sw ? (ka) : (kb); const int _p0 = _sw ? (pb) : (pa), _p1 = _sw ? (pa) : (pb); \
    (ka) = _k0; (kb) = _k1; (pa) = _p0; (pb) = _p1; } while (0)
template <int BASE> DI void sort16_desc(float (&k)[64], int (&p)[64]) {
#pragma unroll
    for (int k2 = 2; k2 <= 16; k2 <<= 1)
#pragma unroll
        for (int j = k2 >> 1; j > 0; j >>= 1)
#pragma unroll
            for (int i = 0; i < 16; ++i) { const int l = i ^ j;
                if (l > i) { if ((i & k2) == 0 || k2 == 16) CE_DESC(k[BASE + i], p[BASE + i], k[BASE + l], p[BASE + l]); else CE_DESC(k[BASE + l], p[BASE + l], k[BASE + i], p[BASE + i]); } }
}
template <int BA, int BB> DI void merge_top16(float (&k)[64], int (&p)[64]) {
#pragma unroll
    for (int i = 0; i < 16; ++i) { const bool sw = k[BB + 15 - i] > k[BA + i]; k[BA + i] = sw ? k[BB + 15 - i] : k[BA + i]; p[BA + i] = sw ? p[BB + 15 - i] : p[BA + i]; }
#pragma unroll
    for (int j = 8; j > 0; j >>= 1)
#pragma unroll
        for (int i = 0; i < 16; ++i) { const int l = i ^ j; if (l > i) CE_DESC(k[BA + i], p[BA + i], k[BA + l], p[BA + l]); }
}
DI void top16_of_64(float (&k)[64], int (&p)[64]) {
    sort16_desc<0>(k, p); sort16_desc<16>(k, p); sort16_desc<32>(k, p); sort16_desc<48>(k, p);
    merge_top16<0, 16>(k, p); merge_top16<32, 48>(k, p); merge_top16<0, 32>(k, p);
}
#define CEK_DESC(ka, kb) do { const float _h = fmaxf((ka), (kb)), _l = fminf((ka), (kb)); (ka) = _h; (kb) = _l; } while (0)
template <int BASE> DI void sort16k_desc(float (&k)[64]) {
#pragma unroll
    for (int k2 = 2; k2 <= 16; k2 <<= 1)
#pragma unroll
        for (int j = k2 >> 1; j > 0; j >>= 1)
#pragma unroll
            for (int i = 0; i < 16; ++i) { const int l = i ^ j;
                if (l > i) { if ((i & k2) == 0) CEK_DESC(k[BASE + i], k[BASE + l]); else CEK_DESC(k[BASE + l], k[BASE + i]); } }
}
template <int BA, int BB> DI void merge_top16k(float (&k)[64]) {
#pragma unroll
    for (int i = 0; i < 16; ++i) k[BA + i] = fmaxf(k[BA + i], k[BB + 15 - i]);
#pragma unroll
    for (int j = 8; j > 0; j >>= 1)
#pragma unroll
        for (int i = 0; i < 16; ++i) { const int l = i ^ j; if (l > i) CEK_DESC(k[BA + i], k[BA + l]); }
}
DI void top16k_of_64(float (&k)[64]) {
    sort16k_desc<0>(k); sort16k_desc<16>(k); sort16k_desc<32>(k); sort16k_desc<48>(k);
    merge_top16k<0, 16>(k); merge_top16k<32, 48>(k); merge_top16k<0, 32>(k);
}
constexpr int cand_off(int a) { int s = 0; for (int i = 0; i < a; ++i) s += 16 / (i + 1); return s; }

DI void p_peer_topk(const Frame& F, const bf16_t* PQ, const bf16_t* SK  , int* EIDX, float* GATE) {
    const int lane = F.lane, r31 = lane & 31, h = lane >> 5, w = F.wave;
    for (int tile = F.bid; tile < T / 64; tile += F.G) {
        for (int tt = 0; tt < 2; ++tt) {
            const int tok = tile * 64 + tt * 32 + r31;
            float lv[2][16];
#pragma unroll
            for (int p = 0; p < 2; ++p) {
                const int hp = 2 * w + p;
                f32x16 acc[4];
#pragma unroll
                for (int nb = 0; nb < 4; ++nb)
#pragma unroll
                    for (int r = 0; r < 16; ++r) acc[nb][r] = 0.f;
                const bf16_t* qp = PQ + (size_t)tok * PQ_LD + hp * 128 + 8 * h;
                const bf16_t* sp = SK + ((size_t)hp * 128 + r31) * 128 + 8 * h;
#pragma unroll 4
                for (int s = 0; s < 8; ++s) { const bf16x8 qf = *(const bf16x8*)(qp + 16 * s);
#pragma unroll
                    for (int nb = 0; nb < 4; ++nb) { const bf16x8 af = *(const bf16x8*)(sp + (size_t)nb * 32 * 128 + 16 * s);
                        acc[nb] = __builtin_amdgcn_mfma_f32_32x32x16_bf16(af, qf, acc[nb], 0, 0, 0); } }
                float k[64];
#pragma unroll
                for (int nb = 0; nb < 4; ++nb)
#pragma unroll
                    for (int r = 0; r < 16; ++r) { const int n = 32 * nb + (r & 3) + 8 * (r >> 2) + 4 * h;
                        k[16 * nb + r] = __uint_as_float((__float_as_uint(acc[nb][r]) & 0xFFFFFF80u) | (unsigned)(127 - n)); }
                top16k_of_64(k);
#pragma unroll
                for (int i = 0; i < 16; ++i) k[16 + i] = __shfl_xor(k[i], 32);
                merge_top16k<0, 16>(k);
#pragma unroll
                for (int i = 0; i < 16; ++i) lv[p][i] = k[i];
                __builtin_amdgcn_sched_barrier(0);
            }
            float ck[64];
#pragma unroll
            for (int i = 0; i < 64; ++i) ck[i] = -INFINITY;
#pragma unroll
            for (int a = 0; a < 16; ++a) {
#pragma unroll
                for (int b2 = 0; b2 < 16 / (a + 1); ++b2) ck[cand_off(a) + b2] = __uint_as_float((__float_as_uint(lv[0][a] + lv[1][b2]) & 0xFFFFFF00u) | (unsigned)(a * 16 + b2)); }
            LAS float* lst = (LAS float*)F.lds + F.tid;
#pragma unroll
            for (int i = 0; i < 16; ++i) { lst[i * NTHREADS] = lv[0][i]; lst[(16 + i) * NTHREADS] = lv[1][i]; }
            top16k_of_64(ck);
            float den = 0.f, ex[16]; int cp[16];
#pragma unroll
            for (int i = 0; i < 16; ++i) { ex[i] = __expf(ck[i] - ck[0]); den += ex[i];
                const unsigned cb = __float_as_uint(ck[i]); const int a = (cb >> 4) & 15, b2 = cb & 15;
                const unsigned u0 = __float_as_uint(lst[a * NTHREADS]), u1 = __float_as_uint(lst[(16 + b2) * NTHREADS]);
                cp[i] = (127 - (int)(u0 & 127u)) * 128 + (127 - (int)(u1 & 127u)); }
            const float iden = 1.0f / den;
            if (h == 0) {
                int* ep = EIDX + (size_t)tok * 128 + w * 16; float* gp = GATE + (size_t)tok * 128 + w * 16;
#pragma unroll
                for (int i = 0; i < 4; ++i) { *(u32x4*)(ep + 4 * i) = (u32x4){(unsigned)cp[4 * i], (unsigned)cp[4 * i + 1], (unsigned)cp[4 * i + 2], (unsigned)cp[4 * i + 3]};
                    *(f32x4*)(gp + 4 * i) = (f32x4){ex[4 * i] * iden, ex[4 * i + 1] * iden, ex[4 * i + 2] * iden, ex[4 * i + 3] * iden}; }
            }
        }
    }
}

DI void fp8x16_to_f32(const u32x4 w, float (&o)[16]) {
    f32x2 t;
    t = __builtin_amdgcn_cvt_pk_f32_fp8((int)w.x, false); o[0] = t[0]; o[1] = t[1];  t = __builtin_amdgcn_cvt_pk_f32_fp8((int)w.x, true); o[2] = t[0]; o[3] = t[1];
    t = __builtin_amdgcn_cvt_pk_f32_fp8((int)w.y, false); o[4] = t[0]; o[5] = t[1];  t = __builtin_amdgcn_cvt_pk_f32_fp8((int)w.y, true); o[6] = t[0]; o[7] = t[1];
    t = __builtin_amdgcn_cvt_pk_f32_fp8((int)w.z, false); o[8] = t[0]; o[9] = t[1];  t = __builtin_amdgcn_cvt_pk_f32_fp8((int)w.z, true); o[10] = t[0]; o[11] = t[1];
    t = __builtin_amdgcn_cvt_pk_f32_fp8((int)w.w, false); o[12] = t[0]; o[13] = t[1]; t = __builtin_amdgcn_cvt_pk_f32_fp8((int)w.w, true); o[14] = t[0]; o[15] = t[1];
}
DI float gelu_tanh_fast(float x) { const float z2 = 2.302208198f * (x + 0.044715f * x * x * x);
    return x * __builtin_amdgcn_rcpf(1.0f + __builtin_amdgcn_exp2f(-z2)); }
constexpr int PB = 4;
DI void peer_load(const unsigned char* PU, const unsigned char* PV, int ev, int base, int lane, u32x4 (&U)[PB], u32x4 (&V)[PB]) {
#pragma unroll
    for (int q = 0; q < PB; ++q) { const int e = __builtin_amdgcn_readlane(ev, base + q);
        U[q] = *(const u32x4*)(PU + (size_t)e * 1024 + 16 * lane); V[q] = *(const u32x4*)(PV + (size_t)e * 1024 + 16 * lane); }
}
struct RsMap { unsigned tag; int l0, l1, l2, l3; };
DI unsigned swp32(unsigned a, unsigned b, unsigned& other) { auto r = __builtin_amdgcn_permlane32_swap(a, b, false, false); other = r[1]; return r[0]; }
DI unsigned swp16(unsigned a, unsigned b, unsigned& other) { auto r = __builtin_amdgcn_permlane16_swap(a, b, false, false); other = r[1]; return r[0]; }
DI RsMap rs_map_init() {
    unsigned o, t0 = 0u, t1 = 1u, t2 = 2u, t3 = 3u;
    asm volatile("" : "+v"(t0), "+v"(t1), "+v"(t2), "+v"(t3));
    const unsigned ta = swp32(t0, t2, o), tb = swp32(t1, t3, o);
    RsMap m; m.tag = swp16(ta, tb, o);
    m.l0 = __builtin_ctzll(__builtin_amdgcn_ballot_w64(m.tag == 0u)); m.l1 = __builtin_ctzll(__builtin_amdgcn_ballot_w64(m.tag == 1u));
    m.l2 = __builtin_ctzll(__builtin_amdgcn_ballot_w64(m.tag == 2u)); m.l3 = __builtin_ctzll(__builtin_amdgcn_ballot_w64(m.tag == 3u));
    return m;
}
template <int CTRL> DI float dpp_g(float v) { return __builtin_bit_cast(float, __builtin_amdgcn_update_dpp(0, __builtin_bit_cast(int, v), CTRL, 0xF, 0xF, true)); }
DI void peer_comp(const u32x4 (&U)[PB], const u32x4 (&V)[PB], float su, float gvs, int base, const RsMap& M, const float (&x)[16], float (&y)[16]) {
    float d[PB];
#pragma unroll
    for (int q = 0; q < PB; ++q) { float u[16]; fp8x16_to_f32(U[q], u);
        float a0 = u[0] * x[0], a1 = u[1] * x[1], a2 = u[2] * x[2], a3 = u[3] * x[3];
#pragma unroll
        for (int i = 4; i < 16; i += 4) { a0 += u[i] * x[i]; a1 += u[i + 1] * x[i + 1]; a2 += u[i + 2] * x[i + 2]; a3 += u[i + 3] * x[i + 3]; }
        d[q] = (a0 + a1) + (a2 + a3); }
    unsigned o;
    const float f0a = __uint_as_float(swp32(__float_as_uint(d[0]), __float_as_uint(d[2]), o)); const float f0 = f0a + __uint_as_float(o);
    const float f1a = __uint_as_float(swp32(__float_as_uint(d[1]), __float_as_uint(d[3]), o)); const float f1 = f1a + __uint_as_float(o);
    const float ga = __uint_as_float(swp16(__float_as_uint(f0), __float_as_uint(f1), o)); float g = ga + __uint_as_float(o);
    g += dpp_g<0xB1>(g); g += dpp_g<0x4E>(g); g += dpp_g<0x141>(g); g += dpp_g<0x140>(g);
    const int src = (base + (int)M.tag) * 4;
    const float su_b = __uint_as_float(__builtin_amdgcn_ds_bpermute(src, __float_as_uint(su))), gv_b = __uint_as_float(__builtin_amdgcn_ds_bpermute(src, __float_as_uint(gvs)));
    const float c = gv_b * gelu_tanh_fast(g * su_b);
    const float c0 = __uint_as_float(__builtin_amdgcn_readlane(__float_as_uint(c), M.l0)), c1 = __uint_as_float(__builtin_amdgcn_readlane(__float_as_uint(c), M.l1));
    const float c2 = __uint_as_float(__builtin_amdgcn_readlane(__float_as_uint(c), M.l2)), c3 = __uint_as_float(__builtin_amdgcn_readlane(__float_as_uint(c), M.l3));
    const float cq[4] = {c0, c1, c2, c3};
#pragma unroll
    for (int q = 0; q < PB; ++q) { float v[16]; fp8x16_to_f32(V[q], v);
#pragma unroll
        for (int i = 0; i < 16; ++i) y[i] += cq[q] * v[i]; }
}
constexpr int PM_SHIFT = 11, PM_NP = 16384 >> PM_SHIFT;
struct PBatch { u32x4 U[4], V[4]; float su[4], gv[4]; int n; };
DI void pm_fetch(PBatch& B, unsigned long long& mA, unsigned long long& mB, int e0, int e1, float su0, float su1, float gv0, float gv1, const unsigned char* PU, const unsigned char* PV, int lane) {
    B.n = 0;
    if ((mA | mB) == 0ull) return;
    int eid[4];
#pragma unroll
    for (int q = 0; q < 4; ++q) {
        if (mA != 0ull) { const int l = __builtin_ctzll(mA); mA &= mA - 1ull;
            eid[q] = __builtin_amdgcn_readlane(e0, l); B.su[q] = __uint_as_float(__builtin_amdgcn_readlane(__float_as_uint(su0), l)); B.gv[q] = __uint_as_float(__builtin_amdgcn_readlane(__float_as_uint(gv0), l)); B.n = q + 1; }
        else if (mB != 0ull) { const int l = __builtin_ctzll(mB); mB &= mB - 1ull;
            eid[q] = __builtin_amdgcn_readlane(e1, l); B.su[q] = __uint_as_float(__builtin_amdgcn_readlane(__float_as_uint(su1), l)); B.gv[q] = __uint_as_float(__builtin_amdgcn_readlane(__float_as_uint(gv1), l)); B.n = q + 1; }
        else { eid[q] = eid[0]; B.su[q] = 0.f; B.gv[q] = 0.f; }
        B.U[q] = *(const u32x4*)(PU + (size_t)eid[q] * 1024 + 16 * lane); B.V[q] = *(const u32x4*)(PV + (size_t)eid[q] * 1024 + 16 * lane);
    }
}
DI void pm_comp(const PBatch& B, const RsMap& M, const float (&x)[16], float (&y)[16]) {
    float d[4];
#pragma unroll
    for (int q = 0; q < 4; ++q) { float u[16]; fp8x16_to_f32(B.U[q], u);
        f32x2 a0 = (f32x2){u[0], u[1]} * (f32x2){x[0], x[1]}, a1 = (f32x2){u[2], u[3]} * (f32x2){x[2], x[3]};
#pragma unroll
        for (int i = 4; i < 16; i += 4) { a0 = __builtin_elementwise_fma((f32x2){u[i], u[i + 1]}, (f32x2){x[i], x[i + 1]}, a0); a1 = __builtin_elementwise_fma((f32x2){u[i + 2], u[i + 3]}, (f32x2){x[i + 2], x[i + 3]}, a1); }
        const f32x2 as = a0 + a1; d[q] = as[0] + as[1]; }
    unsigned o;
    const float f0a = __uint_as_float(swp32(__float_as_uint(d[0]), __float_as_uint(d[2]), o)); const float f0 = f0a + __uint_as_float(o);
    const float f1a = __uint_as_float(swp32(__float_as_uint(d[1]), __float_as_uint(d[3]), o)); const float f1 = f1a + __uint_as_float(o);
    const float ga = __uint_as_float(swp16(__float_as_uint(f0), __float_as_uint(f1), o)); float g = ga + __uint_as_float(o);
    g += dpp_g<0xB1>(g); g += dpp_g<0x4E>(g); g += dpp_g<0x141>(g); g += dpp_g<0x140>(g);
    const float su_b = M.tag == 0u ? B.su[0] : (M.tag == 1u ? B.su[1] : (M.tag == 2u ? B.su[2] : B.su[3]));
    const float gv_b = M.tag == 0u ? B.gv[0] : (M.tag == 1u ? B.gv[1] : (M.tag == 2u ? B.gv[2] : B.gv[3]));
    const float c = gv_b * gelu_tanh_fast(g * su_b);
    const float cq[4] = {__uint_as_float(__builtin_amdgcn_readlane(__float_as_uint(c), M.l0)), __uint_as_float(__builtin_amdgcn_readlane(__float_as_uint(c), M.l1)),
                         __uint_as_float(__builtin_amdgcn_readlane(__float_as_uint(c), M.l2)), __uint_as_float(__builtin_amdgcn_readlane(__float_as_uint(c), M.l3))};
#pragma unroll
    for (int q = 0; q < 4; ++q) { float v[16]; fp8x16_to_f32(B.V[q], v);
#pragma unroll
        for (int i = 0; i < 16; ++i) y[i] += cq[q] * v[i]; }
}
template <bool FINAL> DI void p_peer_gather(const Frame& F, const float* gn  , const float* modl  , const unsigned char* PU, const unsigned char* PV, const float* SU, const float* SV, const int* EIDX, const float* GATE, const float* gt2  , bf16_t* xb, float* out) {
    const int lane = F.lane;
    const RsMap M = rs_map_init();
    for (int tile = F.bid; tile < T / 64; tile += F.G) {
        for (int grp = 0; grp < 4; ++grp) {
            const int tb = tile * 64 + F.wave * 8 + grp * 2;
            float x[2][16], y[2][16]; int e0[2], e1[2]; float su0[2], su1[2], gv0[2], gv1[2];
#pragma unroll
            for (int i = 0; i < 2; ++i) { const int t = tb + i;
                { float rinv; norm_row16_b(xb + (size_t)t * D, lane, x[i], rinv);
                  ada_apply(x[i], rinv, gn, modl + (size_t)(t / SEQ) * 6144 + 4096, modl + (size_t)(t / SEQ) * 6144 + 3072, lane); }
#pragma unroll
                for (int k = 0; k < 16; ++k) y[i][k] = 0.f;
                e0[i] = __builtin_nontemporal_load(EIDX + (size_t)t * 128 + lane); e1[i] = __builtin_nontemporal_load(EIDX + (size_t)t * 128 + 64 + lane);
                su0[i] = SU[e0[i]]; su1[i] = SU[e1[i]]; gv0[i] = __builtin_nontemporal_load(GATE + (size_t)t * 128 + lane) * SV[e0[i]]; gv1[i] = __builtin_nontemporal_load(GATE + (size_t)t * 128 + 64 + lane) * SV[e1[i]]; }
            for (int p = 0; p < PM_NP; ++p) {
#pragma unroll
                for (int i = 0; i < 2; ++i) {
                    unsigned long long mA = __builtin_amdgcn_ballot_w64((e0[i] >> PM_SHIFT) == p), mB = __builtin_amdgcn_ballot_w64((e1[i] >> PM_SHIFT) == p);
                    PBatch A, B;
                    pm_fetch(A, mA, mB, e0[i], e1[i], su0[i], su1[i], gv0[i], gv1[i], PU, PV, lane);
                    while (A.n > 0) {
                        pm_fetch(B, mA, mB, e0[i], e1[i], su0[i], su1[i], gv0[i], gv1[i], PU, PV, lane);
                        pm_comp(A, M, x[i], y[i]);
                        if (B.n == 0) break;
                        pm_fetch(A, mA, mB, e0[i], e1[i], su0[i], su1[i], gv0[i], gv1[i], PU, PV, lane);
                        pm_comp(B, M, x[i], y[i]);
                    }
                }
            }
#pragma unroll
            for (int i = 0; i < 2; ++i) { const int t = tb + i; const int b = t / SEQ; const float* gp = gt2 + (size_t)b * 6144; bf16_t* xp = xb + (size_t)t * D;
#pragma unroll
                for (int j = 0; j < 4; ++j) { const int c = 256 * j + 4 * lane; const f32x4 g = *(const f32x4*)(gp + c); const u32x2 xw = *(const u32x2*)(xp + c);
                    f32x4 xo = (f32x4){bf_lo(xw.x), bf_hi(xw.x), bf_lo(xw.y), bf_hi(xw.y)};
                    xo[0] += g[0] * y[i][4 * j]; xo[1] += g[1] * y[i][4 * j + 1]; xo[2] += g[2] * y[i][4 * j + 2]; xo[3] += g[3] * y[i][4 * j + 3];
                    if (FINAL) __builtin_nontemporal_store(xo, (f32x4*)(out + (size_t)t * D + c)); else *(u32x2*)(xp + c) = (u32x2){pack_bf16(xo[0], xo[1]), pack_bf16(xo[2], xo[3])}; } }
        }
    }
}
DI void norm_row16c(const float* xr, int lane, float (&v)[16], float& rinv) {
    float ss = 0.f;
#pragma unroll
    for (int j = 0; j < 2; ++j)
#pragma unroll
        for (int q = 0; q < 2; ++q) { const f32x4 a = *(const f32x4*)(xr + 512 * j + 8 * lane + 4 * q); v[8 * j + 4 * q] = a[0]; v[8 * j + 4 * q + 1] = a[1]; v[8 * j + 4 * q + 2] = a[2]; v[8 * j + 4 * q + 3] = a[3];
            ss += a[0] * a[0] + a[1] * a[1] + a[2] * a[2] + a[3] * a[3]; }
    ss = wave_sum(ss);
    rinv = rsqrtf(ss * (1.0f / 1024.0f) + 1e-6f);
}
DI void ada_apply_c(float (&v)[16], float rinv, const float* g, const float* sc, const float* sh, int lane) {
#pragma unroll
    for (int j = 0; j < 2; ++j)
#pragma unroll
        for (int q = 0; q < 2; ++q) { const int c = 512 * j + 8 * lane + 4 * q;
            const f32x4 gg = *(const f32x4*)(g + c), s1 = *(const f32x4*)(sc + c), s0 = *(const f32x4*)(sh + c);
#pragma unroll
            for (int e = 0; e < 4; ++e) v[8 * j + 4 * q + e] = v[8 * j + 4 * q + e] * rinv * gg[e] * (1.0f + s1[e]) + s0[e]; }
}
DI void row_load(const bf16_t* xr, int lane, float (&v)[16]) {
#pragma unroll
    for (int j = 0; j < 2; ++j) { const u32x4 a = *(const u32x4*)(xr + 512 * j + 8 * lane);
        v[8 * j] = bf_lo(a.x); v[8 * j + 1] = bf_hi(a.x); v[8 * j + 2] = bf_lo(a.y); v[8 * j + 3] = bf_hi(a.y); v[8 * j + 4] = bf_lo(a.z); v[8 * j + 5] = bf_hi(a.z); v[8 * j + 6] = bf_lo(a.w); v[8 * j + 7] = bf_hi(a.w); }
}
DI void row_finish(const float (&raw)[16], int lane, const LAS float* ga, const LAS float* sh, float (&v)[16]) {
    float ss = 0.f;
#pragma unroll
    for (int e = 0; e < 16; ++e) ss += raw[e] * raw[e];
    ss = wave_sum(ss);
    const float rinv = rsqrtf(ss * (1.0f / 1024.0f) + 1e-6f);
#pragma unroll
    for (int j = 0; j < 2; ++j)
#pragma unroll
        for (int q = 0; q < 2; ++q) { const int c = 512 * j + 8 * lane + 4 * q; const f32x4 gg = *(const LAS f32x4*)(ga + c), s0 = *(const LAS f32x4*)(sh + c);
#pragma unroll
            for (int e = 0; e < 4; ++e) v[8 * j + 4 * q + e] = raw[8 * j + 4 * q + e] * rinv * gg[e] + s0[e]; }
}
DI void p_rwkv_prep(const Frame& F, const bf16_t* x, const float* g, const float* modl, const float* mix, bf16_t* X6) {
    const int lane = F.lane;
    LAS float* ga = (LAS float*)F.lds; LAS float* shl = ga + 1024; LAS float* mixl = ga + 2048;
    int cur_b = -1;
    for (int run0 = F.bid * NWAVES; run0 < T / 8; run0 += F.G * NWAVES) {
        const int run = run0 + F.wave;
        const int bb = (run0 * 8) / SEQ;
        if (bb != cur_b) { __syncthreads();
            for (int i = F.tid; i < 1024; i += NTHREADS) { ga[i] = g[i] * (1.0f + modl[(size_t)bb * 6144 + 1024 + i]); shl[i] = modl[(size_t)bb * 6144 + i]; }
            if (cur_b < 0) for (int i = F.tid; i < 6 * 1024; i += NTHREADS) mixl[i] = mix[i];
            cur_b = bb; __syncthreads(); }
        const int r0 = run * 8, s0 = r0 % SEQ;
        float hp[16], hc[16], hn[16], ra[16], rb[16];
        if (s0 > 0) row_load(x + (size_t)(r0 - 1) * D, lane, ra);
        row_load(x + (size_t)r0 * D, lane, rb);
        if (s0 > 0) row_finish(ra, lane, ga, shl, hp);
        else {
#pragma unroll
            for (int i = 0; i < 16; ++i) hp[i] = 0.f; }
        if (s0 + 1 < SEQ) row_load(x + (size_t)(r0 + 1) * D, lane, ra);
        row_finish(rb, lane, ga, shl, hc);
        for (int i = 0; i < 8; ++i) {
            const int s = s0 + i;
            if (i + 1 < 8 && s + 2 < SEQ) row_load(x + (size_t)(r0 + i + 2) * D, lane, rb);
            if (s + 1 < SEQ) row_finish(ra, lane, ga, shl, hn);
            else {
#pragma unroll
                for (int e = 0; e < 16; ++e) hn[e] = 0.f; }
#pragma unroll
            for (int e = 0; e < 16; ++e) ra[e] = rb[e];
            float xx[16];
#pragma unroll
            for (int e = 0; e < 16; ++e) xx[e] = 0.5f * (hp[e] + hn[e]) - hc[e];
#pragma unroll
            for (int grp = 0; grp < 6; ++grp) { const int mi = grp == 0 ? 0 : (grp == 1 ? 2 : (grp == 2 ? 3 : (grp == 3 ? 1 : grp)));
                bf16_t* op = X6 + ((size_t)grp * T + r0 + i) * D;
#pragma unroll
                for (int j = 0; j < 2; ++j) { const f32x4 m0 = *(const LAS f32x4*)(mixl + mi * 1024 + 512 * j + 8 * lane), m1 = *(const LAS f32x4*)(mixl + mi * 1024 + 512 * j + 8 * lane + 4);
                    u32x4 w; w.x = pack_bf16(hc[8 * j] + xx[8 * j] * m0[0], hc[8 * j + 1] + xx[8 * j + 1] * m0[1]); w.y = pack_bf16(hc[8 * j + 2] + xx[8 * j + 2] * m0[2], hc[8 * j + 3] + xx[8 * j + 3] * m0[3]);
                    w.z = pack_bf16(hc[8 * j + 4] + xx[8 * j + 4] * m1[0], hc[8 * j + 5] + xx[8 * j + 5] * m1[1]); w.w = pack_bf16(hc[8 * j + 6] + xx[8 * j + 6] * m1[2], hc[8 * j + 7] + xx[8 * j + 7] * m1[3]);
                    *(u32x4*)(op + 512 * j + 8 * lane) = w; } }
#pragma unroll
            for (int e = 0; e < 16; ++e) { hp[e] = hc[e]; hc[e] = hn[e]; }
        }
    }
    __syncthreads();
}

constexpr int SC_L = 16;
constexpr int SC_NB = 5;
constexpr int SCP = 272;
constexpr int SCB_W = 0, SCB_BKZ = 16 * SCP, SCB_VV = 32 * SCP, SCB_AR = 48 * SCP, SCB_SIZE = 64 * SCP;
constexpr int SC_Y = SC_NB * SCB_SIZE;
constexpr int SC_CST = SC_Y + SC_NB * 4096;
constexpr int SC_AFR = SC_CST + 1280;
constexpr int SC_PS = SC_AFR + 16384;
constexpr int SC_SCR = SC_PS + SC_NB * 512;
constexpr int SC_FLG = SC_SCR + 16384;
constexpr int SC_CY = SC_FLG + 64;
static_assert(SC_CY + SC_NB * 256 <= LDS_BAR_OFF, "scan LDS map overflows");
DI void lds_wait_ge(volatile LAS int* p, int v) { while (*p < v) __builtin_amdgcn_s_sleep(1); asm volatile("" ::: "memory"); }
DI void p_rwkv_scan(const Frame& F) {
    const bf16_t* RK = (const bf16_t*)(F.ws + WS1_RK);
    bf16_t* Y = (bf16_t*)(F.ws + WS1_Y); float* BON = (float*)(F.ws + WS1_BON);
    const float* k_k = F.in[21]; const float* k_a = F.in[22]; const float* r_k = F.in[23];
    LAS unsigned char* lds = F.lds;
    const int tid = F.tid, lane = F.lane;
    constexpr int NCH = SEQ / SC_L;
    for (int u = F.bid; u < 256; u += F.G) {
        const int b = u >> 5, hd = (u >> 1) & 15, z = u & 1;
        __syncthreads();
        if (tid < 16) ((volatile LAS int*)(lds + SC_FLG))[tid] = 0;
        { const float* w2 = F.in[15] + (size_t)z * 65536 + hd * 64; const float* a2 = F.in[18] + (size_t)z * 65536 + hd * 64;
          LAS unsigned short* stw = (LAS unsigned short*)(lds + SC_AFR);
          for (int idx = tid; idx < 8192; idx += NTHREADS) { const int mat = idx >> 12, i = (idx >> 6) & 63, c = idx & 63;
              const float v = (mat ? a2 : w2)[(size_t)i * 1024 + c]; stw[mat * 4096 + c * 64 + i] = (unsigned short)(pack_bf16(v, 0.f) & 0xffffu); } }
        __syncthreads();
        if (F.wave >= 4) {
            const int pw = F.wave - 4, s16 = lane & 15, q = lane >> 4;
            const int chb = hd * 64 + 4 * q;
            const LAS unsigned short* stg = (const LAS unsigned short*)(lds + SC_AFR);
            LAS float* cst = (LAS float*)(lds + SC_CST);
            { cst[lane] = F.in[13][z * 1024 + hd * 64 + lane]; cst[64 + lane] = F.in[16][z * 1024 + hd * 64 + lane]; cst[128 + lane] = k_k[hd * 64 + lane]; cst[192 + lane] = k_a[hd * 64 + lane]; cst[256 + lane] = r_k[hd * 64 + lane]; }
            u32x2 rr[4], kr[4], vr[4]; u32x4 Bw[2], Ba[2];
#define SC_ROW(i_) ((size_t)(b * SEQ + (z ? (SEQ - 1 - (i_)) : (i_))))
#define SC_LOADC(cc) do { int s16l_ = s16, ql_ = q; asm volatile("" : "+v"(s16l_), "+v"(ql_)); const int chb_ = hd * 64 + 4 * ql_;     \
        const bf16_t* rp_ = RK + SC_ROW((cc) * SC_L + s16l_) * RW_N; \
        _Pragma("unroll") for (int cb = 0; cb < 4; ++cb) { rr[cb] = *(const u32x2*)(rp_ + chb_ + 16 * cb); kr[cb] = *(const u32x2*)(rp_ + 1024 + chb_ + 16 * cb); vr[cb] = *(const u32x2*)(rp_ + 2048 + chb_ + 16 * cb); } \
        _Pragma("unroll") for (int ks = 0; ks < 2; ++ks) { Bw[ks] = *(const u32x4*)(rp_ + 3072 + 64 * z + 32 * ks + 8 * ql_); Ba[ks] = *(const u32x4*)(rp_ + 3328 + 64 * z + 32 * ks + 8 * ql_); } } while (0)
#define SC_XFORM(cc_, buf_) do { \
            int s16_ = s16, q_ = q; asm volatile("" : "+v"(s16_), "+v"(q_));     \
            LAS unsigned char* bp = lds + (buf_) * SCB_SIZE; const int t_ = s16_; const bool odd_ = (s16_ & 1) != 0; \
            float ss = 0.f, bs = 0.f; LAS float* scr_ = (LAS float*)(lds + SC_SCR) + (pw * 4) * 256 + (q_ * 16 + s16_) * 4;     \
            _Pragma("unroll") for (int cb = 0; cb < 4; ++cb) { \
                f32x4 dw = __builtin_amdgcn_mfma_f32_16x16x32_bf16(*(const LAS bf16x8*)(stg + (16 * cb + s16_) * 64 + 8 * q_), __builtin_bit_cast(bf16x8, Bw[0]), (f32x4){0.f, 0.f, 0.f, 0.f}, 0, 0, 0); \
                dw = __builtin_amdgcn_mfma_f32_16x16x32_bf16(*(const LAS bf16x8*)(stg + (16 * cb + s16_) * 64 + 32 + 8 * q_), __builtin_bit_cast(bf16x8, Bw[1]), dw, 0, 0, 0); \
                f32x4 da = __builtin_amdgcn_mfma_f32_16x16x32_bf16(*(const LAS bf16x8*)(stg + 4096 + (16 * cb + s16_) * 64 + 8 * q_), __builtin_bit_cast(bf16x8, Ba[0]), (f32x4){0.f, 0.f, 0.f, 0.f}, 0, 0, 0); \
                da = __builtin_amdgcn_mfma_f32_16x16x32_bf16(*(const LAS bf16x8*)(stg + 4096 + (16 * cb + s16_) * 64 + 32 + 8 * q_), __builtin_bit_cast(bf16x8, Ba[1]), da, 0, 0, 0); \
                const f32x4 w0v = *(const LAS f32x4*)(cst + 16 * cb + 4 * q_), a0v = *(const LAS f32x4*)(cst + 64 + 16 * cb + 4 * q_); \
                const f32x4 kkw = *(const LAS f32x4*)(cst + 128 + 16 * cb + 4 * q_), kaw = *(const LAS f32x4*)(cst + 192 + 16 * cb + 4 * q_), rkw = *(const LAS f32x4*)(cst + 256 + 16 * cb + 4 * q_); \
                const float r4[4] = {bf_lo(rr[cb].x), bf_hi(rr[cb].x), bf_lo(rr[cb].y), bf_hi(rr[cb].y)}, k4[4] = {bf_lo(kr[cb].x), bf_hi(kr[cb].x), bf_lo(kr[cb].y), bf_hi(kr[cb].y)}; \
                f32x4 dec, azq, kzq; \
                _Pragma("unroll") for (int e = 0; e < 4; ++e) { \
                    const float sgw = __builtin_amdgcn_rcpf(1.0f + __builtin_amdgcn_exp2f(-1.4426950408889634f * (dw[e] + w0v[e])));     \
                    dec[e] = __builtin_amdgcn_exp2f(-0.8750387749f * sgw);                                                     \
                    const float az = __builtin_amdgcn_rcpf(1.0f + __builtin_amdgcn_exp2f(-1.4426950408889634f * (da[e] + a0v[e]))); azq[e] = az; \
                    { const float kk_ = k4[e] * kkw[e]; ss += kk_ * kk_; } kzq[e] = k4[e] * (1.0f + (az - 1.0f) * kaw[e]); bs += r4[e] * kzq[e] * rkw[e]; } \
                { const int o = t_ * SCP + (16 * cb + 4 * q_) * 4; \
                    *(LAS f32x4*)(scr_ + cb * 256) = azq; *(LAS f32x4*)(bp + SCB_BKZ + o) = kzq;     \
                    *(LAS f32x4*)(bp + SCB_W + o) = dec;                        \
                    *(LAS f32x4*)(bp + SCB_VV + o) = (f32x4){bf_lo(vr[cb].x), bf_hi(vr[cb].x), bf_lo(vr[cb].y), bf_hi(vr[cb].y)}; } } \
            ss += __shfl_xor(ss, 16); ss += __shfl_xor(ss, 32); bs += __shfl_xor(bs, 16); bs += __shfl_xor(bs, 32); \
            const float inv = __builtin_amdgcn_rsqf(fmaxf(ss, 1e-24f));     \
              \
            float s_bb = 0.f, s_kk = 0.f, c_g = 0.f, c_h = 0.f, c_br = 0.f, c_kr = 0.f; const bool pB_ = (s16_ & 2) != 0;     \
            f32x4 Ga = (f32x4){0.f, 0.f, 0.f, 0.f}, Gr = Ga;     \
            _Pragma("unroll") for (int cb = 0; cb < 4; ++cb) { float kn[4], bo[4], bq[4], kq[4]; \
                const float r4[4] = {bf_lo(rr[cb].x), bf_hi(rr[cb].x), bf_lo(rr[cb].y), bf_hi(rr[cb].y)}, k4[4] = {bf_lo(kr[cb].x), bf_hi(kr[cb].x), bf_lo(kr[cb].y), bf_hi(kr[cb].y)}; \
                const f32x4 kkw = *(const LAS f32x4*)(cst + 128 + 16 * cb + 4 * q_); \
                const f32x4 dcv = *(const LAS f32x4*)(bp + SCB_W + t_ * SCP + (16 * cb + 4 * q_) * 4), wp = *(const LAS f32x4*)(bp + SCB_W + (t_ ^ 1) * SCP + (16 * cb + 4 * q_) * 4);     \
                const f32x4 azq = *(const LAS f32x4*)(scr_ + cb * 256), kzq = *(const LAS f32x4*)(bp + SCB_BKZ + t_ * SCP + (16 * cb + 4 * q_) * 4); \
                _Pragma("unroll") for (int e = 0; e < 4; ++e) { kn[e] = k4[e] * kkw[e] * inv; bo[e] = kn[e] * azq[e]; \
                    bq[e] = dpp_g<0xB1>(bo[e]); kq[e] = dpp_g<0xB1>(kzq[e]); \
                    const float ao = -kn[e], rd = r4[e] * dcv[e]; \
                    s_bb += bo[e] * r4[e]; s_kk += kzq[e] * r4[e]; c_g += bq[e] * ao; c_h += kq[e] * ao; c_br += bq[e] * rd; c_kr += kq[e] * rd; } \
                float fb[4], fk[4], xa[4], xr[4], wq[4], sA[4], sB[4]; \
                _Pragma("unroll") for (int e = 0; e < 4; ++e) { const float wpr = dcv[e] * wp[e], wo = dpp_g<0x4E>(wpr);     \
                    const float mb = odd_ ? 1.0f : wp[e], ma = odd_ ? -wp[e] : -1.0f, mr = odd_ ? wpr : dcv[e]; \
                    fb[e] = bo[e] * mb; fk[e] = kzq[e] * mb; xa[e] = kn[e] * ma; xr[e] = r4[e] * mr; wq[e] = wpr * wo; sA[e] = pB_ ? 1.0f : wo; sB[e] = pB_ ? wo : 1.0f; \
                    const float fb0 = dpp_g<0x00>(fb[e]), fk0 = dpp_g<0x00>(fk[e]), fb1 = dpp_g<0x55>(fb[e]), fk1 = dpp_g<0x55>(fk[e]);     \
                    Ga[0] += fb0 * xa[e]; Ga[1] += fk0 * xa[e]; Ga[2] += fb1 * xa[e]; Ga[3] += fk1 * xa[e]; Gr[0] += fb0 * xr[e]; Gr[1] += fk0 * xr[e]; Gr[2] += fb1 * xr[e]; Gr[3] += fk1 * xr[e]; } \
                *(LAS f32x4*)(bp + SCB_W + t_ * SCP + (16 * cb + 4 * q_) * 4) = (f32x4){wq[0], wq[1], wq[2], wq[3]};            \
                *(LAS u32x4*)(bp + SCB_BKZ + t_ * SCP + (16 * cb + 4 * q_) * 4) = (u32x4){pack_bf16(fb[0] * sA[0], fk[0] * sA[0]), pack_bf16(fb[1] * sA[1], fk[1] * sA[1]), pack_bf16(fb[2] * sA[2], fk[2] * sA[2]), pack_bf16(fb[3] * sA[3], fk[3] * sA[3])};     \
                *(LAS u32x2*)(bp + SCB_AR + t_ * SCP + ((cb >> 1) * 4 + q_) * 16 + (cb & 1) * 8) = (u32x2){pack_bf16(xa[0] * sB[0], xa[1] * sB[1]), pack_bf16(xa[2] * sB[2], xa[3] * sB[3])};            \
                *(LAS u32x2*)(bp + SCB_AR + t_ * SCP + 128 + ((cb >> 1) * 4 + q_) * 16 + (cb & 1) * 8) = (u32x2){pack_bf16(xr[0] * sB[0], xr[1] * sB[1]), pack_bf16(xr[2] * sB[2], xr[3] * sB[3])}; }   \
            s_bb += __shfl_xor(s_bb, 16); s_bb += __shfl_xor(s_bb, 32); s_kk += __shfl_xor(s_kk, 16); s_kk += __shfl_xor(s_kk, 32); \
            c_g += __shfl_xor(c_g, 16); c_g += __shfl_xor(c_g, 32); c_h += __shfl_xor(c_h, 16); c_h += __shfl_xor(c_h, 32); \
            c_br += __shfl_xor(c_br, 16); c_br += __shfl_xor(c_br, 32); c_kr += __shfl_xor(c_kr, 16); c_kr += __shfl_xor(c_kr, 32); \
            _Pragma("unroll") for (int e = 0; e < 4; ++e) { Ga[e] += __shfl_xor(Ga[e], 16); Ga[e] += __shfl_xor(Ga[e], 32); Gr[e] += __shfl_xor(Gr[e], 16); Gr[e] += __shfl_xor(Gr[e], 32); } \
            if (q_ == 0) { LAS float* ps_ = (LAS float*)(lds + SC_PS + (buf_) * 512) + (t_ >> 1) * 8;     \
                if (odd_) { ps_[0] = c_g; ps_[1] = c_h; } \
                if (pB_) { LAS float* pq_ = (LAS float*)(lds + SC_PS + (buf_) * 512) + 64 + (t_ >> 2) * 16 + (odd_ ? 4 : 0); *(LAS f32x4*)pq_ = Ga; } \
                  \
                const float o0_ = odd_ ? c_br : s_bb, o1_ = odd_ ? c_kr : s_kk, o2_ = odd_ ? s_bb : 0.f, o3_ = odd_ ? s_kk : 0.f; \
                const unsigned ow0_ = pack_bf16(o0_, o1_), ow1_ = pack_bf16(o2_, o3_), gw0_ = pack_bf16(Gr[0], Gr[1]), gw1_ = pack_bf16(Gr[2], Gr[3]); \
                *(LAS u32x4*)(lds + SC_CY + (buf_) * 256 + (t_ >> 2) * 64 + (t_ & 3) * 16) = pB_ ? (u32x4){gw0_, gw1_, ow0_, ow1_} : (u32x4){ow0_, ow1_, 0u, 0u}; \
                BON[((size_t)z * T + SC_ROW((cc_) * SC_L + t_)) * 16 + hd] = bs; } } while (0)
#define SC_FLUSH(cc, slot_) do { const LAS float* yb_ = (const LAS float*)(lds + SC_Y + (slot_) * 4096); const int ft_ = lane >> 2, fj_ = (lane & 3) * 16;     \
            const f32x4 y0_ = *(const LAS f32x4*)(yb_ + ft_ * 64 + fj_), y1_ = *(const LAS f32x4*)(yb_ + ft_ * 64 + fj_ + 4), y2_ = *(const LAS f32x4*)(yb_ + ft_ * 64 + fj_ + 8), y3_ = *(const LAS f32x4*)(yb_ + ft_ * 64 + fj_ + 12); \
            bf16_t* yp_ = Y + ((size_t)z * T + SC_ROW((cc) * SC_L + ft_)) * D + hd * 64 + fj_; \
            *(u32x4*)yp_ = (u32x4){pack_bf16(y0_[0], y0_[1]), pack_bf16(y0_[2], y0_[3]), pack_bf16(y1_[0], y1_[1]), pack_bf16(y1_[2], y1_[3])}; \
            *(u32x4*)(yp_ + 8) = (u32x4){pack_bf16(y2_[0], y2_[1]), pack_bf16(y2_[2], y2_[3]), pack_bf16(y3_[0], y3_[1]), pack_bf16(y3_[2], y3_[3])}; } while (0)
            volatile LAS int* rdy = (volatile LAS int*)(lds + SC_FLG); volatile LAS int* prog = rdy + 8;
            SC_LOADC(pw);
            for (int n = pw; n < NCH; n += 4) {
                const int buf = n % SC_NB;
                if (n >= SC_NB) { lds_wait_ge(prog + 0, n - 4); lds_wait_ge(prog + 1, n - 4); lds_wait_ge(prog + 2, n - 4); lds_wait_ge(prog + 3, n - 4); SC_FLUSH(n - SC_NB, buf); }
                SC_XFORM(n, buf);
                asm volatile("s_waitcnt lgkmcnt(0)" ::: "memory");
                if (lane == 0) rdy[buf] = n + 1;
                if (n + 4 < NCH) SC_LOADC(n + 4);
            }
            for (int c = NCH - SC_NB; c < NCH; ++c) if (((c + SC_NB) & 3) == pw) {
                lds_wait_ge(prog + 0, c + 1); lds_wait_ge(prog + 1, c + 1); lds_wait_ge(prog + 2, c + 1); lds_wait_ge(prog + 3, c + 1); SC_FLUSH(c, c % SC_NB); }
#undef SC_ROW
#undef SC_LOADC
#undef SC_XFORM
#undef SC_FLUSH
        } else {
            const int w = F.wave, i16 = lane & 15, q = lane >> 4;
            f32x4 Sd[4];
#pragma unroll
            for (int k = 0; k < 4; ++k) Sd[k] = (f32x4){0.f, 0.f, 0.f, 0.f};
            const int m4 = i16 & 3;
            const int w_off = (4 * q) * 4, bkz_off = i16 * 4, vv_off = (16 * w + i16) * 4, ar_off = (m4 & 1) * SCP + (m4 >> 1) * 128 + q * 16;
            const bool qodd = (q & 1) != 0; const unsigned qmask = (q & 2) ? 0u : 0xffffffffu;
            const int bkq_off = (2 * (q & 1)) * SCP + i16 * 4;
            __builtin_amdgcn_s_setprio(3);
            typedef short s16x4v __attribute__((ext_vector_type(4)));
#define ST_LD(o_, Q_) do { _Pragma("unroll") for (int j = 0; j < 4; ++j) o_.vv[j] = *(const LAS float*)(bp + SCB_VV + (4 * (Q_) + j) * SCP + vv_off); \
        o_.a1lo = *(const LAS bf16x8*)(bp + SCB_AR + (4 * (Q_)) * SCP + ar_off); o_.a1hi = *(const LAS bf16x8*)(bp + SCB_AR + (4 * (Q_)) * SCP + 64 + ar_off); \
        o_.a2lo = *(const LAS bf16x8*)(bp + SCB_AR + (4 * (Q_) + 2) * SCP + ar_off); o_.a2hi = *(const LAS bf16x8*)(bp + SCB_AR + (4 * (Q_) + 2) * SCP + 64 + ar_off); } while (0)
#define ST_STEP(o_, Q_) do { \
        const bf16x8 Bd0 = __builtin_bit_cast(bf16x8, (u32x4){pack_bf16(Sd[0][0], Sd[0][1]), pack_bf16(Sd[0][2], Sd[0][3]), pack_bf16(Sd[1][0], Sd[1][1]), pack_bf16(Sd[1][2], Sd[1][3])}); \
        const bf16x8 Bd1 = __builtin_bit_cast(bf16x8, (u32x4){pack_bf16(Sd[2][0], Sd[2][1]), pack_bf16(Sd[2][2], Sd[2][3]), pack_bf16(Sd[3][0], Sd[3][1]), pack_bf16(Sd[3][2], Sd[3][3])}); \
        const f32x4 d1a = __builtin_amdgcn_mfma_f32_16x16x32_bf16(o_.a1lo, Bd0, (f32x4){0.f, 0.f, 0.f, 0.f}, 0, 0, 0); \
        const f32x4 e1a = __builtin_amdgcn_mfma_f32_16x16x32_bf16(o_.a2lo, Bd0, (f32x4){0.f, 0.f, 0.f, 0.f}, 0, 0, 0); \
        const f32x4 dd = __builtin_amdgcn_mfma_f32_16x16x32_bf16(o_.a1hi, Bd1, d1a, 0, 0, 0); \
        const f32x4 ee = __builtin_amdgcn_mfma_f32_16x16x32_bf16(o_.a2hi, Bd1, e1a, 0, 0, 0); \
        const LAS float* pa_ = psp + (2 * (Q_)) * 8; const LAS float* pg_ = psp + 64 + (Q_) * 16; \
        const f32x4 pA0 = *(const LAS f32x4*)pa_, pB0 = *(const LAS f32x4*)(pa_ + 8), g0 = *(const LAS f32x4*)pg_, g1 = *(const LAS f32x4*)(pg_ + 4); \
        const u32x2 cyw = *(const LAS u32x2*)(cyp + (Q_) * 64); \
        f32x4 wv[4]; u32x2 bk[4]; \
        _Pragma("unroll") for (int k = 0; k < 4; ++k) { wv[k] = *(const LAS f32x4*)(bp + SCB_W + (4 * (Q_)) * SCP + 64 * k + w_off); \
            bk[k] = (u32x2){*(const LAS unsigned*)(bkp + (4 * (Q_)) * SCP + 64 * k), *(const LAS unsigned*)(bkp + (4 * (Q_) + 1) * SCP + 64 * k)}; } \
        const float v1 = o_.vv[0], v2 = o_.vv[1], v3 = o_.vv[2], v4 = o_.vv[3]; \
        const float u1 = dd[0]; \
        const float u2 = dd[1] + u1 * pA0[0] + v1 * pA0[1]; \
        const float u3 = ee[0] + u1 * g0[0] + v1 * g0[1] + u2 * g0[2] + v2 * g0[3]; \
        const float u4 = ee[1] + u1 * g1[0] + v1 * g1[1] + u2 * g1[2] + v2 * g1[3] + u3 * pB0[0] + v3 * pB0[1]; \
        const float x0_ = qodd ? u3 : u1, x1_ = qodd ? v3 : v1, x2_ = qodd ? u4 : u2, x3_ = qodd ? v4 : v2;     \
        const unsigned b2lo = pack_bf16(x0_, x1_) & qmask, b2hi = pack_bf16(x2_, x3_) & qmask;     \
        const s16x4v B2 = __builtin_bit_cast(s16x4v, (u32x2){b2lo, b2hi}); \
        _Pragma("unroll") for (int k = 0; k < 4; ++k) Sd[k] = __builtin_amdgcn_mfma_f32_16x16x16bf16_1k(__builtin_bit_cast(s16x4v, bk[k]), B2, Sd[k] * wv[k], 0, 0, 0); \
        const f32x4 yv = __builtin_amdgcn_mfma_f32_16x16x16bf16_1k(__builtin_bit_cast(s16x4v, cyw), B2, (f32x4){dd[2], dd[3], ee[2], ee[3]}, 0, 0, 0);     \
        yb[(4 * (Q_)) * 64 + 16 * w + i16] = yv[0]; yb[(4 * (Q_) + 1) * 64 + 16 * w + i16] = yv[1]; yb[(4 * (Q_) + 2) * 64 + 16 * w + i16] = yv[2]; yb[(4 * (Q_) + 3) * 64 + 16 * w + i16] = yv[3]; } while (0)
            struct StepOps { float vv[4]; bf16x8 a1lo, a1hi, a2lo, a2hi; };
            volatile LAS int* rdy = (volatile LAS int*)(lds + SC_FLG); volatile LAS int* prog = rdy + 8;
            int buf = 0;
            for (int c = 0; c < NCH; ++c) {
                const LAS unsigned char* bp = lds + buf * SCB_SIZE; LAS float* yb = (LAS float*)(lds + SC_Y + buf * 4096);
                const LAS unsigned char* bkp = bp + SCB_BKZ + bkq_off;
                const LAS float* psp = (const LAS float*)(lds + SC_PS + buf * 512);
                const LAS unsigned char* cyp = lds + SC_CY + buf * 256 + (i16 & 3) * 16 + (q & 1) * 8;
                lds_wait_ge(rdy + buf, c + 1);
                const bool conv = (c & 3) == w; float tv[16]; const int tr = u * NCH + c, ttab = tr >> 14, trow = tr & 16383;
                int ln2 = lane; asm volatile("" : "+v"(ln2));
                if (conv) fp8_row_load(F.in[ttab ? 30 : 29] + (size_t)N_EXPERTS * 1024, trow, ln2, tv);
                else {
#pragma unroll
                    for (int i = 0; i < 16; ++i) tv[i] = 0.f; }
                StepOps oa, ob; ST_LD(oa, 0);
                ST_LD(ob, 1); ST_STEP(oa, 0);
                ST_LD(oa, 2); ST_STEP(ob, 1);
                ST_LD(ob, 3); ST_STEP(oa, 2);
                ST_STEP(ob, 3);
                asm volatile("s_waitcnt lgkmcnt(0)" ::: "memory");
                if (lane == 0) prog[w] = c + 1;
                if (conv) fp8_row_store(tv, trow, ln2, F.ws + (ttab ? WS_PV1 : WS_PU1), (float*)(F.ws + WS_PSC) + (2 + ttab) * N_EXPERTS);
                buf = (buf + 1 == SC_NB) ? 0 : buf + 1;
            }
#undef ST_LD
#undef ST_STEP
            __builtin_amdgcn_s_setprio(0);
            __builtin_amdgcn_s_setprio(0);
        }
    }
    __syncthreads();
}

DI void unpack8(const u32x4 w, float* o) { o[0] = bf_lo(w.x); o[1] = bf_hi(w.x); o[2] = bf_lo(w.y); o[3] = bf_hi(w.y); o[4] = bf_lo(w.z); o[5] = bf_hi(w.z); o[6] = bf_lo(w.w); o[7] = bf_hi(w.w); }
DI void p_rwkv_post(const Frame& F) {
    const bf16_t* RK = (const bf16_t*)(F.ws + WS1_RK); const bf16_t* Y = (const bf16_t*)(F.ws + WS1_Y); const float* BON = (const float*)(F.ws + WS1_BON);
    const bf16_t* G = (const bf16_t*)(F.ws + WS1_G); bf16_t* A3 = (bf16_t*)(F.ws + WS1_A3);
    const float* ln_g = F.in[24]; const float* ln_b = F.in[25];
    const int lane = F.lane, c0 = 16 * lane, hd = lane >> 2;
    for (int t = F.bid * NWAVES + F.wave; t < T; t += F.G * NWAVES) {
        float y[16], tmp[16], vv[16], gg[16];
        unpack8(*(const u32x4*)(Y + (size_t)t * D + c0), y); unpack8(*(const u32x4*)(Y + (size_t)t * D + c0 + 8), y + 8);
        unpack8(*(const u32x4*)(Y + ((size_t)T + t) * D + c0), tmp); unpack8(*(const u32x4*)(Y + ((size_t)T + t) * D + c0 + 8), tmp + 8);
        unpack8(*(const u32x4*)(RK + (size_t)t * RW_N + 2048 + c0), vv); unpack8(*(const u32x4*)(RK + (size_t)t * RW_N + 2048 + c0 + 8), vv + 8);
        unpack8(*(const u32x4*)(G + (size_t)t * D + c0), gg); unpack8(*(const u32x4*)(G + (size_t)t * D + c0 + 8), gg + 8);
        const float bon = BON[(size_t)t * 16 + hd] + BON[((size_t)T + t) * 16 + hd];
        float sm = 0.f;
#pragma unroll
        for (int e = 0; e < 16; ++e) { y[e] += tmp[e]; sm += y[e]; }
        sm += __shfl_xor(sm, 1); sm += __shfl_xor(sm, 2);
        const float mu = sm * (1.0f / 64.0f);
        float vr = 0.f;
#pragma unroll
        for (int e = 0; e < 16; ++e) { const float d = y[e] - mu; vr += d * d; }
        vr += __shfl_xor(vr, 1); vr += __shfl_xor(vr, 2);
        const float rs = rsqrtf(vr * (1.0f / 64.0f) + 64e-5f);
        float o[16];
#pragma unroll
        for (int q = 0; q < 4; ++q) { const f32x4 lg = *(const f32x4*)(ln_g + c0 + 4 * q), lb = *(const f32x4*)(ln_b + c0 + 4 * q);
#pragma unroll
            for (int e = 0; e < 4; ++e) { const int i = 4 * q + e; o[i] = ((y[i] - mu) * rs * lg[e] + lb[e] + bon * vv[i]) * gg[i]; } }
        u32x4 w0, w1; w0.x = pack_bf16(o[0], o[1]); w0.y = pack_bf16(o[2], o[3]); w0.z = pack_bf16(o[4], o[5]); w0.w = pack_bf16(o[6], o[7]);
        w1.x = pack_bf16(o[8], o[9]); w1.y = pack_bf16(o[10], o[11]); w1.z = pack_bf16(o[12], o[13]); w1.w = pack_bf16(o[14], o[15]);
        *(u32x4*)(A3 + (size_t)t * D + c0) = w0; *(u32x4*)(A3 + (size_t)t * D + c0 + 8) = w1;
    }
}
__global__ void __launch_bounds__(NTHREADS, 2) mega_fwd(Params P) {
    extern __shared__ __attribute__((aligned(16))) unsigned char lds_raw[];
    Frame F;
    F.lds = (LAS unsigned char*)lds_raw;
    F.tid = threadIdx.x; F.lane = F.tid & 63; F.wave = __builtin_amdgcn_readfirstlane(F.tid >> 6);
    F.G = gridDim.x; F.bid = blockIdx.x; F.in = P.in; F.out = P.out; F.ws = P.ws;
    volatile LAS unsigned* bst = (volatile LAS unsigned*)(F.lds + LDS_BAR_OFF);
    if (F.tid == 0) { bst[0] = 0u; bst[1] = 0u; bst[2] = 0u; bst[3] = 0u; }
    __syncthreads();
    XcdBarrier bar = xcd_barrier_post((unsigned*)(P.ws + WS_CTL), bst);
    const int lo = P.ph_lo, hi = P.ph_hi;
#ifdef ONLY_PHASE
#define IN(k) ((k) == ONLY_PHASE && lo <= (k) && (k) < hi)
#else
#define IN(k) (lo <= (k) && (k) < hi)
#endif
#define SEAM(k) do { if (IN(k) && IN((k) + 1)) xcd_barrier(bar); } while (0)
#define LSEAM(k) do { if (IN(k) && IN((k) + 1)) __syncthreads(); } while (0)
#define LAUNDER(T, dst, src) T dst; { unsigned long long _v = (unsigned long long)(src); unsigned _lo = (unsigned)_v, _hi = (unsigned)(_v >> 32); asm volatile("" : "+s"(_lo), "+s"(_hi)); dst = (T)(__attribute__((address_space(1))) unsigned char*)(((unsigned long long)_hi << 32) | _lo); }
#define PH_BEGIN LAUNDER(unsigned char*, ws, P.ws) LAUNDER(float*, outp, P.out) F.ws = ws; F.out = outp; \
    const float* mod0 = (const float*)(ws + WS_MOD); const float* mod1 = mod0 + 8 * 6144; const float* norm_g = P.in[4]; bf16_t* H = (bf16_t*)(ws + WS_H); bf16_t* H2 = (bf16_t*)(ws + WS1_H2); \
    (void)mod0; (void)mod1; (void)norm_g; (void)H; (void)H2;

    if (IN(0)) { PH_BEGIN p0_prologue(F); } SEAM(0);
    if (IN(1)) { PH_BEGIN p_norm<false>(F, P.in[0], norm_g + 0 * 1024, mod0, 0, 1024, H); } SEAM(1);
    if (IN(2)) { PH_BEGIN pg8::Gemm g{H, (const bf16_t*)(ws + WS_WIN_T), T, IN_W, 1024, 1024, 1024}; pg8::StaticOrder S; S.init(T, IN_W, F.G, F.bid);
        pg8::EpiBf16<0> E{(bf16_t*)(ws + WS_QKV), IN_W}; pg8::gemm_phase(F.lds, g, S, E);
        p0_late_weights(F, (T / 256) * (IN_W / 256)); } SEAM(2);
    if (IN(3)) { PH_BEGIN p_qkprep(F); } SEAM(3);
    if (IN(4)) { PH_BEGIN p_attention<3>(F); } SEAM(4);
    if (IN(5)) { PH_BEGIN pg8::Gemm g{(const bf16_t*)(ws + WS_O), (const bf16_t*)(ws + WS_WOUT_T), T, 1024, 1024, 1024, 1024}; pg8::StaticOrder S; S.init(T, 1024, F.G, F.bid);
        pg8::EpiResid<false> E{P.in[0], (bf16_t*)(ws + WS_XB), mod0 + 2048, (float*)(ws + WS_SSQ)}; pg8::gemm_phase(F.lds, g, S, E); } SEAM(5);
    if (IN(7)) { PH_BEGIN pg8::Gemm g{(const bf16_t*)(ws + WS_XB), (const bf16_t*)outp, T, 2048, 1024, 1024, 1024}; pg8::BatchOrder S; S.init(T, 2048, F.G, F.bid);
        pg8::EpiQ E{(bf16_t*)(ws + WS_PQ), PQ_LD, (const float*)(ws + WS_SSQ), (const float*)(ws + WS_BQ), nullptr, -1}; { pg8::Unit u0; E.prep(F.lds, S.next(0, u0) ? u0.pm : -1, F.tid); } pg8::gemm_phase(F.lds, g, S, E); } SEAM(7);
    if (IN(8)) { PH_BEGIN p_peer_topk(F, (const bf16_t*)(ws + WS_PQ), (const bf16_t*)(ws + WS_SK), (int*)(ws + WS_EIDX), (float*)(ws + WS_GATE)); } LSEAM(8);
    if (IN(9)) { PH_BEGIN p_peer_gather<false>(F, norm_g + 1 * 1024, mod0, ws + WS_PU0, ws + WS_PV0, (const float*)(ws + WS_PSC), (const float*)(ws + WS_PSC) + N_EXPERTS, (const int*)(ws + WS_EIDX), (const float*)(ws + WS_GATE), mod0 + 5120, (bf16_t*)(ws + WS_XB), outp); } SEAM(9);
    if (IN(10)) { PH_BEGIN p_rwkv_prep(F, (const bf16_t*)(ws + WS_XB), norm_g + 2 * 1024, mod1, P.in[11], (bf16_t*)(ws + WS1_X6)); } SEAM(10);
    if (IN(11)) { PH_BEGIN pg8::Gemm g{(const bf16_t*)(ws + WS1_X6), (const bf16_t*)(ws + WS_WRW_T), 6 * T, RW_N, 1024, 1024, 1024}; pg8::RwOrder S; S.init(F.G, F.bid);
        pg8::EpiBf16<1> E{(bf16_t*)(ws + WS1_RK), RW_N}; pg8::gemm_phase(F.lds, g, S, E);
        p0_late_weights2(F); } SEAM(11);
    if (IN(12)) { PH_BEGIN pg8::Gemm g{(const bf16_t*)(ws + WS1_RK) + 3584, (const bf16_t*)(ws + WS_G2_T), T, 1024, 256, RW_N, 256}; pg8::StaticOrder S; S.init(T, 1024, F.G, F.bid);
        pg8::EpiBf16<0> E{(bf16_t*)(ws + WS1_G), 1024}; pg8::gemm_phase(F.lds, g, S, E); }
    if (IN(13)) { PH_BEGIN p_rwkv_scan(F); } SEAM(13);
    if (IN(14)) { PH_BEGIN p_rwkv_post(F); } SEAM(14);
    if (IN(15)) { PH_BEGIN pg8::Gemm g{(const bf16_t*)(ws + WS1_A3), (const bf16_t*)(ws + WS_WO_T), T, 1024, 1024, 1024, 1024}; pg8::StaticOrder S; S.init(T, 1024, F.G, F.bid);
        pg8::EpiResid<true> E{ws + WS_XB, (bf16_t*)(ws + WS_XB), mod1 + 2048, (float*)(ws + WS_SSQ)}; pg8::gemm_phase(F.lds, g, S, E); } SEAM(15);
    if (IN(17)) { PH_BEGIN pg8::Gemm g{(const bf16_t*)(ws + WS_XB), (const bf16_t*)outp + (size_t)8 * 2048 * 1024, T, 2048, 1024, 1024, 1024}; pg8::BatchOrder S; S.init(T, 2048, F.G, F.bid);
        pg8::EpiQ E{(bf16_t*)(ws + WS1_PQ), PQ_LD, (const float*)(ws + WS_SSQ), (const float*)(ws + WS_BQ) + 8 * 2048, nullptr, -1}; { pg8::Unit u0; E.prep(F.lds, S.next(0, u0) ? u0.pm : -1, F.tid); } pg8::gemm_phase(F.lds, g, S, E); } SEAM(17);
    if (IN(18)) { PH_BEGIN p_peer_topk(F, (const bf16_t*)(ws + WS1_PQ), (const bf16_t*)(ws + WS_SK) + (size_t)16 * 128 * 128, (int*)(ws + WS1_EIDX), (float*)(ws + WS1_GATE)); } LSEAM(18);
    if (IN(19)) { PH_BEGIN p_peer_gather<true>(F, norm_g + 3 * 1024, mod1, ws + WS_PU1, ws + WS_PV1, (const float*)(ws + WS_PSC) + 2 * N_EXPERTS, (const float*)(ws + WS_PSC) + 3 * N_EXPERTS, (const int*)(ws + WS1_EIDX), (const float*)(ws + WS1_GATE), mod1 + 5120, (bf16_t*)(ws + WS_XB), outp); }
    if (hi <= 5) { const f32x4* s = (const f32x4*)P.in[0]; f32x4* d = (f32x4*)P.out;
        for (size_t i = (size_t)F.bid * NTHREADS + F.tid; i < (size_t)T * D / 4; i += (size_t)F.G * NTHREADS) d[i] = s[i]; }
#undef IN
#undef SEAM
#undef LSEAM
}

#ifndef PH_HI
#define PH_HI 20
#endif
extern "C" void kernel_launch(void* const* d_in, const int* in_sizes, int n_in, void* d_out, int out_size, void* d_ws, size_t ws_size, hipStream_t stream) {
    static int grid = 0;
    if (grid == 0) {
        if (n_in != 31 || out_size != T * D || ws_size < WS_END) { fprintf(stderr, "kernel_launch: unexpected shapes (n_in %d, out %d, ws %zu)\n", n_in, out_size, ws_size); grid = -1; return; }
        int dev = 0, cus = 0, per_cu = 0;
        if (hipGetDevice(&dev) != hipSuccess || hipDeviceGetAttribute(&cus, hipDeviceAttributeMultiprocessorCount, dev) != hipSuccess) { grid = -1; return; }
        if (hipFuncSetAttribute((const void*)mega_fwd, hipFuncAttributeMaxDynamicSharedMemorySize, LDS_BYTES) != hipSuccess) { fprintf(stderr, "kernel_launch: hipFuncSetAttribute failed\n"); grid = -1; return; }
        if (hipOccupancyMaxActiveBlocksPerMultiprocessor(&per_cu, (const void*)mega_fwd, NTHREADS, LDS_BYTES) != hipSuccess || per_cu < 1) { fprintf(stderr, "kernel_launch: occupancy query says %d\n", per_cu); (void)hipGetLastError(); grid = -1; return; }
        grid = cus;
    }
    if (grid < 0) return;
    (void)hipMemsetAsync((char*)d_ws + WS_CTL, 0, CTL_ZERO_BYTES, stream);
    Params p{};
    for (int i = 0; i < 31; ++i) p.in[i] = (const float*)d_in[i];
    p.out = (float*)d_out; p.ws = (unsigned char*)d_ws; p.ph_lo = 0; p.ph_hi = PH_HI;
    hipLaunchKernelGGL(mega_fwd, dim3(grid), dim3(NTHREADS), LDS_BYTES, stream, p);
}
```

```cpp
#include <hip/hip_runtime.h>
#include <cstdio>
#include <cstdint>

#define DI __device__ __forceinline__
#define LAS __attribute__((address_space(3)))
typedef unsigned short bf16_t;
typedef short bf16x8 __attribute__((ext_vector_type(8)));
typedef short s16x4 __attribute__((ext_vector_type(4)));
typedef float f32x2 __attribute__((ext_vector_type(2)));
typedef float f32x4 __attribute__((ext_vector_type(4)));
typedef float f32x16 __attribute__((ext_vector_type(16)));
typedef unsigned u32x2 __attribute__((ext_vector_type(2)));
typedef unsigned u32x4 __attribute__((ext_vector_type(4)));
typedef __bf16 bf16x2v __attribute__((ext_vector_type(2)));

DI unsigned pack_bf16(float lo, float hi) { bf16x2v p; p[0] = (__bf16)lo; p[1] = (__bf16)hi; return __builtin_bit_cast(unsigned, p); }
DI float bf_lo(unsigned u) { return __uint_as_float(u << 16); }
DI float bf_hi(unsigned u) { return __uint_as_float(u & 0xffff0000u); }
DI float bf1(bf16_t v) { return __uint_as_float(((unsigned)v) << 16); }
DI float wave_sum(float v) {
#pragma unroll
    for (int o = 32; o > 0; o >>= 1) v += __shfl_xor(v, o);
    return v;
}
DI float sigmoidf_(float x) { return 1.0f / (1.0f + __expf(-x)); }

constexpr int D = 1024, BATCH = 8, SEQ = 2048, T = BATCH * SEQ;
constexpr int IN_W = 2304;
constexpr int NTHREADS = 512, NWAVES = 8;
constexpr int PQ_LD = 2112;
constexpr int N_EXPERTS = 16384;
constexpr float LOG2E = 1.4426950408889634f;
constexpr float QSCALE = 0.125f * LOG2E;
constexpr size_t MiB = 1ull << 20;

constexpr size_t WS_CTL   = 0;
constexpr size_t CTL_ZERO_BYTES = 16384;
constexpr size_t WS_MOD   = 64 * 1024;
constexpr size_t WS_PSC   = 512 * 1024;
constexpr size_t WS_WIN_T = 1 * MiB;
constexpr size_t WS_WOUT_T= 6 * MiB;
constexpr size_t WS_WRW_T = 8 * MiB;
constexpr size_t WS_W2_T  = 22 * MiB;
constexpr size_t WS_SSQ   = 22 * MiB;
constexpr size_t WS_BQ    = 768 * 1024;
constexpr size_t WS_WO_T  = 27 * MiB;
constexpr size_t WS_WQ_T  = 29 * MiB;
constexpr size_t WS_SK    = 37 * MiB;
constexpr size_t WS_PU1   = 38 * MiB;
constexpr size_t WS_PV1   = 54 * MiB;
constexpr size_t WS_XB    = 70 * MiB;
constexpr size_t WS_PU0   = 102 * MiB;
constexpr size_t WS_PV0   = 134 * MiB;
constexpr size_t WS_ACT   = 166 * MiB;
constexpr size_t WS_H     = WS_ACT + 0 * MiB;
constexpr size_t WS_QKV   = WS_ACT + 32 * MiB;
constexpr size_t WS_QA    = WS_ACT + 104 * MiB;
constexpr size_t WS_KA    = WS_ACT + 120 * MiB;
constexpr size_t WS_VAT   = WS_ACT + 136 * MiB;
constexpr size_t WS_QB    = WS_ACT + 152 * MiB;
constexpr size_t WS_KB    = WS_ACT + 168 * MiB;
constexpr size_t WS_VBT   = WS_ACT + 172 * MiB;
constexpr size_t WS_O     = WS_ACT + 176 * MiB;
constexpr size_t WS_PQ    = WS_ACT + 208 * MiB;
constexpr size_t WS_EIDX  = WS_ACT + 276 * MiB;
constexpr size_t WS_GATE  = WS_ACT + 284 * MiB;
constexpr size_t WS_O0S   = WS_ACT + 292 * MiB;
constexpr size_t WS1_RK   = 102 * MiB;
constexpr size_t WS1_DEC  = 222 * MiB;
constexpr size_t WS1_AZ   = 350 * MiB;
constexpr size_t WS1_G    = 414 * MiB;
constexpr size_t WS1_Y    = 446 * MiB;
constexpr size_t WS1_BON  = 510 * MiB;
constexpr size_t WS1_X6   = 222 * MiB;
constexpr size_t WS1_A3   = 222 * MiB;
constexpr size_t WS1_H2   = 254 * MiB;
constexpr size_t WS1_PQ   = 286 * MiB;
constexpr size_t WS1_EIDX = 354 * MiB;
constexpr size_t WS1_GATE = 362 * MiB;
constexpr size_t WS_END   = 512 * MiB;
constexpr int RW_N = 3840, W2_N = 4096, W2_K = 512;
constexpr size_t WS_G2_T  = 26 * MiB;

constexpr int LDS_BYTES = 147456;
constexpr int LDS_BAR_OFF = 147456 - 64;
#define XB_TMO      128
#define XB_XCNT(j)  (256  + 64 * (j))
#define XB_XSUB(j)  (1280 + 64 * (j))
#define XB_XGEN(j)  (2304 + 64 * (j))
#define XB_TOP      3328
#define XB_TOPGEN   3392
#define XCD_BAR_WORDS 3456
#define XB_SPIN_CAP (1u << 18)

__device__ __forceinline__ unsigned xb_ld(unsigned* p)              { return __hip_atomic_load(p, __ATOMIC_RELAXED, __HIP_MEMORY_SCOPE_AGENT); }
__device__ __forceinline__ unsigned xb_add(unsigned* p, unsigned v) { return __hip_atomic_fetch_add(p, v, __ATOMIC_RELAXED, __HIP_MEMORY_SCOPE_AGENT); }
__device__ __forceinline__ unsigned xb_xcc_id() { return (unsigned)__builtin_amdgcn_s_getreg((3 << 11) | 20) & 0xFu; }
#define XB_SPIN(cond, bar) do { unsigned _sp = 0; while (cond) { __builtin_amdgcn_s_sleep(1); \
    if ((++_sp & 255u) == 0u) { if (xb_ld(&(bar)[XB_TMO])) break; if (_sp > XB_SPIN_CAP) { atomicAdd(&(bar)[XB_TMO], 1u); break; } } } } while (0)

struct XcdBarrier { unsigned* bar; unsigned x; volatile LAS unsigned* st; };

__device__ __forceinline__ XcdBarrier xcd_barrier_post(unsigned* bar, volatile LAS unsigned* st) {
    XcdBarrier b; b.bar = bar; b.x = xb_xcc_id(); b.st = st;
    if (threadIdx.x == 0) (void)xb_add(&bar[XB_XCNT(b.x)], 1u);
    return b;
}
__device__ __forceinline__ void xcd_barrier_complete(unsigned* bar, unsigned x, unsigned& nloc, unsigned& nx) {
    const unsigned G = gridDim.x * gridDim.y * gridDim.z;
    unsigned sum, cnt, mine, sp = 0u;
    for (;;) {
        sum = 0u; cnt = 0u; mine = 0u;
#pragma unroll
        for (unsigned j = 0; j < 16; ++j) { const unsigned c = xb_ld(&bar[XB_XCNT(j)]); sum += c; cnt += (c > 0u) ? 1u : 0u; mine = (j == x) ? c : mine; }
        if (sum == G) break;
        __builtin_amdgcn_s_sleep(1);
        if ((++sp & 255u) == 0u) { if (xb_ld(&bar[XB_TMO])) break; if (sp > XB_SPIN_CAP) { atomicAdd(&bar[XB_TMO], 1u); break; } }
    }
    nloc = mine > 0u ? mine : 1u; nx = cnt > 0u ? cnt : 1u;
}
__device__ __forceinline__ void xcd_barrier(const XcdBarrier& b) {
    asm volatile("s_waitcnt vmcnt(0)" ::: "memory");
    __syncthreads();
    if (threadIdx.x == 0) {
        unsigned* bar; { unsigned long long pv = (unsigned long long)b.bar; unsigned plo = (unsigned)pv, phi = (unsigned)(pv >> 32); asm volatile("" : "+s"(plo), "+s"(phi)); bar = (unsigned*)(__attribute__((address_space(1))) unsigned*)(((unsigned long long)phi << 32) | plo); }
        __builtin_amdgcn_s_waitcnt(0);
        unsigned nloc = b.st[0], nx = b.st[1];
        if (nloc == 0u) { xcd_barrier_complete(bar, b.x, nloc, nx); b.st[0] = nloc; b.st[1] = nx; }
        const unsigned old = xb_add(&bar[XB_XSUB(b.x)], 1u);
        const unsigned gen = old / nloc;
        if (old + 1u == (gen + 1u) * nloc) {
            __builtin_amdgcn_fence(__ATOMIC_RELEASE, "agent");
            asm volatile("s_waitcnt vmcnt(0)" ::: "memory");
            const unsigned og = xb_add(&bar[XB_TOP], 1u);
            const unsigned tg = og / nx;
            if (og + 1u == (tg + 1u) * nx) xb_add(&bar[XB_TOPGEN], 1u);
            else XB_SPIN(xb_ld(&bar[XB_TOPGEN]) == tg, bar);
            __builtin_amdgcn_fence(__ATOMIC_ACQUIRE, "agent");
            xb_add(&bar[XB_XGEN(b.x)], 1u);
            asm volatile("s_waitcnt vmcnt(0)" ::: "memory");
        } else {
            XB_SPIN(xb_ld(&bar[XB_XGEN(b.x)]) == gen, bar);
            __builtin_amdgcn_fence(__ATOMIC_ACQUIRE, "agent");
            asm volatile("s_waitcnt vmcnt(0)" ::: "memory");
        }
    }
    __syncthreads();
}
namespace pg8 {
constexpr int BM = 256, BK = 64, HALF = 128, HTB = HALF * BK * 2, STAGE_BYTES = 8 * HTB, NXCD = 8, WGM = 8;
__host__ __device__ __forceinline__ int lds_byte(int r, int c) { const int st = (r >> 4) * 2 + (c >> 5), rr = r & 15, cc = c & 31, ob = rr * 64 + cc * 2; return st * 1024 + (ob ^ (((ob >> 9) & 1) << 5)); }
__host__ __device__ __forceinline__ void stage_rc(int b, int& R, int& C) { const int st = b / 1024, sb = b % 1024, swz = sb ^ (((sb >> 9) & 1) << 5); R = (st >> 1) * 16 + swz / 64; C = (st & 1) * 32 + (swz % 64) / 2; }
__host__ __device__ __forceinline__ int perm32(int rho) { const int n = rho >> 4, i = rho & 15; return 8 * (i >> 2) + 4 * n + (i & 3); }

struct Unit { int pm, pn; };
struct Gemm { const bf16_t* A; const bf16_t* Bt; int M, N, K, lda, ldb; };

struct StaticOrder {
    int nM, nN, nwg, G, c;
    __device__ void init(int M, int N, int G_, int c_) { nM = M / BM; nN = N / BM; nwg = nM * nN; G = G_; c = c_; }
    __device__ __forceinline__ bool next(int i, Unit& u) const {
        const long L = (long)i * G + c; if (L >= nwg) return false;
        int wgid = (int)L; { const int q = nwg / NXCD, r = nwg % NXCD, xcd = wgid % NXCD, off = wgid / NXCD; wgid = (xcd < r ? xcd * (q + 1) : r * (q + 1) + (xcd - r) * q) + off; }
        const int nig = WGM * nN, gid = wgid / nig, fm = gid * WGM, gsz = (nM - fm) < WGM ? (nM - fm) : WGM;
        u.pm = fm + ((wgid % nig) % gsz); u.pn = (wgid % nig) / gsz; return true;
    }
};

struct BatchOrder {
    StaticOrder S;
    __device__ void init(int M, int N, int G_, int c_) { S.init(M, N, G_, c_); }
    __device__ __forceinline__ bool next(int i, Unit& u) const { if (!S.next(i, u)) return false; u.pn += (u.pm / (SEQ / BM)) * S.nN; return true; }
};

struct RwOrder {
    int G, c;
    __device__ void init(int G_, int c_) { G = G_; c = c_; }
    __device__ __forceinline__ bool next(int i, Unit& u) const {
        int grp, pm, pn;
        if ((G & 7) == 0) { const int x = c & 7, n = i * (G >> 3) + (c >> 3); if (n >= 120) return false;
            const int pmh = n / 15, e = n % 15; pm = x + 8 * pmh;
            if (e < 12) { grp = e >> 2; pn = grp * 4 + (e & 3); } else { grp = 3 + (e - 12); pn = 12 + (e - 12); } }
        else { const int L = i * G + c; if (L >= 960) return false;
            if (L < 768) { grp = L >> 8; pm = L & 63; pn = grp * 4 + ((L >> 6) & 3); } else { const int w = L - 768; grp = 3 + (w >> 6); pm = w & 63; pn = 12 + (grp - 3); } }
        u.pm = grp * 64 + pm; u.pn = pn; return true;
    }
};
template <class Epi, class Sched>
__device__ __forceinline__ void gemm_phase(LAS unsigned char* lds, const Gemm g, const Sched& S, const Epi& E) {
    const int tid = threadIdx.x, wid = __builtin_amdgcn_readfirstlane(tid >> 6), lane = tid & 63, wr = wid >> 2, wc = wid & 3, fr = lane & 15, fq = lane >> 4;
    const int K = g.K, nt = K / BK;
    unsigned voffA[2], voffB[2];
#pragma unroll
    for (int i = 0; i < 2; ++i) { int R, C; stage_rc(tid * 16 + i * 8192, R, C); const int Rb = Epi::PERM ? ((R & ~31) + perm32(R & 31)) : R;
        voffA[i] = (unsigned)(R * g.lda + C) * 2u; voffB[i] = (unsigned)(Rb * g.ldb + C) * 2u; }
    const size_t kstep = (size_t)(BK * 2);
    const size_t hstepA = (size_t)HALF * g.lda * 2, hstepB = (size_t)HALF * g.ldb * 2;
    const size_t tstepA = 2 * hstepA, tstepB = 2 * hstepB;
    const unsigned ldsw = (unsigned)wid * 1024u;
    const int aoff = lds_byte(wr * 64 + fr, fq * 8), boff = lds_byte(wc * 32 + fr, fq * 8);
#define PG8_SA(b, h) (((b) * 2 + (h)) * HTB)
#define PG8_SB(b, h) ((4 + (b) * 2 + (h)) * HTB)
#define PG8_STAGE(bufoff, gbase, voff) do { _Pragma("unroll") for (int _i = 0; _i < 2; ++_i) \
        __builtin_amdgcn_global_load_lds((const unsigned*)((const char*)(gbase) + (voff)[_i]), (LAS unsigned*)(lds + (bufoff) + ldsw + _i * 8192), 16, 0, 0); } while (0)
#define PG8_LDA(dst, b, h) do { _Pragma("unroll") for (int m = 0; m < 4; ++m) _Pragma("unroll") for (int k = 0; k < 2; ++k) dst[m][k] = *(const LAS bf16x8*)(lds + PG8_SA(b, h) + aoff + m * 2048 + k * 1024); } while (0)
#define PG8_LDB(dst, b, h) do { _Pragma("unroll") for (int n = 0; n < 2; ++n) _Pragma("unroll") for (int k = 0; k < 2; ++k) dst[n][k] = *(const LAS bf16x8*)(lds + PG8_SB(b, h) + boff + n * 2048 + k * 1024); } while (0)
#define PG8_MMA(ai, bj, At, Bt) do { __builtin_amdgcn_s_setprio(1); _Pragma("unroll") for (int m = 0; m < 4; ++m) _Pragma("unroll") for (int n = 0; n < 2; ++n) _Pragma("unroll") for (int k = 0; k < 2; ++k) \
        acc[ai][bj][m][n] = __builtin_amdgcn_mfma_f32_16x16x32_bf16(Bt[n][k], At[m][k], acc[ai][bj][m][n], 0, 0, 0); __builtin_amdgcn_s_setprio(0); } while (0)
#define PG8_WAIT_V(n) asm volatile("s_waitcnt vmcnt(" #n ")" ::: "memory")
#define PG8_WAIT_L(n) asm volatile("s_waitcnt lgkmcnt(" #n ")" ::: "memory")
#define PG8_BAR __builtin_amdgcn_s_barrier()
#define PG8_SCHED __builtin_amdgcn_sched_barrier(0)
    Unit cur, nxt; int ui = 0;
    if (!S.next(0, cur)) return;
    f32x4 acc[2][2][4][2];
#pragma unroll
    for (int a = 0; a < 2; ++a)
#pragma unroll
        for (int b = 0; b < 2; ++b)
#pragma unroll
            for (int m = 0; m < 4; ++m)
#pragma unroll
                for (int n = 0; n < 2; ++n) acc[a][b][m][n] = (f32x4){0.f, 0.f, 0.f, 0.f};
    bf16x8 At[4][2], B0[2][2], B1[2][2];
    const char* cA = (const char*)g.A + (size_t)cur.pm * tstepA; const char* cB = (const char*)g.Bt + (size_t)cur.pn * tstepB;
    PG8_STAGE(PG8_SB(0, 0), cB, voffB); PG8_STAGE(PG8_SA(0, 0), cA, voffA); PG8_STAGE(PG8_SB(0, 1), cB + hstepB, voffB); PG8_STAGE(PG8_SA(0, 1), cA + hstepA, voffA);
    if (wr == 1) PG8_BAR;
    PG8_WAIT_V(4); PG8_BAR;
    PG8_STAGE(PG8_SB(1, 0), cB + kstep, voffB); PG8_STAGE(PG8_SA(1, 0), cA + kstep, voffA); PG8_STAGE(PG8_SB(1, 1), cB + hstepB + kstep, voffB);
    PG8_WAIT_V(6); PG8_BAR;
    for (;;) {
        const bool has_next = S.next(ui + 1, nxt);
        const char* nA = has_next ? (const char*)g.A + (size_t)nxt.pm * tstepA : cA; const char* nB = has_next ? (const char*)g.Bt + (size_t)nxt.pn * tstepB : cB;
        for (int t = 0; t < nt; t += 2) {
            const bool last = (t == nt - 2);
            const char* a1 = cA + (size_t)(t + 1) * kstep;
            const char* a2 = last ? nA : cA + (size_t)(t + 2) * kstep; const char* b2 = last ? nB : cB + (size_t)(t + 2) * kstep;
            const char* a3 = a2 + kstep; const char* b3 = b2 + kstep;
            PG8_LDB(B0, 0, 0); PG8_SCHED; PG8_LDA(At, 0, 0); PG8_STAGE(PG8_SA(1, 1), a1 + hstepA, voffA);
            PG8_WAIT_L(8); PG8_BAR; PG8_WAIT_L(0); PG8_MMA(0, 0, At, B0); PG8_BAR; PG8_SCHED;
            PG8_LDB(B1, 0, 1); PG8_STAGE(PG8_SB(0, 0), b2, voffB);
            PG8_BAR; PG8_WAIT_L(0); PG8_MMA(0, 1, At, B1); PG8_BAR;
            PG8_LDA(At, 0, 1); PG8_STAGE(PG8_SA(0, 0), a2, voffA);
            PG8_BAR; PG8_WAIT_L(0); PG8_MMA(1, 0, At, B0); PG8_BAR; PG8_SCHED;
            PG8_STAGE(PG8_SB(0, 1), b2 + hstepB, voffB);
            PG8_WAIT_V(6); PG8_BAR; PG8_MMA(1, 1, At, B1); PG8_BAR;
            PG8_LDB(B0, 1, 0); PG8_SCHED; PG8_LDA(At, 1, 0); PG8_STAGE(PG8_SA(0, 1), a2 + hstepA, voffA);
            PG8_WAIT_L(8); PG8_BAR; PG8_WAIT_L(0); PG8_MMA(0, 0, At, B0); PG8_BAR; PG8_SCHED;
            PG8_LDB(B1, 1, 1); PG8_STAGE(PG8_SB(1, 0), b3, voffB);
            PG8_BAR; PG8_WAIT_L(0); PG8_MMA(0, 1, At, B1); PG8_BAR;
            PG8_LDA(At, 1, 1); PG8_STAGE(PG8_SA(1, 0), a3, voffA);
            PG8_BAR; PG8_WAIT_L(0); PG8_MMA(1, 0, At, B0); PG8_BAR; PG8_SCHED;
            PG8_STAGE(PG8_SB(1, 1), b3 + hstepB, voffB);
            PG8_WAIT_V(6); PG8_BAR; PG8_MMA(1, 1, At, B1); PG8_BAR;
        }
        E(acc, cur, wr, wc, fr, fq);
        if (!has_next) break;
#pragma unroll
        for (int a = 0; a < 2; ++a)
#pragma unroll
            for (int b = 0; b < 2; ++b)
#pragma unroll
                for (int m = 0; m < 4; ++m)
#pragma unroll
                    for (int n = 0; n < 2; ++n) acc[a][b][m][n] = (f32x4){0.f, 0.f, 0.f, 0.f};
        cur = nxt; cA = nA; cB = nB; ++ui;
    }
    PG8_WAIT_V(0);
    if (wr == 0) PG8_BAR;
    PG8_BAR;
#undef PG8_SA
#undef PG8_SB
#undef PG8_STAGE
#undef PG8_LDA
#undef PG8_LDB
#undef PG8_MMA
#undef PG8_WAIT_V
#undef PG8_WAIT_L
#undef PG8_BAR
#undef PG8_SCHED
}

template <int ACT> struct EpiBf16 {
    static constexpr bool PERM = true;
    __device__ __forceinline__ void prefetch(LAS unsigned char*, const Unit&, int) const {}
    bf16_t* O; int ldc;
    __device__ __forceinline__ void operator()(const f32x4 (&acc)[2][2][4][2], const Unit& u, int wr, int wc, int fr, int fq) const {
        const int row0 = (ACT == 1 ? (u.pm & 63) : u.pm) * BM + wr * 64 + fr; const int col0 = u.pn * BM + wc * 32 + 8 * fq;
#pragma unroll
        for (int ai = 0; ai < 2; ++ai)
#pragma unroll
            for (int m = 0; m < 4; ++m) { bf16_t* rowp = O + (size_t)(row0 + ai * HALF + m * 16) * ldc + col0;
#pragma unroll
                for (int bj = 0; bj < 2; ++bj) { f32x4 v0 = acc[ai][bj][m][0], v1 = acc[ai][bj][m][1];
                    if (ACT == 1) { const int c = col0 + bj * HALF;
                        if (c >= 3072 && c < 3200) {
#pragma unroll
                            for (int e = 0; e < 4; ++e) { v0[e] = tanhf(v0[e]); v1[e] = tanhf(v1[e]); } }
                        else if (c >= 3584 && c < 3712) {
#pragma unroll
                            for (int e = 0; e < 4; ++e) { v0[e] = sigmoidf_(v0[e]); v1[e] = sigmoidf_(v1[e]); } } }
                    u32x4 w; w.x = pack_bf16(v0[0], v0[1]); w.y = pack_bf16(v0[2], v0[3]); w.z = pack_bf16(v1[0], v1[1]); w.w = pack_bf16(v1[2], v1[3]);
                    *(u32x4*)(rowp + bj * HALF) = w; } }
    }
};
template <bool IN_BF16> struct EpiResid {
    static constexpr bool PERM = false;
    __device__ __forceinline__ void prefetch(LAS unsigned char* lds, const Unit& u, int tid) const {
        constexpr int RB = IN_BF16 ? 512 : 1024, LPR = RB / 128, NL = 256 * LPR;
        const char* base = (const char*)xin + ((size_t)u.pm * BM * D + (size_t)u.pn * BM) * (IN_BF16 ? 2 : 4);
#pragma unroll
        for (int i = 0; i < NL / NTHREADS; ++i) { const int ln = i * NTHREADS + tid, r = ln / LPR, c = ln % LPR;
            __builtin_amdgcn_global_load_lds((const unsigned*)(base + (size_t)r * D * (IN_BF16 ? 2 : 4) + c * 128), (LAS unsigned*)(lds + STAGE_BYTES + 2048 + (tid >> 6) * 256), 4, 0, 0); }
    }
    const void* xin; bf16_t* out; const float* gate; float* ssq;
    __device__ __forceinline__ void operator()(const f32x4 (&acc)[2][2][4][2], const Unit& u, int wr, int wc, int fr, int fq) const {
        const int row0 = u.pm * BM + wr * 64 + fr, col0 = u.pn * BM + wc * 32 + 4 * fq;
        const float* gp = gate + (size_t)((u.pm * BM) / SEQ) * 6144 + col0;
        f32x4 gv[2][2];
#pragma unroll
        for (int bj = 0; bj < 2; ++bj)
#pragma unroll
            for (int n = 0; n < 2; ++n) gv[bj][n] = *(const f32x4*)(gp + bj * HALF + n * 16);
#pragma unroll
        for (int ai = 0; ai < 2; ++ai)
#pragma unroll
            for (int m = 0; m < 4; ++m) { const size_t off = (size_t)(row0 + ai * HALF + m * 16) * D + col0; float ss = 0.f;
#pragma unroll
                for (int bj = 0; bj < 2; ++bj)
#pragma unroll
                    for (int n = 0; n < 2; ++n) { f32x4 xv;
                        if (IN_BF16) { const u32x2 w = *(const u32x2*)((const bf16_t*)xin + off + bj * HALF + n * 16); xv = (f32x4){bf_lo(w.x), bf_hi(w.x), bf_lo(w.y), bf_hi(w.y)}; }
                        else xv = *(const f32x4*)((const float*)xin + off + bj * HALF + n * 16);
                        const f32x4 r = xv + gv[bj][n] * acc[ai][bj][m][n];
                        ss += (r[0] * r[0] + r[1] * r[1]) + (r[2] * r[2] + r[3] * r[3]);
                        *(u32x2*)(out + off + bj * HALF + n * 16) = (u32x2){pack_bf16(r[0], r[1]), pack_bf16(r[2], r[3])}; }
                ss += __shfl_xor(ss, 16); ss += __shfl_xor(ss, 32);
                if (fq == 0) ssq[(size_t)(row0 + ai * HALF + m * 16) * 16 + u.pn * 4 + wc] = ss; }
    }
};
struct EpiQ {
    static constexpr bool PERM = true;
    __device__ __forceinline__ void prefetch(LAS unsigned char*, const Unit&, int) const {}
    bf16_t* O; int ldc; const float* ssq; const float* bq; const LAS float* rl; int pm_l;
    __device__ __forceinline__ void prep(LAS unsigned char* lds, int pm, int tid) { LAS float* w = (LAS float*)(lds + STAGE_BYTES); rl = w; pm_l = pm;
        if (pm >= 0 && tid < BM) { const f32x4* sp = (const f32x4*)(ssq + (size_t)(pm * BM + tid) * 16); const f32x4 s4 = (sp[0] + sp[1]) + (sp[2] + sp[3]);
            w[tid] = rsqrtf(((s4[0] + s4[1]) + (s4[2] + s4[3])) * (1.0f / 1024.0f) + 1e-6f); }
        __syncthreads(); }
    __device__ __forceinline__ void operator()(const f32x4 (&acc)[2][2][4][2], const Unit& u, int wr, int wc, int fr, int fq) const {
        const int row0 = u.pm * BM + wr * 64 + fr; const int col0 = (u.pn & 7) * BM + wc * 32 + 8 * fq;
        const float* bp = bq + (size_t)(u.pn >> 3) * 2048 + col0;
        f32x4 b0[2], b1[2];
#pragma unroll
        for (int bj = 0; bj < 2; ++bj) { b0[bj] = *(const f32x4*)(bp + bj * HALF); b1[bj] = *(const f32x4*)(bp + bj * HALF + 4); }
#pragma unroll
        for (int ai = 0; ai < 2; ++ai)
#pragma unroll
            for (int m = 0; m < 4; ++m) { const int r = row0 + ai * HALF + m * 16; bf16_t* rowp = O + (size_t)r * ldc + col0;
                float rinv;
                if (u.pm == pm_l) rinv = rl[wr * 64 + fr + ai * HALF + m * 16];
                else { const f32x4* sp = (const f32x4*)(ssq + (size_t)r * 16); const f32x4 s4 = (sp[0] + sp[1]) + (sp[2] + sp[3]);
                    rinv = rsqrtf(((s4[0] + s4[1]) + (s4[2] + s4[3])) * (1.0f / 1024.0f) + 1e-6f); }
#pragma unroll
                for (int bj = 0; bj < 2; ++bj) { const f32x4 v0 = acc[ai][bj][m][0] * rinv + b0[bj], v1 = acc[ai][bj][m][1] * rinv + b1[bj];
                    u32x4 w; w.x = pack_bf16(v0[0], v0[1]); w.y = pack_bf16(v0[2], v0[3]); w.z = pack_bf16(v1[0], v1[1]); w.w = pack_bf16(v1[2], v1[3]);
                    *(u32x4*)(rowp + bj * HALF) = w; } }
    }
};
struct EpiRw2 {
    static constexpr bool PERM = true;
    __device__ __forceinline__ void prefetch(LAS unsigned char*, const Unit&, int) const {}
    float* DEC; bf16_t* AZ; bf16_t* G; const float* w0; const float* a0;
    __device__ __forceinline__ void operator()(const f32x4 (&acc)[2][2][4][2], const Unit& u, int wr, int wc, int fr, int fq) const {
        const int row0 = u.pm * BM + wr * 64 + fr; const int col0 = u.pn * BM + wc * 32 + 8 * fq;
        const int cls = u.pn < 8 ? 0 : 1;
#pragma unroll
        for (int bj = 0; bj < 2; ++bj) {
            const int c = col0 + bj * HALF;
            f32x4 b0 = (f32x4){0.f, 0.f, 0.f, 0.f}, b1 = b0;
            if (cls == 0) { b0 = *(const f32x4*)(w0 + c); b1 = *(const f32x4*)(w0 + c + 4); }
            else if (cls == 1) { b0 = *(const f32x4*)(a0 + c - 2048); b1 = *(const f32x4*)(a0 + c - 2048 + 4); }
#pragma unroll
            for (int ai = 0; ai < 2; ++ai)
#pragma unroll
                for (int m = 0; m < 4; ++m) { const size_t r = (size_t)(row0 + ai * HALF + m * 16);
                    f32x4 v0 = acc[ai][bj][m][0] + b0, v1 = acc[ai][bj][m][1] + b1;
                    if (cls == 0) {
#pragma unroll
                        for (int e = 0; e < 4; ++e) { v0[e] = __expf(-0.6065306597126334f * sigmoidf_(v0[e])); v1[e] = __expf(-0.6065306597126334f * sigmoidf_(v1[e])); }
                        *(f32x4*)(DEC + r * 2048 + c) = v0; *(f32x4*)(DEC + r * 2048 + c + 4) = v1;
                    } else {
                        if (cls == 1) {
#pragma unroll
                            for (int e = 0; e < 4; ++e) { v0[e] = sigmoidf_(v0[e]); v1[e] = sigmoidf_(v1[e]); } }
                        u32x4 w; w.x = pack_bf16(v0[0], v0[1]); w.y = pack_bf16(v0[2], v0[3]); w.z = pack_bf16(v1[0], v1[1]); w.w = pack_bf16(v1[2], v1[3]);
                        if (cls == 1) *(u32x4*)(AZ + r * 2048 + (c - 2048)) = w; else *(u32x4*)(G + r * 1024 + (c - 4096)) = w;
                    } }
        }
    }
};
}
struct Params { const float* in[31]; float* out; unsigned char* ws; int ph_lo, ph_hi; };
struct Frame {
    LAS unsigned char* lds; int tid, lane, wave, G, bid;
    const float* const* in; float* out; unsigned char* ws;
};

DI void fp8_row_store(const float (&v)[16], int row, int lane, unsigned char* dst, float* scale);
DI void fp8_row_load(const float* src, int row, int lane, float (&v)[16]);
DI void p0_convert_fp8(const Frame& F, const float* src, unsigned char* dst, float* scale, int widx, int nw);
template <bool SPLIT> DI void p0_mod(const Frame& F) {
    constexpr int NKG = SPLIT ? 21 : 42, NB = SPLIT ? 4 : 2, NTH = NKG * 12;
    const float* c = F.in[1]; const float* ada_w = F.in[2]; const float* ada_b = F.in[3];
    float* mod = (float*)(F.ws + WS_MOD);
    LAS float* sc = (LAS float*)F.lds;
    LAS float* part = (LAS float*)(F.lds + 32768);
    for (int i = F.tid; i < 8 * 1024; i += NTHREADS) { const int b = i >> 10, k = i & 1023; const float v = c[i]; sc[k * 8 + b] = v * sigmoidf_(v); }
    __syncthreads();
    for (int cb = F.bid; cb < 256; cb += F.G) {
        const int colbase = cb * 48, l = colbase / 6144, n0 = colbase % 6144;
        if (F.tid < NTH) {
            const int q = F.tid % 12, kg = F.tid / 12, krot = (cb * 148) & 1023;
            const float* wp = ada_w + (size_t)l * 1024 * 6144 + n0 + 4 * q;
            f32x4 acc[8];
#pragma unroll
            for (int b = 0; b < 8; ++b) acc[b] = (f32x4){0.f, 0.f, 0.f, 0.f};
#pragma unroll
            for (int bt = 0; bt < NB; ++bt) {
                f32x4 w[13];
#pragma unroll
                for (int i = 0; i < 13; ++i) { const int k = kg + NKG * (13 * bt + i), kk = ((k < 1024 ? k : 1023) + krot) & 1023; w[i] = *(const f32x4*)(wp + (size_t)kk * 6144); }
#pragma unroll
                for (int i = 0; i < 13; ++i) { const int k = kg + NKG * (13 * bt + i), kk = ((k < 1024 ? k : 1023) + krot) & 1023;
                    const f32x4 wv = k < 1024 ? w[i] : (f32x4){0.f, 0.f, 0.f, 0.f};
                    const f32x4 s0 = *(const LAS f32x4*)(sc + kk * 8), s1 = *(const LAS f32x4*)(sc + kk * 8 + 4);
                    acc[0] += wv * s0[0]; acc[1] += wv * s0[1]; acc[2] += wv * s0[2]; acc[3] += wv * s0[3];
                    acc[4] += wv * s1[0]; acc[5] += wv * s1[1]; acc[6] += wv * s1[2]; acc[7] += wv * s1[3]; }
            }
#pragma unroll
            for (int e = 0; e < 4; ++e) { LAS float* pp = part + ((size_t)kg * 48 + 4 * q + e) * 8;
                *(LAS f32x4*)pp = (f32x4){acc[0][e], acc[1][e], acc[2][e], acc[3][e]}; *(LAS f32x4*)(pp + 4) = (f32x4){acc[4][e], acc[5][e], acc[6][e], acc[7][e]}; }
        } else if (SPLIT && F.wave >= 4) {
            p0_convert_fp8(F, F.in[29], F.ws + WS_PU0, (float*)(F.ws + WS_PSC), F.bid * 4 + (F.wave - 4), F.G * 4);
        }
        __syncthreads();
        if (F.tid < 256) for (int o = F.tid; o < 384; o += 256) {
            const int cl = o >> 3, b = o & 7; const int col = colbase + cl;
            float s = ada_b[col];
#pragma unroll
            for (int kg = 0; kg < NKG; ++kg) s += part[(kg * 48 + cl) * 8 + b];
            mod[((size_t)l * 8 + b) * 6144 + n0 + cl] = s;
        }
        __syncthreads();
    }
}
DI void p0_transpose(const Frame& F, const float* src, int ld, int K, int N, bf16_t* dst, int ldd, const float* mix) {
    (void)mix;
    LAS float* tiles = (LAS float*)F.lds;
    const int tn = N / 64, nt = (K / 64) * tn;
    for (int t0 = F.bid; t0 < nt; t0 += 4 * F.G) {
        __syncthreads();
        f32x4 v[4][2];
#pragma unroll
        for (int q = 0; q < 4; ++q) { const int tt = t0 + q * F.G, t = tt < nt ? tt : t0; const int k0 = (t / tn) * 64, n0 = (t % tn) * 64;
#pragma unroll
            for (int h = 0; h < 2; ++h) { const int i = F.tid + h * NTHREADS, r = i >> 4, c4 = (i & 15) * 4; v[q][h] = *(const f32x4*)(src + (size_t)(k0 + r) * ld + n0 + c4); } }
#pragma unroll
        for (int q = 0; q < 4; ++q)
#pragma unroll
            for (int h = 0; h < 2; ++h) { const int i = F.tid + h * NTHREADS, r = i >> 4, c4 = (i & 15) * 4; LAS float* tp = tiles + q * 4160 + r * 65 + c4;
                tp[0] = v[q][h][0]; tp[1] = v[q][h][1]; tp[2] = v[q][h][2]; tp[3] = v[q][h][3]; }
        __syncthreads();
#pragma unroll
        for (int q = 0; q < 4; ++q) { const int t = t0 + q * F.G; if (t < nt) { const int k0 = (t / tn) * 64, n0 = (t % tn) * 64;
            const int n = F.tid >> 3, kc = (F.tid & 7) * 8;
            float w8[8];
#pragma unroll
            for (int e = 0; e < 8; ++e) w8[e] = tiles[q * 4160 + (kc + e) * 65 + n];
            u32x4 w; w.x = pack_bf16(w8[0], w8[1]); w.y = pack_bf16(w8[2], w8[3]); w.z = pack_bf16(w8[4], w8[5]); w.w = pack_bf16(w8[6], w8[7]);
            *(u32x4*)(dst + (size_t)(n0 + n) * ldd + k0 + kc) = w; } }
    }
    __syncthreads();
}
DI void p0_wqs(const Frame& F, const float* W, const float* g, const float* modl, bf16_t* dst) {
    LAS float* tiles = (LAS float*)F.lds;
    LAS float* gsl = (LAS float*)(F.lds + 69632);
    const int nt = 16 * 32;
    if (F.bid >= nt) return;
    __syncthreads();
    for (int i = F.tid; i < 8 * 1024; i += NTHREADS) gsl[i] = g[i & 1023] * (1.0f + modl[(size_t)(i >> 10) * 6144 + 4096 + (i & 1023)]);
    for (int t0 = F.bid; t0 < nt; t0 += 4 * F.G) {
        __syncthreads();
        f32x4 v[4][2];
#pragma unroll
        for (int q = 0; q < 4; ++q) { const int tt = t0 + q * F.G, t = tt < nt ? tt : t0; const int k0 = (t / 32) * 64, n0 = (t % 32) * 64;
#pragma unroll
            for (int h = 0; h < 2; ++h) { const int i = F.tid + h * NTHREADS, r = i >> 4, c4 = (i & 15) * 4; v[q][h] = *(const f32x4*)(W + (size_t)(k0 + r) * 2048 + n0 + c4); } }
#pragma unroll
        for (int q = 0; q < 4; ++q)
#pragma unroll
            for (int h = 0; h < 2; ++h) { const int i = F.tid + h * NTHREADS, r = i >> 4, c4 = (i & 15) * 4; LAS float* tp = tiles + q * 4160 + r * 65 + c4;
                tp[0] = v[q][h][0]; tp[1] = v[q][h][1]; tp[2] = v[q][h][2]; tp[3] = v[q][h][3]; }
        __syncthreads();
        for (int q = 0; q < 4; ++q) { const int t = t0 + q * F.G; if (t < nt) { const int k0 = (t / 32) * 64, n0 = (t % 32) * 64;
            const int n = F.tid >> 3, kc = (F.tid & 7) * 8;
            float w8[8];
#pragma unroll
            for (int e = 0; e < 8; ++e) w8[e] = tiles[q * 4160 + (kc + e) * 65 + n];
#pragma unroll
            for (int b = 0; b < 8; ++b) { const f32x4 s0 = *(const LAS f32x4*)(gsl + b * 1024 + k0 + kc), s1 = *(const LAS f32x4*)(gsl + b * 1024 + k0 + kc + 4);
                u32x4 w; w.x = pack_bf16(w8[0] * s0[0], w8[1] * s0[1]); w.y = pack_bf16(w8[2] * s0[2], w8[3] * s0[3]);
                w.z = pack_bf16(w8[4] * s1[0], w8[5] * s1[1]); w.w = pack_bf16(w8[6] * s1[2], w8[7] * s1[3]);
                *(u32x4*)(dst + ((size_t)b * 2048 + n0 + n) * 1024 + k0 + kc) = w; } } }
    }
    __syncthreads();
}
DI void p0_bq(const Frame& F, const float* W, const float* modl, float* bq) {
    LAS float* shl = (LAS float*)F.lds;
    LAS float* part = (LAS float*)(F.lds + 32768);
    if (F.bid >= 128) return;
    __syncthreads();
    for (int i = F.tid; i < 8 * 1024; i += NTHREADS) { const int b = i >> 10, k = i & 1023; shl[k * 8 + b] = modl[(size_t)b * 6144 + 3072 + k]; }
    __syncthreads();
    for (int task = F.bid; task < 128; task += F.G) {
        const int cl = F.tid & 15, kp = F.tid >> 4; const float* wp = W + (size_t)(kp * 32) * 2048 + task * 16 + cl;
        float wv[32];
#pragma unroll
        for (int k = 0; k < 32; ++k) wv[k] = wp[(size_t)k * 2048];
        float a[8];
#pragma unroll
        for (int b = 0; b < 8; ++b) a[b] = 0.f;
#pragma unroll
        for (int k = 0; k < 32; ++k) { const float w = wv[k];
            const f32x4 s0 = *(const LAS f32x4*)(shl + (kp * 32 + k) * 8), s1 = *(const LAS f32x4*)(shl + (kp * 32 + k) * 8 + 4);
            a[0] += w * s0[0]; a[1] += w * s0[1]; a[2] += w * s0[2]; a[3] += w * s0[3]; a[4] += w * s1[0]; a[5] += w * s1[1]; a[6] += w * s1[2]; a[7] += w * s1[3]; }
#pragma unroll
        for (int b = 0; b < 8; ++b) part[(kp * 16 + cl) * 8 + b] = a[b];
        __syncthreads();
        if (F.tid < 128) { const int c2 = F.tid >> 3, b = F.tid & 7; float s = 0.f;
#pragma unroll
            for (int q = 0; q < 32; ++q) s += part[(q * 16 + c2) * 8 + b];
            bq[(size_t)b * 2048 + task * 16 + c2] = s; }
        __syncthreads();
    }
}
DI void p0_convert(const Frame& F, const float* src, bf16_t* dst, size_t n) {
    const size_t n8 = n / 8;
    for (size_t i = (size_t)F.bid * NTHREADS + F.tid; i < n8; i += (size_t)F.G * NTHREADS) {
        const f32x4 a = *(const f32x4*)(src + i * 8), b = *(const f32x4*)(src + i * 8 + 4);
        u32x4 w; w.x = pack_bf16(a[0], a[1]); w.y = pack_bf16(a[2], a[3]); w.z = pack_bf16(b[0], b[1]); w.w = pack_bf16(b[2], b[3]);
        *(u32x4*)(dst + i * 8) = w;
    }
}
DI void fp8_row_store(const float (&v)[16], int row, int lane, unsigned char* dst, float* scale) {
    float am = 0.f;
#pragma unroll
    for (int e = 0; e < 16; ++e) am = fmaxf(am, fabsf(v[e]));
#pragma unroll
    for (int o = 32; o > 0; o >>= 1) am = fmaxf(am, __shfl_xor(am, o));
    const float sc = am > 0.f ? am * (1.0f / 384.0f) : 1.0f, inv = 1.0f / sc;
    u32x4 w;
    { int t0 = 0; t0 = __builtin_amdgcn_cvt_pk_fp8_f32(v[0] * inv, v[1] * inv, t0, false); t0 = __builtin_amdgcn_cvt_pk_fp8_f32(v[2] * inv, v[3] * inv, t0, true); w.x = (unsigned)t0; }
    { int t0 = 0; t0 = __builtin_amdgcn_cvt_pk_fp8_f32(v[4] * inv, v[5] * inv, t0, false); t0 = __builtin_amdgcn_cvt_pk_fp8_f32(v[6] * inv, v[7] * inv, t0, true); w.y = (unsigned)t0; }
    { int t0 = 0; t0 = __builtin_amdgcn_cvt_pk_fp8_f32(v[8] * inv, v[9] * inv, t0, false); t0 = __builtin_amdgcn_cvt_pk_fp8_f32(v[10] * inv, v[11] * inv, t0, true); w.z = (unsigned)t0; }
    { int t0 = 0; t0 = __builtin_amdgcn_cvt_pk_fp8_f32(v[12] * inv, v[13] * inv, t0, false); t0 = __builtin_amdgcn_cvt_pk_fp8_f32(v[14] * inv, v[15] * inv, t0, true); w.w = (unsigned)t0; }
    *(u32x4*)(dst + (size_t)row * 1024 + 16 * lane) = w;
    if (lane == 0) scale[row] = sc;
}
DI void fp8_row_load(const float* src, int row, int lane, float (&v)[16]) {
#pragma unroll
    for (int j = 0; j < 4; ++j) { const f32x4 a = *(const f32x4*)(src + (size_t)row * 1024 + 256 * j + 4 * lane); v[4 * j] = a[0]; v[4 * j + 1] = a[1]; v[4 * j + 2] = a[2]; v[4 * j + 3] = a[3]; }
}
DI void p0_convert_fp8(const Frame& F, const float* src, unsigned char* dst, float* scale, int widx, int nw) {
    const int lane = F.lane;
    for (int row = widx; row < N_EXPERTS; row += 4 * nw) {
        float v0[16], v1[16], v2[16], v3[16];
        const int r1 = row + nw, r2 = row + 2 * nw, r3 = row + 3 * nw;
        fp8_row_load(src, row, lane, v0);
        if (r1 < N_EXPERTS) fp8_row_load(src, r1, lane, v1);
        if (r2 < N_EXPERTS) fp8_row_load(src, r2, lane, v2);
        if (r3 < N_EXPERTS) fp8_row_load(src, r3, lane, v3);
        fp8_row_store(v0, row, lane, dst, scale);
        if (r1 < N_EXPERTS) fp8_row_store(v1, r1, lane, dst, scale);
        if (r2 < N_EXPERTS) fp8_row_store(v2, r2, lane, dst, scale);
        if (r3 < N_EXPERTS) fp8_row_store(v3, r3, lane, dst, scale);
    }
}
DI void p0_prologue(const Frame& F) {
    const bool split = (F.G == 256);
    if (split) p0_mod<true>(F); else p0_mod<false>(F);
    bf16_t* WIN_T = (bf16_t*)(F.ws + WS_WIN_T);
    p0_transpose(F, F.in[5], IN_W, 1024, IN_W, WIN_T, 1024, nullptr);
    float* psc = (float*)(F.ws + WS_PSC);
    if (!split) p0_convert_fp8(F, F.in[29], F.ws + WS_PU0, psc + 0 * N_EXPERTS, F.bid * NWAVES + F.wave, F.G * NWAVES);
    p0_convert_fp8(F, F.in[30], F.ws + WS_PV0, psc + 1 * N_EXPERTS, F.bid * NWAVES + F.wave, F.G * NWAVES);
}
DI void p0_late_weights(const Frame& Fin, int nunits) {
    const int nmax = (nunits + Fin.G - 1) / Fin.G, nfull = nunits - (nmax - 1) * Fin.G;
    Frame F = Fin;
    if (nfull < Fin.G) { if (Fin.bid < nfull) return; F.bid = Fin.bid - nfull; F.G = Fin.G - nfull; }
    bf16_t* WRW_T = (bf16_t*)(F.ws + WS_WRW_T);
    p0_transpose(F, F.in[12] + 0 * 1048576, 1024, 1024, 1024, WRW_T + (size_t)0    * 1024, 1024, nullptr);
    p0_transpose(F, F.in[12] + 1 * 1048576, 1024, 1024, 1024, WRW_T + (size_t)1024 * 1024, 1024, nullptr);
    p0_transpose(F, F.in[12] + 2 * 1048576, 1024, 1024, 1024, WRW_T + (size_t)2048 * 1024, 1024, nullptr);
    p0_transpose(F, F.in[14] + 0 * 65536, 64, 1024, 64, WRW_T + (size_t)3072 * 1024, 1024, nullptr);
    p0_transpose(F, F.in[14] + 1 * 65536, 64, 1024, 64, WRW_T + (size_t)3136 * 1024, 1024, nullptr);
    p0_transpose(F, F.in[17] + 0 * 65536, 64, 1024, 64, WRW_T + (size_t)3328 * 1024, 1024, nullptr);
    p0_transpose(F, F.in[17] + 1 * 65536, 64, 1024, 64, WRW_T + (size_t)3392 * 1024, 1024, nullptr);
    p0_transpose(F, F.in[19], 128, 1024, 128, WRW_T + (size_t)3584 * 1024, 1024, nullptr);
    { const u32x4 z = (u32x4){0u, 0u, 0u, 0u};
      for (int i = F.bid * NTHREADS + F.tid; i < 3 * 128 * 1024 / 8; i += F.G * NTHREADS) { const int blk = i / (128 * 128), r = i % (128 * 128);
          ((u32x4*)(WRW_T + (size_t)(3200 + 256 * blk) * 1024))[r] = z; } }
    { const float* g2 = F.in[20]; bf16_t* G2_T = (bf16_t*)(F.ws + WS_G2_T);
      for (int i = F.bid * NTHREADS + F.tid; i < 1024 * 32; i += F.G * NTHREADS) { const int n = i % 1024, k0 = (i / 1024) * 8;
          float v[8];
#pragma unroll
          for (int e = 0; e < 8; ++e) v[e] = (k0 + e < 128) ? g2[(size_t)(k0 + e) * 1024 + n] : 0.f;
          u32x4 w; w.x = pack_bf16(v[0], v[1]); w.y = pack_bf16(v[2], v[3]); w.z = pack_bf16(v[4], v[5]); w.w = pack_bf16(v[6], v[7]);
          *(u32x4*)(G2_T + (size_t)n * 256 + k0) = w; } }
    p0_transpose(F, F.in[9], 1024, 1024, 1024, (bf16_t*)(F.ws + WS_WOUT_T), 1024, nullptr);
    p0_convert(F, F.in[28], (bf16_t*)(F.ws + WS_SK), (size_t)2 * 16 * 128 * 128);
    const float* mod = (const float*)(F.ws + WS_MOD);
    p0_wqs(F, F.in[27], F.in[4] + 1 * 1024, mod, (bf16_t*)F.out);
    { Frame Fr = F; Fr.bid = F.G - 1 - F.bid;
      p0_bq(Fr, F.in[27], mod, (float*)(F.ws + WS_BQ)); }
}
DI void p0_late_weights2(const Frame& Fin) {
    Frame F = Fin;
    if ((Fin.G & 7) == 0) { const int g8 = Fin.G >> 3, nmax = (120 + g8 - 1) / g8, nfull = 120 - (nmax - 1) * g8;
        if (nfull < g8) { if ((Fin.bid >> 3) < nfull) return; F.bid = ((Fin.bid >> 3) - nfull) * 8 + (Fin.bid & 7); F.G = (g8 - nfull) * 8; } }
    else { const int nmax = (960 + Fin.G - 1) / Fin.G, nfull = 960 - (nmax - 1) * Fin.G;
        if (nfull < Fin.G) { if (Fin.bid < nfull) return; F.bid = Fin.bid - nfull; F.G = Fin.G - nfull; } }
    p0_wqs(F, F.in[27] + (size_t)1024 * 2048, F.in[4] + 3 * 1024, (const float*)(F.ws + WS_MOD) + 8 * 6144, (bf16_t*)F.out + (size_t)8 * 2048 * 1024);
    p0_transpose(F, F.in[26], 1024, 1024, 1024, (bf16_t*)(F.ws + WS_WO_T), 1024, nullptr);
    { Frame Fr = F; Fr.bid = F.G - 1 - F.bid; p0_bq(Fr, F.in[27] + (size_t)1024 * 2048, (const float*)(F.ws + WS_MOD) + 8 * 6144, (float*)(F.ws + WS_BQ) + 8 * 2048); }
}

DI void norm_row16(const float* xr, int lane, float (&v)[16], float& rinv) {
    float ss = 0.f;
#pragma unroll
    for (int j = 0; j < 4; ++j) { const f32x4 a = *(const f32x4*)(xr + j * 256 + lane * 4); v[4 * j] = a[0]; v[4 * j + 1] = a[1]; v[4 * j + 2] = a[2]; v[4 * j + 3] = a[3];
        ss += a[0] * a[0] + a[1] * a[1] + a[2] * a[2] + a[3] * a[3]; }
    ss = wave_sum(ss);
    rinv = rsqrtf(ss * (1.0f / 1024.0f) + 1e-6f);
}
DI void ada_apply(float (&v)[16], float rinv, const float* g, const float* sc, const float* sh, int lane) {
#pragma unroll
    for (int j = 0; j < 4; ++j) { const int c = j * 256 + lane * 4;
        const f32x4 gg = *(const f32x4*)(g + c), s1 = *(const f32x4*)(sc + c), s0 = *(const f32x4*)(sh + c);
#pragma unroll
        for (int e = 0; e < 4; ++e) v[4 * j + e] = v[4 * j + e] * rinv * gg[e] * (1.0f + s1[e]) + s0[e]; }
}
DI void norm_row16_b(const bf16_t* xr, int lane, float (&v)[16], float& rinv) {
    float ss = 0.f;
#pragma unroll
    for (int j = 0; j < 4; ++j) { const u32x2 a = *(const u32x2*)(xr + j * 256 + lane * 4); v[4 * j] = bf_lo(a.x); v[4 * j + 1] = bf_hi(a.x); v[4 * j + 2] = bf_lo(a.y); v[4 * j + 3] = bf_hi(a.y);
        ss += v[4 * j] * v[4 * j] + v[4 * j + 1] * v[4 * j + 1] + v[4 * j + 2] * v[4 * j + 2] + v[4 * j + 3] * v[4 * j + 3]; }
    ss = wave_sum(ss);
    rinv = rsqrtf(ss * (1.0f / 1024.0f) + 1e-6f);
}
template <bool IN_BF16> DI void p_norm(const Frame& F, const void* x, const float* g, const float* modl  , int sh_off, int sc_off, bf16_t* H) {
    for (int r = F.bid * NWAVES + F.wave; r < T; r += F.G * NWAVES) {
        const int b = r / SEQ; float v[16], rinv;
        if (IN_BF16) norm_row16_b((const bf16_t*)x + (size_t)r * D, F.lane, v, rinv); else norm_row16((const float*)x + (size_t)r * D, F.lane, v, rinv);
        ada_apply(v, rinv, g, modl + (size_t)b * 6144 + sc_off, modl + (size_t)b * 6144 + sh_off, F.lane);
#pragma unroll
        for (int j = 0; j < 4; ++j) { u32x2 w; w.x = pack_bf16(v[4 * j], v[4 * j + 1]); w.y = pack_bf16(v[4 * j + 2], v[4 * j + 3]);
            *(u32x2*)(H + (size_t)r * D + j * 256 + F.lane * 4) = w; }
    }
}
DI void p_qkprep(const Frame& F) {
    const bf16_t* QKV = (const bf16_t*)(F.ws + WS_QKV);
    bf16_t* QA = (bf16_t*)(F.ws + WS_QA); bf16_t* KA = (bf16_t*)(F.ws + WS_KA); bf16_t* VAT = (bf16_t*)(F.ws + WS_VAT);
    bf16_t* QB = (bf16_t*)(F.ws + WS_QB); bf16_t* KB = (bf16_t*)(F.ws + WS_KB); bf16_t* VBT = (bf16_t*)(F.ws + WS_VBT);
    const float* qk_g = F.in[6];
    LAS float* cs = (LAS float*)F.lds;
    LAS unsigned short* vt = (LAS unsigned short*)(F.lds + 16384);
    for (int tile = F.bid; tile < T / 64; tile += F.G) {
        const int t0 = tile * 64, b = t0 / SEQ, s0 = t0 % SEQ;
        __syncthreads();
        for (int i = F.tid; i < 64 * 32; i += NTHREADS) { const int tok = i >> 5, ai = i & 31, axis = ai >> 4, ii = ai & 15;
            const int s = s0 + tok; const float pos = (float)(axis == 0 ? (s >> 6) : (s & 63));
            const float inv = exp2f(-(float)ii * (13.287712379549449f / 16.0f));
            float sn, cn; sincosf(pos * inv, &sn, &cn); cs[2 * i] = cn; cs[2 * i + 1] = sn; }
        for (int i = F.tid; i < 64 * 80; i += NTHREADS) { const int tok = i / 80, ch = i % 80; const int col = ch < 64 ? 1024 + 8 * ch : 2176 + 8 * (ch - 64);
            const u32x4 v = *(const u32x4*)(QKV + (size_t)(t0 + tok) * IN_W + col);
            *(LAS u32x4*)(vt + tok * 648 + 8 * ch) = v; }
        __syncthreads();
        const int tok = F.tid >> 3, j = F.tid & 7, s = s0 + tok;
        for (int slot = 0; slot < 26; ++slot) {
            int col, type; bf16_t* dst;
            if (slot < 8)       { col = 64 * slot;               type = 0; dst = QA + ((size_t)(b * 8 + slot) * SEQ + s) * 64; }
            else if (slot < 16) { col = 512 + 64 * (slot - 8);   type = 1; dst = KA + ((size_t)(b * 8 + slot - 8) * SEQ + s) * 64; }
            else if (slot < 24) { col = 1536 + 64 * (slot - 16); type = 2; dst = QB + ((size_t)(b * 8 + slot - 16) * SEQ + s) * 64; }
            else                { col = 2048 + 64 * (slot - 24); type = 3; dst = KB + ((size_t)(b * 2 + slot - 24) * SEQ + s) * 64; }
            const u32x4 raw = *(const u32x4*)(QKV + (size_t)(t0 + tok) * IN_W + col + 8 * j);
            float v[8]; v[0] = bf_lo(raw.x); v[1] = bf_hi(raw.x); v[2] = bf_lo(raw.y); v[3] = bf_hi(raw.y); v[4] = bf_lo(raw.z); v[5] = bf_hi(raw.z); v[6] = bf_lo(raw.w); v[7] = bf_hi(raw.w);
            float ss = 0.f;
#pragma unroll
            for (int e = 0; e < 8; ++e) ss += v[e] * v[e];
            ss += __shfl_xor(ss, 1); ss += __shfl_xor(ss, 2); ss += __shfl_xor(ss, 4);
            const float rinv = rsqrtf(ss * (1.0f / 64.0f) + 1e-6f);
            const f32x4 g0 = *(const f32x4*)(qk_g + type * 64 + 8 * j), g1 = *(const f32x4*)(qk_g + type * 64 + 8 * j + 4);
#pragma unroll
            for (int e = 0; e < 4; ++e) { v[e] = v[e] * rinv * g0[e]; v[4 + e] = v[4 + e] * rinv * g1[e]; }
            if (type >= 2) {
                const int axis = j >> 2; const bool first = (j & 2) == 0;
#pragma unroll
                for (int e = 0; e < 8; ++e) { const float p = __shfl_xor(v[e], 2); const int ii = 8 * (j & 1) + e;
                    const float cn = cs[2 * (tok * 32 + axis * 16 + ii)], sn = cs[2 * (tok * 32 + axis * 16 + ii) + 1];
                    v[e] = first ? (v[e] * cn - p * sn) : (v[e] * cn + p * sn); }
            }
            if (type == 0 || type == 2) {
#pragma unroll
                for (int e = 0; e < 8; ++e) v[e] *= QSCALE; }
            u32x4 w; w.x = pack_bf16(v[0], v[1]); w.y = pack_bf16(v[2], v[3]); w.z = pack_bf16(v[4], v[5]); w.w = pack_bf16(v[6], v[7]);
            *(u32x4*)(dst + 8 * j) = w;
        }
        for (int i = F.tid; i < 640 * 8; i += NTHREADS) { const int c = i & 7, dv = i >> 3;
            unsigned short e[8];
#pragma unroll
            for (int k = 0; k < 8; ++k) e[k] = vt[(16 * (c >> 1) + 4 * (c & 1) + (k & 3) + 8 * (k >> 2)) * 648 + dv];
            u32x4 w; w.x = e[0] | ((unsigned)e[1] << 16); w.y = e[2] | ((unsigned)e[3] << 16); w.z = e[4] | ((unsigned)e[5] << 16); w.w = e[6] | ((unsigned)e[7] << 16);
            bf16_t* dp = dv < 512 ? VAT + ((size_t)b * 512 + dv) * SEQ + s0 + 8 * c : VBT + ((size_t)b * 128 + (dv - 512)) * SEQ + s0 + 8 * c;
            *(u32x4*)dp = w; }
    }
    __syncthreads();
}

DI int t5_bucket(int rel) {
    const int ret = rel > 0 ? 16 : 0; const int n = rel < 0 ? -rel : rel;
    if (n < 8) return ret + n;
    int large = 8 + (n >= 12) + (n >= 16) + (n >= 23) + (n >= 32) + (n >= 46) + (n >= 64) + (n >= 91);
    return ret + large;
}
constexpr int AT_NS = 4, AT_PD = AT_NS - 1, AT_STG = 24576, AT_TB = AT_NS * AT_STG, AT_Q = AT_TB + 3072;
DI void glds16(const void* gsrc, unsigned lds_dst) { unsigned keep;
    asm volatile("s_mov_b32 %0, m0\n\ts_mov_b32 m0, %2\n\ts_nop 0\n\tglobal_load_lds_dwordx4 %1, off\n\ts_mov_b32 m0, %0" : "=&s"(keep) : "v"(gsrc), "s"(lds_dst) : "memory"); }

template <int NC, bool BIAS>
DI void attn_pass(const Frame& F, const bf16_t* Qp, const bf16_t* Kp, const bf16_t* Vt, int q0, const LAS float* tb, float c_neg, float c_pos, f32x16 (&o)[NC], float& l_out) {
    int lane = F.lane, tid_ = F.tid; asm volatile("" : "+v"(lane), "+v"(tid_));
    const int r31 = lane & 31, h = lane >> 5;
    LAS unsigned char* lds = F.lds;
    constexpr int NT = SEQ / 64, PT = 1 + NC / 2;
    __syncthreads();
#pragma unroll
    for (int i = 0; i < 4; ++i) { const int idx = i * NTHREADS + tid_, row = idx >> 3, ch = idx & 7;
        const u32x4 v = *(const u32x4*)(Qp + (size_t)(q0 + row) * 64 + 8 * ch);
        *(LAS u32x4*)(lds + AT_Q + row * 128 + ((ch ^ (row & 7)) << 4)) = v; }
    unsigned koffs[4], qoffs[4], voffs[4];
#pragma unroll
    for (int s_ = 0; s_ < 4; ++s_) { const unsigned sw = (unsigned)(((2 * s_ + h) ^ (r31 & 7)) << 4);
        koffs[s_] = (unsigned)(r31 * 128) + sw; qoffs[s_] = (unsigned)(AT_Q + (32 * F.wave + r31) * 128) + sw;
        voffs[s_] = 8192u + (unsigned)(r31 * 128) + (unsigned)(((2 * s_ + h) ^ ((r31 >> 1) & 7)) << 4); }
#pragma unroll
    for (int c = 0; c < NC; ++c)
#pragma unroll
        for (int r = 0; r < 16; ++r) o[c][r] = 0.f;
    float m = -INFINITY, l = 0.f;
    const int qlo = q0 + 32 * F.wave, qme = qlo + r31;
    const int krow = F.wave * 8 + (lane >> 3);
    const bf16_t* ksrc = Kp + (size_t)krow * 64 + 8 * ((lane & 7) ^ (krow & 7));
    const bf16_t* vsrc[NC / 2];
#pragma unroll
    for (int i = 0; i < NC / 2; ++i) { const int vrow = (i * 8 + F.wave) * 8 + (lane >> 3); vsrc[i] = Vt + (size_t)vrow * SEQ + 8 * ((lane & 7) ^ ((vrow >> 1) & 7)); }
    const unsigned lbase = (unsigned)(size_t)lds;
    const unsigned kdst = lbase + (unsigned)F.wave * 1024u;
#define AT_ISSUE(tt) do { const unsigned sb_ = (unsigned)(((tt) % AT_NS) * AT_STG); \
        glds16(ksrc + (size_t)(tt) * 64 * 64, (unsigned)__builtin_amdgcn_readfirstlane(kdst + sb_)); \
        _Pragma("unroll") for (int i_ = 0; i_ < NC / 2; ++i_) glds16(vsrc[i_] + (size_t)(tt) * 64, (unsigned)__builtin_amdgcn_readfirstlane(kdst + sb_ + 8192u + (unsigned)i_ * 8192u)); } while (0)
    __syncthreads();
    bf16x8 qreg[4];
    {
#pragma unroll
        for (int s = 0; s < 4; ++s) qreg[s] = *(const LAS bf16x8*)(lds + qoffs[s]); }
#pragma unroll
    for (int tt = 0; tt < AT_PD; ++tt) AT_ISSUE(tt);
#pragma unroll 1
    for (int t = 0; t < NT; ++t) {
        const int k0 = t * 64;
        if (t < NT - 2) { if (PT == 3) asm volatile("s_waitcnt vmcnt(6)" ::: "memory"); else asm volatile("s_waitcnt vmcnt(4)" ::: "memory"); }
        else if (t == NT - 2) { if (PT == 3) asm volatile("s_waitcnt vmcnt(3)" ::: "memory"); else asm volatile("s_waitcnt vmcnt(2)" ::: "memory"); }
        else asm volatile("s_waitcnt vmcnt(0)" ::: "memory");
        __builtin_amdgcn_s_barrier();
        asm volatile("" ::: "memory");
        if (t + AT_PD < NT) AT_ISSUE(t + AT_PD);
        const LAS unsigned char* st_ = lds + (t % AT_NS) * AT_STG;
        f32x16 sT[2];
#pragma unroll
        for (int s = 0; s < 4; ++s) { const bf16x8 qf = qreg[s];
#pragma unroll
            for (int kb = 0; kb < 2; ++kb) { const bf16x8 kf = *(const LAS bf16x8*)(st_ + koffs[s] + kb * 4096);
                if (s == 0) sT[kb] = __builtin_amdgcn_mfma_f32_32x32x16_bf16(kf, qf, (f32x16){0.f, 0.f, 0.f, 0.f, 0.f, 0.f, 0.f, 0.f, 0.f, 0.f, 0.f, 0.f, 0.f, 0.f, 0.f, 0.f}, 0, 0, 0);
                else sT[kb] = __builtin_amdgcn_mfma_f32_32x32x16_bf16(kf, qf, sT[kb], 0, 0, 0); } }
        float cb = 0.f;
        if (BIAS) {
            if (k0 + 63 - qlo <= -91) cb = c_neg;
            else if (k0 - (qlo + 31) >= 91) cb = c_pos;
            else {
#pragma unroll
                for (int kb = 0; kb < 2; ++kb)
#pragma unroll
                    for (int r = 0; r < 16; ++r) { const int key = k0 + 32 * kb + (r & 3) + 8 * (r >> 2) + 4 * h; sT[kb][r] += tb[key - qme + 192]; }
            }
        }
        float mx = sT[0][0];
#pragma unroll
        for (int kb = 0; kb < 2; ++kb)
#pragma unroll
            for (int r = 0; r < 16; ++r) mx = fmaxf(mx, sT[kb][r]);
        mx = fmaxf(mx, __shfl_xor(mx, 32)) + cb;
        if (__builtin_amdgcn_ballot_w64(mx > m) != 0ull) {
            const float mn = fmaxf(m, mx), alpha = __builtin_amdgcn_exp2f(m - mn);
            m = mn; l *= alpha;
#pragma unroll
            for (int c = 0; c < NC; ++c)
#pragma unroll
                for (int r = 0; r < 16; ++r) o[c][r] *= alpha;
        }
        const float sh = cb - m;
        float ps = 0.f;
#pragma unroll
        for (int kb = 0; kb < 2; ++kb)
#pragma unroll
            for (int r = 0; r < 16; ++r) { const float p = __builtin_amdgcn_exp2f(sT[kb][r] + sh); sT[kb][r] = p; ps += p; }
        l += ps;
        bf16x8 pf[2][2];
#pragma unroll
        for (int kb = 0; kb < 2; ++kb)
#pragma unroll
            for (int s2 = 0; s2 < 2; ++s2) {
                u32x4 pw; pw.x = pack_bf16(sT[kb][8 * s2 + 0], sT[kb][8 * s2 + 1]); pw.y = pack_bf16(sT[kb][8 * s2 + 2], sT[kb][8 * s2 + 3]);
                pw.z = pack_bf16(sT[kb][8 * s2 + 4], sT[kb][8 * s2 + 5]); pw.w = pack_bf16(sT[kb][8 * s2 + 6], sT[kb][8 * s2 + 7]);
                pf[kb][s2] = __builtin_bit_cast(bf16x8, pw); }
        __builtin_amdgcn_sched_barrier(0);
#pragma unroll
        for (int g = 0; g < 4; ++g) {
#pragma unroll
            for (int c = 0; c < NC; ++c) { const bf16x8 vf = *(const LAS bf16x8*)(st_ + voffs[g] + c * 4096);
                o[c] = __builtin_amdgcn_mfma_f32_32x32x16_bf16(vf, pf[g >> 1][g & 1], o[c], 0, 0, 0); }
        }
    }
#undef AT_ISSUE
    l_out = l + __shfl_xor(l, 32);
}

template <int MODE> DI void p_attention(const Frame& F) {
    const bf16_t* QA = (const bf16_t*)(F.ws + WS_QA); const bf16_t* KA = (const bf16_t*)(F.ws + WS_KA); const bf16_t* VAT = (const bf16_t*)(F.ws + WS_VAT);
    const bf16_t* QB = (const bf16_t*)(F.ws + WS_QB); const bf16_t* KB = (const bf16_t*)(F.ws + WS_KB); const bf16_t* VBT = (const bf16_t*)(F.ws + WS_VBT);
    bf16_t* O = (bf16_t*)(F.ws + WS_O);
    const float* rel_bias = F.in[10]; const float* lv = F.in[7]; const float* subg = F.in[8];
    LAS float* tb = (LAS float*)(F.lds + AT_TB);
    const int lane = F.lane;
    float lam;
    { const float a = lv[lane] * lv[64 + lane], b2 = lv[128 + lane] * lv[192 + lane];
      lam = __expf(wave_sum(a)) - __expf(wave_sum(b2)) + 0.2f; }
    if (MODE & 1) for (int u = F.bid; u < 256; u += F.G) {
        const int b = u >> 5, hd = (u >> 3) & 3, qb = u & 7, q0 = qb * 256;
        __syncthreads();
        for (int i = F.tid; i < 2 * 384; i += NTHREADS) { const int mi = i / 384, ii = i % 384; tb[i] = rel_bias[t5_bucket(ii - 192) * 8 + 2 * hd + mi] * LOG2E; }
        __syncthreads();
        const bf16_t* Vt = VAT + (size_t)(b * 4 + hd) * 128 * SEQ;
        unsigned* o0s = (unsigned*)(F.ws + WS_O0S) + (size_t)F.bid * NTHREADS + F.tid;
        const size_t o0p = (size_t)F.G * NTHREADS;
        f32x16 o[4]; float l;
        { const int mp = 2 * hd;
          attn_pass<4, true>(F, QA + (size_t)(b * 8 + mp) * SEQ * 64, KA + (size_t)(b * 8 + mp) * SEQ * 64, Vt, q0, tb, rel_bias[15 * 8 + mp] * LOG2E, rel_bias[31 * 8 + mp] * LOG2E, o, l);
          const float il = 1.0f / l;
#pragma unroll
          for (int c = 0; c < 4; ++c)
#pragma unroll
              for (int r = 0; r < 8; ++r) o0s[(c * 8 + r) * o0p] = pack_bf16(o[c][2 * r] * il, o[c][2 * r + 1] * il); }
        { const int mp = 2 * hd + 1;
          attn_pass<4, true>(F, QA + (size_t)(b * 8 + mp) * SEQ * 64, KA + (size_t)(b * 8 + mp) * SEQ * 64, Vt, q0, tb + 384, rel_bias[15 * 8 + mp] * LOG2E, rel_bias[31 * 8 + mp] * LOG2E, o, l);
          int ln = F.lane; asm volatile("" : "+v"(ln)); const int r31 = ln & 31, h = ln >> 5;
          const float il = lam / l; float ss = 0.f;
#pragma unroll
          for (int c = 0; c < 4; ++c)
#pragma unroll
              for (int r = 0; r < 8; ++r) { const unsigned pk = __hip_atomic_load(o0s + (c * 8 + r) * o0p, __ATOMIC_RELAXED, __HIP_MEMORY_SCOPE_AGENT); const float d0 = bf_lo(pk) - o[c][2 * r] * il, d1 = bf_hi(pk) - o[c][2 * r + 1] * il; o[c][2 * r] = d0; o[c][2 * r + 1] = d1; ss += d0 * d0 + d1 * d1; }
          ss += __shfl_xor(ss, 32);
          const float rinv = rsqrtf(ss * (1.0f / 128.0f) + 1e-6f) * 0.8f;
          bf16_t* op = O + (size_t)(b * SEQ + q0 + 32 * F.wave + r31) * D + hd * 128;
#pragma unroll
          for (int c = 0; c < 4; ++c)
#pragma unroll
              for (int g = 0; g < 4; ++g) { const int dv = 32 * c + 8 * g + 4 * h; const f32x4 sg = *(const f32x4*)(subg + dv);
                  u32x2 w; w.x = pack_bf16(o[c][4 * g] * rinv * sg[0], o[c][4 * g + 1] * rinv * sg[1]); w.y = pack_bf16(o[c][4 * g + 2] * rinv * sg[2], o[c][4 * g + 3] * rinv * sg[3]);
                  *(u32x2*)(op + dv) = w; } }
    }
    if (MODE & 2) for (int u = F.bid; u < 512; u += F.G) {
        const int b = u >> 6, hq = (u >> 3) & 7, qb = u & 7, q0 = qb * 256, kv = hq >> 2;
        f32x16 o[2]; float l;
        attn_pass<2, false>(F, QB + (size_t)(b * 8 + hq) * SEQ * 64, KB + (size_t)(b * 2 + kv) * SEQ * 64, VBT + (size_t)(b * 2 + kv) * 64 * SEQ, q0, tb, 0.f, 0.f, o, l);
        int ln = F.lane; asm volatile("" : "+v"(ln)); const int r31 = ln & 31, h = ln >> 5;
        const float il = 1.0f / l;
        bf16_t* op = O + (size_t)(b * SEQ + q0 + 32 * F.wave + r31) * D + 512 + hq * 64;
#pragma unroll
        for (int c = 0; c < 2; ++c)
#pragma unroll
            for (int g = 0; g < 4; ++g) { const int dv = 32 * c + 8 * g + 4 * h;
                u32x2 w; w.x = pack_bf16(o[c][4 * g] * il, o[c][4 * g + 1] * il); w.y = pack_bf16(o[c][4 * g + 2] * il, o[c][4 * g + 3] * il);
                *(u32x2*)(op + dv) = w; }
    }
    __syncthreads();
}
#define CE_DESC(ka, pa, kb, pb) do { const bool _sw = (kb) > (ka); const float _k0 = _sw ? (kb) : (ka), _k1 = _sw ? (ka) : (kb); const int _p0 = _sw ? (pb) : (pa), _p1 = _sw ? (pa) : (pb); \
    (ka) = _k0; (kb) = _k1; (pa) = _p0; (pb) = _p1; } while (0)
template <int BASE> DI void sort16_desc(float (&k)[64], int (&p)[64]) {
#pragma unroll
    for (int k2 = 2; k2 <= 16; k2 <<= 1)
#pragma unroll
        for (int j = k2 >> 1; j > 0; j >>= 1)
#pragma unroll
            for (int i = 0; i < 16; ++i) { const int l = i ^ j;
                if (l > i) { if ((i & k2) == 0 || k2 == 16) CE_DESC(k[BASE + i], p[BASE + i], k[BASE + l], p[BASE + l]); else CE_DESC(k[BASE + l], p[BASE + l], k[BASE + i], p[BASE + i]); } }
}
template <int BA, int BB> DI void merge_top16(float (&k)[64], int (&p)[64]) {
#pragma unroll
    for (int i = 0; i < 16; ++i) { const bool sw = k[BB + 15 - i] > k[BA + i]; k[BA + i] = sw ? k[BB + 15 - i] : k[BA + i]; p[BA + i] = sw ? p[BB + 15 - i] : p[BA + i]; }
#pragma unroll
    for (int j = 8; j > 0; j >>= 1)
#pragma unroll
        for (int i = 0; i < 16; ++i) { const int l = i ^ j; if (l > i) CE_DESC(k[BA + i], p[BA + i], k[BA + l], p[BA + l]); }
}
DI void top16_of_64(float (&k)[64], int (&p)[64]) {
    sort16_desc<0>(k, p); sort16_desc<16>(k, p); sort16_desc<32>(k, p); sort16_desc<48>(k, p);
    merge_top16<0, 16>(k, p); merge_top16<32, 48>(k, p); merge_top16<0, 32>(k, p);
}
#define CEK_DESC(ka, kb) do { const float _h = fmaxf((ka), (kb)), _l = fminf((ka), (kb)); (ka) = _h; (kb) = _l; } while (0)
template <int BASE> DI void sort16k_desc(float (&k)[64]) {
#pragma unroll
    for (int k2 = 2; k2 <= 16; k2 <<= 1)
#pragma unroll
        for (int j = k2 >> 1; j > 0; j >>= 1)
#pragma unroll
            for (int i = 0; i < 16; ++i) { const int l = i ^ j;
                if (l > i) { if ((i & k2) == 0) CEK_DESC(k[BASE + i], k[BASE + l]); else CEK_DESC(k[BASE + l], k[BASE + i]); } }
}
template <int BA, int BB> DI void merge_top16k(float (&k)[64]) {
#pragma unroll
    for (int i = 0; i < 16; ++i) k[BA + i] = fmaxf(k[BA + i], k[BB + 15 - i]);
#pragma unroll
    for (int j = 8; j > 0; j >>= 1)
#pragma unroll
        for (int i = 0; i < 16; ++i) { const int l = i ^ j; if (l > i) CEK_DESC(k[BA + i], k[BA + l]); }
}
DI void top16k_of_64(float (&k)[64]) {
    sort16k_desc<0>(k); sort16k_desc<16>(k); sort16k_desc<32>(k); sort16k_desc<48>(k);
    merge_top16k<0, 16>(k); merge_top16k<32, 48>(k); merge_top16k<0, 32>(k);
}
constexpr int cand_off(int a) { int s = 0; for (int i = 0; i < a; ++i) s += 16 / (i + 1); return s; }

DI void p_peer_topk(const Frame& F, const bf16_t* PQ, const bf16_t* SK  , int* EIDX, float* GATE) {
    const int lane = F.lane, r31 = lane & 31, h = lane >> 5, w = F.wave;
    for (int tile = F.bid; tile < T / 64; tile += F.G) {
        for (int tt = 0; tt < 2; ++tt) {
            const int tok = tile * 64 + tt * 32 + r31;
            float lv[2][16];
#pragma unroll
            for (int p = 0; p < 2; ++p) {
                const int hp = 2 * w + p;
                f32x16 acc[4];
#pragma unroll
                for (int nb = 0; nb < 4; ++nb)
#pragma unroll
                    for (int r = 0; r < 16; ++r) acc[nb][r] = 0.f;
                const bf16_t* qp = PQ + (size_t)tok * PQ_LD + hp * 128 + 8 * h;
                const bf16_t* sp = SK + ((size_t)hp * 128 + r31) * 128 + 8 * h;
#pragma unroll 4
                for (int s = 0; s < 8; ++s) { const bf16x8 qf = *(const bf16x8*)(qp + 16 * s);
#pragma unroll
                    for (int nb = 0; nb < 4; ++nb) { const bf16x8 af = *(const bf16x8*)(sp + (size_t)nb * 32 * 128 + 16 * s);
                        acc[nb] = __builtin_amdgcn_mfma_f32_32x32x16_bf16(af, qf, acc[nb], 0, 0, 0); } }
                float k[64];
#pragma unroll
                for (int nb = 0; nb < 4; ++nb)
#pragma unroll
                    for (int r = 0; r < 16; ++r) { const int n = 32 * nb + (r & 3) + 8 * (r >> 2) + 4 * h;
                        k[16 * nb + r] = __uint_as_float((__float_as_uint(acc[nb][r]) & 0xFFFFFF80u) | (unsigned)(127 - n)); }
                top16k_of_64(k);
#pragma unroll
                for (int i = 0; i < 16; ++i) k[16 + i] = __shfl_xor(k[i], 32);
                merge_top16k<0, 16>(k);
#pragma unroll
                for (int i = 0; i < 16; ++i) lv[p][i] = k[i];
                __builtin_amdgcn_sched_barrier(0);
            }
            float ck[64];
#pragma unroll
            for (int i = 0; i < 64; ++i) ck[i] = -INFINITY;
#pragma unroll
            for (int a = 0; a < 16; ++a) {
#pragma unroll
                for (int b2 = 0; b2 < 16 / (a + 1); ++b2) ck[cand_off(a) + b2] = __uint_as_float((__float_as_uint(lv[0][a] + lv[1][b2]) & 0xFFFFFF00u) | (unsigned)(a * 16 + b2)); }
            LAS float* lst = (LAS float*)F.lds + F.tid;
#pragma unroll
            for (int i = 0; i < 16; ++i) { lst[i * NTHREADS] = lv[0][i]; lst[(16 + i) * NTHREADS] = lv[1][i]; }
            top16k_of_64(ck);
            float den = 0.f, ex[16]; int cp[16];
#pragma unroll
            for (int i = 0; i < 16; ++i) { ex[i] = __expf(ck[i] - ck[0]); den += ex[i];
                const unsigned cb = __float_as_uint(ck[i]); const int a = (cb >> 4) & 15, b2 = cb & 15;
                const unsigned u0 = __float_as_uint(lst[a * NTHREADS]), u1 = __float_as_uint(lst[(16 + b2) * NTHREADS]);
                cp[i] = (127 - (int)(u0 & 127u)) * 128 + (127 - (int)(u1 & 127u)); }
            const float iden = 1.0f / den;
            if (h == 0) {
                int* ep = EIDX + (size_t)tok * 128 + w * 16; float* gp = GATE + (size_t)tok * 128 + w * 16;
#pragma unroll
                for (int i = 0; i < 4; ++i) { *(u32x4*)(ep + 4 * i) = (u32x4){(unsigned)cp[4 * i], (unsigned)cp[4 * i + 1], (unsigned)cp[4 * i + 2], (unsigned)cp[4 * i + 3]};
                    *(f32x4*)(gp + 4 * i) = (f32x4){ex[4 * i] * iden, ex[4 * i + 1] * iden, ex[4 * i + 2] * iden, ex[4 * i + 3] * iden}; }
            }
        }
    }
}

DI void fp8x16_to_f32(const u32x4 w, float (&o)[16]) {
    f32x2 t;
    t = __builtin_amdgcn_cvt_pk_f32_fp8((int)w.x, false); o[0] = t[0]; o[1] = t[1];  t = __builtin_amdgcn_cvt_pk_f32_fp8((int)w.x, true); o[2] = t[0]; o[3] = t[1];
    t = __builtin_amdgcn_cvt_pk_f32_fp8((int)w.y, false); o[4] = t[0]; o[5] = t[1];  t = __builtin_amdgcn_cvt_pk_f32_fp8((int)w.y, true); o[6] = t[0]; o[7] = t[1];
    t = __builtin_amdgcn_cvt_pk_f32_fp8((int)w.z, false); o[8] = t[0]; o[9] = t[1];  t = __builtin_amdgcn_cvt_pk_f32_fp8((int)w.z, true); o[10] = t[0]; o[11] = t[1];
    t = __builtin_amdgcn_cvt_pk_f32_fp8((int)w.w, false); o[12] = t[0]; o[13] = t[1]; t = __builtin_amdgcn_cvt_pk_f32_fp8((int)w.w, true); o[14] = t[0]; o[15] = t[1];
}
DI float gelu_tanh_fast(float x) { const float z2 = 2.302208198f * (x + 0.044715f * x * x * x);
    return x * __builtin_amdgcn_rcpf(1.0f + __builtin_amdgcn_exp2f(-z2)); }
constexpr int PB = 4;
DI void peer_load(const unsigned char* PU, const unsigned char* PV, int ev, int base, int lane, u32x4 (&U)[PB], u32x4 (&V)[PB]) {
#pragma unroll
    for (int q = 0; q < PB; ++q) { const int e = __builtin_amdgcn_readlane(ev, base + q);
        U[q] = *(const u32x4*)(PU + (size_t)e * 1024 + 16 * lane); V[q] = *(const u32x4*)(PV + (size_t)e * 1024 + 16 * lane); }
}
struct RsMap { unsigned tag; int l0, l1, l2, l3; };
DI unsigned swp32(unsigned a, unsigned b, unsigned& other) { auto r = __builtin_amdgcn_permlane32_swap(a, b, false, false); other = r[1]; return r[0]; }
DI unsigned swp16(unsigned a, unsigned b, unsigned& other) { auto r = __builtin_amdgcn_permlane16_swap(a, b, false, false); other = r[1]; return r[0]; }
DI RsMap rs_map_init() {
    unsigned o, t0 = 0u, t1 = 1u, t2 = 2u, t3 = 3u;
    asm volatile("" : "+v"(t0), "+v"(t1), "+v"(t2), "+v"(t3));
    const unsigned ta = swp32(t0, t2, o), tb = swp32(t1, t3, o);
    RsMap m; m.tag = swp16(ta, tb, o);
    m.l0 = __builtin_ctzll(__builtin_amdgcn_ballot_w64(m.tag == 0u)); m.l1 = __builtin_ctzll(__builtin_amdgcn_ballot_w64(m.tag == 1u));
    m.l2 = __builtin_ctzll(__builtin_amdgcn_ballot_w64(m.tag == 2u)); m.l3 = __builtin_ctzll(__builtin_amdgcn_ballot_w64(m.tag == 3u));
    return m;
}
template <int CTRL> DI float dpp_g(float v) { return __builtin_bit_cast(float, __builtin_amdgcn_update_dpp(0, __builtin_bit_cast(int, v), CTRL, 0xF, 0xF, true)); }
DI void peer_comp(const u32x4 (&U)[PB], const u32x4 (&V)[PB], float su, float gvs, int base, const RsMap& M, const float (&x)[16], float (&y)[16]) {
    float d[PB];
#pragma unroll
    for (int q = 0; q < PB; ++q) { float u[16]; fp8x16_to_f32(U[q], u);
        float a0 = u[0] * x[0], a1 = u[1] * x[1], a2 = u[2] * x[2], a3 = u[3] * x[3];
#pragma unroll
        for (int i = 4; i < 16; i += 4) { a0 += u[i] * x[i]; a1 += u[i + 1] * x[i + 1]; a2 += u[i + 2] * x[i + 2]; a3 += u[i + 3] * x[i + 3]; }
        d[q] = (a0 + a1) + (a2 + a3); }
    unsigned o;
    const float f0a = __uint_as_float(swp32(__float_as_uint(d[0]), __float_as_uint(d[2]), o)); const float f0 = f0a + __uint_as_float(o);
    const float f1a = __uint_as_float(swp32(__float_as_uint(d[1]), __float_as_uint(d[3]), o)); const float f1 = f1a + __uint_as_float(o);
    const float ga = __uint_as_float(swp16(__float_as_uint(f0), __float_as_uint(f1), o)); float g = ga + __uint_as_float(o);
    g += dpp_g<0xB1>(g); g += dpp_g<0x4E>(g); g += dpp_g<0x141>(g); g += dpp_g<0x140>(g);
    const int src = (base + (int)M.tag) * 4;
    const float su_b = __uint_as_float(__builtin_amdgcn_ds_bpermute(src, __float_as_uint(su))), gv_b = __uint_as_float(__builtin_amdgcn_ds_bpermute(src, __float_as_uint(gvs)));
    const float c = gv_b * gelu_tanh_fast(g * su_b);
    const float c0 = __uint_as_float(__builtin_amdgcn_readlane(__float_as_uint(c), M.l0)), c1 = __uint_as_float(__builtin_amdgcn_readlane(__float_as_uint(c), M.l1));
    const float c2 = __uint_as_float(__builtin_amdgcn_readlane(__float_as_uint(c), M.l2)), c3 = __uint_as_float(__builtin_amdgcn_readlane(__float_as_uint(c), M.l3));
    const float cq[4] = {c0, c1, c2, c3};
#pragma unroll
    for (int q = 0; q < PB; ++q) { float v[16]; fp8x16_to_f32(V[q], v);
#pragma unroll
        for (int i = 0; i < 16; ++i) y[i] += cq[q] * v[i]; }
}
constexpr int PM_SHIFT = 11, PM_NP = 16384 >> PM_SHIFT;
struct PBatch { u32x4 U[4], V[4]; float su[4], gv[4]; int n; };
DI void pm_fetch(PBatch& B, unsigned long long& mA, unsigned long long& mB, int e0, int e1, float su0, float su1, float gv0, float gv1, const unsigned char* PU, const unsigned char* PV, int lane) {
    B.n = 0;
    if ((mA | mB) == 0ull) return;
    int eid[4];
#pragma unroll
    for (int q = 0; q < 4; ++q) {
        if (mA != 0ull) { const int l = __builtin_ctzll(mA); mA &= mA - 1ull;
            eid[q] = __builtin_amdgcn_readlane(e0, l); B.su[q] = __uint_as_float(__builtin_amdgcn_readlane(__float_as_uint(su0), l)); B.gv[q] = __uint_as_float(__builtin_amdgcn_readlane(__float_as_uint(gv0), l)); B.n = q + 1; }
        else if (mB != 0ull) { const int l = __builtin_ctzll(mB); mB &= mB - 1ull;
            eid[q] = __builtin_amdgcn_readlane(e1, l); B.su[q] = __uint_as_float(__builtin_amdgcn_readlane(__float_as_uint(su1), l)); B.gv[q] = __uint_as_float(__builtin_amdgcn_readlane(__float_as_uint(gv1), l)); B.n = q + 1; }
        else { eid[q] = eid[0]; B.su[q] = 0.f; B.gv[q] = 0.f; }
        B.U[q] = *(const u32x4*)(PU + (size_t)eid[q] * 1024 + 16 * lane); B.V[q] = *(const u32x4*)(PV + (size_t)eid[q] * 1024 + 16 * lane);
    }
}
DI void pm_comp(const PBatch& B, const RsMap& M, const float (&x)[16], float (&y)[16]) {
    float d[4];
#pragma unroll
    for (int q = 0; q < 4; ++q) { float u[16]; fp8x16_to_f32(B.U[q], u);
        f32x2 a0 = (f32x2){u[0], u[1]} * (f32x2){x[0], x[1]}, a1 = (f32x2){u[2], u[3]} * (f32x2){x[2], x[3]};
#pragma unroll
        for (int i = 4; i < 16; i += 4) { a0 = __builtin_elementwise_fma((f32x2){u[i], u[i + 1]}, (f32x2){x[i], x[i + 1]}, a0); a1 = __builtin_elementwise_fma((f32x2){u[i + 2], u[i + 3]}, (f32x2){x[i + 2], x[i + 3]}, a1); }
        const f32x2 as = a0 + a1; d[q] = as[0] + as[1]; }
    unsigned o;
    const float f0a = __uint_as_float(swp32(__float_as_uint(d[0]), __float_as_uint(d[2]), o)); const float f0 = f0a + __uint_as_float(o);
    const float f1a = __uint_as_float(swp32(__float_as_uint(d[1]), __float_as_uint(d[3]), o)); const float f1 = f1a + __uint_as_float(o);
    const float ga = __uint_as_float(swp16(__float_as_uint(f0), __float_as_uint(f1), o)); float g = ga + __uint_as_float(o);
    g += dpp_g<0xB1>(g); g += dpp_g<0x4E>(g); g += dpp_g<0x141>(g); g += dpp_g<0x140>(g);
    const float su_b = M.tag == 0u ? B.su[0] : (M.tag == 1u ? B.su[1] : (M.tag == 2u ? B.su[2] : B.su[3]));
    const float gv_b = M.tag == 0u ? B.gv[0] : (M.tag == 1u ? B.gv[1] : (M.tag == 2u ? B.gv[2] : B.gv[3]));
    const float c = gv_b * gelu_tanh_fast(g * su_b);
    const float cq[4] = {__uint_as_float(__builtin_amdgcn_readlane(__float_as_uint(c), M.l0)), __uint_as_float(__builtin_amdgcn_readlane(__float_as_uint(c), M.l1)),
                         __uint_as_float(__builtin_amdgcn_readlane(__float_as_uint(c), M.l2)), __uint_as_float(__builtin_amdgcn_readlane(__float_as_uint(c), M.l3))};
#pragma unroll
    for (int q = 0; q < 4; ++q) { float v[16]; fp8x16_to_f32(B.V[q], v);
#pragma unroll
        for (int i = 0; i < 16; ++i) y[i] += cq[q] * v[i]; }
}
template <bool FINAL> DI void p_peer_gather(const Frame& F, const float* gn  , const float* modl  , const unsigned char* PU, const unsigned char* PV, const float* SU, const float* SV, const int* EIDX, const float* GATE, const float* gt2  , bf16_t* xb, float* out) {
    const int lane = F.lane;
    const RsMap M = rs_map_init();
    for (int tile = F.bid; tile < T / 64; tile += F.G) {
        for (int grp = 0; grp < 4; ++grp) {
            const int tb = tile * 64 + F.wave * 8 + grp * 2;
            float x[2][16], y[2][16]; int e0[2], e1[2]; float su0[2], su1[2], gv0[2], gv1[2];
#pragma unroll
            for (int i = 0; i < 2; ++i) { const int t = tb + i;
                { float rinv; norm_row16_b(xb + (size_t)t * D, lane, x[i], rinv);
                  ada_apply(x[i], rinv, gn, modl + (size_t)(t / SEQ) * 6144 + 4096, modl + (size_t)(t / SEQ) * 6144 + 3072, lane); }
#pragma unroll
                for (int k = 0; k < 16; ++k) y[i][k] = 0.f;
                e0[i] = __builtin_nontemporal_load(EIDX + (size_t)t * 128 + lane); e1[i] = __builtin_nontemporal_load(EIDX + (size_t)t * 128 + 64 + lane);
                su0[i] = SU[e0[i]]; su1[i] = SU[e1[i]]; gv0[i] = __builtin_nontemporal_load(GATE + (size_t)t * 128 + lane) * SV[e0[i]]; gv1[i] = __builtin_nontemporal_load(GATE + (size_t)t * 128 + 64 + lane) * SV[e1[i]]; }
            for (int pp = 0; pp < PM_NP; ++pp) { const int p = (grp & 1) ? PM_NP - 1 - pp : pp;
#pragma unroll
                for (int i = 0; i < 2; ++i) {
                    unsigned long long mA = __builtin_amdgcn_ballot_w64((e0[i] >> PM_SHIFT) == p), mB = __builtin_amdgcn_ballot_w64((e1[i] >> PM_SHIFT) == p);
                    PBatch A, B;
                    pm_fetch(A, mA, mB, e0[i], e1[i], su0[i], su1[i], gv0[i], gv1[i], PU, PV, lane);
                    while (A.n > 0) {
                        pm_fetch(B, mA, mB, e0[i], e1[i], su0[i], su1[i], gv0[i], gv1[i], PU, PV, lane);
                        pm_comp(A, M, x[i], y[i]);
                        if (B.n == 0) break;
                        pm_fetch(A, mA, mB, e0[i], e1[i], su0[i], su1[i], gv0[i], gv1[i], PU, PV, lane);
                        pm_comp(B, M, x[i], y[i]);
                    }
                }
            }
#pragma unroll
            for (int i = 0; i < 2; ++i) { const int t = tb + i; const int b = t / SEQ; const float* gp = gt2 + (size_t)b * 6144; bf16_t* xp = xb + (size_t)t * D;
#pragma unroll
                for (int j = 0; j < 4; ++j) { const int c = 256 * j + 4 * lane; const f32x4 g = *(const f32x4*)(gp + c); const u32x2 xw = *(const u32x2*)(xp + c);
                    f32x4 xo = (f32x4){bf_lo(xw.x), bf_hi(xw.x), bf_lo(xw.y), bf_hi(xw.y)};
                    xo[0] += g[0] * y[i][4 * j]; xo[1] += g[1] * y[i][4 * j + 1]; xo[2] += g[2] * y[i][4 * j + 2]; xo[3] += g[3] * y[i][4 * j + 3];
                    if (FINAL) __builtin_nontemporal_store(xo, (f32x4*)(out + (size_t)t * D + c)); else *(u32x2*)(xp + c) = (u32x2){pack_bf16(xo[0], xo[1]), pack_bf16(xo[2], xo[3])}; } }
        }
    }
}
DI void norm_row16c(const float* xr, int lane, float (&v)[16], float& rinv) {
    float ss = 0.f;
#pragma unroll
    for (int j = 0; j < 2; ++j)
#pragma unroll
        for (int q = 0; q < 2; ++q) { const f32x4 a = *(const f32x4*)(xr + 512 * j + 8 * lane + 4 * q); v[8 * j + 4 * q] = a[0]; v[8 * j + 4 * q + 1] = a[1]; v[8 * j + 4 * q + 2] = a[2]; v[8 * j + 4 * q + 3] = a[3];
            ss += a[0] * a[0] + a[1] * a[1] + a[2] * a[2] + a[3] * a[3]; }
    ss = wave_sum(ss);
    rinv = rsqrtf(ss * (1.0f / 1024.0f) + 1e-6f);
}
DI void ada_apply_c(float (&v)[16], float rinv, const float* g, const float* sc, const float* sh, int lane) {
#pragma unroll
    for (int j = 0; j < 2; ++j)
#pragma unroll
        for (int q = 0; q < 2; ++q) { const int c = 512 * j + 8 * lane + 4 * q;
            const f32x4 gg = *(const f32x4*)(g + c), s1 = *(const f32x4*)(sc + c), s0 = *(const f32x4*)(sh + c);
#pragma unroll
            for (int e = 0; e < 4; ++e) v[8 * j + 4 * q + e] = v[8 * j + 4 * q + e] * rinv * gg[e] * (1.0f + s1[e]) + s0[e]; }
}
DI void row_load(const bf16_t* xr, int lane, float (&v)[16]) {
#pragma unroll
    for (int j = 0; j < 2; ++j) { const u32x4 a = *(const u32x4*)(xr + 512 * j + 8 * lane);
        v[8 * j] = bf_lo(a.x); v[8 * j + 1] = bf_hi(a.x); v[8 * j + 2] = bf_lo(a.y); v[8 * j + 3] = bf_hi(a.y); v[8 * j + 4] = bf_lo(a.z); v[8 * j + 5] = bf_hi(a.z); v[8 * j + 6] = bf_lo(a.w); v[8 * j + 7] = bf_hi(a.w); }
}
DI void row_finish(const float (&raw)[16], int lane, const LAS float* ga, const LAS float* sh, float (&v)[16]) {
    float ss = 0.f;
#pragma unroll
    for (int e = 0; e < 16; ++e) ss += raw[e] * raw[e];
    ss = wave_sum(ss);
    const float rinv = rsqrtf(ss * (1.0f / 1024.0f) + 1e-6f);
#pragma unroll
    for (int j = 0; j < 2; ++j)
#pragma unroll
        for (int q = 0; q < 2; ++q) { const int c = 512 * j + 8 * lane + 4 * q; const f32x4 gg = *(const LAS f32x4*)(ga + c), s0 = *(const LAS f32x4*)(sh + c);
#pragma unroll
            for (int e = 0; e < 4; ++e) v[8 * j + 4 * q + e] = raw[8 * j + 4 * q + e] * rinv * gg[e] + s0[e]; }
}
DI void p_rwkv_prep(const Frame& F, const bf16_t* x, const float* g, const float* modl, const float* mix, bf16_t* X6) {
    const int lane = F.lane;
    LAS float* ga = (LAS float*)F.lds; LAS float* shl = ga + 1024; LAS float* mixl = ga + 2048;
    int cur_b = -1;
    for (int run0 = F.bid * NWAVES; run0 < T / 8; run0 += F.G * NWAVES) {
        const int run = run0 + F.wave;
        const int bb = (run0 * 8) / SEQ;
        if (bb != cur_b) { __syncthreads();
            for (int i = F.tid; i < 1024; i += NTHREADS) { ga[i] = g[i] * (1.0f + modl[(size_t)bb * 6144 + 1024 + i]); shl[i] = modl[(size_t)bb * 6144 + i]; }
            if (cur_b < 0) for (int i = F.tid; i < 6 * 1024; i += NTHREADS) mixl[i] = mix[i];
            cur_b = bb; __syncthreads(); }
        const int r0 = run * 8, s0 = r0 % SEQ;
        float hp[16], hc[16], hn[16], ra[16], rb[16];
        if (s0 > 0) row_load(x + (size_t)(r0 - 1) * D, lane, ra);
        row_load(x + (size_t)r0 * D, lane, rb);
        if (s0 > 0) row_finish(ra, lane, ga, shl, hp);
        else {
#pragma unroll
            for (int i = 0; i < 16; ++i) hp[i] = 0.f; }
        if (s0 + 1 < SEQ) row_load(x + (size_t)(r0 + 1) * D, lane, ra);
        row_finish(rb, lane, ga, shl, hc);
        for (int i = 0; i < 8; ++i) {
            const int s = s0 + i;
            if (i + 1 < 8 && s + 2 < SEQ) row_load(x + (size_t)(r0 + i + 2) * D, lane, rb);
            if (s + 1 < SEQ) row_finish(ra, lane, ga, shl, hn);
            else {
#pragma unroll
                for (int e = 0; e < 16; ++e) hn[e] = 0.f; }
#pragma unroll
            for (int e = 0; e < 16; ++e) ra[e] = rb[e];
            float xx[16];
#pragma unroll
            for (int e = 0; e < 16; ++e) xx[e] = 0.5f * (hp[e] + hn[e]) - hc[e];
#pragma unroll
            for (int grp = 0; grp < 6; ++grp) { const int mi = grp == 0 ? 0 : (grp == 1 ? 2 : (grp == 2 ? 3 : (grp == 3 ? 1 : grp)));
                bf16_t* op = X6 + ((size_t)grp * T + r0 + i) * D;
#pragma unroll
                for (int j = 0; j < 2; ++j) { const f32x4 m0 = *(const LAS f32x4*)(mixl + mi * 1024 + 512 * j + 8 * lane), m1 = *(const LAS f32x4*)(mixl + mi * 1024 + 512 * j + 8 * lane + 4);
                    u32x4 w; w.x = pack_bf16(hc[8 * j] + xx[8 * j] * m0[0], hc[8 * j + 1] + xx[8 * j + 1] * m0[1]); w.y = pack_bf16(hc[8 * j + 2] + xx[8 * j + 2] * m0[2], hc[8 * j + 3] + xx[8 * j + 3] * m0[3]);
                    w.z = pack_bf16(hc[8 * j + 4] + xx[8 * j + 4] * m1[0], hc[8 * j + 5] + xx[8 * j + 5] * m1[1]); w.w = pack_bf16(hc[8 * j + 6] + xx[8 * j + 6] * m1[2], hc[8 * j + 7] + xx[8 * j + 7] * m1[3]);
                    *(u32x4*)(op + 512 * j + 8 * lane) = w; } }
#pragma unroll
            for (int e = 0; e < 16; ++e) { hp[e] = hc[e]; hc[e] = hn[e]; }
        }
    }
    __syncthreads();
}

constexpr int SC_L = 16;
constexpr int SC_NB = 5;
constexpr int SCP = 272;
constexpr int SCB_W = 0, SCB_BKZ = 16 * SCP, SCB_VV = 32 * SCP, SCB_AR = 48 * SCP, SCB_SIZE = 64 * SCP;
constexpr int SC_Y = SC_NB * SCB_SIZE;
constexpr int SC_CST = SC_Y + SC_NB * 4096;
constexpr int SC_AFR = SC_CST + 1280;
constexpr int SC_PS = SC_AFR + 16384;
constexpr int SC_SCR = SC_PS + SC_NB * 512;
constexpr int SC_FLG = SC_SCR + 16384;
constexpr int SC_CY = SC_FLG + 64;
static_assert(SC_CY + SC_NB * 256 <= LDS_BAR_OFF, "scan LDS map overflows");
DI void lds_wait_ge(volatile LAS int* p, int v) { while (*p < v) __builtin_amdgcn_s_sleep(1); asm volatile("" ::: "memory"); }
DI void p_rwkv_scan(const Frame& F) {
    const bf16_t* RK = (const bf16_t*)(F.ws + WS1_RK);
    bf16_t* Y = (bf16_t*)(F.ws + WS1_Y); float* BON = (float*)(F.ws + WS1_BON);
    const float* k_k = F.in[21]; const float* k_a = F.in[22]; const float* r_k = F.in[23];
    LAS unsigned char* lds = F.lds;
    const int tid = F.tid, lane = F.lane;
    constexpr int NCH = SEQ / SC_L;
    for (int u = F.bid; u < 256; u += F.G) {
        const int b = u >> 5, hd = (u >> 1) & 15, z = u & 1;
        __syncthreads();
        if (tid < 16) ((volatile LAS int*)(lds + SC_FLG))[tid] = 0;
        { const float* w2 = F.in[15] + (size_t)z * 65536 + hd * 64; const float* a2 = F.in[18] + (size_t)z * 65536 + hd * 64;
          LAS unsigned short* stw = (LAS unsigned short*)(lds + SC_AFR);
          for (int idx = tid; idx < 8192; idx += NTHREADS) { const int mat = idx >> 12, i = (idx >> 6) & 63, c = idx & 63;
              const float v = (mat ? a2 : w2)[(size_t)i * 1024 + c]; stw[mat * 4096 + c * 64 + i] = (unsigned short)(pack_bf16(v, 0.f) & 0xffffu); } }
        __syncthreads();
        if (F.wave >= 4) {
            const int pw = F.wave - 4, s16 = lane & 15, q = lane >> 4;
            const int chb = hd * 64 + 4 * q;
            const LAS unsigned short* stg = (const LAS unsigned short*)(lds + SC_AFR);
            LAS float* cst = (LAS float*)(lds + SC_CST);
            { cst[lane] = F.in[13][z * 1024 + hd * 64 + lane]; cst[64 + lane] = F.in[16][z * 1024 + hd * 64 + lane]; cst[128 + lane] = k_k[hd * 64 + lane]; cst[192 + lane] = k_a[hd * 64 + lane]; cst[256 + lane] = r_k[hd * 64 + lane]; }
            u32x2 rr[4], kr[4], vr[4]; u32x4 Bw[2], Ba[2];
#define SC_ROW(i_) ((size_t)(b * SEQ + (z ? (SEQ - 1 - (i_)) : (i_))))
#define SC_LOADC(cc) do { int s16l_ = s16, ql_ = q; asm volatile("" : "+v"(s16l_), "+v"(ql_)); const int chb_ = hd * 64 + 4 * ql_;     \
        const bf16_t* rp_ = RK + SC_ROW((cc) * SC_L + s16l_) * RW_N; \
        _Pragma("unroll") for (int cb = 0; cb < 4; ++cb) { rr[cb] = *(const u32x2*)(rp_ + chb_ + 16 * cb); kr[cb] = *(const u32x2*)(rp_ + 1024 + chb_ + 16 * cb); vr[cb] = *(const u32x2*)(rp_ + 2048 + chb_ + 16 * cb); } \
        _Pragma("unroll") for (int ks = 0; ks < 2; ++ks) { Bw[ks] = *(const u32x4*)(rp_ + 3072 + 64 * z + 32 * ks + 8 * ql_); Ba[ks] = *(const u32x4*)(rp_ + 3328 + 64 * z + 32 * ks + 8 * ql_); } } while (0)
#define SC_XFORM(cc_, buf_) do { \
            int s16_ = s16, q_ = q; asm volatile("" : "+v"(s16_), "+v"(q_));     \
            LAS unsigned char* bp = lds + (buf_) * SCB_SIZE; const int t_ = s16_; const bool odd_ = (s16_ & 1) != 0; \
            float ss = 0.f, bs = 0.f; LAS float* scr_ = (LAS float*)(lds + SC_SCR) + (pw * 4) * 256 + (q_ * 16 + s16_) * 4;     \
            _Pragma("unroll") for (int cb = 0; cb < 4; ++cb) { \
                f32x4 dw = __builtin_amdgcn_mfma_f32_16x16x32_bf16(*(const LAS bf16x8*)(stg + (16 * cb + s16_) * 64 + 8 * q_), __builtin_bit_cast(bf16x8, Bw[0]), (f32x4){0.f, 0.f, 0.f, 0.f}, 0, 0, 0); \
                dw = __builtin_amdgcn_mfma_f32_16x16x32_bf16(*(const LAS bf16x8*)(stg + (16 * cb + s16_) * 64 + 32 + 8 * q_), __builtin_bit_cast(bf16x8, Bw[1]), dw, 0, 0, 0); \
                f32x4 da = __builtin_amdgcn_mfma_f32_16x16x32_bf16(*(const LAS bf16x8*)(stg + 4096 + (16 * cb + s16_) * 64 + 8 * q_), __builtin_bit_cast(bf16x8, Ba[0]), (f32x4){0.f, 0.f, 0.f, 0.f}, 0, 0, 0); \
                da = __builtin_amdgcn_mfma_f32_16x16x32_bf16(*(const LAS bf16x8*)(stg + 4096 + (16 * cb + s16_) * 64 + 32 + 8 * q_), __builtin_bit_cast(bf16x8, Ba[1]), da, 0, 0, 0); \
                const f32x4 w0v = *(const LAS f32x4*)(cst + 16 * cb + 4 * q_), a0v = *(const LAS f32x4*)(cst + 64 + 16 * cb + 4 * q_); \
                const f32x4 kkw = *(const LAS f32x4*)(cst + 128 + 16 * cb + 4 * q_), kaw = *(const LAS f32x4*)(cst + 192 + 16 * cb + 4 * q_), rkw = *(const LAS f32x4*)(cst + 256 + 16 * cb + 4 * q_); \
                const float r4[4] = {bf_lo(rr[cb].x), bf_hi(rr[cb].x), bf_lo(rr[cb].y), bf_hi(rr[cb].y)}, k4[4] = {bf_lo(kr[cb].x), bf_hi(kr[cb].x), bf_lo(kr[cb].y), bf_hi(kr[cb].y)}; \
                f32x4 dec, azq, kzq; \
                _Pragma("unroll") for (int e = 0; e < 4; ++e) { \
                    const float sgw = __builtin_amdgcn_rcpf(1.0f + __builtin_amdgcn_exp2f(-1.4426950408889634f * (dw[e] + w0v[e])));     \
                    dec[e] = __builtin_amdgcn_exp2f(-0.8750387749f * sgw);                                                     \
                    const float az = __builtin_amdgcn_rcpf(1.0f + __builtin_amdgcn_exp2f(-1.4426950408889634f * (da[e] + a0v[e]))); azq[e] = az; \
                    { const float kk_ = k4[e] * kkw[e]; ss += kk_ * kk_; } kzq[e] = k4[e] * (1.0f + (az - 1.0f) * kaw[e]); bs += r4[e] * kzq[e] * rkw[e]; } \
                { const int o = t_ * SCP + (16 * cb + 4 * q_) * 4; \
                    *(LAS f32x4*)(scr_ + cb * 256) = azq; *(LAS f32x4*)(bp + SCB_BKZ + o) = kzq;     \
                    *(LAS f32x4*)(bp + SCB_W + o) = dec;                        \
                    *(LAS f32x4*)(bp + SCB_VV + o) = (f32x4){bf_lo(vr[cb].x), bf_hi(vr[cb].x), bf_lo(vr[cb].y), bf_hi(vr[cb].y)}; } } \
            ss += __shfl_xor(ss, 16); ss += __shfl_xor(ss, 32); bs += __shfl_xor(bs, 16); bs += __shfl_xor(bs, 32); \
            const float inv = __builtin_amdgcn_rsqf(fmaxf(ss, 1e-24f));     \
              \
            float s_bb = 0.f, s_kk = 0.f, c_g = 0.f, c_h = 0.f, c_br = 0.f, c_kr = 0.f; const bool pB_ = (s16_ & 2) != 0;     \
            f32x4 Ga = (f32x4){0.f, 0.f, 0.f, 0.f}, Gr = Ga;     \
            _Pragma("unroll") for (int cb = 0; cb < 4; ++cb) { float kn[4], bo[4], bq[4], kq[4]; \
                const float r4[4] = {bf_lo(rr[cb].x), bf_hi(rr[cb].x), bf_lo(rr[cb].y), bf_hi(rr[cb].y)}, k4[4] = {bf_lo(kr[cb].x), bf_hi(kr[cb].x), bf_lo(kr[cb].y), bf_hi(kr[cb].y)}; \
                const f32x4 kkw = *(const LAS f32x4*)(cst + 128 + 16 * cb + 4 * q_); \
                const f32x4 dcv = *(const LAS f32x4*)(bp + SCB_W + t_ * SCP + (16 * cb + 4 * q_) * 4), wp = *(const LAS f32x4*)(bp + SCB_W + (t_ ^ 1) * SCP + (16 * cb + 4 * q_) * 4);     \
                const f32x4 azq = *(const LAS f32x4*)(scr_ + cb * 256), kzq = *(const LAS f32x4*)(bp + SCB_BKZ + t_ * SCP + (16 * cb + 4 * q_) * 4); \
                _Pragma("unroll") for (int e = 0; e < 4; ++e) { kn[e] = k4[e] * kkw[e] * inv; bo[e] = kn[e] * azq[e]; \
                    bq[e] = dpp_g<0xB1>(bo[e]); kq[e] = dpp_g<0xB1>(kzq[e]); \
                    const float ao = -kn[e], rd = r4[e] * dcv[e]; \
                    s_bb += bo[e] * r4[e]; s_kk += kzq[e] * r4[e]; c_g += bq[e] * ao; c_h += kq[e] * ao; c_br += bq[e] * rd; c_kr += kq[e] * rd; } \
                float fb[4], fk[4], xa[4], xr[4], wq[4], sA[4], sB[4]; \
                _Pragma("unroll") for (int e = 0; e < 4; ++e) { const float wpr = dcv[e] * wp[e], wo = dpp_g<0x4E>(wpr);     \
                    const float mb = odd_ ? 1.0f : wp[e], ma = odd_ ? -wp[e] : -1.0f, mr = odd_ ? wpr : dcv[e]; \
                    fb[e] = bo[e] * mb; fk[e] = kzq[e] * mb; xa[e] = kn[e] * ma; xr[e] = r4[e] * mr; wq[e] = wpr * wo; sA[e] = pB_ ? 1.0f : wo; sB[e] = pB_ ? wo : 1.0f; \
                    const float fb0 = dpp_g<0x00>(fb[e]), fk0 = dpp_g<0x00>(fk[e]), fb1 = dpp_g<0x55>(fb[e]), fk1 = dpp_g<0x55>(fk[e]);     \
                    Ga[0] += fb0 * xa[e]; Ga[1] += fk0 * xa[e]; Ga[2] += fb1 * xa[e]; Ga[3] += fk1 * xa[e]; Gr[0] += fb0 * xr[e]; Gr[1] += fk0 * xr[e]; Gr[2] += fb1 * xr[e]; Gr[3] += fk1 * xr[e]; } \
                *(LAS f32x4*)(bp + SCB_W + t_ * SCP + (16 * cb + 4 * q_) * 4) = (f32x4){wq[0], wq[1], wq[2], wq[3]};            \
                *(LAS u32x4*)(bp + SCB_BKZ + t_ * SCP + (16 * cb + 4 * q_) * 4) = (u32x4){pack_bf16(fb[0] * sA[0], fk[0] * sA[0]), pack_bf16(fb[1] * sA[1], fk[1] * sA[1]), pack_bf16(fb[2] * sA[2], fk[2] * sA[2]), pack_bf16(fb[3] * sA[3], fk[3] * sA[3])};     \
                *(LAS u32x2*)(bp + SCB_AR + t_ * SCP + ((cb >> 1) * 4 + q_) * 16 + (cb & 1) * 8) = (u32x2){pack_bf16(xa[0] * sB[0], xa[1] * sB[1]), pack_bf16(xa[2] * sB[2], xa[3] * sB[3])};            \
                *(LAS u32x2*)(bp + SCB_AR + t_ * SCP + 128 + ((cb >> 1) * 4 + q_) * 16 + (cb & 1) * 8) = (u32x2){pack_bf16(xr[0] * sB[0], xr[1] * sB[1]), pack_bf16(xr[2] * sB[2], xr[3] * sB[3])}; }   \
            s_bb += __shfl_xor(s_bb, 16); s_bb += __shfl_xor(s_bb, 32); s_kk += __shfl_xor(s_kk, 16); s_kk += __shfl_xor(s_kk, 32); \
            c_g += __shfl_xor(c_g, 16); c_g += __shfl_xor(c_g, 32); c_h += __shfl_xor(c_h, 16); c_h += __shfl_xor(c_h, 32); \
            c_br += __shfl_xor(c_br, 16); c_br += __shfl_xor(c_br, 32); c_kr += __shfl_xor(c_kr, 16); c_kr += __shfl_xor(c_kr, 32); \
            _Pragma("unroll") for (int e = 0; e < 4; ++e) { Ga[e] += __shfl_xor(Ga[e], 16); Ga[e] += __shfl_xor(Ga[e], 32); Gr[e] += __shfl_xor(Gr[e], 16); Gr[e] += __shfl_xor(Gr[e], 32); } \
            if (q_ == 0) { LAS float* ps_ = (LAS float*)(lds + SC_PS + (buf_) * 512) + (t_ >> 1) * 8;     \
                if (odd_) { ps_[0] = c_g; ps_[1] = c_h; } \
                if (pB_) { LAS float* pq_ = (LAS float*)(lds + SC_PS + (buf_) * 512) + 64 + (t_ >> 2) * 16 + (odd_ ? 4 : 0); *(LAS f32x4*)pq_ = Ga; } \
                  \
                const float o0_ = odd_ ? c_br : s_bb, o1_ = odd_ ? c_kr : s_kk, o2_ = odd_ ? s_bb : 0.f, o3_ = odd_ ? s_kk : 0.f; \
                const unsigned ow0_ = pack_bf16(o0_, o1_), ow1_ = pack_bf16(o2_, o3_), gw0_ = pack_bf16(Gr[0], Gr[1]), gw1_ = pack_bf16(Gr[2], Gr[3]); \
                *(LAS u32x4*)(lds + SC_CY + (buf_) * 256 + (t_ >> 2) * 64 + (t_ & 3) * 16) = pB_ ? (u32x4){gw0_, gw1_, ow0_, ow1_} : (u32x4){ow0_, ow1_, 0u, 0u}; \
                BON[((size_t)z * T + SC_ROW((cc_) * SC_L + t_)) * 16 + hd] = bs; } } while (0)
#define SC_FLUSH(cc, slot_) do { const LAS float* yb_ = (const LAS float*)(lds + SC_Y + (slot_) * 4096); const int ft_ = lane >> 2, fj_ = (lane & 3) * 16;     \
            const f32x4 y0_ = *(const LAS f32x4*)(yb_ + ft_ * 64 + fj_), y1_ = *(const LAS f32x4*)(yb_ + ft_ * 64 + fj_ + 4), y2_ = *(const LAS f32x4*)(yb_ + ft_ * 64 + fj_ + 8), y3_ = *(const LAS f32x4*)(yb_ + ft_ * 64 + fj_ + 12); \
            bf16_t* yp_ = Y + ((size_t)z * T + SC_ROW((cc) * SC_L + ft_)) * D + hd * 64 + fj_; \
            *(u32x4*)yp_ = (u32x4){pack_bf16(y0_[0], y0_[1]), pack_bf16(y0_[2], y0_[3]), pack_bf16(y1_[0], y1_[1]), pack_bf16(y1_[2], y1_[3])}; \
            *(u32x4*)(yp_ + 8) = (u32x4){pack_bf16(y2_[0], y2_[1]), pack_bf16(y2_[2], y2_[3]), pack_bf16(y3_[0], y3_[1]), pack_bf16(y3_[2], y3_[3])}; } while (0)
            volatile LAS int* rdy = (volatile LAS int*)(lds + SC_FLG); volatile LAS int* prog = rdy + 8;
            SC_LOADC(pw);
            for (int n = pw; n < NCH; n += 4) {
                const int buf = n % SC_NB;
                if (n >= SC_NB) { lds_wait_ge(prog + 0, n - 4); lds_wait_ge(prog + 1, n - 4); lds_wait_ge(prog + 2, n - 4); lds_wait_ge(prog + 3, n - 4); SC_FLUSH(n - SC_NB, buf); }
                SC_XFORM(n, buf);
                asm volatile("s_waitcnt lgkmcnt(0)" ::: "memory");
                if (lane == 0) rdy[buf] = n + 1;
                if (n + 4 < NCH) SC_LOADC(n + 4);
            }
            for (int c = NCH - SC_NB; c < NCH; ++c) if (((c + SC_NB) & 3) == pw) {
                lds_wait_ge(prog + 0, c + 1); lds_wait_ge(prog + 1, c + 1); lds_wait_ge(prog + 2, c + 1); lds_wait_ge(prog + 3, c + 1); SC_FLUSH(c, c % SC_NB); }
#undef SC_ROW
#undef SC_LOADC
#undef SC_XFORM
#undef SC_FLUSH
        } else {
            const int w = F.wave, i16 = lane & 15, q = lane >> 4;
            f32x4 Sd[4];
#pragma unroll
            for (int k = 0; k < 4; ++k) Sd[k] = (f32x4){0.f, 0.f, 0.f, 0.f};
            const int m4 = i16 & 3;
            const int w_off = (4 * q) * 4, bkz_off = i16 * 4, vv_off = (16 * w + i16) * 4, ar_off = (m4 & 1) * SCP + (m4 >> 1) * 128 + q * 16;
            const bool qodd = (q & 1) != 0; const unsigned qmask = (q & 2) ? 0u : 0xffffffffu;
            const int bkq_off = (2 * (q & 1)) * SCP + i16 * 4;
            __builtin_amdgcn_s_setprio(3);
            typedef short s16x4v __attribute__((ext_vector_type(4)));
#define ST_LD(o_, Q_) do { _Pragma("unroll") for (int j = 0; j < 4; ++j) o_.vv[j] = *(const LAS float*)(bp + SCB_VV + (4 * (Q_) + j) * SCP + vv_off); \
        o_.a1lo = *(const LAS bf16x8*)(bp + SCB_AR + (4 * (Q_)) * SCP + ar_off); o_.a1hi = *(const LAS bf16x8*)(bp + SCB_AR + (4 * (Q_)) * SCP + 64 + ar_off); \
        o_.a2lo = *(const LAS bf16x8*)(bp + SCB_AR + (4 * (Q_) + 2) * SCP + ar_off); o_.a2hi = *(const LAS bf16x8*)(bp + SCB_AR + (4 * (Q_) + 2) * SCP + 64 + ar_off); } while (0)
#define ST_STEP(o_, Q_) do { \
        const bf16x8 Bd0 = __builtin_bit_cast(bf16x8, (u32x4){pack_bf16(Sd[0][0], Sd[0][1]), pack_bf16(Sd[0][2], Sd[0][3]), pack_bf16(Sd[1][0], Sd[1][1]), pack_bf16(Sd[1][2], Sd[1][3])}); \
        const bf16x8 Bd1 = __builtin_bit_cast(bf16x8, (u32x4){pack_bf16(Sd[2][0], Sd[2][1]), pack_bf16(Sd[2][2], Sd[2][3]), pack_bf16(Sd[3][0], Sd[3][1]), pack_bf16(Sd[3][2], Sd[3][3])}); \
        const f32x4 d1a = __builtin_amdgcn_mfma_f32_16x16x32_bf16(o_.a1lo, Bd0, (f32x4){0.f, 0.f, 0.f, 0.f}, 0, 0, 0); \
        const f32x4 e1a = __builtin_amdgcn_mfma_f32_16x16x32_bf16(o_.a2lo, Bd0, (f32x4){0.f, 0.f, 0.f, 0.f}, 0, 0, 0); \
        const f32x4 dd = __builtin_amdgcn_mfma_f32_16x16x32_bf16(o_.a1hi, Bd1, d1a, 0, 0, 0); \
        const f32x4 ee = __builtin_amdgcn_mfma_f32_16x16x32_bf16(o_.a2hi, Bd1, e1a, 0, 0, 0); \
        const LAS float* pa_ = psp + (2 * (Q_)) * 8; const LAS float* pg_ = psp + 64 + (Q_) * 16; \
        const f32x4 pA0 = *(const LAS f32x4*)pa_, pB0 = *(const LAS f32x4*)(pa_ + 8), g0 = *(const LAS f32x4*)pg_, g1 = *(const LAS f32x4*)(pg_ + 4); \
        const u32x2 cyw = *(const LAS u32x2*)(cyp + (Q_) * 64); \
        f32x4 wv[4]; u32x2 bk[4]; \
        _Pragma("unroll") for (int k = 0; k < 4; ++k) { wv[k] = *(const LAS f32x4*)(bp + SCB_W + (4 * (Q_)) * SCP + 64 * k + w_off); \
            bk[k] = (u32x2){*(const LAS unsigned*)(bkp + (4 * (Q_)) * SCP + 64 * k), *(const LAS unsigned*)(bkp + (4 * (Q_) + 1) * SCP + 64 * k)}; } \
        const float v1 = o_.vv[0], v2 = o_.vv[1], v3 = o_.vv[2], v4 = o_.vv[3]; \
        const float u1 = dd[0]; \
        const float u2 = dd[1] + u1 * pA0[0] + v1 * pA0[1]; \
        const float u3 = ee[0] + u1 * g0[0] + v1 * g0[1] + u2 * g0[2] + v2 * g0[3]; \
        const float u4 = ee[1] + u1 * g1[0] + v1 * g1[1] + u2 * g1[2] + v2 * g1[3] + u3 * pB0[0] + v3 * pB0[1]; \
        const float x0_ = qodd ? u3 : u1, x1_ = qodd ? v3 : v1, x2_ = qodd ? u4 : u2, x3_ = qodd ? v4 : v2;     \
        const unsigned b2lo = pack_bf16(x0_, x1_) & qmask, b2hi = pack_bf16(x2_, x3_) & qmask;     \
        const s16x4v B2 = __builtin_bit_cast(s16x4v, (u32x2){b2lo, b2hi}); \
        _Pragma("unroll") for (int k = 0; k < 4; ++k) Sd[k] = __builtin_amdgcn_mfma_f32_16x16x16bf16_1k(__builtin_bit_cast(s16x4v, bk[k]), B2, Sd[k] * wv[k], 0, 0, 0); \
        const f32x4 yv = __builtin_amdgcn_mfma_f32_16x16x16bf16_1k(__builtin_bit_cast(s16x4v, cyw), B2, (f32x4){dd[2], dd[3], ee[2], ee[3]}, 0, 0, 0);     \
        yb[(4 * (Q_)) * 64 + 16 * w + i16] = yv[0]; yb[(4 * (Q_) + 1) * 64 + 16 * w + i16] = yv[1]; yb[(4 * (Q_) + 2) * 64 + 16 * w + i16] = yv[2]; yb[(4 * (Q_) + 3) * 64 + 16 * w + i16] = yv[3]; } while (0)
            struct StepOps { float vv[4]; bf16x8 a1lo, a1hi, a2lo, a2hi; };
            volatile LAS int* rdy = (volatile LAS int*)(lds + SC_FLG); volatile LAS int* prog = rdy + 8;
            int buf = 0;
            for (int c = 0; c < NCH; ++c) {
                const LAS unsigned char* bp = lds + buf * SCB_SIZE; LAS float* yb = (LAS float*)(lds + SC_Y + buf * 4096);
                const LAS unsigned char* bkp = bp + SCB_BKZ + bkq_off;
                const LAS float* psp = (const LAS float*)(lds + SC_PS + buf * 512);
                const LAS unsigned char* cyp = lds + SC_CY + buf * 256 + (i16 & 3) * 16 + (q & 1) * 8;
                lds_wait_ge(rdy + buf, c + 1);
                const bool conv = (c & 3) == w; float tv[16]; const int tr = u * NCH + c, ttab = tr >> 14, trow = tr & 16383;
                int ln2 = lane; asm volatile("" : "+v"(ln2));
                if (conv) fp8_row_load(F.in[ttab ? 30 : 29] + (size_t)N_EXPERTS * 1024, trow, ln2, tv);
                else {
#pragma unroll
                    for (int i = 0; i < 16; ++i) tv[i] = 0.f; }
                StepOps oa, ob; ST_LD(oa, 0);
                ST_LD(ob, 1); ST_STEP(oa, 0);
                ST_LD(oa, 2); ST_STEP(ob, 1);
                ST_LD(ob, 3); ST_STEP(oa, 2);
                ST_STEP(ob, 3);
                asm volatile("s_waitcnt lgkmcnt(0)" ::: "memory");
                if (lane == 0) prog[w] = c + 1;
                if (conv) fp8_row_store(tv, trow, ln2, F.ws + (ttab ? WS_PV1 : WS_PU1), (float*)(F.ws + WS_PSC) + (2 + ttab) * N_EXPERTS);
                buf = (buf + 1 == SC_NB) ? 0 : buf + 1;
            }
#undef ST_LD
#undef ST_STEP
            __builtin_amdgcn_s_setprio(0);
            __builtin_amdgcn_s_setprio(0);
        }
    }
    __syncthreads();
}

DI void unpack8(const u32x4 w, float* o) { o[0] = bf_lo(w.x); o[1] = bf_hi(w.x); o[2] = bf_lo(w.y); o[3] = bf_hi(w.y); o[4] = bf_lo(w.z); o[5] = bf_hi(w.z); o[6] = bf_lo(w.w); o[7] = bf_hi(w.w); }
DI void p_rwkv_post(const Frame& F) {
    const bf16_t* RK = (const bf16_t*)(F.ws + WS1_RK); const bf16_t* Y = (const bf16_t*)(F.ws + WS1_Y); const float* BON = (const float*)(F.ws + WS1_BON);
    const bf16_t* G = (const bf16_t*)(F.ws + WS1_G); bf16_t* A3 = (bf16_t*)(F.ws + WS1_A3);
    const float* ln_g = F.in[24]; const float* ln_b = F.in[25];
    const int lane = F.lane, c0 = 16 * lane, hd = lane >> 2;
    for (int t = F.bid * NWAVES + F.wave; t < T; t += F.G * NWAVES) {
        float y[16], tmp[16], vv[16], gg[16];
        unpack8(*(const u32x4*)(Y + (size_t)t * D + c0), y); unpack8(*(const u32x4*)(Y + (size_t)t * D + c0 + 8), y + 8);
        unpack8(*(const u32x4*)(Y + ((size_t)T + t) * D + c0), tmp); unpack8(*(const u32x4*)(Y + ((size_t)T + t) * D + c0 + 8), tmp + 8);
        unpack8(*(const u32x4*)(RK + (size_t)t * RW_N + 2048 + c0), vv); unpack8(*(const u32x4*)(RK + (size_t)t * RW_N + 2048 + c0 + 8), vv + 8);
        unpack8(*(const u32x4*)(G + (size_t)t * D + c0), gg); unpack8(*(const u32x4*)(G + (size_t)t * D + c0 + 8), gg + 8);
        const float bon = BON[(size_t)t * 16 + hd] + BON[((size_t)T + t) * 16 + hd];
        float sm = 0.f;
#pragma unroll
        for (int e = 0; e < 16; ++e) { y[e] += tmp[e]; sm += y[e]; }
        sm += __shfl_xor(sm, 1); sm += __shfl_xor(sm, 2);
        const float mu = sm * (1.0f / 64.0f);
        float vr = 0.f;
#pragma unroll
        for (int e = 0; e < 16; ++e) { const float d = y[e] - mu; vr += d * d; }
        vr += __shfl_xor(vr, 1); vr += __shfl_xor(vr, 2);
        const float rs = rsqrtf(vr * (1.0f / 64.0f) + 64e-5f);
        float o[16];
#pragma unroll
        for (int q = 0; q < 4; ++q) { const f32x4 lg = *(const f32x4*)(ln_g + c0 + 4 * q), lb = *(const f32x4*)(ln_b + c0 + 4 * q);
#pragma unroll
            for (int e = 0; e < 4; ++e) { const int i = 4 * q + e; o[i] = ((y[i] - mu) * rs * lg[e] + lb[e] + bon * vv[i]) * gg[i]; } }
        u32x4 w0, w1; w0.x = pack_bf16(o[0], o[1]); w0.y = pack_bf16(o[2], o[3]); w0.z = pack_bf16(o[4], o[5]); w0.w = pack_bf16(o[6], o[7]);
        w1.x = pack_bf16(o[8], o[9]); w1.y = pack_bf16(o[10], o[11]); w1.z = pack_bf16(o[12], o[13]); w1.w = pack_bf16(o[14], o[15]);
        *(u32x4*)(A3 + (size_t)t * D + c0) = w0; *(u32x4*)(A3 + (size_t)t * D + c0 + 8) = w1;
    }
}
__global__ void __launch_bounds__(NTHREADS, 2) mega_fwd(Params P) {
    extern __shared__ __attribute__((aligned(16))) unsigned char lds_raw[];
    Frame F;
    F.lds = (LAS unsigned char*)lds_raw;
    F.tid = threadIdx.x; F.lane = F.tid & 63; F.wave = __builtin_amdgcn_readfirstlane(F.tid >> 6);
    F.G = gridDim.x; F.bid = blockIdx.x; F.in = P.in; F.out = P.out; F.ws = P.ws;
    volatile LAS unsigned* bst = (volatile LAS unsigned*)(F.lds + LDS_BAR_OFF);
    if (F.tid == 0) { bst[0] = 0u; bst[1] = 0u; bst[2] = 0u; bst[3] = 0u; }
    __syncthreads();
    XcdBarrier bar = xcd_barrier_post((unsigned*)(P.ws + WS_CTL), bst);
    const int lo = P.ph_lo, hi = P.ph_hi;
#ifdef ONLY_PHASE
#define IN(k) ((k) == ONLY_PHASE && lo <= (k) && (k) < hi)
#else
#define IN(k) (lo <= (k) && (k) < hi)
#endif
#define SEAM(k) do { if (IN(k) && IN((k) + 1)) xcd_barrier(bar); } while (0)
#define LSEAM(k) do { if (IN(k) && IN((k) + 1)) __syncthreads(); } while (0)
#define LAUNDER(T, dst, src) T dst; { unsigned long long _v = (unsigned long long)(src); unsigned _lo = (unsigned)_v, _hi = (unsigned)(_v >> 32); asm volatile("" : "+s"(_lo), "+s"(_hi)); dst = (T)(__attribute__((address_space(1))) unsigned char*)(((unsigned long long)_hi << 32) | _lo); }
#define PH_BEGIN LAUNDER(unsigned char*, ws, P.ws) LAUNDER(float*, outp, P.out) F.ws = ws; F.out = outp; \
    const float* mod0 = (const float*)(ws + WS_MOD); const float* mod1 = mod0 + 8 * 6144; const float* norm_g = P.in[4]; bf16_t* H = (bf16_t*)(ws + WS_H); bf16_t* H2 = (bf16_t*)(ws + WS1_H2); \
    (void)mod0; (void)mod1; (void)norm_g; (void)H; (void)H2;

    if (IN(0)) { PH_BEGIN p0_prologue(F); } SEAM(0);
    if (IN(1)) { PH_BEGIN p_norm<false>(F, P.in[0], norm_g + 0 * 1024, mod0, 0, 1024, H); } SEAM(1);
    if (IN(2)) { PH_BEGIN pg8::Gemm g{H, (const bf16_t*)(ws + WS_WIN_T), T, IN_W, 1024, 1024, 1024}; pg8::StaticOrder S; S.init(T, IN_W, F.G, F.bid);
        pg8::EpiBf16<0> E{(bf16_t*)(ws + WS_QKV), IN_W}; pg8::gemm_phase(F.lds, g, S, E);
        p0_late_weights(F, (T / 256) * (IN_W / 256)); } SEAM(2);
    if (IN(3)) { PH_BEGIN p_qkprep(F); } SEAM(3);
    if (IN(4)) { PH_BEGIN p_attention<3>(F); } SEAM(4);
    if (IN(5)) { PH_BEGIN pg8::Gemm g{(const bf16_t*)(ws + WS_O), (const bf16_t*)(ws + WS_WOUT_T), T, 1024, 1024, 1024, 1024}; pg8::StaticOrder S; S.init(T, 1024, F.G, F.bid);
        pg8::EpiResid<false> E{P.in[0], (bf16_t*)(ws + WS_XB), mod0 + 2048, (float*)(ws + WS_SSQ)}; pg8::gemm_phase(F.lds, g, S, E); } SEAM(5);
    if (IN(7)) { PH_BEGIN pg8::Gemm g{(const bf16_t*)(ws + WS_XB), (const bf16_t*)outp, T, 2048, 1024, 1024, 1024}; pg8::BatchOrder S; S.init(T, 2048, F.G, F.bid);
        pg8::EpiQ E{(bf16_t*)(ws + WS_PQ), PQ_LD, (const float*)(ws + WS_SSQ), (const float*)(ws + WS_BQ), nullptr, -1}; { pg8::Unit u0; E.prep(F.lds, S.next(0, u0) ? u0.pm : -1, F.tid); } pg8::gemm_phase(F.lds, g, S, E); } SEAM(7);
    if (IN(8)) { PH_BEGIN p_peer_topk(F, (const bf16_t*)(ws + WS_PQ), (const bf16_t*)(ws + WS_SK), (int*)(ws + WS_EIDX), (float*)(ws + WS_GATE)); } LSEAM(8);
    if (IN(9)) { PH_BEGIN p_peer_gather<false>(F, norm_g + 1 * 1024, mod0, ws + WS_PU0, ws + WS_PV0, (const float*)(ws + WS_PSC), (const float*)(ws + WS_PSC) + N_EXPERTS, (const int*)(ws + WS_EIDX), (const float*)(ws + WS_GATE), mod0 + 5120, (bf16_t*)(ws + WS_XB), outp); } SEAM(9);
    if (IN(10)) { PH_BEGIN p_rwkv_prep(F, (const bf16_t*)(ws + WS_XB), norm_g + 2 * 1024, mod1, P.in[11], (bf16_t*)(ws + WS1_X6)); } SEAM(10);
    if (IN(11)) { PH_BEGIN pg8::Gemm g{(const bf16_t*)(ws + WS1_X6), (const bf16_t*)(ws + WS_WRW_T), 6 * T, RW_N, 1024, 1024, 1024}; pg8::RwOrder S; S.init(F.G, F.bid);
        pg8::EpiBf16<1> E{(bf16_t*)(ws + WS1_RK), RW_N}; pg8::gemm_phase(F.lds, g, S, E);
        p0_late_weights2(F); } SEAM(11);
    if (IN(12)) { PH_BEGIN pg8::Gemm g{(const bf16_t*)(ws + WS1_RK) + 3584, (const bf16_t*)(ws + WS_G2_T), T, 1024, 256, RW_N, 256}; pg8::StaticOrder S; S.init(T, 1024, F.G, F.bid);
        pg8::EpiBf16<0> E{(bf16_t*)(ws + WS1_G), 1024}; pg8::gemm_phase(F.lds, g, S, E); }
    if (IN(13)) { PH_BEGIN p_rwkv_scan(F); } SEAM(13);
    if (IN(14)) { PH_BEGIN p_rwkv_post(F); } SEAM(14);
    if (IN(15)) { PH_BEGIN pg8::Gemm g{(const bf16_t*)(ws + WS1_A3), (const bf16_t*)(ws + WS_WO_T), T, 1024, 1024, 1024, 1024}; pg8::StaticOrder S; S.init(T, 1024, F.G, F.bid);
        pg8::EpiResid<true> E{ws + WS_XB, (bf16_t*)(ws + WS_XB), mod1 + 2048, (float*)(ws + WS_SSQ)}; pg8::gemm_phase(F.lds, g, S, E); } SEAM(15);
    if (IN(17)) { PH_BEGIN pg8::Gemm g{(const bf16_t*)(ws + WS_XB), (const bf16_t*)outp + (size_t)8 * 2048 * 1024, T, 2048, 1024, 1024, 1024}; pg8::BatchOrder S; S.init(T, 2048, F.G, F.bid);
        pg8::EpiQ E{(bf16_t*)(ws + WS1_PQ), PQ_LD, (const float*)(ws + WS_SSQ), (const float*)(ws + WS_BQ) + 8 * 2048, nullptr, -1}; { pg8::Unit u0; E.prep(F.lds, S.next(0, u0) ? u0.pm : -1, F.tid); } pg8::gemm_phase(F.lds, g, S, E); } SEAM(17);
    if (IN(18)) { PH_BEGIN p_peer_topk(F, (const bf16_t*)(ws + WS1_PQ), (const bf16_t*)(ws + WS_SK) + (size_t)16 * 128 * 128, (int*)(ws + WS1_EIDX), (float*)(ws + WS1_GATE)); } LSEAM(18);
    if (IN(19)) { PH_BEGIN p_peer_gather<true>(F, norm_g + 3 * 1024, mod1, ws + WS_PU1, ws + WS_PV1, (const float*)(ws + WS_PSC) + 2 * N_EXPERTS, (const float*)(ws + WS_PSC) + 3 * N_EXPERTS, (const int*)(ws + WS1_EIDX), (const float*)(ws + WS1_GATE), mod1 + 5120, (bf16_t*)(ws + WS_XB), outp); }
    if (hi <= 5) { const f32x4* s = (const f32x4*)P.in[0]; f32x4* d = (f32x4*)P.out;
        for (size_t i = (size_t)F.bid * NTHREADS + F.tid; i < (size_t)T * D / 4; i += (size_t)F.G * NTHREADS) d[i] = s[i]; }
#undef IN
#undef SEAM
#undef LSEAM
}

#ifndef PH_HI
#define PH_HI 20
#endif
extern "C" void kernel_launch(void* const* d_in, const int* in_sizes, int n_in, void* d_out, int out_size, void* d_ws, size_t ws_size, hipStream_t stream) {
    static int grid = 0;
    if (grid == 0) {
        if (n_in != 31 || out_size != T * D || ws_size < WS_END) { fprintf(stderr, "kernel_launch: unexpected shapes (n_in %d, out %d, ws %zu)\n", n_in, out_size, ws_size); grid = -1; return; }
        int dev = 0, cus = 0, per_cu = 0;
        if (hipGetDevice(&dev) != hipSuccess || hipDeviceGetAttribute(&cus, hipDeviceAttributeMultiprocessorCount, dev) != hipSuccess) { grid = -1; return; }
        if (hipFuncSetAttribute((const void*)mega_fwd, hipFuncAttributeMaxDynamicSharedMemorySize, LDS_BYTES) != hipSuccess) { fprintf(stderr, "kernel_launch: hipFuncSetAttribute failed\n"); grid = -1; return; }
        if (hipOccupancyMaxActiveBlocksPerMultiprocessor(&per_cu, (const void*)mega_fwd, NTHREADS, LDS_BYTES) != hipSuccess || per_cu < 1) { fprintf(stderr, "kernel_launch: occupancy query says %d\n", per_cu); (void)hipGetLastError(); grid = -1; return; }
        grid = cus;
    }
    if (grid < 0) return;
    (void)hipMemsetAsync((char*)d_ws + WS_CTL, 0, CTL_ZERO_BYTES, stream);
    Params p{};
    for (int i = 0; i < 31; ++i) p.in[i] = (const float*)d_in[i];
    p.out = (float*)d_out; p.ws = (unsigned char*)d_ws; p.ph_lo = 0; p.ph_hi = PH_HI;
    hipLaunchKernelGGL(mega_fwd, dim3(grid), dim3(NTHREADS), LDS_BYTES, stream, p);
}
```

```cpp
#include <hip/hip_runtime.h>
#include <cstdio>
#include <cstdint>

#define DI __device__ __forceinline__
#define LAS __attribute__((address_space(3)))
typedef unsigned short bf16_t;
typedef short bf16x8 __attribute__((ext_vector_type(8)));
typedef short s16x4 __attribute__((ext_vector_type(4)));
typedef float f32x2 __attribute__((ext_vector_type(2)));
typedef float f32x4 __attribute__((ext_vector_type(4)));
typedef float f32x16 __attribute__((ext_vector_type(16)));
typedef unsigned u32x2 __attribute__((ext_vector_type(2)));
typedef unsigned u32x4 __attribute__((ext_vector_type(4)));
typedef __bf16 bf16x2v __attribute__((ext_vector_type(2)));

DI unsigned pack_bf16(float lo, float hi) { bf16x2v p; p[0] = (__bf16)lo; p[1] = (__bf16)hi; return __builtin_bit_cast(unsigned, p); }
DI float bf_lo(unsigned u) { return __uint_as_float(u << 16); }
DI float bf_hi(unsigned u) { return __uint_as_float(u & 0xffff0000u); }
DI float bf1(bf16_t v) { return __uint_as_float(((unsigned)v) << 16); }
DI float wave_sum(float v) {
#pragma unroll
    for (int o = 32; o > 0; o >>= 1) v += __shfl_xor(v, o);
    return v;
}
DI float sigmoidf_(float x) { return 1.0f / (1.0f + __expf(-x)); }

constexpr int D = 1024, BATCH = 8, SEQ = 2048, T = BATCH * SEQ;
constexpr int IN_W = 2304;
constexpr int NTHREADS = 512, NWAVES = 8;
constexpr int PQ_LD = 2112;
constexpr int N_EXPERTS = 16384;
constexpr float LOG2E = 1.4426950408889634f;
constexpr float QSCALE = 0.125f * LOG2E;
constexpr size_t MiB = 1ull << 20;

constexpr size_t WS_CTL   = 0;
constexpr size_t CTL_ZERO_BYTES = 16384;
constexpr size_t WS_MOD   = 64 * 1024;
constexpr size_t WS_PSC   = 512 * 1024;
constexpr size_t WS_WIN_T = 1 * MiB;
constexpr size_t WS_WOUT_T= 6 * MiB;
constexpr size_t WS_WRW_T = 8 * MiB;
constexpr size_t WS_W2_T  = 22 * MiB;
constexpr size_t WS_SSQ   = 22 * MiB;
constexpr size_t WS_BQ    = 768 * 1024;
constexpr size_t WS_WO_T  = 27 * MiB;
constexpr size_t WS_WQ_T  = 29 * MiB;
constexpr size_t WS_SK    = 37 * MiB;
constexpr size_t WS_PU1   = 38 * MiB;
constexpr size_t WS_PV1   = 54 * MiB;
constexpr size_t WS_XB    = 70 * MiB;
constexpr size_t WS_PU0   = 102 * MiB;
constexpr size_t WS_PV0   = 134 * MiB;
constexpr size_t WS_ACT   = 166 * MiB;
constexpr size_t WS_H     = WS_ACT + 0 * MiB;
constexpr size_t WS_QKV   = WS_ACT + 32 * MiB;
constexpr size_t WS_QA    = WS_ACT + 104 * MiB;
constexpr size_t WS_KA    = WS_ACT + 120 * MiB;
constexpr size_t WS_VAT   = WS_ACT + 136 * MiB;
constexpr size_t WS_QB    = WS_ACT + 152 * MiB;
constexpr size_t WS_KB    = WS_ACT + 168 * MiB;
constexpr size_t WS_VBT   = WS_ACT + 172 * MiB;
constexpr size_t WS_O     = WS_ACT + 176 * MiB;
constexpr size_t WS_PQ    = WS_ACT + 208 * MiB;
constexpr size_t WS_EIDX  = WS_ACT + 276 * MiB;
constexpr size_t WS_GATE  = WS_ACT + 284 * MiB;
constexpr size_t WS_WQS0  = 474 * MiB;
constexpr size_t WS_O0S   = WS_ACT + 292 * MiB;
constexpr size_t WS1_RK   = 102 * MiB;
constexpr size_t WS1_DEC  = 222 * MiB;
constexpr size_t WS1_AZ   = 350 * MiB;
constexpr size_t WS1_G    = 414 * MiB;
constexpr size_t WS1_Y    = 286 * MiB;
constexpr size_t WS1_WQS1 = 446 * MiB;
constexpr size_t WS1_BON  = 510 * MiB;
constexpr size_t WS1_X6   = 222 * MiB;
constexpr size_t WS1_A3   = 222 * MiB;
constexpr size_t WS1_H2   = 254 * MiB;
constexpr size_t WS1_PQ   = 286 * MiB;
constexpr size_t WS1_EIDX = 354 * MiB;
constexpr size_t WS1_GATE = 362 * MiB;
constexpr size_t WS_END   = 512 * MiB;
constexpr int RW_N = 3840, W2_N = 4096, W2_K = 512;
constexpr size_t WS_G2_T  = 26 * MiB;

constexpr int LDS_BYTES = 147456;
constexpr int LDS_BAR_OFF = 147456 - 64;
#define XB_TMO      128
#define XB_XCNT(j)  (256  + 64 * (j))
#define XB_XSUB(j)  (1280 + 64 * (j))
#define XB_XGEN(j)  (2304 + 64 * (j))
#define XB_TOP      3328
#define XB_TOPGEN   3392
#define XCD_BAR_WORDS 3456
#define XB_SPIN_CAP (1u << 18)

__device__ __forceinline__ unsigned xb_ld(unsigned* p)              { return __hip_atomic_load(p, __ATOMIC_RELAXED, __HIP_MEMORY_SCOPE_AGENT); }
__device__ __forceinline__ unsigned xb_add(unsigned* p, unsigned v) { return __hip_atomic_fetch_add(p, v, __ATOMIC_RELAXED, __HIP_MEMORY_SCOPE_AGENT); }
__device__ __forceinline__ unsigned xb_xcc_id() { return (unsigned)__builtin_amdgcn_s_getreg((3 << 11) | 20) & 0xFu; }
#define XB_SPIN(cond, bar) do { unsigned _sp = 0; while (cond) { __builtin_amdgcn_s_sleep(1); \
    if ((++_sp & 255u) == 0u) { if (xb_ld(&(bar)[XB_TMO])) break; if (_sp > XB_SPIN_CAP) { atomicAdd(&(bar)[XB_TMO], 1u); break; } } } } while (0)

struct XcdBarrier { unsigned* bar; unsigned x; volatile LAS unsigned* st; };

__device__ __forceinline__ XcdBarrier xcd_barrier_post(unsigned* bar, volatile LAS unsigned* st) {
    XcdBarrier b; b.bar = bar; b.x = xb_xcc_id(); b.st = st;
    if (threadIdx.x == 0) (void)xb_add(&bar[XB_XCNT(b.x)], 1u);
    return b;
}
__device__ __forceinline__ void xcd_barrier_complete(unsigned* bar, unsigned x, unsigned& nloc, unsigned& nx) {
    const unsigned G = gridDim.x * gridDim.y * gridDim.z;
    unsigned sum, cnt, mine, sp = 0u;
    for (;;) {
        sum = 0u; cnt = 0u; mine = 0u;
#pragma unroll
        for (unsigned j = 0; j < 16; ++j) { const unsigned c = xb_ld(&bar[XB_XCNT(j)]); sum += c; cnt += (c > 0u) ? 1u : 0u; mine = (j == x) ? c : mine; }
        if (sum == G) break;
        __builtin_amdgcn_s_sleep(1);
        if ((++sp & 255u) == 0u) { if (xb_ld(&bar[XB_TMO])) break; if (sp > XB_SPIN_CAP) { atomicAdd(&bar[XB_TMO], 1u); break; } }
    }
    nloc = mine > 0u ? mine : 1u; nx = cnt > 0u ? cnt : 1u;
}
__device__ __forceinline__ void xcd_barrier(const XcdBarrier& b) {
    asm volatile("s_waitcnt vmcnt(0)" ::: "memory");
    __syncthreads();
    if (threadIdx.x == 0) {
        unsigned* bar; { unsigned long long pv = (unsigned long long)b.bar; unsigned plo = (unsigned)pv, phi = (unsigned)(pv >> 32); asm volatile("" : "+s"(plo), "+s"(phi)); bar = (unsigned*)(__attribute__((address_space(1))) unsigned*)(((unsigned long long)phi << 32) | plo); }
        __builtin_amdgcn_s_waitcnt(0);
        unsigned nloc = b.st[0], nx = b.st[1];
        if (nloc == 0u) { xcd_barrier_complete(bar, b.x, nloc, nx); b.st[0] = nloc; b.st[1] = nx; }
        const unsigned old = xb_add(&bar[XB_XSUB(b.x)], 1u);
        const unsigned gen = old / nloc;
        if (old + 1u == (gen + 1u) * nloc) {
            __builtin_amdgcn_fence(__ATOMIC_RELEASE, "agent");
            asm volatile("s_waitcnt vmcnt(0)" ::: "memory");
            const unsigned og = xb_add(&bar[XB_TOP], 1u);
            const unsigned tg = og / nx;
            if (og + 1u == (tg + 1u) * nx) xb_add(&bar[XB_TOPGEN], 1u);
            else XB_SPIN(xb_ld(&bar[XB_TOPGEN]) == tg, bar);
            __builtin_amdgcn_fence(__ATOMIC_ACQUIRE, "agent");
            xb_add(&bar[XB_XGEN(b.x)], 1u);
            asm volatile("s_waitcnt vmcnt(0)" ::: "memory");
        } else {
            XB_SPIN(xb_ld(&bar[XB_XGEN(b.x)]) == gen, bar);
            __builtin_amdgcn_fence(__ATOMIC_ACQUIRE, "agent");
            asm volatile("s_waitcnt vmcnt(0)" ::: "memory");
        }
    }
    __syncthreads();
}
namespace pg8 {
constexpr int BM = 256, BK = 64, HALF = 128, HTB = HALF * BK * 2, STAGE_BYTES = 8 * HTB, NXCD = 8, WGM = 8;
__host__ __device__ __forceinline__ int lds_byte(int r, int c) { const int st = (r >> 4) * 2 + (c >> 5), rr = r & 15, cc = c & 31, ob = rr * 64 + cc * 2; return st * 1024 + (ob ^ (((ob >> 9) & 1) << 5)); }
__host__ __device__ __forceinline__ void stage_rc(int b, int& R, int& C) { const int st = b / 1024, sb = b % 1024, swz = sb ^ (((sb >> 9) & 1) << 5); R = (st >> 1) * 16 + swz / 64; C = (st & 1) * 32 + (swz % 64) / 2; }
__host__ __device__ __forceinline__ int perm32(int rho) { const int n = rho >> 4, i = rho & 15; return 8 * (i >> 2) + 4 * n + (i & 3); }

struct Unit { int pm, pn; };
struct Gemm { const bf16_t* A; const bf16_t* Bt; int M, N, K, lda, ldb; };

struct StaticOrder {
    int nM, nN, nwg, G, c;
    __device__ void init(int M, int N, int G_, int c_) { nM = M / BM; nN = N / BM; nwg = nM * nN; G = G_; c = c_; }
    __device__ __forceinline__ bool next(int i, Unit& u) const {
        const long L = (long)i * G + c; if (L >= nwg) return false;
        int wgid = (int)L; { const int q = nwg / NXCD, r = nwg % NXCD, xcd = wgid % NXCD, off = wgid / NXCD; wgid = (xcd < r ? xcd * (q + 1) : r * (q + 1) + (xcd - r) * q) + off; }
        const int nig = WGM * nN, gid = wgid / nig, fm = gid * WGM, gsz = (nM - fm) < WGM ? (nM - fm) : WGM;
        u.pm = fm + ((wgid % nig) % gsz); u.pn = (wgid % nig) / gsz; return true;
    }
};

struct BatchOrder {
    StaticOrder S;
    __device__ void init(int M, int N, int G_, int c_) { S.init(M, N, G_, c_); }
    __device__ __forceinline__ bool next(int i, Unit& u) const { if (!S.next(i, u)) return false; u.pn += (u.pm / (SEQ / BM)) * S.nN; return true; }
};

struct RwOrder {
    int G, c;
    __device__ void init(int G_, int c_) { G = G_; c = c_; }
    __device__ __forceinline__ bool next(int i, Unit& u) const {
        int grp, pm, pn;
        if ((G & 7) == 0) { const int x = c & 7, n = i * (G >> 3) + (c >> 3); if (n >= 120) return false;
            const int pmh = n / 15, e = n % 15; pm = x + 8 * pmh;
            if (e < 12) { grp = e >> 2; pn = grp * 4 + (e & 3); } else { grp = 3 + (e - 12); pn = 12 + (e - 12); } }
        else { const int L = i * G + c; if (L >= 960) return false;
            if (L < 768) { grp = L >> 8; pm = L & 63; pn = grp * 4 + ((L >> 6) & 3); } else { const int w = L - 768; grp = 3 + (w >> 6); pm = w & 63; pn = 12 + (grp - 3); } }
        u.pm = pm * 6 + grp; u.pn = pn; return true;
    }
};
template <class Epi, class Sched>
__device__ __forceinline__ void gemm_phase(LAS unsigned char* lds, const Gemm g, const Sched& S, const Epi& E) {
    const int tid = threadIdx.x, wid = __builtin_amdgcn_readfirstlane(tid >> 6), lane = tid & 63, wr = wid >> 2, wc = wid & 3, fr = lane & 15, fq = lane >> 4;
    const int K = g.K, nt = K / BK;
    unsigned voffA[2], voffB[2];
#pragma unroll
    for (int i = 0; i < 2; ++i) { int R, C; stage_rc(tid * 16 + i * 8192, R, C); const int Rb = Epi::PERM ? ((R & ~31) + perm32(R & 31)) : R;
        voffA[i] = (unsigned)(R * g.lda + C) * 2u; voffB[i] = (unsigned)(Rb * g.ldb + C) * 2u; }
    const size_t kstep = (size_t)(BK * 2);
    const size_t hstepA = (size_t)HALF * g.lda * 2, hstepB = (size_t)HALF * g.ldb * 2;
    const size_t tstepA = 2 * hstepA, tstepB = 2 * hstepB;
    const unsigned ldsw = (unsigned)wid * 1024u;
    const int aoff = lds_byte(wr * 64 + fr, fq * 8), boff = lds_byte(wc * 32 + fr, fq * 8);
#define PG8_SA(b, h) (((b) * 2 + (h)) * HTB)
#define PG8_SB(b, h) ((4 + (b) * 2 + (h)) * HTB)
#define PG8_STAGE(bufoff, gbase, voff) do { _Pragma("unroll") for (int _i = 0; _i < 2; ++_i) \
        __builtin_amdgcn_global_load_lds((const unsigned*)((const char*)(gbase) + (voff)[_i]), (LAS unsigned*)(lds + (bufoff) + ldsw + _i * 8192), 16, 0, 0); } while (0)
#define PG8_LDA(dst, b, h) do { _Pragma("unroll") for (int m = 0; m < 4; ++m) _Pragma("unroll") for (int k = 0; k < 2; ++k) dst[m][k] = *(const LAS bf16x8*)(lds + PG8_SA(b, h) + aoff + m * 2048 + k * 1024); } while (0)
#define PG8_LDB(dst, b, h) do { _Pragma("unroll") for (int n = 0; n < 2; ++n) _Pragma("unroll") for (int k = 0; k < 2; ++k) dst[n][k] = *(const LAS bf16x8*)(lds + PG8_SB(b, h) + boff + n * 2048 + k * 1024); } while (0)
#define PG8_MMA(ai, bj, At, Bt) do { __builtin_amdgcn_s_setprio(1); _Pragma("unroll") for (int m = 0; m < 4; ++m) _Pragma("unroll") for (int n = 0; n < 2; ++n) _Pragma("unroll") for (int k = 0; k < 2; ++k) \
        acc[ai][bj][m][n] = __builtin_amdgcn_mfma_f32_16x16x32_bf16(Bt[n][k], At[m][k], acc[ai][bj][m][n], 0, 0, 0); __builtin_amdgcn_s_setprio(0); } while (0)
#define PG8_WAIT_V(n) asm volatile("s_waitcnt vmcnt(" #n ")" ::: "memory")
#define PG8_WAIT_L(n) asm volatile("s_waitcnt lgkmcnt(" #n ")" ::: "memory")
#define PG8_BAR __builtin_amdgcn_s_barrier()
#define PG8_SCHED __builtin_amdgcn_sched_barrier(0)
    Unit cur, nxt; int ui = 0;
    if (!S.next(0, cur)) return;
    f32x4 acc[2][2][4][2];
#pragma unroll
    for (int a = 0; a < 2; ++a)
#pragma unroll
        for (int b = 0; b < 2; ++b)
#pragma unroll
            for (int m = 0; m < 4; ++m)
#pragma unroll
                for (int n = 0; n < 2; ++n) acc[a][b][m][n] = (f32x4){0.f, 0.f, 0.f, 0.f};
    bf16x8 At[4][2], B0[2][2], B1[2][2];
    const char* cA = (const char*)g.A + (size_t)cur.pm * tstepA; const char* cB = (const char*)g.Bt + (size_t)cur.pn * tstepB;
    PG8_STAGE(PG8_SB(0, 0), cB, voffB); PG8_STAGE(PG8_SA(0, 0), cA, voffA); PG8_STAGE(PG8_SB(0, 1), cB + hstepB, voffB); PG8_STAGE(PG8_SA(0, 1), cA + hstepA, voffA);
    if (wr == 1) PG8_BAR;
    PG8_WAIT_V(4); PG8_BAR;
    PG8_STAGE(PG8_SB(1, 0), cB + kstep, voffB); PG8_STAGE(PG8_SA(1, 0), cA + kstep, voffA); PG8_STAGE(PG8_SB(1, 1), cB + hstepB + kstep, voffB);
    PG8_WAIT_V(6); PG8_BAR;
    for (;;) {
        const bool has_next = S.next(ui + 1, nxt);
        const char* nA = has_next ? (const char*)g.A + (size_t)nxt.pm * tstepA : cA; const char* nB = has_next ? (const char*)g.Bt + (size_t)nxt.pn * tstepB : cB;
        for (int t = 0; t < nt; t += 2) {
            const bool last = (t == nt - 2);
            const char* a1 = cA + (size_t)(t + 1) * kstep;
            const char* a2 = last ? nA : cA + (size_t)(t + 2) * kstep; const char* b2 = last ? nB : cB + (size_t)(t + 2) * kstep;
            const char* a3 = a2 + kstep; const char* b3 = b2 + kstep;
            PG8_LDB(B0, 0, 0); PG8_SCHED; PG8_LDA(At, 0, 0); PG8_STAGE(PG8_SA(1, 1), a1 + hstepA, voffA);
            PG8_WAIT_L(8); PG8_BAR; PG8_WAIT_L(0); PG8_MMA(0, 0, At, B0); PG8_BAR; PG8_SCHED;
            PG8_LDB(B1, 0, 1); PG8_STAGE(PG8_SB(0, 0), b2, voffB);
            PG8_BAR; PG8_WAIT_L(0); PG8_MMA(0, 1, At, B1); PG8_BAR;
            PG8_LDA(At, 0, 1); PG8_STAGE(PG8_SA(0, 0), a2, voffA);
            PG8_BAR; PG8_WAIT_L(0); PG8_MMA(1, 0, At, B0); PG8_BAR; PG8_SCHED;
            PG8_STAGE(PG8_SB(0, 1), b2 + hstepB, voffB);
            PG8_WAIT_V(6); PG8_BAR; PG8_MMA(1, 1, At, B1); PG8_BAR;
            PG8_LDB(B0, 1, 0); PG8_SCHED; PG8_LDA(At, 1, 0); PG8_STAGE(PG8_SA(0, 1), a2 + hstepA, voffA);
            PG8_WAIT_L(8); PG8_BAR; PG8_WAIT_L(0); PG8_MMA(0, 0, At, B0); PG8_BAR; PG8_SCHED;
            PG8_LDB(B1, 1, 1); PG8_STAGE(PG8_SB(1, 0), b3, voffB);
            PG8_BAR; PG8_WAIT_L(0); PG8_MMA(0, 1, At, B1); PG8_BAR;
            PG8_LDA(At, 1, 1); PG8_STAGE(PG8_SA(1, 0), a3, voffA);
            PG8_BAR; PG8_WAIT_L(0); PG8_MMA(1, 0, At, B0); PG8_BAR; PG8_SCHED;
            PG8_STAGE(PG8_SB(1, 1), b3 + hstepB, voffB);
            PG8_WAIT_V(6); PG8_BAR; PG8_MMA(1, 1, At, B1); PG8_BAR;
        }
        E(acc, cur, wr, wc, fr, fq);
        if (!has_next) break;
#pragma unroll
        for (int a = 0; a < 2; ++a)
#pragma unroll
            for (int b = 0; b < 2; ++b)
#pragma unroll
                for (int m = 0; m < 4; ++m)
#pragma unroll
                    for (int n = 0; n < 2; ++n) acc[a][b][m][n] = (f32x4){0.f, 0.f, 0.f, 0.f};
        cur = nxt; cA = nA; cB = nB; ++ui;
    }
    PG8_WAIT_V(0);
    if (wr == 0) PG8_BAR;
    PG8_BAR;
#undef PG8_SA
#undef PG8_SB
#undef PG8_STAGE
#undef PG8_LDA
#undef PG8_LDB
#undef PG8_MMA
#undef PG8_WAIT_V
#undef PG8_WAIT_L
#undef PG8_BAR
#undef PG8_SCHED
}

template <int ACT> struct EpiBf16 {
    static constexpr bool PERM = true;
    __device__ __forceinline__ void prefetch(LAS unsigned char*, const Unit&, int) const {}
    bf16_t* O; int ldc;
    __device__ __forceinline__ void operator()(const f32x4 (&acc)[2][2][4][2], const Unit& u, int wr, int wc, int fr, int fq) const {
        const int row0 = (ACT == 1 ? (u.pm / 6) : u.pm) * BM + wr * 64 + fr; const int col0 = u.pn * BM + wc * 32 + 8 * fq;
#pragma unroll
        for (int ai = 0; ai < 2; ++ai)
#pragma unroll
            for (int m = 0; m < 4; ++m) { bf16_t* rowp = O + (size_t)(row0 + ai * HALF + m * 16) * ldc + col0;
#pragma unroll
                for (int bj = 0; bj < 2; ++bj) { f32x4 v0 = acc[ai][bj][m][0], v1 = acc[ai][bj][m][1];
                    if (ACT == 1) { const int c = col0 + bj * HALF;
                        if (c >= 3072 && c < 3200) {
#pragma unroll
                            for (int e = 0; e < 4; ++e) { v0[e] = 1.0f - 2.0f * __builtin_amdgcn_rcpf(1.0f + __builtin_amdgcn_exp2f(2.8853900817779268f * v0[e])); v1[e] = 1.0f - 2.0f * __builtin_amdgcn_rcpf(1.0f + __builtin_amdgcn_exp2f(2.8853900817779268f * v1[e])); } }
                        else if (c >= 3584 && c < 3712) {
#pragma unroll
                            for (int e = 0; e < 4; ++e) { v0[e] = __builtin_amdgcn_rcpf(1.0f + __builtin_amdgcn_exp2f(-1.4426950408889634f * v0[e])); v1[e] = __builtin_amdgcn_rcpf(1.0f + __builtin_amdgcn_exp2f(-1.4426950408889634f * v1[e])); } } }
                    u32x4 w; w.x = pack_bf16(v0[0], v0[1]); w.y = pack_bf16(v0[2], v0[3]); w.z = pack_bf16(v1[0], v1[1]); w.w = pack_bf16(v1[2], v1[3]);
                    *(u32x4*)(rowp + bj * HALF) = w; } }
    }
};
template <bool IN_BF16> struct EpiResid {
    static constexpr bool PERM = false;
    __device__ __forceinline__ void prefetch(LAS unsigned char* lds, const Unit& u, int tid) const {
        constexpr int RB = IN_BF16 ? 512 : 1024, LPR = RB / 128, NL = 256 * LPR;
        const char* base = (const char*)xin + ((size_t)u.pm * BM * D + (size_t)u.pn * BM) * (IN_BF16 ? 2 : 4);
#pragma unroll
        for (int i = 0; i < NL / NTHREADS; ++i) { const int ln = i * NTHREADS + tid, r = ln / LPR, c = ln % LPR;
            __builtin_amdgcn_global_load_lds((const unsigned*)(base + (size_t)r * D * (IN_BF16 ? 2 : 4) + c * 128), (LAS unsigned*)(lds + STAGE_BYTES + 2048 + (tid >> 6) * 256), 4, 0, 0); }
    }
    const void* xin; bf16_t* out; const float* gate; float* ssq;
    __device__ __forceinline__ void operator()(const f32x4 (&acc)[2][2][4][2], const Unit& u, int wr, int wc, int fr, int fq) const {
        const int row0 = u.pm * BM + wr * 64 + fr, col0 = u.pn * BM + wc * 32 + 4 * fq;
        const float* gp = gate + (size_t)((u.pm * BM) / SEQ) * 6144 + col0;
        f32x4 gv[2][2];
#pragma unroll
        for (int bj = 0; bj < 2; ++bj)
#pragma unroll
            for (int n = 0; n < 2; ++n) gv[bj][n] = *(const f32x4*)(gp + bj * HALF + n * 16);
#pragma unroll
        for (int ai = 0; ai < 2; ++ai)
#pragma unroll
            for (int m = 0; m < 4; ++m) { const size_t off = (size_t)(row0 + ai * HALF + m * 16) * D + col0; float ss = 0.f;
#pragma unroll
                for (int bj = 0; bj < 2; ++bj)
#pragma unroll
                    for (int n = 0; n < 2; ++n) { f32x4 xv;
                        if (IN_BF16) { const u32x2 w = *(const u32x2*)((const bf16_t*)xin + off + bj * HALF + n * 16); xv = (f32x4){bf_lo(w.x), bf_hi(w.x), bf_lo(w.y), bf_hi(w.y)}; }
                        else xv = *(const f32x4*)((const float*)xin + off + bj * HALF + n * 16);
                        const f32x4 r = xv + gv[bj][n] * acc[ai][bj][m][n];
                        ss += (r[0] * r[0] + r[1] * r[1]) + (r[2] * r[2] + r[3] * r[3]);
                        *(u32x2*)(out + off + bj * HALF + n * 16) = (u32x2){pack_bf16(r[0], r[1]), pack_bf16(r[2], r[3])}; }
                ss += __shfl_xor(ss, 16); ss += __shfl_xor(ss, 32);
                if (fq == 0) ssq[(size_t)(row0 + ai * HALF + m * 16) * 16 + u.pn * 4 + wc] = ss; }
    }
};
struct EpiQ {
    static constexpr bool PERM = true;
    __device__ __forceinline__ void prefetch(LAS unsigned char*, const Unit&, int) const {}
    bf16_t* O; int ldc; const float* ssq; const float* bq; const LAS float* rl; int pm_l;
    __device__ __forceinline__ void prep(LAS unsigned char* lds, int pm, int tid) { LAS float* w = (LAS float*)(lds + STAGE_BYTES); rl = w; pm_l = pm;
        if (pm >= 0 && tid < BM) { const f32x4* sp = (const f32x4*)(ssq + (size_t)(pm * BM + tid) * 16); const f32x4 s4 = (sp[0] + sp[1]) + (sp[2] + sp[3]);
            w[tid] = rsqrtf(((s4[0] + s4[1]) + (s4[2] + s4[3])) * (1.0f / 1024.0f) + 1e-6f); }
        __syncthreads(); }
    __device__ __forceinline__ void operator()(const f32x4 (&acc)[2][2][4][2], const Unit& u, int wr, int wc, int fr, int fq) const {
        const int row0 = u.pm * BM + wr * 64 + fr; const int col0 = (u.pn & 7) * BM + wc * 32 + 8 * fq;
        const float* bp = bq + (size_t)(u.pn >> 3) * 2048 + col0;
        f32x4 b0[2], b1[2];
#pragma unroll
        for (int bj = 0; bj < 2; ++bj) { b0[bj] = *(const f32x4*)(bp + bj * HALF); b1[bj] = *(const f32x4*)(bp + bj * HALF + 4); }
#pragma unroll
        for (int ai = 0; ai < 2; ++ai)
#pragma unroll
            for (int m = 0; m < 4; ++m) { const int r = row0 + ai * HALF + m * 16; bf16_t* rowp = O + (size_t)r * ldc + col0;
                float rinv;
                if (u.pm == pm_l) rinv = rl[wr * 64 + fr + ai * HALF + m * 16];
                else { const f32x4* sp = (const f32x4*)(ssq + (size_t)r * 16); const f32x4 s4 = (sp[0] + sp[1]) + (sp[2] + sp[3]);
                    rinv = rsqrtf(((s4[0] + s4[1]) + (s4[2] + s4[3])) * (1.0f / 1024.0f) + 1e-6f); }
#pragma unroll
                for (int bj = 0; bj < 2; ++bj) { const f32x4 v0 = acc[ai][bj][m][0] * rinv + b0[bj], v1 = acc[ai][bj][m][1] * rinv + b1[bj];
                    u32x4 w; w.x = pack_bf16(v0[0], v0[1]); w.y = pack_bf16(v0[2], v0[3]); w.z = pack_bf16(v1[0], v1[1]); w.w = pack_bf16(v1[2], v1[3]);
                    *(u32x4*)(rowp + bj * HALF) = w; } }
    }
};
struct EpiRw2 {
    static constexpr bool PERM = true;
    __device__ __forceinline__ void prefetch(LAS unsigned char*, const Unit&, int) const {}
    float* DEC; bf16_t* AZ; bf16_t* G; const float* w0; const float* a0;
    __device__ __forceinline__ void operator()(const f32x4 (&acc)[2][2][4][2], const Unit& u, int wr, int wc, int fr, int fq) const {
        const int row0 = u.pm * BM + wr * 64 + fr; const int col0 = u.pn * BM + wc * 32 + 8 * fq;
        const int cls = u.pn < 8 ? 0 : 1;
#pragma unroll
        for (int bj = 0; bj < 2; ++bj) {
            const int c = col0 + bj * HALF;
            f32x4 b0 = (f32x4){0.f, 0.f, 0.f, 0.f}, b1 = b0;
            if (cls == 0) { b0 = *(const f32x4*)(w0 + c); b1 = *(const f32x4*)(w0 + c + 4); }
            else if (cls == 1) { b0 = *(const f32x4*)(a0 + c - 2048); b1 = *(const f32x4*)(a0 + c - 2048 + 4); }
#pragma unroll
            for (int ai = 0; ai < 2; ++ai)
#pragma unroll
                for (int m = 0; m < 4; ++m) { const size_t r = (size_t)(row0 + ai * HALF + m * 16);
                    f32x4 v0 = acc[ai][bj][m][0] + b0, v1 = acc[ai][bj][m][1] + b1;
                    if (cls == 0) {
#pragma unroll
                        for (int e = 0; e < 4; ++e) { v0[e] = __expf(-0.6065306597126334f * sigmoidf_(v0[e])); v1[e] = __expf(-0.6065306597126334f * sigmoidf_(v1[e])); }
                        *(f32x4*)(DEC + r * 2048 + c) = v0; *(f32x4*)(DEC + r * 2048 + c + 4) = v1;
                    } else {
                        if (cls == 1) {
#pragma unroll
                            for (int e = 0; e < 4; ++e) { v0[e] = sigmoidf_(v0[e]); v1[e] = sigmoidf_(v1[e]); } }
                        u32x4 w; w.x = pack_bf16(v0[0], v0[1]); w.y = pack_bf16(v0[2], v0[3]); w.z = pack_bf16(v1[0], v1[1]); w.w = pack_bf16(v1[2], v1[3]);
                        if (cls == 1) *(u32x4*)(AZ + r * 2048 + (c - 2048)) = w; else *(u32x4*)(G + r * 1024 + (c - 4096)) = w;
                    } }
        }
    }
};
}
struct Params { const float* in[31]; float* out; unsigned char* ws; int ph_lo, ph_hi; };
struct Frame {
    LAS unsigned char* lds; int tid, lane, wave, G, bid;
    const float* const* in; float* out; unsigned char* ws;
};

DI void fp8_row_store(const float (&v)[16], int row, int lane, unsigned char* dst, float* scale);
DI void fp8_row_load(const float* src, int row, int lane, float (&v)[16]);
DI void p0_convert_fp8(const Frame& F, const float* src, unsigned char* dst, float* scale, int widx, int nw);
template <bool SPLIT> DI void p0_mod(const Frame& F) {
    constexpr int NKG = SPLIT ? 21 : 42, NB = SPLIT ? 4 : 2, NTH = NKG * 12;
    const float* c = F.in[1]; const float* ada_w = F.in[2]; const float* ada_b = F.in[3];
    float* mod = (float*)(F.ws + WS_MOD);
    LAS float* sc = (LAS float*)F.lds;
    LAS float* part = (LAS float*)(F.lds + 32768);
    for (int i = F.tid; i < 8 * 1024; i += NTHREADS) { const int b = i >> 10, k = i & 1023; const float v = c[i]; sc[k * 8 + b] = v * sigmoidf_(v); }
    __syncthreads();
    for (int cb = F.bid; cb < 256; cb += F.G) {
        const int colbase = cb * 48, l = colbase / 6144, n0 = colbase % 6144;
        if (F.tid < NTH) {
            const int q = F.tid % 12, kg = F.tid / 12, krot = (cb * 148) & 1023;
            const float* wp = ada_w + (size_t)l * 1024 * 6144 + n0 + 4 * q;
            f32x4 acc[8];
#pragma unroll
            for (int b = 0; b < 8; ++b) acc[b] = (f32x4){0.f, 0.f, 0.f, 0.f};
#pragma unroll
            for (int bt = 0; bt < NB; ++bt) {
                f32x4 w[13];
#pragma unroll
                for (int i = 0; i < 13; ++i) { const int k = kg + NKG * (13 * bt + i), kk = ((k < 1024 ? k : 1023) + krot) & 1023; w[i] = *(const f32x4*)(wp + (size_t)kk * 6144); }
#pragma unroll
                for (int i = 0; i < 13; ++i) { const int k = kg + NKG * (13 * bt + i), kk = ((k < 1024 ? k : 1023) + krot) & 1023;
                    const f32x4 wv = k < 1024 ? w[i] : (f32x4){0.f, 0.f, 0.f, 0.f};
                    const f32x4 s0 = *(const LAS f32x4*)(sc + kk * 8), s1 = *(const LAS f32x4*)(sc + kk * 8 + 4);
                    acc[0] += wv * s0[0]; acc[1] += wv * s0[1]; acc[2] += wv * s0[2]; acc[3] += wv * s0[3];
                    acc[4] += wv * s1[0]; acc[5] += wv * s1[1]; acc[6] += wv * s1[2]; acc[7] += wv * s1[3]; }
            }
#pragma unroll
            for (int e = 0; e < 4; ++e) { LAS float* pp = part + ((size_t)kg * 48 + 4 * q + e) * 8;
                *(LAS f32x4*)pp = (f32x4){acc[0][e], acc[1][e], acc[2][e], acc[3][e]}; *(LAS f32x4*)(pp + 4) = (f32x4){acc[4][e], acc[5][e], acc[6][e], acc[7][e]}; }
        } else if (SPLIT && F.wave >= 4) {
            p0_convert_fp8(F, F.in[29], F.ws + WS_PU0, (float*)(F.ws + WS_PSC), F.bid * 4 + (F.wave - 4), F.G * 4);
        }
        __syncthreads();
        if (F.tid < 256) for (int o = F.tid; o < 384; o += 256) {
            const int cl = o >> 3, b = o & 7; const int col = colbase + cl;
            float s = ada_b[col];
#pragma unroll
            for (int kg = 0; kg < NKG; ++kg) s += part[(kg * 48 + cl) * 8 + b];
            mod[((size_t)l * 8 + b) * 6144 + n0 + cl] = s;
        }
        __syncthreads();
    }
}
DI void p0_transpose(const Frame& F, const float* src, int ld, int K, int N, bf16_t* dst, int ldd, const float* mix) {
    (void)mix;
    LAS float* tiles = (LAS float*)F.lds;
    const int tn = N / 64, nt = (K / 64) * tn;
    for (int t0 = F.bid; t0 < nt; t0 += 4 * F.G) {
        __syncthreads();
        f32x4 v[4][2];
#pragma unroll
        for (int q = 0; q < 4; ++q) { const int tt = t0 + q * F.G, t = tt < nt ? tt : t0; const int k0 = (t / tn) * 64, n0 = (t % tn) * 64;
#pragma unroll
            for (int h = 0; h < 2; ++h) { const int i = F.tid + h * NTHREADS, r = i >> 4, c4 = (i & 15) * 4; v[q][h] = *(const f32x4*)(src + (size_t)(k0 + r) * ld + n0 + c4); } }
#pragma unroll
        for (int q = 0; q < 4; ++q)
#pragma unroll
            for (int h = 0; h < 2; ++h) { const int i = F.tid + h * NTHREADS, r = i >> 4, c4 = (i & 15) * 4; LAS float* tp = tiles + q * 4160 + r * 65 + c4;
                tp[0] = v[q][h][0]; tp[1] = v[q][h][1]; tp[2] = v[q][h][2]; tp[3] = v[q][h][3]; }
        __syncthreads();
#pragma unroll
        for (int q = 0; q < 4; ++q) { const int t = t0 + q * F.G; if (t < nt) { const int k0 = (t / tn) * 64, n0 = (t % tn) * 64;
            const int n = F.tid >> 3, kc = (F.tid & 7) * 8;
            float w8[8];
#pragma unroll
            for (int e = 0; e < 8; ++e) w8[e] = tiles[q * 4160 + (kc + e) * 65 + n];
            u32x4 w; w.x = pack_bf16(w8[0], w8[1]); w.y = pack_bf16(w8[2], w8[3]); w.z = pack_bf16(w8[4], w8[5]); w.w = pack_bf16(w8[6], w8[7]);
            *(u32x4*)(dst + (size_t)(n0 + n) * ldd + k0 + kc) = w; } }
    }
    __syncthreads();
}
DI void p0_wqs(const Frame& F, const float* W, const float* g, const float* modl, bf16_t* dst) {
    LAS float* tiles = (LAS float*)F.lds;
    LAS float* gsl = (LAS float*)(F.lds + 69632);
    const int nt = 16 * 32;
    if (F.bid >= nt) return;
    __syncthreads();
    for (int i = F.tid; i < 8 * 1024; i += NTHREADS) gsl[i] = g[i & 1023] * (1.0f + modl[(size_t)(i >> 10) * 6144 + 4096 + (i & 1023)]);
    for (int t0 = F.bid; t0 < nt; t0 += 4 * F.G) {
        __syncthreads();
        f32x4 v[4][2];
#pragma unroll
        for (int q = 0; q < 4; ++q) { const int tt = t0 + q * F.G, t = tt < nt ? tt : t0; const int k0 = (t / 32) * 64, n0 = (t % 32) * 64;
#pragma unroll
            for (int h = 0; h < 2; ++h) { const int i = F.tid + h * NTHREADS, r = i >> 4, c4 = (i & 15) * 4; v[q][h] = *(const f32x4*)(W + (size_t)(k0 + r) * 2048 + n0 + c4); } }
#pragma unroll
        for (int q = 0; q < 4; ++q)
#pragma unroll
            for (int h = 0; h < 2; ++h) { const int i = F.tid + h * NTHREADS, r = i >> 4, c4 = (i & 15) * 4; LAS float* tp = tiles + q * 4160 + r * 65 + c4;
                tp[0] = v[q][h][0]; tp[1] = v[q][h][1]; tp[2] = v[q][h][2]; tp[3] = v[q][h][3]; }
        __syncthreads();
        for (int q = 0; q < 4; ++q) { const int t = t0 + q * F.G; if (t < nt) { const int k0 = (t / 32) * 64, n0 = (t % 32) * 64;
            const int n = F.tid >> 3, kc = (F.tid & 7) * 8;
            float w8[8];
#pragma unroll
            for (int e = 0; e < 8; ++e) w8[e] = tiles[q * 4160 + (kc + e) * 65 + n];
#pragma unroll
            for (int b = 0; b < 8; ++b) { const f32x4 s0 = *(const LAS f32x4*)(gsl + b * 1024 + k0 + kc), s1 = *(const LAS f32x4*)(gsl + b * 1024 + k0 + kc + 4);
                u32x4 w; w.x = pack_bf16(w8[0] * s0[0], w8[1] * s0[1]); w.y = pack_bf16(w8[2] * s0[2], w8[3] * s0[3]);
                w.z = pack_bf16(w8[4] * s1[0], w8[5] * s1[1]); w.w = pack_bf16(w8[6] * s1[2], w8[7] * s1[3]);
                *(u32x4*)(dst + ((size_t)b * 2048 + n0 + n) * 1024 + k0 + kc) = w; } } }
    }
    __syncthreads();
}
DI void p0_bq(const Frame& F, const float* W, const float* modl, float* bq) {
    LAS float* shl = (LAS float*)F.lds;
    LAS float* part = (LAS float*)(F.lds + 32768);
    if (F.bid >= 128) return;
    __syncthreads();
    for (int i = F.tid; i < 8 * 1024; i += NTHREADS) { const int b = i >> 10, k = i & 1023; shl[k * 8 + b] = modl[(size_t)b * 6144 + 3072 + k]; }
    __syncthreads();
    for (int task = F.bid; task < 128; task += F.G) {
        const int cl = F.tid & 15, kp = F.tid >> 4; const float* wp = W + (size_t)(kp * 32) * 2048 + task * 16 + cl;
        float wv[32];
#pragma unroll
        for (int k = 0; k < 32; ++k) wv[k] = wp[(size_t)k * 2048];
        float a[8];
#pragma unroll
        for (int b = 0; b < 8; ++b) a[b] = 0.f;
#pragma unroll
        for (int k = 0; k < 32; ++k) { const float w = wv[k];
            const f32x4 s0 = *(const LAS f32x4*)(shl + (kp * 32 + k) * 8), s1 = *(const LAS f32x4*)(shl + (kp * 32 + k) * 8 + 4);
            a[0] += w * s0[0]; a[1] += w * s0[1]; a[2] += w * s0[2]; a[3] += w * s0[3]; a[4] += w * s1[0]; a[5] += w * s1[1]; a[6] += w * s1[2]; a[7] += w * s1[3]; }
#pragma unroll
        for (int b = 0; b < 8; ++b) part[(kp * 16 + cl) * 8 + b] = a[b];
        __syncthreads();
        if (F.tid < 128) { const int c2 = F.tid >> 3, b = F.tid & 7; float s = 0.f;
#pragma unroll
            for (int q = 0; q < 32; ++q) s += part[(q * 16 + c2) * 8 + b];
            bq[(size_t)b * 2048 + task * 16 + c2] = s; }
        __syncthreads();
    }
}
DI void p0_convert(const Frame& F, const float* src, bf16_t* dst, size_t n) {
    const size_t n8 = n / 8;
    for (size_t i = (size_t)F.bid * NTHREADS + F.tid; i < n8; i += (size_t)F.G * NTHREADS) {
        const f32x4 a = *(const f32x4*)(src + i * 8), b = *(const f32x4*)(src + i * 8 + 4);
        u32x4 w; w.x = pack_bf16(a[0], a[1]); w.y = pack_bf16(a[2], a[3]); w.z = pack_bf16(b[0], b[1]); w.w = pack_bf16(b[2], b[3]);
        *(u32x4*)(dst + i * 8) = w;
    }
}
DI void fp8_row_store(const float (&v)[16], int row, int lane, unsigned char* dst, float* scale) {
    float am = 0.f;
#pragma unroll
    for (int e = 0; e < 16; ++e) am = fmaxf(am, fabsf(v[e]));
#pragma unroll
    for (int o = 32; o > 0; o >>= 1) am = fmaxf(am, __shfl_xor(am, o));
    const float sc = am > 0.f ? am * (1.0f / 384.0f) : 1.0f, inv = 1.0f / sc;
    u32x4 w;
    { int t0 = 0; t0 = __builtin_amdgcn_cvt_pk_fp8_f32(v[0] * inv, v[1] * inv, t0, false); t0 = __builtin_amdgcn_cvt_pk_fp8_f32(v[2] * inv, v[3] * inv, t0, true); w.x = (unsigned)t0; }
    { int t0 = 0; t0 = __builtin_amdgcn_cvt_pk_fp8_f32(v[4] * inv, v[5] * inv, t0, false); t0 = __builtin_amdgcn_cvt_pk_fp8_f32(v[6] * inv, v[7] * inv, t0, true); w.y = (unsigned)t0; }
    { int t0 = 0; t0 = __builtin_amdgcn_cvt_pk_fp8_f32(v[8] * inv, v[9] * inv, t0, false); t0 = __builtin_amdgcn_cvt_pk_fp8_f32(v[10] * inv, v[11] * inv, t0, true); w.z = (unsigned)t0; }
    { int t0 = 0; t0 = __builtin_amdgcn_cvt_pk_fp8_f32(v[12] * inv, v[13] * inv, t0, false); t0 = __builtin_amdgcn_cvt_pk_fp8_f32(v[14] * inv, v[15] * inv, t0, true); w.w = (unsigned)t0; }
    *(u32x4*)(dst + (size_t)row * 1024 + 16 * lane) = w;
    if (lane == 0) scale[row] = sc;
}
DI void fp8_row_load(const float* src, int row, int lane, float (&v)[16]) {
#pragma unroll
    for (int j = 0; j < 4; ++j) { const f32x4 a = *(const f32x4*)(src + (size_t)row * 1024 + 256 * j + 4 * lane); v[4 * j] = a[0]; v[4 * j + 1] = a[1]; v[4 * j + 2] = a[2]; v[4 * j + 3] = a[3]; }
}
DI void p0_convert_fp8(const Frame& F, const float* src, unsigned char* dst, float* scale, int widx, int nw) {
    const int lane = F.lane;
    for (int row = widx; row < N_EXPERTS; row += 4 * nw) {
        float v0[16], v1[16], v2[16], v3[16];
        const int r1 = row + nw, r2 = row + 2 * nw, r3 = row + 3 * nw;
        fp8_row_load(src, row, lane, v0);
        if (r1 < N_EXPERTS) fp8_row_load(src, r1, lane, v1);
        if (r2 < N_EXPERTS) fp8_row_load(src, r2, lane, v2);
        if (r3 < N_EXPERTS) fp8_row_load(src, r3, lane, v3);
        fp8_row_store(v0, row, lane, dst, scale);
        if (r1 < N_EXPERTS) fp8_row_store(v1, r1, lane, dst, scale);
        if (r2 < N_EXPERTS) fp8_row_store(v2, r2, lane, dst, scale);
        if (r3 < N_EXPERTS) fp8_row_store(v3, r3, lane, dst, scale);
    }
}
DI void p0_prologue(const Frame& F) {
    const bool split = (F.G == 256);
    if (split) p0_mod<true>(F); else p0_mod<false>(F);
    bf16_t* WIN_T = (bf16_t*)(F.ws + WS_WIN_T);
    p0_transpose(F, F.in[5], IN_W, 1024, IN_W, WIN_T, 1024, nullptr);
    float* psc = (float*)(F.ws + WS_PSC);
    if (!split) p0_convert_fp8(F, F.in[29], F.ws + WS_PU0, psc + 0 * N_EXPERTS, F.bid * NWAVES + F.wave, F.G * NWAVES);
    p0_convert_fp8(F, F.in[30], F.ws + WS_PV0, psc + 1 * N_EXPERTS, F.bid * NWAVES + F.wave, F.G * NWAVES);
}
DI void p0_late_weights(const Frame& Fin, int nunits) {
    const int nmax = (nunits + Fin.G - 1) / Fin.G, nfull = nunits - (nmax - 1) * Fin.G;
    Frame F = Fin;
    if (nfull < Fin.G) { if (Fin.bid < nfull) return; F.bid = Fin.bid - nfull; F.G = Fin.G - nfull; }
    bf16_t* WRW_T = (bf16_t*)(F.ws + WS_WRW_T);
    p0_transpose(F, F.in[12] + 0 * 1048576, 1024, 1024, 1024, WRW_T + (size_t)0    * 1024, 1024, nullptr);
    p0_transpose(F, F.in[12] + 1 * 1048576, 1024, 1024, 1024, WRW_T + (size_t)1024 * 1024, 1024, nullptr);
    p0_transpose(F, F.in[12] + 2 * 1048576, 1024, 1024, 1024, WRW_T + (size_t)2048 * 1024, 1024, nullptr);
    p0_transpose(F, F.in[14] + 0 * 65536, 64, 1024, 64, WRW_T + (size_t)3072 * 1024, 1024, nullptr);
    p0_transpose(F, F.in[14] + 1 * 65536, 64, 1024, 64, WRW_T + (size_t)3136 * 1024, 1024, nullptr);
    p0_transpose(F, F.in[17] + 0 * 65536, 64, 1024, 64, WRW_T + (size_t)3328 * 1024, 1024, nullptr);
    p0_transpose(F, F.in[17] + 1 * 65536, 64, 1024, 64, WRW_T + (size_t)3392 * 1024, 1024, nullptr);
    p0_transpose(F, F.in[19], 128, 1024, 128, WRW_T + (size_t)3584 * 1024, 1024, nullptr);
    { const u32x4 z = (u32x4){0u, 0u, 0u, 0u};
      for (int i = F.bid * NTHREADS + F.tid; i < 3 * 128 * 1024 / 8; i += F.G * NTHREADS) { const int blk = i / (128 * 128), r = i % (128 * 128);
          ((u32x4*)(WRW_T + (size_t)(3200 + 256 * blk) * 1024))[r] = z; } }
    { const float* g2 = F.in[20]; bf16_t* G2_T = (bf16_t*)(F.ws + WS_G2_T);
      for (int i = F.bid * NTHREADS + F.tid; i < 1024 * 32; i += F.G * NTHREADS) { const int n = i % 1024, k0 = (i / 1024) * 8;
          float v[8];
#pragma unroll
          for (int e = 0; e < 8; ++e) v[e] = (k0 + e < 128) ? g2[(size_t)(k0 + e) * 1024 + n] : 0.f;
          u32x4 w; w.x = pack_bf16(v[0], v[1]); w.y = pack_bf16(v[2], v[3]); w.z = pack_bf16(v[4], v[5]); w.w = pack_bf16(v[6], v[7]);
          *(u32x4*)(G2_T + (size_t)n * 256 + k0) = w; } }
    p0_transpose(F, F.in[9], 1024, 1024, 1024, (bf16_t*)(F.ws + WS_WOUT_T), 1024, nullptr);
    p0_convert(F, F.in[28], (bf16_t*)(F.ws + WS_SK), (size_t)2 * 16 * 128 * 128);
    const float* mod = (const float*)(F.ws + WS_MOD);
    p0_wqs(F, F.in[27], F.in[4] + 1 * 1024, mod, (bf16_t*)(F.ws + WS_WQS0));
    { Frame Fr = F; Fr.bid = F.G - 1 - F.bid;
      p0_bq(Fr, F.in[27], mod, (float*)(F.ws + WS_BQ)); }
}
DI void p0_late_weights2(const Frame& Fin) {
    Frame F = Fin;
    if ((Fin.G & 7) == 0) { const int g8 = Fin.G >> 3, nmax = (120 + g8 - 1) / g8, nfull = 120 - (nmax - 1) * g8;
        if (nfull < g8) { if ((Fin.bid >> 3) < nfull) return; F.bid = ((Fin.bid >> 3) - nfull) * 8 + (Fin.bid & 7); F.G = (g8 - nfull) * 8; } }
    else { const int nmax = (960 + Fin.G - 1) / Fin.G, nfull = 960 - (nmax - 1) * Fin.G;
        if (nfull < Fin.G) { if (Fin.bid < nfull) return; F.bid = Fin.bid - nfull; F.G = Fin.G - nfull; } }
    p0_wqs(F, F.in[27] + (size_t)1024 * 2048, F.in[4] + 3 * 1024, (const float*)(F.ws + WS_MOD) + 8 * 6144, (bf16_t*)(F.ws + WS1_WQS1));
    p0_transpose(F, F.in[26], 1024, 1024, 1024, (bf16_t*)(F.ws + WS_WO_T), 1024, nullptr);
    { Frame Fr = F; Fr.bid = F.G - 1 - F.bid; p0_bq(Fr, F.in[27] + (size_t)1024 * 2048, (const float*)(F.ws + WS_MOD) + 8 * 6144, (float*)(F.ws + WS_BQ) + 8 * 2048); }
}

DI void norm_row16(const float* xr, int lane, float (&v)[16], float& rinv) {
    float ss = 0.f;
#pragma unroll
    for (int j = 0; j < 4; ++j) { const f32x4 a = *(const f32x4*)(xr + j * 256 + lane * 4); v[4 * j] = a[0]; v[4 * j + 1] = a[1]; v[4 * j + 2] = a[2]; v[4 * j + 3] = a[3];
        ss += a[0] * a[0] + a[1] * a[1] + a[2] * a[2] + a[3] * a[3]; }
    ss = wave_sum(ss);
    rinv = rsqrtf(ss * (1.0f / 1024.0f) + 1e-6f);
}
DI void ada_apply(float (&v)[16], float rinv, const float* g, const float* sc, const float* sh, int lane) {
#pragma unroll
    for (int j = 0; j < 4; ++j) { const int c = j * 256 + lane * 4;
        const f32x4 gg = *(const f32x4*)(g + c), s1 = *(const f32x4*)(sc + c), s0 = *(const f32x4*)(sh + c);
#pragma unroll
        for (int e = 0; e < 4; ++e) v[4 * j + e] = v[4 * j + e] * rinv * gg[e] * (1.0f + s1[e]) + s0[e]; }
}
DI void norm_row16_b(const bf16_t* xr, int lane, float (&v)[16], float& rinv) {
    float ss = 0.f;
#pragma unroll
    for (int j = 0; j < 4; ++j) { const u32x2 a = *(const u32x2*)(xr + j * 256 + lane * 4); v[4 * j] = bf_lo(a.x); v[4 * j + 1] = bf_hi(a.x); v[4 * j + 2] = bf_lo(a.y); v[4 * j + 3] = bf_hi(a.y);
        ss += v[4 * j] * v[4 * j] + v[4 * j + 1] * v[4 * j + 1] + v[4 * j + 2] * v[4 * j + 2] + v[4 * j + 3] * v[4 * j + 3]; }
    ss = wave_sum(ss);
    rinv = rsqrtf(ss * (1.0f / 1024.0f) + 1e-6f);
}
template <bool IN_BF16> DI void p_norm(const Frame& F, const void* x, const float* g, const float* modl  , int sh_off, int sc_off, bf16_t* H) {
    for (int r = F.bid * NWAVES + F.wave; r < T; r += F.G * NWAVES) {
        const int b = r / SEQ; float v[16], rinv;
        if (IN_BF16) norm_row16_b((const bf16_t*)x + (size_t)r * D, F.lane, v, rinv); else norm_row16((const float*)x + (size_t)r * D, F.lane, v, rinv);
        ada_apply(v, rinv, g, modl + (size_t)b * 6144 + sc_off, modl + (size_t)b * 6144 + sh_off, F.lane);
#pragma unroll
        for (int j = 0; j < 4; ++j) { u32x2 w; w.x = pack_bf16(v[4 * j], v[4 * j + 1]); w.y = pack_bf16(v[4 * j + 2], v[4 * j + 3]);
            *(u32x2*)(H + (size_t)r * D + j * 256 + F.lane * 4) = w; }
    }
}
DI void p_qkprep(const Frame& F) {
    const bf16_t* QKV = (const bf16_t*)(F.ws + WS_QKV);
    bf16_t* QA = (bf16_t*)(F.ws + WS_QA); bf16_t* KA = (bf16_t*)(F.ws + WS_KA); bf16_t* VAT = (bf16_t*)(F.ws + WS_VAT);
    bf16_t* QB = (bf16_t*)(F.ws + WS_QB); bf16_t* KB = (bf16_t*)(F.ws + WS_KB); bf16_t* VBT = (bf16_t*)(F.ws + WS_VBT);
    const float* qk_g = F.in[6];
    LAS float* cs = (LAS float*)F.lds;
    LAS unsigned short* vt = (LAS unsigned short*)(F.lds + 16384);
    for (int tile = F.bid; tile < T / 64; tile += F.G) {
        const int t0 = tile * 64, b = t0 / SEQ, s0 = t0 % SEQ;
        __syncthreads();
        for (int i = F.tid; i < 64 * 32; i += NTHREADS) { const int tok = i >> 5, ai = i & 31, axis = ai >> 4, ii = ai & 15;
            const int s = s0 + tok; const float pos = (float)(axis == 0 ? (s >> 6) : (s & 63));
            const float inv = exp2f(-(float)ii * (13.287712379549449f / 16.0f));
            float sn, cn; sincosf(pos * inv, &sn, &cn); cs[2 * i] = cn; cs[2 * i + 1] = sn; }
        for (int i = F.tid; i < 64 * 80; i += NTHREADS) { const int tok = i / 80, ch = i % 80; const int col = ch < 64 ? 1024 + 8 * ch : 2176 + 8 * (ch - 64);
            const u32x4 v = *(const u32x4*)(QKV + (size_t)(t0 + tok) * IN_W + col);
            *(LAS u32x4*)(vt + tok * 648 + 8 * ch) = v; }
        __syncthreads();
        const int tok = F.tid >> 3, j = F.tid & 7, s = s0 + tok;
        for (int slot = 0; slot < 26; ++slot) {
            int col, type; bf16_t* dst;
            if (slot < 8)       { col = 64 * slot;               type = 0; dst = QA + ((size_t)(b * 8 + slot) * SEQ + s) * 64; }
            else if (slot < 16) { col = 512 + 64 * (slot - 8);   type = 1; dst = KA + ((size_t)(b * 8 + slot - 8) * SEQ + s) * 64; }
            else if (slot < 24) { col = 1536 + 64 * (slot - 16); type = 2; dst = QB + ((size_t)(b * 8 + slot - 16) * SEQ + s) * 64; }
            else                { col = 2048 + 64 * (slot - 24); type = 3; dst = KB + ((size_t)(b * 2 + slot - 24) * SEQ + s) * 64; }
            const u32x4 raw = *(const u32x4*)(QKV + (size_t)(t0 + tok) * IN_W + col + 8 * j);
            float v[8]; v[0] = bf_lo(raw.x); v[1] = bf_hi(raw.x); v[2] = bf_lo(raw.y); v[3] = bf_hi(raw.y); v[4] = bf_lo(raw.z); v[5] = bf_hi(raw.z); v[6] = bf_lo(raw.w); v[7] = bf_hi(raw.w);
            float ss = 0.f;
#pragma unroll
            for (int e = 0; e < 8; ++e) ss += v[e] * v[e];
            ss += __shfl_xor(ss, 1); ss += __shfl_xor(ss, 2); ss += __shfl_xor(ss, 4);
            const float rinv = rsqrtf(ss * (1.0f / 64.0f) + 1e-6f);
            const f32x4 g0 = *(const f32x4*)(qk_g + type * 64 + 8 * j), g1 = *(const f32x4*)(qk_g + type * 64 + 8 * j + 4);
#pragma unroll
            for (int e = 0; e < 4; ++e) { v[e] = v[e] * rinv * g0[e]; v[4 + e] = v[4 + e] * rinv * g1[e]; }
            if (type >= 2) {
                const int axis = j >> 2; const bool first = (j & 2) == 0;
#pragma unroll
                for (int e = 0; e < 8; ++e) { const float p = __shfl_xor(v[e], 2); const int ii = 8 * (j & 1) + e;
                    const float cn = cs[2 * (tok * 32 + axis * 16 + ii)], sn = cs[2 * (tok * 32 + axis * 16 + ii) + 1];
                    v[e] = first ? (v[e] * cn - p * sn) : (v[e] * cn + p * sn); }
            }
            if (type == 0 || type == 2) {
#pragma unroll
                for (int e = 0; e < 8; ++e) v[e] *= QSCALE; }
            u32x4 w; w.x = pack_bf16(v[0], v[1]); w.y = pack_bf16(v[2], v[3]); w.z = pack_bf16(v[4], v[5]); w.w = pack_bf16(v[6], v[7]);
            *(u32x4*)(dst + 8 * j) = w;
        }
        for (int i = F.tid; i < 640 * 8; i += NTHREADS) { const int c = i & 7, dv = i >> 3;
            unsigned short e[8];
#pragma unroll
            for (int k = 0; k < 8; ++k) e[k] = vt[(16 * (c >> 1) + 4 * (c & 1) + (k & 3) + 8 * (k >> 2)) * 648 + dv];
            u32x4 w; w.x = e[0] | ((unsigned)e[1] << 16); w.y = e[2] | ((unsigned)e[3] << 16); w.z = e[4] | ((unsigned)e[5] << 16); w.w = e[6] | ((unsigned)e[7] << 16);
            bf16_t* dp = dv < 512 ? VAT + ((size_t)b * 512 + dv) * SEQ + s0 + 8 * c : VBT + ((size_t)b * 128 + (dv - 512)) * SEQ + s0 + 8 * c;
            *(u32x4*)dp = w; }
    }
    __syncthreads();
}

DI int t5_bucket(int rel) {
    const int ret = rel > 0 ? 16 : 0; const int n = rel < 0 ? -rel : rel;
    if (n < 8) return ret + n;
    int large = 8 + (n >= 12) + (n >= 16) + (n >= 23) + (n >= 32) + (n >= 46) + (n >= 64) + (n >= 91);
    return ret + large;
}
constexpr int AT_NS = 4, AT_PD = AT_NS - 1, AT_STG = 24576, AT_TB = AT_NS * AT_STG, AT_Q = AT_TB + 3072;
DI void glds16(const void* gsrc, unsigned lds_dst) { unsigned keep;
    asm volatile("s_mov_b32 %0, m0\n\ts_mov_b32 m0, %2\n\ts_nop 0\n\tglobal_load_lds_dwordx4 %1, off\n\ts_mov_b32 m0, %0" : "=&s"(keep) : "v"(gsrc), "s"(lds_dst) : "memory"); }

template <int NC, bool BIAS>
DI void attn_pass(const Frame& F, const bf16_t* Qp, const bf16_t* Kp, const bf16_t* Vt, int q0, const LAS float* tb, float c_neg, float c_pos, f32x16 (&o)[NC], float& l_out) {
    int lane = F.lane, tid_ = F.tid; asm volatile("" : "+v"(lane), "+v"(tid_));
    const int r31 = lane & 31, h = lane >> 5;
    LAS unsigned char* lds = F.lds;
    constexpr int NT = SEQ / 64, PT = 1 + NC / 2;
    __syncthreads();
#pragma unroll
    for (int i = 0; i < 4; ++i) { const int idx = i * NTHREADS + tid_, row = idx >> 3, ch = idx & 7;
        const u32x4 v = *(const u32x4*)(Qp + (size_t)(q0 + row) * 64 + 8 * ch);
        *(LAS u32x4*)(lds + AT_Q + row * 128 + ((ch ^ (row & 7)) << 4)) = v; }
    unsigned koffs[4], qoffs[4], voffs[4];
#pragma unroll
    for (int s_ = 0; s_ < 4; ++s_) { const unsigned sw = (unsigned)(((2 * s_ + h) ^ (r31 & 7)) << 4);
        koffs[s_] = (unsigned)(r31 * 128) + sw; qoffs[s_] = (unsigned)(AT_Q + (32 * F.wave + r31) * 128) + sw;
        voffs[s_] = 8192u + (unsigned)(r31 * 128) + (unsigned)(((2 * s_ + h) ^ ((r31 >> 1) & 7)) << 4); }
#pragma unroll
    for (int c = 0; c < NC; ++c)
#pragma unroll
        for (int r = 0; r < 16; ++r) o[c][r] = 0.f;
    float m = -INFINITY, l = 0.f;
    const int qlo = q0 + 32 * F.wave, qme = qlo + r31;
    const int krow = F.wave * 8 + (lane >> 3);
    const bf16_t* ksrc = Kp + (size_t)krow * 64 + 8 * ((lane & 7) ^ (krow & 7));
    const bf16_t* vsrc[NC / 2];
#pragma unroll
    for (int i = 0; i < NC / 2; ++i) { const int vrow = (i * 8 + F.wave) * 8 + (lane >> 3); vsrc[i] = Vt + (size_t)vrow * SEQ + 8 * ((lane & 7) ^ ((vrow >> 1) & 7)); }
    const unsigned lbase = (unsigned)(size_t)lds;
    const unsigned kdst = lbase + (unsigned)F.wave * 1024u;
#define AT_ISSUE(tt) do { const unsigned sb_ = (unsigned)(((tt) % AT_NS) * AT_STG); \
        glds16(ksrc + (size_t)(tt) * 64 * 64, (unsigned)__builtin_amdgcn_readfirstlane(kdst + sb_)); \
        _Pragma("unroll") for (int i_ = 0; i_ < NC / 2; ++i_) glds16(vsrc[i_] + (size_t)(tt) * 64, (unsigned)__builtin_amdgcn_readfirstlane(kdst + sb_ + 8192u + (unsigned)i_ * 8192u)); } while (0)
    __syncthreads();
    bf16x8 qreg[4];
    {
#pragma unroll
        for (int s = 0; s < 4; ++s) qreg[s] = *(const LAS bf16x8*)(lds + qoffs[s]); }
#pragma unroll
    for (int tt = 0; tt < AT_PD; ++tt) AT_ISSUE(tt);
#pragma unroll 1
    for (int t = 0; t < NT; ++t) {
        const int k0 = t * 64;
        if (t < NT - 2) { if (PT == 3) asm volatile("s_waitcnt vmcnt(6)" ::: "memory"); else asm volatile("s_waitcnt vmcnt(4)" ::: "memory"); }
        else if (t == NT - 2) { if (PT == 3) asm volatile("s_waitcnt vmcnt(3)" ::: "memory"); else asm volatile("s_waitcnt vmcnt(2)" ::: "memory"); }
        else asm volatile("s_waitcnt vmcnt(0)" ::: "memory");
        __builtin_amdgcn_s_barrier();
        asm volatile("" ::: "memory");
        if (t + AT_PD < NT) AT_ISSUE(t + AT_PD);
        const LAS unsigned char* st_ = lds + (t % AT_NS) * AT_STG;
        f32x16 sT[2];
#pragma unroll
        for (int s = 0; s < 4; ++s) { const bf16x8 qf = qreg[s];
#pragma unroll
            for (int kb = 0; kb < 2; ++kb) { const bf16x8 kf = *(const LAS bf16x8*)(st_ + koffs[s] + kb * 4096);
                if (s == 0) sT[kb] = __builtin_amdgcn_mfma_f32_32x32x16_bf16(kf, qf, (f32x16){0.f, 0.f, 0.f, 0.f, 0.f, 0.f, 0.f, 0.f, 0.f, 0.f, 0.f, 0.f, 0.f, 0.f, 0.f, 0.f}, 0, 0, 0);
                else sT[kb] = __builtin_amdgcn_mfma_f32_32x32x16_bf16(kf, qf, sT[kb], 0, 0, 0); } }
        float cb = 0.f;
        if (BIAS) {
            if (k0 + 63 - qlo <= -91) cb = c_neg;
            else if (k0 - (qlo + 31) >= 91) cb = c_pos;
            else {
#pragma unroll
                for (int kb = 0; kb < 2; ++kb)
#pragma unroll
                    for (int r = 0; r < 16; ++r) { const int key = k0 + 32 * kb + (r & 3) + 8 * (r >> 2) + 4 * h; sT[kb][r] += tb[key - qme + 192]; }
            }
        }
        float mx = sT[0][0];
#pragma unroll
        for (int kb = 0; kb < 2; ++kb)
#pragma unroll
            for (int r = 0; r < 16; ++r) mx = fmaxf(mx, sT[kb][r]);
        mx = fmaxf(mx, __shfl_xor(mx, 32)) + cb;
        if (__builtin_amdgcn_ballot_w64(mx > m) != 0ull) {
            const float mn = fmaxf(m, mx), alpha = __builtin_amdgcn_exp2f(m - mn);
            m = mn; l *= alpha;
#pragma unroll
            for (int c = 0; c < NC; ++c)
#pragma unroll
                for (int r = 0; r < 16; ++r) o[c][r] *= alpha;
        }
        const float sh = cb - m;
        float ps = 0.f;
#pragma unroll
        for (int kb = 0; kb < 2; ++kb)
#pragma unroll
            for (int r = 0; r < 16; ++r) { const float p = __builtin_amdgcn_exp2f(sT[kb][r] + sh); sT[kb][r] = p; ps += p; }
        l += ps;
        bf16x8 pf[2][2];
#pragma unroll
        for (int kb = 0; kb < 2; ++kb)
#pragma unroll
            for (int s2 = 0; s2 < 2; ++s2) {
                u32x4 pw; pw.x = pack_bf16(sT[kb][8 * s2 + 0], sT[kb][8 * s2 + 1]); pw.y = pack_bf16(sT[kb][8 * s2 + 2], sT[kb][8 * s2 + 3]);
                pw.z = pack_bf16(sT[kb][8 * s2 + 4], sT[kb][8 * s2 + 5]); pw.w = pack_bf16(sT[kb][8 * s2 + 6], sT[kb][8 * s2 + 7]);
                pf[kb][s2] = __builtin_bit_cast(bf16x8, pw); }
        __builtin_amdgcn_sched_barrier(0);
#pragma unroll
        for (int g = 0; g < 4; ++g) {
#pragma unroll
            for (int c = 0; c < NC; ++c) { const bf16x8 vf = *(const LAS bf16x8*)(st_ + voffs[g] + c * 4096);
                o[c] = __builtin_amdgcn_mfma_f32_32x32x16_bf16(vf, pf[g >> 1][g & 1], o[c], 0, 0, 0); }
        }
    }
#undef AT_ISSUE
    l_out = l + __shfl_xor(l, 32);
}

template <int MODE> DI void p_attention(const Frame& F) {
    const bf16_t* QA = (const bf16_t*)(F.ws + WS_QA); const bf16_t* KA = (const bf16_t*)(F.ws + WS_KA); const bf16_t* VAT = (const bf16_t*)(F.ws + WS_VAT);
    const bf16_t* QB = (const bf16_t*)(F.ws + WS_QB); const bf16_t* KB = (const bf16_t*)(F.ws + WS_KB); const bf16_t* VBT = (const bf16_t*)(F.ws + WS_VBT);
    bf16_t* O = (bf16_t*)(F.ws + WS_O);
    const float* rel_bias = F.in[10]; const float* lv = F.in[7]; const float* subg = F.in[8];
    LAS float* tb = (LAS float*)(F.lds + AT_TB);
    const int lane = F.lane;
    float lam;
    { const float a = lv[lane] * lv[64 + lane], b2 = lv[128 + lane] * lv[192 + lane];
      lam = __expf(wave_sum(a)) - __expf(wave_sum(b2)) + 0.2f; }
    if (MODE & 1) for (int n = F.bid; n < 256; n += F.G) {
        const int u = (F.G == 256) ? ((n & 7) * 32 + (n >> 3)) : n;
        const int b = u >> 5, hd = (u >> 3) & 3, qb = u & 7, q0 = qb * 256;
        __syncthreads();
        for (int i = F.tid; i < 2 * 384; i += NTHREADS) { const int mi = i / 384, ii = i % 384; tb[i] = rel_bias[t5_bucket(ii - 192) * 8 + 2 * hd + mi] * LOG2E; }
        __syncthreads();
        const bf16_t* Vt = VAT + (size_t)(b * 4 + hd) * 128 * SEQ;
        unsigned* o0s = (unsigned*)(F.ws + WS_O0S) + (size_t)F.bid * NTHREADS + F.tid;
        const size_t o0p = (size_t)F.G * NTHREADS;
        f32x16 o[4]; float l;
        { const int mp = 2 * hd;
          attn_pass<4, true>(F, QA + (size_t)(b * 8 + mp) * SEQ * 64, KA + (size_t)(b * 8 + mp) * SEQ * 64, Vt, q0, tb, rel_bias[15 * 8 + mp] * LOG2E, rel_bias[31 * 8 + mp] * LOG2E, o, l);
          const float il = 1.0f / l;
#pragma unroll
          for (int c = 0; c < 4; ++c)
#pragma unroll
              for (int r = 0; r < 8; ++r) o0s[(c * 8 + r) * o0p] = pack_bf16(o[c][2 * r] * il, o[c][2 * r + 1] * il); }
        { const int mp = 2 * hd + 1;
          attn_pass<4, true>(F, QA + (size_t)(b * 8 + mp) * SEQ * 64, KA + (size_t)(b * 8 + mp) * SEQ * 64, Vt, q0, tb + 384, rel_bias[15 * 8 + mp] * LOG2E, rel_bias[31 * 8 + mp] * LOG2E, o, l);
          int ln = F.lane; asm volatile("" : "+v"(ln)); const int r31 = ln & 31, h = ln >> 5;
          const float il = lam / l; float ss = 0.f;
#pragma unroll
          for (int c = 0; c < 4; ++c)
#pragma unroll
              for (int r = 0; r < 8; ++r) { const unsigned pk = __hip_atomic_load(o0s + (c * 8 + r) * o0p, __ATOMIC_RELAXED, __HIP_MEMORY_SCOPE_AGENT); const float d0 = bf_lo(pk) - o[c][2 * r] * il, d1 = bf_hi(pk) - o[c][2 * r + 1] * il; o[c][2 * r] = d0; o[c][2 * r + 1] = d1; ss += d0 * d0 + d1 * d1; }
          ss += __shfl_xor(ss, 32);
          const float rinv = rsqrtf(ss * (1.0f / 128.0f) + 1e-6f) * 0.8f;
          bf16_t* op = O + (size_t)(b * SEQ + q0 + 32 * F.wave + r31) * D + hd * 128;
#pragma unroll
          for (int c = 0; c < 4; ++c)
#pragma unroll
              for (int g = 0; g < 4; ++g) { const int dv = 32 * c + 8 * g + 4 * h; const f32x4 sg = *(const f32x4*)(subg + dv);
                  u32x2 w; w.x = pack_bf16(o[c][4 * g] * rinv * sg[0], o[c][4 * g + 1] * rinv * sg[1]); w.y = pack_bf16(o[c][4 * g + 2] * rinv * sg[2], o[c][4 * g + 3] * rinv * sg[3]);
                  *(u32x2*)(op + dv) = w; } }
    }
    if (MODE & 2) for (int n = F.bid; n < 512; n += F.G) {
        const int u = (F.G == 256) ? ((n & 7) * 64 + ((n & 255) >> 3) * 2 + (n >> 8)) : n;
        const int b = u >> 6, hq = (u >> 3) & 7, qb = u & 7, q0 = qb * 256, kv = hq >> 2;
        f32x16 o[2]; float l;
        attn_pass<2, false>(F, QB + (size_t)(b * 8 + hq) * SEQ * 64, KB + (size_t)(b * 2 + kv) * SEQ * 64, VBT + (size_t)(b * 2 + kv) * 64 * SEQ, q0, tb, 0.f, 0.f, o, l);
        int ln = F.lane; asm volatile("" : "+v"(ln)); const int r31 = ln & 31, h = ln >> 5;
        const float il = 1.0f / l;
        bf16_t* op = O + (size_t)(b * SEQ + q0 + 32 * F.wave + r31) * D + 512 + hq * 64;
#pragma unroll
        for (int c = 0; c < 2; ++c)
#pragma unroll
            for (int g = 0; g < 4; ++g) { const int dv = 32 * c + 8 * g + 4 * h;
                u32x2 w; w.x = pack_bf16(o[c][4 * g] * il, o[c][4 * g + 1] * il); w.y = pack_bf16(o[c][4 * g + 2] * il, o[c][4 * g + 3] * il);
                *(u32x2*)(op + dv) = w; }
    }
    __syncthreads();
}
#define CE_DESC(ka, pa, kb, pb) do { const bool _sw = (kb) > (ka); const float _k0 = _sw ? (kb) : (ka), _k1 = _sw ? (ka) : (kb); const int _p0 = _sw ? (pb) : (pa), _p1 = _sw ? (pa) : (pb); \
    (ka) = _k0; (kb) = _k1; (pa) = _p0; (pb) = _p1; } while (0)
template <int BASE> DI void sort16_desc(float (&k)[64], int (&p)[64]) {
#pragma unroll
    for (int k2 = 2; k2 <= 16; k2 <<= 1)
#pragma unroll
        for (int j = k2 >> 1; j > 0; j >>= 1)
#pragma unroll
            for (int i = 0; i < 16; ++i) { const int l = i ^ j;
                if (l > i) { if ((i & k2) == 0 || k2 == 16) CE_DESC(k[BASE + i], p[BASE + i], k[BASE + l], p[BASE + l]); else CE_DESC(k[BASE + l], p[BASE + l], k[BASE + i], p[BASE + i]); } }
}
template <int BA, int BB> DI void merge_top16(float (&k)[64], int (&p)[64]) {
#pragma unroll
    for (int i = 0; i < 16; ++i) { const bool sw = k[BB + 15 - i] > k[BA + i]; k[BA + i] = sw ? k[BB + 15 - i] : k[BA + i]; p[BA + i] = sw ? p[BB + 15 - i] : p[BA + i]; }
#pragma unroll
    for (int j = 8; j > 0; j >>= 1)
#pragma unroll
        for (int i = 0; i < 16; ++i) { const int l = i ^ j; if (l > i) CE_DESC(k[BA + i], p[BA + i], k[BA + l], p[BA + l]); }
}
DI void top16_of_64(float (&k)[64], int (&p)[64]) {
    sort16_desc<0>(k, p); sort16_desc<16>(k, p); sort16_desc<32>(k, p); sort16_desc<48>(k, p);
    merge_top16<0, 16>(k, p); merge_top16<32, 48>(k, p); merge_top16<0, 32>(k, p);
}
#define CEK_DESC(ka, kb) do { const float _h = fmaxf((ka), (kb)), _l = fminf((ka), (kb)); (ka) = _h; (kb) = _l; } while (0)
template <int BASE> DI void sort16k_desc(float (&k)[64]) {
#pragma unroll
    for (int k2 = 2; k2 <= 16; k2 <<= 1)
#pragma unroll
        for (int j = k2 >> 1; j > 0; j >>= 1)
#pragma unroll
            for (int i = 0; i < 16; ++i) { const int l = i ^ j;
                if (l > i) { if ((i & k2) == 0) CEK_DESC(k[BASE + i], k[BASE + l]); else CEK_DESC(k[BASE + l], k[BASE + i]); } }
}
template <int BA, int BB> DI void merge_top16k(float (&k)[64]) {
#pragma unroll
    for (int i = 0; i < 16; ++i) k[BA + i] = fmaxf(k[BA + i], k[BB + 15 - i]);
#pragma unroll
    for (int j = 8; j > 0; j >>= 1)
#pragma unroll
        for (int i = 0; i < 16; ++i) { const int l = i ^ j; if (l > i) CEK_DESC(k[BA + i], k[BA + l]); }
}
DI void top16k_of_64(float (&k)[64]) {
    sort16k_desc<0>(k); sort16k_desc<16>(k); sort16k_desc<32>(k); sort16k_desc<48>(k);
    merge_top16k<0, 16>(k); merge_top16k<32, 48>(k); merge_top16k<0, 32>(k);
}
constexpr int cand_off(int a) { int s = 0; for (int i = 0; i < a; ++i) s += 16 / (i + 1); return s; }

DI void p_peer_topk(const Frame& F, const bf16_t* PQ, const bf16_t* SK  , int* EIDX, float* GATE) {
    const int lane = F.lane, r31 = lane & 31, h = lane >> 5, w = F.wave;
    for (int tn = F.bid; tn < T / 64; tn += F.G) { const int tile = (F.G == T / 64) ? ((tn & 7) * 32 + (tn >> 3)) : tn;
        for (int tt = 0; tt < 2; ++tt) {
            const int tok = tile * 64 + tt * 32 + r31;
            float lv[2][16];
#pragma unroll
            for (int p = 0; p < 2; ++p) {
                const int hp = 2 * w + p;
                f32x16 acc[4];
#pragma unroll
                for (int nb = 0; nb < 4; ++nb)
#pragma unroll
                    for (int r = 0; r < 16; ++r) acc[nb][r] = 0.f;
                const bf16_t* qp = PQ + (size_t)tok * PQ_LD + hp * 128 + 8 * h;
                const bf16_t* sp = SK + ((size_t)hp * 128 + r31) * 128 + 8 * h;
#pragma unroll 4
                for (int s = 0; s < 8; ++s) { const bf16x8 qf = *(const bf16x8*)(qp + 16 * s);
#pragma unroll
                    for (int nb = 0; nb < 4; ++nb) { const bf16x8 af = *(const bf16x8*)(sp + (size_t)nb * 32 * 128 + 16 * s);
                        acc[nb] = __builtin_amdgcn_mfma_f32_32x32x16_bf16(af, qf, acc[nb], 0, 0, 0); } }
                float k[64];
#pragma unroll
                for (int nb = 0; nb < 4; ++nb)
#pragma unroll
                    for (int r = 0; r < 16; ++r) { const int n = 32 * nb + (r & 3) + 8 * (r >> 2) + 4 * h;
                        k[16 * nb + r] = __uint_as_float((__float_as_uint(acc[nb][r]) & 0xFFFFFF80u) | (unsigned)(127 - n)); }
                top16k_of_64(k);
#pragma unroll
                for (int i = 0; i < 16; ++i) k[16 + i] = __shfl_xor(k[i], 32);
                merge_top16k<0, 16>(k);
#pragma unroll
                for (int i = 0; i < 16; ++i) lv[p][i] = k[i];
                __builtin_amdgcn_sched_barrier(0);
            }
            float ck[64];
#pragma unroll
            for (int i = 0; i < 64; ++i) ck[i] = -INFINITY;
#pragma unroll
            for (int a = 0; a < 16; ++a) {
#pragma unroll
                for (int b2 = 0; b2 < 16 / (a + 1); ++b2) ck[cand_off(a) + b2] = __uint_as_float((__float_as_uint(lv[0][a] + lv[1][b2]) & 0xFFFFFF00u) | (unsigned)(a * 16 + b2)); }
            LAS float* lst = (LAS float*)F.lds + F.tid;
#pragma unroll
            for (int i = 0; i < 16; ++i) { lst[i * NTHREADS] = lv[0][i]; lst[(16 + i) * NTHREADS] = lv[1][i]; }
            top16k_of_64(ck);
            float den = 0.f, ex[16]; int cp[16];
#pragma unroll
            for (int i = 0; i < 16; ++i) { ex[i] = __expf(ck[i] - ck[0]); den += ex[i];
                const unsigned cb = __float_as_uint(ck[i]); const int a = (cb >> 4) & 15, b2 = cb & 15;
                const unsigned u0 = __float_as_uint(lst[a * NTHREADS]), u1 = __float_as_uint(lst[(16 + b2) * NTHREADS]);
                cp[i] = (127 - (int)(u0 & 127u)) * 128 + (127 - (int)(u1 & 127u)); }
            const float iden = 1.0f / den;
            if (h == 0) {
                int* ep = EIDX + (size_t)tok * 128 + w * 16; float* gp = GATE + (size_t)tok * 128 + w * 16;
#pragma unroll
                for (int i = 0; i < 4; ++i) { *(u32x4*)(ep + 4 * i) = (u32x4){(unsigned)cp[4 * i], (unsigned)cp[4 * i + 1], (unsigned)cp[4 * i + 2], (unsigned)cp[4 * i + 3]};
                    *(f32x4*)(gp + 4 * i) = (f32x4){ex[4 * i] * iden, ex[4 * i + 1] * iden, ex[4 * i + 2] * iden, ex[4 * i + 3] * iden}; }
            }
        }
    }
}

DI void fp8x16_to_f32(const u32x4 w, float (&o)[16]) {
    f32x2 t;
    t = __builtin_amdgcn_cvt_pk_f32_fp8((int)w.x, false); o[0] = t[0]; o[1] = t[1];  t = __builtin_amdgcn_cvt_pk_f32_fp8((int)w.x, true); o[2] = t[0]; o[3] = t[1];
    t = __builtin_amdgcn_cvt_pk_f32_fp8((int)w.y, false); o[4] = t[0]; o[5] = t[1];  t = __builtin_amdgcn_cvt_pk_f32_fp8((int)w.y, true); o[6] = t[0]; o[7] = t[1];
    t = __builtin_amdgcn_cvt_pk_f32_fp8((int)w.z, false); o[8] = t[0]; o[9] = t[1];  t = __builtin_amdgcn_cvt_pk_f32_fp8((int)w.z, true); o[10] = t[0]; o[11] = t[1];
    t = __builtin_amdgcn_cvt_pk_f32_fp8((int)w.w, false); o[12] = t[0]; o[13] = t[1]; t = __builtin_amdgcn_cvt_pk_f32_fp8((int)w.w, true); o[14] = t[0]; o[15] = t[1];
}
DI float gelu_tanh_fast(float x) { const float z2 = 2.302208198f * (x + 0.044715f * x * x * x);
    return x * __builtin_amdgcn_rcpf(1.0f + __builtin_amdgcn_exp2f(-z2)); }
constexpr int PB = 4;
DI void peer_load(const unsigned char* PU, const unsigned char* PV, int ev, int base, int lane, u32x4 (&U)[PB], u32x4 (&V)[PB]) {
#pragma unroll
    for (int q = 0; q < PB; ++q) { const int e = __builtin_amdgcn_readlane(ev, base + q);
        U[q] = *(const u32x4*)(PU + (size_t)e * 1024 + 16 * lane); V[q] = *(const u32x4*)(PV + (size_t)e * 1024 + 16 * lane); }
}
struct RsMap { unsigned tag; int l0, l1, l2, l3; };
DI unsigned swp32(unsigned a, unsigned b, unsigned& other) { auto r = __builtin_amdgcn_permlane32_swap(a, b, false, false); other = r[1]; return r[0]; }
DI unsigned swp16(unsigned a, unsigned b, unsigned& other) { auto r = __builtin_amdgcn_permlane16_swap(a, b, false, false); other = r[1]; return r[0]; }
DI RsMap rs_map_init() {
    unsigned o, t0 = 0u, t1 = 1u, t2 = 2u, t3 = 3u;
    asm volatile("" : "+v"(t0), "+v"(t1), "+v"(t2), "+v"(t3));
    const unsigned ta = swp32(t0, t2, o), tb = swp32(t1, t3, o);
    RsMap m; m.tag = swp16(ta, tb, o);
    m.l0 = __builtin_ctzll(__builtin_amdgcn_ballot_w64(m.tag == 0u)); m.l1 = __builtin_ctzll(__builtin_amdgcn_ballot_w64(m.tag == 1u));
    m.l2 = __builtin_ctzll(__builtin_amdgcn_ballot_w64(m.tag == 2u)); m.l3 = __builtin_ctzll(__builtin_amdgcn_ballot_w64(m.tag == 3u));
    return m;
}
template <int CTRL> DI float dpp_g(float v) { return __builtin_bit_cast(float, __builtin_amdgcn_update_dpp(0, __builtin_bit_cast(int, v), CTRL, 0xF, 0xF, true)); }
DI void peer_comp(const u32x4 (&U)[PB], const u32x4 (&V)[PB], float su, float gvs, int base, const RsMap& M, const float (&x)[16], float (&y)[16]) {
    float d[PB];
#pragma unroll
    for (int q = 0; q < PB; ++q) { float u[16]; fp8x16_to_f32(U[q], u);
        float a0 = u[0] * x[0], a1 = u[1] * x[1], a2 = u[2] * x[2], a3 = u[3] * x[3];
#pragma unroll
        for (int i = 4; i < 16; i += 4) { a0 += u[i] * x[i]; a1 += u[i + 1] * x[i + 1]; a2 += u[i + 2] * x[i + 2]; a3 += u[i + 3] * x[i + 3]; }
        d[q] = (a0 + a1) + (a2 + a3); }
    unsigned o;
    const float f0a = __uint_as_float(swp32(__float_as_uint(d[0]), __float_as_uint(d[2]), o)); const float f0 = f0a + __uint_as_float(o);
    const float f1a = __uint_as_float(swp32(__float_as_uint(d[1]), __float_as_uint(d[3]), o)); const float f1 = f1a + __uint_as_float(o);
    const float ga = __uint_as_float(swp16(__float_as_uint(f0), __float_as_uint(f1), o)); float g = ga + __uint_as_float(o);
    g += dpp_g<0xB1>(g); g += dpp_g<0x4E>(g); g += dpp_g<0x141>(g); g += dpp_g<0x140>(g);
    const int src = (base + (int)M.tag) * 4;
    const float su_b = __uint_as_float(__builtin_amdgcn_ds_bpermute(src, __float_as_uint(su))), gv_b = __uint_as_float(__builtin_amdgcn_ds_bpermute(src, __float_as_uint(gvs)));
    const float c = gv_b * gelu_tanh_fast(g * su_b);
    const float c0 = __uint_as_float(__builtin_amdgcn_readlane(__float_as_uint(c), M.l0)), c1 = __uint_as_float(__builtin_amdgcn_readlane(__float_as_uint(c), M.l1));
    const float c2 = __uint_as_float(__builtin_amdgcn_readlane(__float_as_uint(c), M.l2)), c3 = __uint_as_float(__builtin_amdgcn_readlane(__float_as_uint(c), M.l3));
    const float cq[4] = {c0, c1, c2, c3};
#pragma unroll
    for (int q = 0; q < PB; ++q) { float v[16]; fp8x16_to_f32(V[q], v);
#pragma unroll
        for (int i = 0; i < 16; ++i) y[i] += cq[q] * v[i]; }
}
constexpr int PM_SHIFT = 10, PM_NP = 16384 >> PM_SHIFT;
struct PBatch { u32x4 U[4], V[4]; float su[4], gv[4]; int n; };
DI void pm_fetch(PBatch& B, int& nb, unsigned long long& mA, unsigned long long& mB, int e0, int e1, float su0, float su1, float gv0, float gv1, const unsigned char* PU, const unsigned char* PV, int lane) {
    B.n = 0;
    if (nb <= 0 || (mA | mB) == 0ull) return;
    --nb;
    __builtin_amdgcn_s_setprio(2);
    int eid[4];
#pragma unroll
    for (int q = 0; q < 4; ++q) {
        if (mA != 0ull) { const int l = __builtin_ctzll(mA); mA &= mA - 1ull;
            eid[q] = __builtin_amdgcn_readlane(e0, l); B.su[q] = __uint_as_float(__builtin_amdgcn_readlane(__float_as_uint(su0), l)); B.gv[q] = __uint_as_float(__builtin_amdgcn_readlane(__float_as_uint(gv0), l)); B.n = q + 1; }
        else if (mB != 0ull) { const int l = __builtin_ctzll(mB); mB &= mB - 1ull;
            eid[q] = __builtin_amdgcn_readlane(e1, l); B.su[q] = __uint_as_float(__builtin_amdgcn_readlane(__float_as_uint(su1), l)); B.gv[q] = __uint_as_float(__builtin_amdgcn_readlane(__float_as_uint(gv1), l)); B.n = q + 1; }
        else { eid[q] = eid[0]; B.su[q] = 0.f; B.gv[q] = 0.f; }
        B.U[q] = *(const u32x4*)(PU + (size_t)eid[q] * 1024 + 16 * lane); B.V[q] = *(const u32x4*)(PV + (size_t)eid[q] * 1024 + 16 * lane);
    }
    __builtin_amdgcn_s_setprio(0);
}
DI void pm_comp(const PBatch& B, const RsMap& M, const float (&x)[16], float (&y)[16]) {
    float d[4];
#pragma unroll
    for (int q = 0; q < 4; ++q) { float u[16]; fp8x16_to_f32(B.U[q], u);
        f32x2 a0 = (f32x2){u[0], u[1]} * (f32x2){x[0], x[1]}, a1 = (f32x2){u[2], u[3]} * (f32x2){x[2], x[3]};
#pragma unroll
        for (int i = 4; i < 16; i += 4) { a0 = __builtin_elementwise_fma((f32x2){u[i], u[i + 1]}, (f32x2){x[i], x[i + 1]}, a0); a1 = __builtin_elementwise_fma((f32x2){u[i + 2], u[i + 3]}, (f32x2){x[i + 2], x[i + 3]}, a1); }
        const f32x2 as = a0 + a1; d[q] = as[0] + as[1]; }
    unsigned o;
    const float f0a = __uint_as_float(swp32(__float_as_uint(d[0]), __float_as_uint(d[2]), o)); const float f0 = f0a + __uint_as_float(o);
    const float f1a = __uint_as_float(swp32(__float_as_uint(d[1]), __float_as_uint(d[3]), o)); const float f1 = f1a + __uint_as_float(o);
    const float ga = __uint_as_float(swp16(__float_as_uint(f0), __float_as_uint(f1), o)); float g = ga + __uint_as_float(o);
    g += dpp_g<0xB1>(g); g += dpp_g<0x4E>(g); g += dpp_g<0x141>(g); g += dpp_g<0x140>(g);
    const float su_b = M.tag == 0u ? B.su[0] : (M.tag == 1u ? B.su[1] : (M.tag == 2u ? B.su[2] : B.su[3]));
    const float gv_b = M.tag == 0u ? B.gv[0] : (M.tag == 1u ? B.gv[1] : (M.tag == 2u ? B.gv[2] : B.gv[3]));
    const float c = gv_b * gelu_tanh_fast(g * su_b);
    const float cq[4] = {__uint_as_float(__builtin_amdgcn_readlane(__float_as_uint(c), M.l0)), __uint_as_float(__builtin_amdgcn_readlane(__float_as_uint(c), M.l1)),
                         __uint_as_float(__builtin_amdgcn_readlane(__float_as_uint(c), M.l2)), __uint_as_float(__builtin_amdgcn_readlane(__float_as_uint(c), M.l3))};
#pragma unroll
    for (int q = 0; q < 4; ++q) { float v[16]; fp8x16_to_f32(B.V[q], v);
#pragma unroll
        for (int i = 0; i < 16; ++i) y[i] += cq[q] * v[i]; }
}
template <bool FINAL> DI void p_peer_gather(const Frame& F, const float* gn  , const float* modl  , const unsigned char* PU, const unsigned char* PV, const float* SU, const float* SV, const int* EIDX, const float* GATE, const float* gt2  , bf16_t* xb, float* out) {
    const int lane = F.lane;
    const RsMap M = rs_map_init();
    for (int tn = F.bid; tn < T / 64; tn += F.G) { const int tile = (F.G == T / 64) ? ((tn & 7) * 32 + (tn >> 3)) : tn;
        for (int grp = 0; grp < 4; ++grp) {
            const int tb = tile * 64 + grp * 16 + F.wave * 2;
            float x[2][16], y[2][16]; int e0[2], e1[2]; float su0[2], su1[2], gv0[2], gv1[2];
#pragma unroll
            for (int i = 0; i < 2; ++i) { const int t = tb + i;
                { float rinv; norm_row16_b(xb + (size_t)t * D, lane, x[i], rinv);
                  ada_apply(x[i], rinv, gn, modl + (size_t)(t / SEQ) * 6144 + 4096, modl + (size_t)(t / SEQ) * 6144 + 3072, lane); }
#pragma unroll
                for (int k = 0; k < 16; ++k) y[i][k] = 0.f;
                e0[i] = __builtin_nontemporal_load(EIDX + (size_t)t * 128 + lane); e1[i] = __builtin_nontemporal_load(EIDX + (size_t)t * 128 + 64 + lane);
                su0[i] = SU[e0[i]]; su1[i] = SU[e1[i]]; gv0[i] = __builtin_nontemporal_load(GATE + (size_t)t * 128 + lane) * SV[e0[i]]; gv1[i] = __builtin_nontemporal_load(GATE + (size_t)t * 128 + 64 + lane) * SV[e1[i]]; }
            unsigned long long mAq[2] = {0ull, 0ull}, mBq[2] = {0ull, 0ull};
            for (int pp = 0; pp < PM_NP; ++pp) { const int p = (grp & 1) ? PM_NP - 1 - pp : pp;
#pragma unroll
                for (int i = 0; i < 2; ++i) {
                    unsigned long long mA = mAq[i] | __builtin_amdgcn_ballot_w64((e0[i] >> PM_SHIFT) == p), mB = mBq[i] | __builtin_amdgcn_ballot_w64((e1[i] >> PM_SHIFT) == p);
                    const int avail = __builtin_popcountll(mA) + __builtin_popcountll(mB);
                    int nb = (pp == PM_NP - 1) ? (avail + 3) >> 2 : avail >> 2;
                    PBatch A, B;
                    pm_fetch(A, nb, mA, mB, e0[i], e1[i], su0[i], su1[i], gv0[i], gv1[i], PU, PV, lane);
                    while (A.n > 0) {
                        pm_fetch(B, nb, mA, mB, e0[i], e1[i], su0[i], su1[i], gv0[i], gv1[i], PU, PV, lane);
                        pm_comp(A, M, x[i], y[i]);
                        if (B.n == 0) break;
                        pm_fetch(A, nb, mA, mB, e0[i], e1[i], su0[i], su1[i], gv0[i], gv1[i], PU, PV, lane);
                        pm_comp(B, M, x[i], y[i]);
                    }
                    mAq[i] = mA; mBq[i] = mB;
                }
            }
#pragma unroll
            for (int i = 0; i < 2; ++i) { const int t = tb + i; const int b = t / SEQ; const float* gp = gt2 + (size_t)b * 6144; bf16_t* xp = xb + (size_t)t * D;
#pragma unroll
                for (int j = 0; j < 4; ++j) { const int c = 256 * j + 4 * lane; const f32x4 g = *(const f32x4*)(gp + c); const u32x2 xw = *(const u32x2*)(xp + c);
                    f32x4 xo = (f32x4){bf_lo(xw.x), bf_hi(xw.x), bf_lo(xw.y), bf_hi(xw.y)};
                    xo[0] += g[0] * y[i][4 * j]; xo[1] += g[1] * y[i][4 * j + 1]; xo[2] += g[2] * y[i][4 * j + 2]; xo[3] += g[3] * y[i][4 * j + 3];
                    if (FINAL) __builtin_nontemporal_store(xo, (f32x4*)(out + (size_t)t * D + c)); else *(u32x2*)(xp + c) = (u32x2){pack_bf16(xo[0], xo[1]), pack_bf16(xo[2], xo[3])}; } }
        }
    }
}
DI void norm_row16c(const float* xr, int lane, float (&v)[16], float& rinv) {
    float ss = 0.f;
#pragma unroll
    for (int j = 0; j < 2; ++j)
#pragma unroll
        for (int q = 0; q < 2; ++q) { const f32x4 a = *(const f32x4*)(xr + 512 * j + 8 * lane + 4 * q); v[8 * j + 4 * q] = a[0]; v[8 * j + 4 * q + 1] = a[1]; v[8 * j + 4 * q + 2] = a[2]; v[8 * j + 4 * q + 3] = a[3];
            ss += a[0] * a[0] + a[1] * a[1] + a[2] * a[2] + a[3] * a[3]; }
    ss = wave_sum(ss);
    rinv = rsqrtf(ss * (1.0f / 1024.0f) + 1e-6f);
}
DI void ada_apply_c(float (&v)[16], float rinv, const float* g, const float* sc, const float* sh, int lane) {
#pragma unroll
    for (int j = 0; j < 2; ++j)
#pragma unroll
        for (int q = 0; q < 2; ++q) { const int c = 512 * j + 8 * lane + 4 * q;
            const f32x4 gg = *(const f32x4*)(g + c), s1 = *(const f32x4*)(sc + c), s0 = *(const f32x4*)(sh + c);
#pragma unroll
            for (int e = 0; e < 4; ++e) v[8 * j + 4 * q + e] = v[8 * j + 4 * q + e] * rinv * gg[e] * (1.0f + s1[e]) + s0[e]; }
}
DI void row_load(const bf16_t* xr, int lane, float (&v)[16]) {
#pragma unroll
    for (int j = 0; j < 2; ++j) { const u32x4 a = *(const u32x4*)(xr + 512 * j + 8 * lane);
        v[8 * j] = bf_lo(a.x); v[8 * j + 1] = bf_hi(a.x); v[8 * j + 2] = bf_lo(a.y); v[8 * j + 3] = bf_hi(a.y); v[8 * j + 4] = bf_lo(a.z); v[8 * j + 5] = bf_hi(a.z); v[8 * j + 6] = bf_lo(a.w); v[8 * j + 7] = bf_hi(a.w); }
}
DI void row_finish(const float (&raw)[16], int lane, const LAS float* ga, const LAS float* sh, float (&v)[16]) {
    float ss = 0.f;
#pragma unroll
    for (int e = 0; e < 16; ++e) ss += raw[e] * raw[e];
    ss = wave_sum(ss);
    const float rinv = rsqrtf(ss * (1.0f / 1024.0f) + 1e-6f);
#pragma unroll
    for (int j = 0; j < 2; ++j)
#pragma unroll
        for (int q = 0; q < 2; ++q) { const int c = 512 * j + 8 * lane + 4 * q; const f32x4 gg = *(const LAS f32x4*)(ga + c), s0 = *(const LAS f32x4*)(sh + c);
#pragma unroll
            for (int e = 0; e < 4; ++e) v[8 * j + 4 * q + e] = raw[8 * j + 4 * q + e] * rinv * gg[e] + s0[e]; }
}
DI void p_rwkv_prep(const Frame& F, const bf16_t* x, const float* g, const float* modl, const float* mix, bf16_t* X6) {
    const int lane = F.lane;
    LAS float* ga = (LAS float*)F.lds; LAS float* shl = ga + 1024; LAS float* mixl = ga + 2048;
    int cur_b = -1;
    for (int run0 = F.bid * NWAVES; run0 < T / 8; run0 += F.G * NWAVES) {
        const int run = run0 + F.wave;
        const int bb = (run0 * 8) / SEQ;
        if (bb != cur_b) { __syncthreads();
            for (int i = F.tid; i < 1024; i += NTHREADS) { ga[i] = g[i] * (1.0f + modl[(size_t)bb * 6144 + 1024 + i]); shl[i] = modl[(size_t)bb * 6144 + i]; }
            if (cur_b < 0) for (int i = F.tid; i < 6 * 1024; i += NTHREADS) mixl[i] = mix[i];
            cur_b = bb; __syncthreads(); }
        const int r0 = run * 8, s0 = r0 % SEQ;
        float hp[16], hc[16], hn[16], ra[16], rb[16];
        if (s0 > 0) row_load(x + (size_t)(r0 - 1) * D, lane, ra);
        row_load(x + (size_t)r0 * D, lane, rb);
        if (s0 > 0) row_finish(ra, lane, ga, shl, hp);
        else {
#pragma unroll
            for (int i = 0; i < 16; ++i) hp[i] = 0.f; }
        if (s0 + 1 < SEQ) row_load(x + (size_t)(r0 + 1) * D, lane, ra);
        row_finish(rb, lane, ga, shl, hc);
        for (int i = 0; i < 8; ++i) {
            const int s = s0 + i;
            __builtin_amdgcn_s_setprio(2);
            if (i + 1 < 8 && s + 2 < SEQ) row_load(x + (size_t)(r0 + i + 2) * D, lane, rb);
            __builtin_amdgcn_s_setprio(0);
            if (s + 1 < SEQ) row_finish(ra, lane, ga, shl, hn);
            else {
#pragma unroll
                for (int e = 0; e < 16; ++e) hn[e] = 0.f; }
#pragma unroll
            for (int e = 0; e < 16; ++e) ra[e] = rb[e];
            float xx[16];
#pragma unroll
            for (int e = 0; e < 16; ++e) xx[e] = 0.5f * (hp[e] + hn[e]) - hc[e];
#pragma unroll
            for (int grp = 0; grp < 6; ++grp) { const int mi = grp == 0 ? 0 : (grp == 1 ? 2 : (grp == 2 ? 3 : (grp == 3 ? 1 : grp)));
                bf16_t* op = X6 + ((size_t)(((r0 + i) >> 8) * 6 + grp) * 256 + ((r0 + i) & 255)) * D;
#pragma unroll
                for (int j = 0; j < 2; ++j) { const f32x4 m0 = *(const LAS f32x4*)(mixl + mi * 1024 + 512 * j + 8 * lane), m1 = *(const LAS f32x4*)(mixl + mi * 1024 + 512 * j + 8 * lane + 4);
                    u32x4 w; w.x = pack_bf16(hc[8 * j] + xx[8 * j] * m0[0], hc[8 * j + 1] + xx[8 * j + 1] * m0[1]); w.y = pack_bf16(hc[8 * j + 2] + xx[8 * j + 2] * m0[2], hc[8 * j + 3] + xx[8 * j + 3] * m0[3]);
                    w.z = pack_bf16(hc[8 * j + 4] + xx[8 * j + 4] * m1[0], hc[8 * j + 5] + xx[8 * j + 5] * m1[1]); w.w = pack_bf16(hc[8 * j + 6] + xx[8 * j + 6] * m1[2], hc[8 * j + 7] + xx[8 * j + 7] * m1[3]);
                    *(u32x4*)(op + 512 * j + 8 * lane) = w; } }
#pragma unroll
            for (int e = 0; e < 16; ++e) { hp[e] = hc[e]; hc[e] = hn[e]; }
        }
    }
    __syncthreads();
}

constexpr int SC_L = 16;
constexpr int SC_NB = 5;
constexpr int SCP = 272;
constexpr int SCB_W = 0, SCB_BKZ = 16 * SCP, SCB_VV = 32 * SCP, SCB_AR = 48 * SCP, SCB_SIZE = 64 * SCP;
constexpr int SC_Y = SC_NB * SCB_SIZE;
constexpr int SC_CST = SC_Y + SC_NB * 4096;
constexpr int SC_AFR = SC_CST + 1280;
constexpr int SC_PS = SC_AFR + 16384;
constexpr int SC_SCR = SC_PS + SC_NB * 512;
constexpr int SC_FLG = SC_SCR + 16384;
constexpr int SC_CY = SC_FLG + 64;
static_assert(SC_CY + SC_NB * 256 <= LDS_BAR_OFF, "scan LDS map overflows");
DI void lds_wait_ge(volatile LAS int* p, int v) { while (*p < v) __builtin_amdgcn_s_sleep(1); asm volatile("" ::: "memory"); }
DI void p_rwkv_scan(const Frame& F) {
    const bf16_t* RK = (const bf16_t*)(F.ws + WS1_RK);
    bf16_t* Y = (bf16_t*)(F.ws + WS1_Y); float* BON = (float*)(F.ws + WS1_BON);
    const float* k_k = F.in[21]; const float* k_a = F.in[22]; const float* r_k = F.in[23];
    LAS unsigned char* lds = F.lds;
    const int tid = F.tid, lane = F.lane;
    constexpr int NCH = SEQ / SC_L;
    for (int u = F.bid; u < 256; u += F.G) {
        const int b = u >> 5, hd = (u >> 1) & 15, z = u & 1;
        __syncthreads();
        if (tid < 16) ((volatile LAS int*)(lds + SC_FLG))[tid] = 0;
        { const float* w2 = F.in[15] + (size_t)z * 65536 + hd * 64; const float* a2 = F.in[18] + (size_t)z * 65536 + hd * 64;
          LAS unsigned short* stw = (LAS unsigned short*)(lds + SC_AFR);
          for (int idx = tid; idx < 8192; idx += NTHREADS) { const int mat = idx >> 12, i = (idx >> 6) & 63, c = idx & 63;
              const float v = (mat ? a2 : w2)[(size_t)i * 1024 + c]; stw[mat * 4096 + c * 64 + i] = (unsigned short)(pack_bf16(v, 0.f) & 0xffffu); } }
        __syncthreads();
        if (F.wave >= 4) {
            const int pw = F.wave - 4, s16 = lane & 15, q = lane >> 4;
            const int chb = hd * 64 + 4 * q;
            const LAS unsigned short* stg = (const LAS unsigned short*)(lds + SC_AFR);
            LAS float* cst = (LAS float*)(lds + SC_CST);
            { cst[lane] = F.in[13][z * 1024 + hd * 64 + lane]; cst[64 + lane] = F.in[16][z * 1024 + hd * 64 + lane]; cst[128 + lane] = k_k[hd * 64 + lane]; cst[192 + lane] = k_a[hd * 64 + lane]; cst[256 + lane] = r_k[hd * 64 + lane]; }
            u32x2 rr[4], kr[4], vr[4]; u32x4 Bw[2], Ba[2];
#define SC_ROW(i_) ((size_t)(b * SEQ + (z ? (SEQ - 1 - (i_)) : (i_))))
#define SC_LOADC(cc) do { int s16l_ = s16, ql_ = q; asm volatile("" : "+v"(s16l_), "+v"(ql_)); const int chb_ = hd * 64 + 4 * ql_;     \
        const bf16_t* rp_ = RK + SC_ROW((cc) * SC_L + s16l_) * RW_N; \
        _Pragma("unroll") for (int cb = 0; cb < 4; ++cb) { rr[cb] = *(const u32x2*)(rp_ + chb_ + 16 * cb); kr[cb] = *(const u32x2*)(rp_ + 1024 + chb_ + 16 * cb); vr[cb] = *(const u32x2*)(rp_ + 2048 + chb_ + 16 * cb); } \
        _Pragma("unroll") for (int ks = 0; ks < 2; ++ks) { Bw[ks] = *(const u32x4*)(rp_ + 3072 + 64 * z + 32 * ks + 8 * ql_); Ba[ks] = *(const u32x4*)(rp_ + 3328 + 64 * z + 32 * ks + 8 * ql_); } } while (0)
#define SC_XFORM(cc_, buf_) do { \
            int s16_ = s16, q_ = q; asm volatile("" : "+v"(s16_), "+v"(q_));     \
            LAS unsigned char* bp = lds + (buf_) * SCB_SIZE; const int t_ = s16_; const bool odd_ = (s16_ & 1) != 0; \
            float ss = 0.f, bs = 0.f; LAS float* scr_ = (LAS float*)(lds + SC_SCR) + (pw * 4) * 256 + (q_ * 16 + s16_) * 4;     \
            _Pragma("unroll") for (int cb = 0; cb < 4; ++cb) { \
                f32x4 dw = __builtin_amdgcn_mfma_f32_16x16x32_bf16(*(const LAS bf16x8*)(stg + (16 * cb + s16_) * 64 + 8 * q_), __builtin_bit_cast(bf16x8, Bw[0]), (f32x4){0.f, 0.f, 0.f, 0.f}, 0, 0, 0); \
                dw = __builtin_amdgcn_mfma_f32_16x16x32_bf16(*(const LAS bf16x8*)(stg + (16 * cb + s16_) * 64 + 32 + 8 * q_), __builtin_bit_cast(bf16x8, Bw[1]), dw, 0, 0, 0); \
                f32x4 da = __builtin_amdgcn_mfma_f32_16x16x32_bf16(*(const LAS bf16x8*)(stg + 4096 + (16 * cb + s16_) * 64 + 8 * q_), __builtin_bit_cast(bf16x8, Ba[0]), (f32x4){0.f, 0.f, 0.f, 0.f}, 0, 0, 0); \
                da = __builtin_amdgcn_mfma_f32_16x16x32_bf16(*(const LAS bf16x8*)(stg + 4096 + (16 * cb + s16_) * 64 + 32 + 8 * q_), __builtin_bit_cast(bf16x8, Ba[1]), da, 0, 0, 0); \
                const f32x4 w0v = *(const LAS f32x4*)(cst + 16 * cb + 4 * q_), a0v = *(const LAS f32x4*)(cst + 64 + 16 * cb + 4 * q_); \
                const f32x4 kkw = *(const LAS f32x4*)(cst + 128 + 16 * cb + 4 * q_), kaw = *(const LAS f32x4*)(cst + 192 + 16 * cb + 4 * q_), rkw = *(const LAS f32x4*)(cst + 256 + 16 * cb + 4 * q_); \
                const float r4[4] = {bf_lo(rr[cb].x), bf_hi(rr[cb].x), bf_lo(rr[cb].y), bf_hi(rr[cb].y)}, k4[4] = {bf_lo(kr[cb].x), bf_hi(kr[cb].x), bf_lo(kr[cb].y), bf_hi(kr[cb].y)}; \
                f32x4 dec, azq, kzq; \
                _Pragma("unroll") for (int e = 0; e < 4; ++e) { \
                    const float sgw = __builtin_amdgcn_rcpf(1.0f + __builtin_amdgcn_exp2f(-1.4426950408889634f * (dw[e] + w0v[e])));     \
                    dec[e] = __builtin_amdgcn_exp2f(-0.8750387749f * sgw);                                                     \
                    const float az = __builtin_amdgcn_rcpf(1.0f + __builtin_amdgcn_exp2f(-1.4426950408889634f * (da[e] + a0v[e]))); azq[e] = az; \
                    { const float kk_ = k4[e] * kkw[e]; ss += kk_ * kk_; } kzq[e] = k4[e] * (1.0f + (az - 1.0f) * kaw[e]); bs += r4[e] * kzq[e] * rkw[e]; } \
                { const int o = t_ * SCP + (16 * cb + 4 * q_) * 4; \
                    *(LAS f32x4*)(scr_ + cb * 256) = azq; *(LAS f32x4*)(bp + SCB_BKZ + o) = kzq;     \
                    *(LAS f32x4*)(bp + SCB_W + o) = dec;                        \
                    *(LAS f32x4*)(bp + SCB_VV + o) = (f32x4){bf_lo(vr[cb].x), bf_hi(vr[cb].x), bf_lo(vr[cb].y), bf_hi(vr[cb].y)}; } } \
            ss += __shfl_xor(ss, 16); ss += __shfl_xor(ss, 32); bs += __shfl_xor(bs, 16); bs += __shfl_xor(bs, 32); \
            const float inv = __builtin_amdgcn_rsqf(fmaxf(ss, 1e-24f));     \
              \
            float s_bb = 0.f, s_kk = 0.f, c_g = 0.f, c_h = 0.f, c_br = 0.f, c_kr = 0.f; const bool pB_ = (s16_ & 2) != 0;     \
            f32x4 Ga = (f32x4){0.f, 0.f, 0.f, 0.f}, Gr = Ga;     \
            _Pragma("unroll") for (int cb = 0; cb < 4; ++cb) { float kn[4], bo[4], bq[4], kq[4]; \
                const float r4[4] = {bf_lo(rr[cb].x), bf_hi(rr[cb].x), bf_lo(rr[cb].y), bf_hi(rr[cb].y)}, k4[4] = {bf_lo(kr[cb].x), bf_hi(kr[cb].x), bf_lo(kr[cb].y), bf_hi(kr[cb].y)}; \
                const f32x4 kkw = *(const LAS f32x4*)(cst + 128 + 16 * cb + 4 * q_); \
                const f32x4 dcv = *(const LAS f32x4*)(bp + SCB_W + t_ * SCP + (16 * cb + 4 * q_) * 4), wp = *(const LAS f32x4*)(bp + SCB_W + (t_ ^ 1) * SCP + (16 * cb + 4 * q_) * 4);     \
                const f32x4 azq = *(const LAS f32x4*)(scr_ + cb * 256), kzq = *(const LAS f32x4*)(bp + SCB_BKZ + t_ * SCP + (16 * cb + 4 * q_) * 4); \
                _Pragma("unroll") for (int e = 0; e < 4; ++e) { kn[e] = k4[e] * kkw[e] * inv; bo[e] = kn[e] * azq[e]; \
                    bq[e] = dpp_g<0xB1>(bo[e]); kq[e] = dpp_g<0xB1>(kzq[e]); \
                    const float ao = -kn[e], rd = r4[e] * dcv[e]; \
                    s_bb += bo[e] * r4[e]; s_kk += kzq[e] * r4[e]; c_g += bq[e] * ao; c_h += kq[e] * ao; c_br += bq[e] * rd; c_kr += kq[e] * rd; } \
                float fb[4], fk[4], xa[4], xr[4], wq[4], sA[4], sB[4]; \
                _Pragma("unroll") for (int e = 0; e < 4; ++e) { const float wpr = dcv[e] * wp[e], wo = dpp_g<0x4E>(wpr);     \
                    const float mb = odd_ ? 1.0f : wp[e], ma = odd_ ? -wp[e] : -1.0f, mr = odd_ ? wpr : dcv[e]; \
                    fb[e] = bo[e] * mb; fk[e] = kzq[e] * mb; xa[e] = kn[e] * ma; xr[e] = r4[e] * mr; wq[e] = wpr * wo; sA[e] = pB_ ? 1.0f : wo; sB[e] = pB_ ? wo : 1.0f; \
                    const float fb0 = dpp_g<0x00>(fb[e]), fk0 = dpp_g<0x00>(fk[e]), fb1 = dpp_g<0x55>(fb[e]), fk1 = dpp_g<0x55>(fk[e]);     \
                    Ga[0] += fb0 * xa[e]; Ga[1] += fk0 * xa[e]; Ga[2] += fb1 * xa[e]; Ga[3] += fk1 * xa[e]; Gr[0] += fb0 * xr[e]; Gr[1] += fk0 * xr[e]; Gr[2] += fb1 * xr[e]; Gr[3] += fk1 * xr[e]; } \
                *(LAS f32x4*)(bp + SCB_W + t_ * SCP + (16 * cb + 4 * q_) * 4) = (f32x4){wq[0], wq[1], wq[2], wq[3]};            \
                *(LAS u32x4*)(bp + SCB_BKZ + t_ * SCP + (16 * cb + 4 * q_) * 4) = (u32x4){pack_bf16(fb[0] * sA[0], fk[0] * sA[0]), pack_bf16(fb[1] * sA[1], fk[1] * sA[1]), pack_bf16(fb[2] * sA[2], fk[2] * sA[2]), pack_bf16(fb[3] * sA[3], fk[3] * sA[3])};     \
                *(LAS u32x2*)(bp + SCB_AR + t_ * SCP + ((cb >> 1) * 4 + q_) * 16 + (cb & 1) * 8) = (u32x2){pack_bf16(xa[0] * sB[0], xa[1] * sB[1]), pack_bf16(xa[2] * sB[2], xa[3] * sB[3])};            \
                *(LAS u32x2*)(bp + SCB_AR + t_ * SCP + 128 + ((cb >> 1) * 4 + q_) * 16 + (cb & 1) * 8) = (u32x2){pack_bf16(xr[0] * sB[0], xr[1] * sB[1]), pack_bf16(xr[2] * sB[2], xr[3] * sB[3])}; }   \
            s_bb += __shfl_xor(s_bb, 16); s_bb += __shfl_xor(s_bb, 32); s_kk += __shfl_xor(s_kk, 16); s_kk += __shfl_xor(s_kk, 32); \
            c_g += __shfl_xor(c_g, 16); c_g += __shfl_xor(c_g, 32); c_h += __shfl_xor(c_h, 16); c_h += __shfl_xor(c_h, 32); \
            c_br += __shfl_xor(c_br, 16); c_br += __shfl_xor(c_br, 32); c_kr += __shfl_xor(c_kr, 16); c_kr += __shfl_xor(c_kr, 32); \
            _Pragma("unroll") for (int e = 0; e < 4; ++e) { Ga[e] += __shfl_xor(Ga[e], 16); Ga[e] += __shfl_xor(Ga[e], 32); Gr[e] += __shfl_xor(Gr[e], 16); Gr[e] += __shfl_xor(Gr[e], 32); } \
            if (q_ == 0) { LAS float* ps_ = (LAS float*)(lds + SC_PS + (buf_) * 512) + (t_ >> 1) * 8;     \
                if (odd_) { ps_[0] = c_g; ps_[1] = c_h; } \
                if (pB_) { LAS float* pq_ = (LAS float*)(lds + SC_PS + (buf_) * 512) + 64 + (t_ >> 2) * 16 + (odd_ ? 4 : 0); *(LAS f32x4*)pq_ = Ga; } \
                  \
                const float o0_ = odd_ ? c_br : s_bb, o1_ = odd_ ? c_kr : s_kk, o2_ = odd_ ? s_bb : 0.f, o3_ = odd_ ? s_kk : 0.f; \
                const unsigned ow0_ = pack_bf16(o0_, o1_), ow1_ = pack_bf16(o2_, o3_), gw0_ = pack_bf16(Gr[0], Gr[1]), gw1_ = pack_bf16(Gr[2], Gr[3]); \
                *(LAS u32x4*)(lds + SC_CY + (buf_) * 256 + (t_ >> 2) * 64 + (t_ & 3) * 16) = pB_ ? (u32x4){gw0_, gw1_, ow0_, ow1_} : (u32x4){ow0_, ow1_, 0u, 0u}; \
                BON[((size_t)z * T + SC_ROW((cc_) * SC_L + t_)) * 16 + hd] = bs; } } while (0)
#define SC_FLUSH(cc, slot_) do { const LAS float* yb_ = (const LAS float*)(lds + SC_Y + (slot_) * 4096); const int ft_ = lane >> 2, fj_ = (lane & 3) * 16;     \
            const f32x4 y0_ = *(const LAS f32x4*)(yb_ + ft_ * 64 + fj_), y1_ = *(const LAS f32x4*)(yb_ + ft_ * 64 + fj_ + 4), y2_ = *(const LAS f32x4*)(yb_ + ft_ * 64 + fj_ + 8), y3_ = *(const LAS f32x4*)(yb_ + ft_ * 64 + fj_ + 12); \
            bf16_t* yp_ = Y + ((size_t)z * T + SC_ROW((cc) * SC_L + ft_)) * D + hd * 64 + fj_; \
            *(u32x4*)yp_ = (u32x4){pack_bf16(y0_[0], y0_[1]), pack_bf16(y0_[2], y0_[3]), pack_bf16(y1_[0], y1_[1]), pack_bf16(y1_[2], y1_[3])}; \
            *(u32x4*)(yp_ + 8) = (u32x4){pack_bf16(y2_[0], y2_[1]), pack_bf16(y2_[2], y2_[3]), pack_bf16(y3_[0], y3_[1]), pack_bf16(y3_[2], y3_[3])}; } while (0)
            volatile LAS int* rdy = (volatile LAS int*)(lds + SC_FLG); volatile LAS int* prog = rdy + 8;
            SC_LOADC(pw);
            for (int n = pw; n < NCH; n += 4) {
                const int buf = n % SC_NB;
                if (n >= SC_NB) { lds_wait_ge(prog + 0, n - 4); lds_wait_ge(prog + 1, n - 4); lds_wait_ge(prog + 2, n - 4); lds_wait_ge(prog + 3, n - 4); SC_FLUSH(n - SC_NB, buf); }
                SC_XFORM(n, buf);
                asm volatile("s_waitcnt lgkmcnt(0)" ::: "memory");
                if (lane == 0) rdy[buf] = n + 1;
                if (n + 4 < NCH) SC_LOADC(n + 4);
            }
            for (int c = NCH - SC_NB; c < NCH; ++c) if (((c + SC_NB) & 3) == pw) {
                lds_wait_ge(prog + 0, c + 1); lds_wait_ge(prog + 1, c + 1); lds_wait_ge(prog + 2, c + 1); lds_wait_ge(prog + 3, c + 1); SC_FLUSH(c, c % SC_NB); }
#undef SC_ROW
#undef SC_LOADC
#undef SC_XFORM
#undef SC_FLUSH
        } else {
            const int w = F.wave, i16 = lane & 15, q = lane >> 4;
            f32x4 Sd[4];
#pragma unroll
            for (int k = 0; k < 4; ++k) Sd[k] = (f32x4){0.f, 0.f, 0.f, 0.f};
            const int m4 = i16 & 3;
            const int w_off = (4 * q) * 4, bkz_off = i16 * 4, vv_off = (16 * w + i16) * 4, ar_off = (m4 & 1) * SCP + (m4 >> 1) * 128 + q * 16;
            const bool qodd = (q & 1) != 0; const unsigned qmask = (q & 2) ? 0u : 0xffffffffu;
            const int bkq_off = (2 * (q & 1)) * SCP + i16 * 4;
            __builtin_amdgcn_s_setprio(3);
            typedef short s16x4v __attribute__((ext_vector_type(4)));
#define ST_LD(o_, Q_) do { _Pragma("unroll") for (int j = 0; j < 4; ++j) o_.vv[j] = *(const LAS float*)(bp + SCB_VV + (4 * (Q_) + j) * SCP + vv_off); \
        o_.a1lo = *(const LAS bf16x8*)(bp + SCB_AR + (4 * (Q_)) * SCP + ar_off); o_.a1hi = *(const LAS bf16x8*)(bp + SCB_AR + (4 * (Q_)) * SCP + 64 + ar_off); \
        o_.a2lo = *(const LAS bf16x8*)(bp + SCB_AR + (4 * (Q_) + 2) * SCP + ar_off); o_.a2hi = *(const LAS bf16x8*)(bp + SCB_AR + (4 * (Q_) + 2) * SCP + 64 + ar_off); } while (0)
#define ST_STEP(o_, Q_) do { \
        const bf16x8 Bd0 = __builtin_bit_cast(bf16x8, (u32x4){pack_bf16(Sd[0][0], Sd[0][1]), pack_bf16(Sd[0][2], Sd[0][3]), pack_bf16(Sd[1][0], Sd[1][1]), pack_bf16(Sd[1][2], Sd[1][3])}); \
        const bf16x8 Bd1 = __builtin_bit_cast(bf16x8, (u32x4){pack_bf16(Sd[2][0], Sd[2][1]), pack_bf16(Sd[2][2], Sd[2][3]), pack_bf16(Sd[3][0], Sd[3][1]), pack_bf16(Sd[3][2], Sd[3][3])}); \
        const f32x4 d1a = __builtin_amdgcn_mfma_f32_16x16x32_bf16(o_.a1lo, Bd0, (f32x4){0.f, 0.f, 0.f, 0.f}, 0, 0, 0); \
        const f32x4 e1a = __builtin_amdgcn_mfma_f32_16x16x32_bf16(o_.a2lo, Bd0, (f32x4){0.f, 0.f, 0.f, 0.f}, 0, 0, 0); \
        const f32x4 dd = __builtin_amdgcn_mfma_f32_16x16x32_bf16(o_.a1hi, Bd1, d1a, 0, 0, 0); \
        const f32x4 ee = __builtin_amdgcn_mfma_f32_16x16x32_bf16(o_.a2hi, Bd1, e1a, 0, 0, 0); \
        const LAS float* pa_ = psp + (2 * (Q_)) * 8; const LAS float* pg_ = psp + 64 + (Q_) * 16; \
        const f32x4 pA0 = *(const LAS f32x4*)pa_, pB0 = *(const LAS f32x4*)(pa_ + 8), g0 = *(const LAS f32x4*)pg_, g1 = *(const LAS f32x4*)(pg_ + 4); \
        const u32x2 cyw = *(const LAS u32x2*)(cyp + (Q_) * 64); \
        f32x4 wv[4]; u32x2 bk[4]; \
        _Pragma("unroll") for (int k = 0; k < 4; ++k) { wv[k] = *(const LAS f32x4*)(bp + SCB_W + (4 * (Q_)) * SCP + 64 * k + w_off); \
            bk[k] = (u32x2){*(const LAS unsigned*)(bkp + (4 * (Q_)) * SCP + 64 * k), *(const LAS unsigned*)(bkp + (4 * (Q_) + 1) * SCP + 64 * k)}; } \
        const float v1 = o_.vv[0], v2 = o_.vv[1], v3 = o_.vv[2], v4 = o_.vv[3]; \
        const float u1 = dd[0]; \
        const float u2 = dd[1] + u1 * pA0[0] + v1 * pA0[1]; \
        const float u3 = ee[0] + u1 * g0[0] + v1 * g0[1] + u2 * g0[2] + v2 * g0[3]; \
        const float u4 = ee[1] + u1 * g1[0] + v1 * g1[1] + u2 * g1[2] + v2 * g1[3] + u3 * pB0[0] + v3 * pB0[1]; \
        const float x0_ = qodd ? u3 : u1, x1_ = qodd ? v3 : v1, x2_ = qodd ? u4 : u2, x3_ = qodd ? v4 : v2;     \
        const unsigned b2lo = pack_bf16(x0_, x1_) & qmask, b2hi = pack_bf16(x2_, x3_) & qmask;     \
        const s16x4v B2 = __builtin_bit_cast(s16x4v, (u32x2){b2lo, b2hi}); \
        _Pragma("unroll") for (int k = 0; k < 4; ++k) Sd[k] = __builtin_amdgcn_mfma_f32_16x16x16bf16_1k(__builtin_bit_cast(s16x4v, bk[k]), B2, Sd[k] * wv[k], 0, 0, 0); \
        const f32x4 yv = __builtin_amdgcn_mfma_f32_16x16x16bf16_1k(__builtin_bit_cast(s16x4v, cyw), B2, (f32x4){dd[2], dd[3], ee[2], ee[3]}, 0, 0, 0);     \
        yb[(4 * (Q_)) * 64 + 16 * w + i16] = yv[0]; yb[(4 * (Q_) + 1) * 64 + 16 * w + i16] = yv[1]; yb[(4 * (Q_) + 2) * 64 + 16 * w + i16] = yv[2]; yb[(4 * (Q_) + 3) * 64 + 16 * w + i16] = yv[3]; } while (0)
            struct StepOps { float vv[4]; bf16x8 a1lo, a1hi, a2lo, a2hi; };
            volatile LAS int* rdy = (volatile LAS int*)(lds + SC_FLG); volatile LAS int* prog = rdy + 8;
            int buf = 0;
            for (int c = 0; c < NCH; ++c) {
                const LAS unsigned char* bp = lds + buf * SCB_SIZE; LAS float* yb = (LAS float*)(lds + SC_Y + buf * 4096);
                const LAS unsigned char* bkp = bp + SCB_BKZ + bkq_off;
                const LAS float* psp = (const LAS float*)(lds + SC_PS + buf * 512);
                const LAS unsigned char* cyp = lds + SC_CY + buf * 256 + (i16 & 3) * 16 + (q & 1) * 8;
                lds_wait_ge(rdy + buf, c + 1);
                const bool conv = (c & 3) == w; float tv[16]; const int tr = u * NCH + c, ttab = tr >> 14, trow = tr & 16383;
                int ln2 = lane; asm volatile("" : "+v"(ln2));
                if (conv) fp8_row_load(F.in[ttab ? 30 : 29] + (size_t)N_EXPERTS * 1024, trow, ln2, tv);
                else {
#pragma unroll
                    for (int i = 0; i < 16; ++i) tv[i] = 0.f; }
                StepOps oa, ob; ST_LD(oa, 0);
                ST_LD(ob, 1); ST_STEP(oa, 0);
                ST_LD(oa, 2); ST_STEP(ob, 1);
                ST_LD(ob, 3); ST_STEP(oa, 2);
                ST_STEP(ob, 3);
                asm volatile("s_waitcnt lgkmcnt(0)" ::: "memory");
                if (lane == 0) prog[w] = c + 1;
                if (conv) fp8_row_store(tv, trow, ln2, F.ws + (ttab ? WS_PV1 : WS_PU1), (float*)(F.ws + WS_PSC) + (2 + ttab) * N_EXPERTS);
                buf = (buf + 1 == SC_NB) ? 0 : buf + 1;
            }
#undef ST_LD
#undef ST_STEP
            __builtin_amdgcn_s_setprio(0);
            __builtin_amdgcn_s_setprio(0);
        }
    }
    __syncthreads();
}

DI void unpack8(const u32x4 w, float* o) { o[0] = bf_lo(w.x); o[1] = bf_hi(w.x); o[2] = bf_lo(w.y); o[3] = bf_hi(w.y); o[4] = bf_lo(w.z); o[5] = bf_hi(w.z); o[6] = bf_lo(w.w); o[7] = bf_hi(w.w); }
DI void p_rwkv_post(const Frame& F) {
    const bf16_t* RK = (const bf16_t*)(F.ws + WS1_RK); const bf16_t* Y = (const bf16_t*)(F.ws + WS1_Y); const float* BON = (const float*)(F.ws + WS1_BON);
    const bf16_t* G = (const bf16_t*)(F.ws + WS1_G); bf16_t* A3 = (bf16_t*)(F.ws + WS1_A3);
    const float* ln_g = F.in[24]; const float* ln_b = F.in[25];
    const int lane = F.lane, c0 = 16 * lane, hd = lane >> 2;
    for (int t = F.bid * NWAVES + F.wave; t < T; t += F.G * NWAVES) {
        float y[16], tmp[16], vv[16], gg[16];
        __builtin_amdgcn_s_setprio(2);
        unpack8(*(const u32x4*)(Y + (size_t)t * D + c0), y); unpack8(*(const u32x4*)(Y + (size_t)t * D + c0 + 8), y + 8);
        unpack8(*(const u32x4*)(Y + ((size_t)T + t) * D + c0), tmp); unpack8(*(const u32x4*)(Y + ((size_t)T + t) * D + c0 + 8), tmp + 8);
        unpack8(*(const u32x4*)(RK + (size_t)t * RW_N + 2048 + c0), vv); unpack8(*(const u32x4*)(RK + (size_t)t * RW_N + 2048 + c0 + 8), vv + 8);
        unpack8(*(const u32x4*)(G + (size_t)t * D + c0), gg); unpack8(*(const u32x4*)(G + (size_t)t * D + c0 + 8), gg + 8);
        const float bon = BON[(size_t)t * 16 + hd] + BON[((size_t)T + t) * 16 + hd];
        __builtin_amdgcn_s_setprio(0);
        float sm = 0.f;
#pragma unroll
        for (int e = 0; e < 16; ++e) { y[e] += tmp[e]; sm += y[e]; }
        sm += __shfl_xor(sm, 1); sm += __shfl_xor(sm, 2);
        const float mu = sm * (1.0f / 64.0f);
        float vr = 0.f;
#pragma unroll
        for (int e = 0; e < 16; ++e) { const float d = y[e] - mu; vr += d * d; }
        vr += __shfl_xor(vr, 1); vr += __shfl_xor(vr, 2);
        const float rs = rsqrtf(vr * (1.0f / 64.0f) + 64e-5f);
        float o[16];
#pragma unroll
        for (int q = 0; q < 4; ++q) { const f32x4 lg = *(const f32x4*)(ln_g + c0 + 4 * q), lb = *(const f32x4*)(ln_b + c0 + 4 * q);
#pragma unroll
            for (int e = 0; e < 4; ++e) { const int i = 4 * q + e; o[i] = ((y[i] - mu) * rs * lg[e] + lb[e] + bon * vv[i]) * gg[i]; } }
        u32x4 w0, w1; w0.x = pack_bf16(o[0], o[1]); w0.y = pack_bf16(o[2], o[3]); w0.z = pack_bf16(o[4], o[5]); w0.w = pack_bf16(o[6], o[7]);
        w1.x = pack_bf16(o[8], o[9]); w1.y = pack_bf16(o[10], o[11]); w1.z = pack_bf16(o[12], o[13]); w1.w = pack_bf16(o[14], o[15]);
        *(u32x4*)(A3 + (size_t)t * D + c0) = w0; *(u32x4*)(A3 + (size_t)t * D + c0 + 8) = w1;
    }
}
__global__ void __launch_bounds__(NTHREADS, 2) mega_fwd(Params P) {
    extern __shared__ __attribute__((aligned(16))) unsigned char lds_raw[];
    Frame F;
    F.lds = (LAS unsigned char*)lds_raw;
    F.tid = threadIdx.x; F.lane = F.tid & 63; F.wave = __builtin_amdgcn_readfirstlane(F.tid >> 6);
    F.G = gridDim.x; F.bid = blockIdx.x; F.in = P.in; F.out = P.out; F.ws = P.ws;
    volatile LAS unsigned* bst = (volatile LAS unsigned*)(F.lds + LDS_BAR_OFF);
    if (F.tid == 0) { bst[0] = 0u; bst[1] = 0u; bst[2] = 0u; bst[3] = 0u; }
    __syncthreads();
    XcdBarrier bar = xcd_barrier_post((unsigned*)(P.ws + WS_CTL), bst);
    const int lo = P.ph_lo, hi = P.ph_hi;
#ifdef ONLY_PHASE
#define IN(k) ((k) == ONLY_PHASE && lo <= (k) && (k) < hi)
#else
#define IN(k) (lo <= (k) && (k) < hi)
#endif
#define SEAM(k) do { if (IN(k) && IN((k) + 1)) xcd_barrier(bar); } while (0)
#define LSEAM(k) do { if (IN(k) && IN((k) + 1)) __syncthreads(); } while (0)
#define LAUNDER(T, dst, src) T dst; { unsigned long long _v = (unsigned long long)(src); unsigned _lo = (unsigned)_v, _hi = (unsigned)(_v >> 32); asm volatile("" : "+s"(_lo), "+s"(_hi)); dst = (T)(__attribute__((address_space(1))) unsigned char*)(((unsigned long long)_hi << 32) | _lo); }
#define PH_BEGIN LAUNDER(unsigned char*, ws, P.ws) LAUNDER(float*, outp, P.out) F.ws = ws; F.out = outp; \
    const float* mod0 = (const float*)(ws + WS_MOD); const float* mod1 = mod0 + 8 * 6144; const float* norm_g = P.in[4]; bf16_t* H = (bf16_t*)(ws + WS_H); bf16_t* H2 = (bf16_t*)(ws + WS1_H2); \
    (void)mod0; (void)mod1; (void)norm_g; (void)H; (void)H2;

    if (IN(0)) { PH_BEGIN p0_prologue(F); } SEAM(0);
    if (IN(1)) { PH_BEGIN p_norm<false>(F, P.in[0], norm_g + 0 * 1024, mod0, 0, 1024, H); } SEAM(1);
    if (IN(2)) { PH_BEGIN pg8::Gemm g{H, (const bf16_t*)(ws + WS_WIN_T), T, IN_W, 1024, 1024, 1024}; pg8::StaticOrder S; S.init(T, IN_W, F.G, F.bid);
        pg8::EpiBf16<0> E{(bf16_t*)(ws + WS_QKV), IN_W}; pg8::gemm_phase(F.lds, g, S, E);
        p0_late_weights(F, (T / 256) * (IN_W / 256)); } SEAM(2);
    if (IN(3)) { PH_BEGIN p_qkprep(F); } SEAM(3);
    if (IN(4)) { PH_BEGIN p_attention<3>(F); } SEAM(4);
    if (IN(5)) { PH_BEGIN pg8::Gemm g{(const bf16_t*)(ws + WS_O), (const bf16_t*)(ws + WS_WOUT_T), T, 1024, 1024, 1024, 1024}; pg8::StaticOrder S; S.init(T, 1024, F.G, F.bid);
        pg8::EpiResid<false> E{P.in[0], (bf16_t*)(ws + WS_XB), mod0 + 2048, (float*)(ws + WS_SSQ)}; pg8::gemm_phase(F.lds, g, S, E); } SEAM(5);
    if (IN(7)) { PH_BEGIN pg8::Gemm g{(const bf16_t*)(ws + WS_XB), (const bf16_t*)(ws + WS_WQS0), T, 2048, 1024, 1024, 1024}; pg8::BatchOrder S; S.init(T, 2048, F.G, F.bid);
        pg8::EpiQ E{(bf16_t*)(ws + WS_PQ), PQ_LD, (const float*)(ws + WS_SSQ), (const float*)(ws + WS_BQ), nullptr, -1}; { pg8::Unit u0; E.prep(F.lds, S.next(0, u0) ? u0.pm : -1, F.tid); } pg8::gemm_phase(F.lds, g, S, E); } SEAM(7);
    if (IN(8)) { PH_BEGIN p_peer_topk(F, (const bf16_t*)(ws + WS_PQ), (const bf16_t*)(ws + WS_SK), (int*)(ws + WS_EIDX), (float*)(ws + WS_GATE)); } LSEAM(8);
    if (IN(9)) { PH_BEGIN p_peer_gather<false>(F, norm_g + 1 * 1024, mod0, ws + WS_PU0, ws + WS_PV0, (const float*)(ws + WS_PSC), (const float*)(ws + WS_PSC) + N_EXPERTS, (const int*)(ws + WS_EIDX), (const float*)(ws + WS_GATE), mod0 + 5120, (bf16_t*)(ws + WS_XB), outp); } SEAM(9);
    if (IN(10)) { PH_BEGIN p_rwkv_prep(F, (const bf16_t*)(ws + WS_XB), norm_g + 2 * 1024, mod1, P.in[11], (bf16_t*)(ws + WS1_X6)); } SEAM(10);
    if (IN(11)) { PH_BEGIN pg8::Gemm g{(const bf16_t*)(ws + WS1_X6), (const bf16_t*)(ws + WS_WRW_T), 6 * T, RW_N, 1024, 1024, 1024}; pg8::RwOrder S; S.init(F.G, F.bid);
        pg8::EpiBf16<1> E{(bf16_t*)(ws + WS1_RK), RW_N}; pg8::gemm_phase(F.lds, g, S, E);
        p0_late_weights2(F); } SEAM(11);
    if (IN(12)) { PH_BEGIN pg8::Gemm g{(const bf16_t*)(ws + WS1_RK) + 3584, (const bf16_t*)(ws + WS_G2_T), T, 1024, 256, RW_N, 256}; pg8::StaticOrder S; S.init(T, 1024, F.G, F.bid);
        pg8::EpiBf16<0> E{(bf16_t*)(ws + WS1_G), 1024}; pg8::gemm_phase(F.lds, g, S, E); }
    if (IN(13)) { PH_BEGIN p_rwkv_scan(F); } SEAM(13);
    if (IN(14)) { PH_BEGIN p_rwkv_post(F); } SEAM(14);
    if (IN(15)) { PH_BEGIN pg8::Gemm g{(const bf16_t*)(ws + WS1_A3), (const bf16_t*)(ws + WS_WO_T), T, 1024, 1024, 1024, 1024}; pg8::StaticOrder S; S.init(T, 1024, F.G, F.bid);
        pg8::EpiResid<true> E{ws + WS_XB, (bf16_t*)(ws + WS_XB), mod1 + 2048, (float*)(ws + WS_SSQ)}; pg8::gemm_phase(F.lds, g, S, E); } SEAM(15);
    if (IN(17)) { PH_BEGIN pg8::Gemm g{(const bf16_t*)(ws + WS_XB), (const bf16_t*)(ws + WS1_WQS1), T, 2048, 1024, 1024, 1024}; pg8::BatchOrder S; S.init(T, 2048, F.G, F.bid);
        pg8::EpiQ E{(bf16_t*)(ws + WS1_PQ), PQ_LD, (const float*)(ws + WS_SSQ), (const float*)(ws + WS_BQ) + 8 * 2048, nullptr, -1}; { pg8::Unit u0; E.prep(F.lds, S.next(0, u0) ? u0.pm : -1, F.tid); } pg8::gemm_phase(F.lds, g, S, E); } SEAM(17);
    if (IN(18)) { PH_BEGIN p_peer_topk(F, (const bf16_t*)(ws + WS1_PQ), (const bf16_t*)(ws + WS_SK) + (size_t)16 * 128 * 128, (int*)(ws + WS1_EIDX), (float*)(ws + WS1_GATE)); } LSEAM(18);
    if (IN(19)) { PH_BEGIN p_peer_gather<true>(F, norm_g + 3 * 1024, mod1, ws + WS_PU1, ws + WS_PV1, (const float*)(ws + WS_PSC) + 2 * N_EXPERTS, (const float*)(ws + WS_PSC) + 3 * N_EXPERTS, (const int*)(ws + WS1_EIDX), (const float*)(ws + WS1_GATE), mod1 + 5120, (bf16_t*)(ws + WS_XB), outp); }
    if (hi <= 5) { const f32x4* s = (const f32x4*)P.in[0]; f32x4* d = (f32x4*)P.out;
        for (size_t i = (size_t)F.bid * NTHREADS + F.tid; i < (size_t)T * D / 4; i += (size_t)F.G * NTHREADS) d[i] = s[i]; }
#undef IN
#undef SEAM
#undef LSEAM
}

#ifndef PH_HI
#define PH_HI 20
#endif
extern "C" void kernel_launch(void* const* d_in, const int* in_sizes, int n_in, void* d_out, int out_size, void* d_ws, size_t ws_size, hipStream_t stream) {
    static int grid = 0;
    if (grid == 0) {
        if (n_in != 31 || out_size != T * D || ws_size < WS_END) { fprintf(stderr, "kernel_launch: unexpected shapes (n_in %d, out %d, ws %zu)\n", n_in, out_size, ws_size); grid = -1; return; }
        int dev = 0, cus = 0, per_cu = 0;
        if (hipGetDevice(&dev) != hipSuccess || hipDeviceGetAttribute(&cus, hipDeviceAttributeMultiprocessorCount, dev) != hipSuccess) { grid = -1; return; }
        if (hipFuncSetAttribute((const void*)mega_fwd, hipFuncAttributeMaxDynamicSharedMemorySize, LDS_BYTES) != hipSuccess) { fprintf(stderr, "kernel_launch: hipFuncSetAttribute failed\n"); grid = -1; return; }
        if (hipOccupancyMaxActiveBlocksPerMultiprocessor(&per_cu, (const void*)mega_fwd, NTHREADS, LDS_BYTES) != hipSuccess || per_cu < 1) { fprintf(stderr, "kernel_launch: occupancy query says %d\n", per_cu); (void)hipGetLastError(); grid = -1; return; }
        grid = cus;
    }
    if (grid < 0) return;
    (void)hipMemsetAsync((char*)d_ws + WS_CTL, 0, CTL_ZERO_BYTES, stream);
    Params p{};
    for (int i = 0; i < 31; ++i) p.in[i] = (const float*)d_in[i];
    p.out = (float*)d_out; p.ws = (unsigned char*)d_ws; p.ph_lo = 0; p.ph_hi = PH_HI;
    hipLaunchKernelGGL(mega_fwd, dim3(grid), dim3(NTHREADS), LDS_BYTES, stream, p);
}
```
